# Optimizing an MI355X kernel written in HIP

```python
import math
import jax, jax.numpy as jnp
from jax import lax
import numpy as np

D_MODEL = 1024
BATCH = 16
SEQ = 4096
DEPTH = 2

MEM_LEN = 256
Q_BLOCK = 128
NSA_Q_BLOCK = 32
N_BUCKETS = 32
MAX_DISTANCE = 128
RMS_EPS = 1e-6
ROPE_THETA = 10000.0
NEG_INF = -1e30
D_FF = 2816
A_HEADS = 8
A_KV = 2
A_GRP = A_HEADS // A_KV
A_DH = 64
CMP_LEN = 32
CMP_STRIDE = 16
SLC_LEN = 64
SLC_TOP = 16
WIN = 512
FORCE_BONUS = 1e3
B_HEADS = 8
B_DH = 64
IDX_HEADS = 8
IDX_DH = 32
IDX_TOPK_MAX = 256
C_HEADS = 8
C_Q_RANK = 256
C_KV_RANK = 128
C_DN = 64
C_DR = 32
C_DV = 64
D_HEADS = 4
D_DH = 64
D_DV = 128
X_HEADS = 4
X_DH = 128
N_BIAS_HEADS = A_HEADS + B_HEADS + D_HEADS

EV_SIZES = (A_HEADS * A_DH, 6 * A_KV * A_DH, 3 * A_HEADS,
            B_HEADS * B_DH, B_DH, B_DH, IDX_HEADS * IDX_DH, IDX_DH, IDX_HEADS)
EV_IN = sum(EV_SIZES)
EV_OUT = A_HEADS * A_DH + B_HEADS * B_DH
OD_SIZES = (C_Q_RANK, C_KV_RANK, C_DR, D_HEADS * 2 * D_DH, D_HEADS * 2 * D_DH, D_HEADS * D_DV)
OD_IN = sum(OD_SIZES)
OD_OUT = C_HEADS * C_DV + D_HEADS * D_DV

kernel_name = 'hybrid_nsa_dsa_mla_diff_macaron_block'


def rmsnorm(x, g):
    x32 = x.astype(jnp.float32)
    y = x32 * lax.rsqrt(jnp.mean(x32 * x32, axis=-1, keepdims=True) + RMS_EPS)
    return (y * g.astype(jnp.float32)).astype(x.dtype)


def swiglu(h, wg, wu, wd):
    return (jax.nn.silu(h @ wg) * (h @ wu)) @ wd


def split_cols(p, sizes):
    return jnp.split(p, [int(c) for c in np.cumsum(sizes)[:-1]], axis=-1)


def masked_softmax(logits, mask):
    p = jax.nn.softmax(jnp.where(mask, logits, NEG_INF), axis=-1)
    return p * mask


def rel_bucket(dist):
    max_exact = N_BUCKETS // 2
    d = jnp.maximum(dist, 0)
    log_ratio = jnp.log(jnp.maximum(d, 1).astype(jnp.float32) / max_exact) / math.log(MAX_DISTANCE / max_exact)
    large = jnp.minimum(max_exact + (log_ratio * (N_BUCKETS - max_exact)).astype(jnp.int32), N_BUCKETS - 1)
    return jnp.where(d < max_exact, d, large)


def rel_bias(dist, tab):
    b = tab.astype(jnp.float32)[rel_bucket(dist)]
    nh = tab.ndim - 1
    return jnp.moveaxis(b, tuple(range(dist.ndim, dist.ndim + nh)), tuple(range(nh)))


def rope(x):
    S = x.shape[1]
    half = x.shape[-1] // 2
    inv = ROPE_THETA ** (-jnp.arange(half, dtype=jnp.float32) / half)
    ang = jnp.arange(S, dtype=jnp.float32)[:, None] * inv[None, :]
    shape = (S,) + (1,) * (x.ndim - 3) + (half,)
    cos, sin = jnp.cos(ang).reshape(shape), jnp.sin(ang).reshape(shape)
    x1 = x[..., :half].astype(jnp.float32)
    x2 = x[..., half:].astype(jnp.float32)
    return jnp.concatenate([x1 * cos - x2 * sin, x1 * sin + x2 * cos], axis=-1).astype(x.dtype)


def blockwise(fn, blk, *q_side):
    B, S = q_side[0].shape[:2]
    n = S // blk
    xs = tuple(jnp.moveaxis(a.reshape((B, n, blk) + a.shape[2:]), 1, 0) for a in q_side)
    out = lax.map(lambda a: fn(a[0], *a[1:]), (jnp.arange(n, dtype=jnp.int32),) + xs)
    return jnp.moveaxis(out, 0, 1).reshape((B, S) + out.shape[3:])


def gather_rows(a, idx):
    return jax.vmap(lambda ai, ii: ai[ii])(a, idx)


def nsa_mixer(q, kv6, gate_logits, tab, cmp_pe, cmp_w):
    B, S = q.shape[:2]
    q = q.reshape(B, S, A_KV, A_GRP, A_DH)
    gate_logits = gate_logits.reshape(B, S, A_KV, A_GRP, 3)
    kv6 = kv6.reshape(B, S, 6, A_KV, A_DH)
    k_c, v_c, k_s, v_s, k_w, v_w = (kv6[:, :, i] for i in range(6))
    tab_g = tab.reshape(N_BUCKETS, A_KV, A_GRP)
    scale = A_DH ** -0.5
    n_cmp = (S - CMP_LEN) // CMP_STRIDE + 1
    cmp_start = jnp.arange(n_cmp) * CMP_STRIDE
    cmp_end = cmp_start + CMP_LEN - 1
    tok = cmp_start[:, None] + jnp.arange(CMP_LEN)[None, :]
    k_cmp = jnp.einsum('bnlgd,lde->bnge', k_c[:, tok] + cmp_pe[0][:, None, :], cmp_w[0])
    v_cmp = jnp.einsum('bnlgd,lde->bnge', v_c[:, tok] + cmp_pe[1][:, None, :], cmp_w[1])
    n_sb = S // SLC_LEN
    n_top = min(SLC_TOP, n_sb)
    sb_start = jnp.arange(n_sb) * SLC_LEN
    overlap = ((cmp_start[:, None] < sb_start[None, :] + SLC_LEN)
               & (cmp_end[:, None] >= sb_start[None, :])).astype(jnp.float32)
    k_sb = k_s.reshape(B, n_sb, SLC_LEN, A_KV, A_DH).transpose(0, 3, 1, 2, 4)
    v_sb = v_s.reshape(B, n_sb, SLC_LEN, A_KV, A_DH).transpose(0, 3, 1, 2, 4)
    k_wp = jnp.pad(k_w, ((0, 0), (WIN, 0), (0, 0), (0, 0)))
    v_wp = jnp.pad(v_w, ((0, 0), (WIN, 0), (0, 0), (0, 0)))
    blk_ids = jnp.arange(n_sb)
    g_ids = jnp.arange(A_KV)[:, None, None]

    def block(qi, qb, gb):
        T = qb.shape[1]
        t = qi * T + jnp.arange(T)
        s_c = (jnp.einsum('btgrd,bngd->bgrtn', qb, k_cmp).astype(jnp.float32) * scale
               + rel_bias(t[:, None] - cmp_end[None, :], tab_g))
        p_c = masked_softmax(s_c, cmp_end[None, :] <= t[:, None])
        o_c = jnp.einsum('bgrtn,bngd->btgrd', p_c.astype(v_cmp.dtype), v_cmp)
        imp = jnp.einsum('bgrtn,nj->bgtj', p_c, overlap)
        cur = (t // SLC_LEN)[:, None]
        forced = (blk_ids == 0) | (blk_ids == cur) | (blk_ids == cur - 1)
        score = jnp.where(blk_ids <= cur, imp + FORCE_BONUS * forced, NEG_INF)
        _, sel = lax.top_k(score, n_top)
        k_sel = jax.vmap(gather_rows)(k_sb, sel).reshape(B, A_KV, T, n_top * SLC_LEN, A_DH)
        v_sel = jax.vmap(gather_rows)(v_sb, sel).reshape(B, A_KV, T, n_top * SLC_LEN, A_DH)
        pos = (sel[..., None] * SLC_LEN + jnp.arange(SLC_LEN)).reshape(B, A_KV, T, n_top * SLC_LEN)
        dist = t[:, None] - pos
        bias_s = jnp.moveaxis(tab_g.astype(jnp.float32)[rel_bucket(dist), g_ids], -1, 2)
        s_s = jnp.einsum('btgrd,bgtkd->bgrtk', qb, k_sel).astype(jnp.float32) * scale + bias_s
        p_s = masked_softmax(s_s, (dist >= 0)[:, :, None])
        o_s = jnp.einsum('bgrtk,bgtkd->btgrd', p_s.astype(v_sel.dtype), v_sel)
        k_win = lax.dynamic_slice_in_dim(k_wp, qi * T, T + WIN, axis=1)
        v_win = lax.dynamic_slice_in_dim(v_wp, qi * T, T + WIN, axis=1)
        s_pos = qi * T - WIN + jnp.arange(T + WIN)
        dist_w = t[:, None] - s_pos[None, :]
        vis_w = (dist_w >= 0) & (dist_w < WIN) & (s_pos[None, :] >= 0)
        s_w = (jnp.einsum('btgrd,bsgd->bgrts', qb, k_win).astype(jnp.float32) * scale
               + rel_bias(dist_w, tab_g))
        p_w = masked_softmax(s_w, vis_w)
        o_w = jnp.einsum('bgrts,bsgd->btgrd', p_w.astype(v_win.dtype), v_win)
        g = jax.nn.sigmoid(gb.astype(jnp.float32))
        o = g[..., 0:1] * o_c + g[..., 1:2] * o_s + g[..., 2:3] * o_w
        return o.astype(qb.dtype)

    out = blockwise(block, NSA_Q_BLOCK, q, gate_logits)
    return out.reshape(B, S, A_HEADS * A_DH)


def dsa_mixer(q, k, v, iq, ik, iw, tab):
    B, S = q.shape[:2]
    k_top = min(IDX_TOPK_MAX, S // 4)
    q = q.reshape(B, S, B_HEADS, B_DH)
    iq = iq.reshape(B, S, IDX_HEADS, IDX_DH)
    scale = B_DH ** -0.5
    key_pos = jnp.arange(S)

    def block(qi, qb, iqb, iwb):
        T = qb.shape[1]
        t = qi * T + jnp.arange(T)
        idx_logit = jax.nn.relu(jnp.einsum('bthd,bsd->bths', iqb, ik).astype(jnp.float32))
        idx_score = jnp.einsum('bth,bths->bts', iwb.astype(jnp.float32), idx_logit)
        idx_score = jnp.where(key_pos[None, :] <= t[:, None], idx_score, NEG_INF)
        _, sel = lax.top_k(idx_score, k_top)
        k_sel = gather_rows(k, sel)
        v_sel = gather_rows(v, sel)
        dist = t[:, None] - sel
        s = (jnp.einsum('bthd,btkd->bhtk', qb, k_sel).astype(jnp.float32) * scale
             + jnp.moveaxis(tab.astype(jnp.float32)[rel_bucket(dist)], -1, 1))
        p = masked_softmax(s, (dist >= 0)[:, None])
        o = jnp.einsum('bhtk,btkd->bthd', p.astype(v_sel.dtype), v_sel)
        return o.reshape(B, T, B_HEADS * B_DH)

    return blockwise(block, Q_BLOCK, q, iq, iw)


def mla_mixer(c_q, c_kv, k_rope, q_norm, kv_norm, w_uq, w_ukv):
    B, S = c_q.shape[:2]
    q = (rmsnorm(c_q, q_norm) @ w_uq).reshape(B, S, C_HEADS, C_DN + C_DR)
    q_nope, q_rope = q[..., :C_DN], rope(q[..., C_DN:])
    kv = (rmsnorm(c_kv, kv_norm) @ w_ukv).reshape(B, S, C_HEADS, C_DN + C_DV)
    k_nope, v = kv[..., :C_DN], kv[..., C_DN:]
    k_r = rope(k_rope)
    scale = (C_DN + C_DR) ** -0.5
    key_pos = jnp.arange(S)

    def block(qi, qn, qr):
        T = qn.shape[1]
        t = qi * T + jnp.arange(T)
        s = (jnp.einsum('bthd,bshd->bhts', qn, k_nope)
             + jnp.einsum('bthd,bsd->bhts', qr, k_r)).astype(jnp.float32) * scale
        p = masked_softmax(s, key_pos[None, :] <= t[:, None])
        o = jnp.einsum('bhts,bshd->bthd', p.astype(v.dtype), v)
        return o.reshape(B, T, C_HEADS * C_DV)

    return blockwise(block, Q_BLOCK, q_nope, q_rope)


def diff_mixer(q, k, v, lam, subln, tab, lam_init):
    B, S = q.shape[:2]
    q = q.reshape(B, S, D_HEADS, 2, D_DH)
    k = k.reshape(B, S, D_HEADS, 2, D_DH)
    v = v.reshape(B, S, D_HEADS, D_DV)
    lam32 = lam.astype(jnp.float32)
    lam_full = jnp.exp(jnp.sum(lam32[0] * lam32[1])) - jnp.exp(jnp.sum(lam32[2] * lam32[3])) + lam_init
    scale = D_DH ** -0.5
    key_pos = jnp.arange(S)

    def block(qi, qb):
        T = qb.shape[1]
        t = qi * T + jnp.arange(T)
        dist = t[:, None] - key_pos[None, :]
        s = jnp.einsum('bthed,bshed->behts', qb, k).astype(jnp.float32) * scale + rel_bias(dist, tab)
        p = masked_softmax(s, dist >= 0)
        a = p[:, 0] - lam_full * p[:, 1]
        o = jnp.einsum('bhts,bshd->bthd', a.astype(v.dtype), v)
        o = rmsnorm(o, subln) * (1.0 - lam_init)
        return o.reshape(B, T, D_HEADS * D_DV)

    return blockwise(block, Q_BLOCK, q)


def mem_xattn(h, m, wq, wkv, wo):
    B, S = h.shape[:2]
    q = (h @ wq).reshape(B, S, X_HEADS, X_DH)
    kv = (m @ wkv).reshape(B, m.shape[1], 2, X_HEADS, X_DH)
    k, v = kv[:, :, 0], kv[:, :, 1]
    s = jnp.einsum('bshd,bmhd->bhsm', q, k).astype(jnp.float32) * X_DH ** -0.5
    p = jax.nn.softmax(s, axis=-1)
    o = jnp.einsum('bhsm,bmhd->bshd', p.astype(v.dtype), v)
    return o.reshape(B, S, X_HEADS * X_DH) @ wo


def even_mixer(h, w_in, w_out, cmp_pe, cmp_w, rel_tab):
    qa, kva, ga, qb, kb, vb, iq, ik, iw = split_cols(h @ w_in, EV_SIZES)
    o_a = nsa_mixer(qa, kva, ga, rel_tab[:, :A_HEADS], cmp_pe, cmp_w)
    o_b = dsa_mixer(qb, kb, vb, iq, ik, iw, rel_tab[:, A_HEADS:A_HEADS + B_HEADS])
    return jnp.concatenate([o_a, o_b], axis=-1) @ w_out


def odd_mixer(h, w_in, w_out, q_norm, kv_norm, w_uq, w_ukv, lam, subln, rel_tab, lam_init):
    c_q, c_kv, k_rope, qd, kd, vd = split_cols(h @ w_in, OD_SIZES)
    o_c = mla_mixer(c_q, c_kv, k_rope, q_norm, kv_norm, w_uq, w_ukv)
    o_d = diff_mixer(qd, kd, vd, lam, subln, rel_tab[:, A_HEADS + B_HEADS:], lam_init)
    return jnp.concatenate([o_c, o_d], axis=-1) @ w_out


def setup_inputs(seed: int = 0) -> dict:
    key = jax.random.key(seed)
    ks = jax.random.split(key, 24)
    n_even = (DEPTH + 1) // 2
    n_odd = DEPTH // 2
    f32 = jnp.float32

    def dense(k, shape, fan_in):
        return jax.random.normal(k, shape, f32) * fan_in ** -0.5

    def gain(k, shape):
        return 1.0 + 0.05 * jax.random.normal(k, shape, f32)

    return {
        'x': jax.random.normal(ks[0], (BATCH, SEQ, D_MODEL), f32),
        'mem': jax.random.normal(ks[1], (BATCH, MEM_LEN, D_MODEL), f32),
        'rel_bias_table': 0.2 * jax.random.normal(ks[2], (N_BUCKETS, N_BIAS_HEADS), f32),
        'norm_pre': gain(ks[3], (DEPTH, 4, D_MODEL)),
        'norm_post': gain(ks[4], (DEPTH, 4, D_MODEL)),
        'mem_norm': gain(ks[5], (DEPTH, D_MODEL)),
        'ffn_wg': dense(ks[6], (DEPTH, 2, D_MODEL, D_FF), D_MODEL),
        'ffn_wu': dense(ks[7], (DEPTH, 2, D_MODEL, D_FF), D_MODEL),
        'ffn_wd': dense(ks[8], (DEPTH, 2, D_FF, D_MODEL), D_FF),
        'ev_w_in': dense(ks[9], (n_even, D_MODEL, EV_IN), D_MODEL),
        'ev_cmp_pe': 0.5 * jax.random.normal(ks[10], (n_even, 2, CMP_LEN, A_DH), f32),
        'ev_cmp_w': dense(ks[11], (n_even, 2, CMP_LEN, A_DH, A_DH), CMP_LEN * A_DH),
        'ev_w_out': dense(ks[12], (n_even, EV_OUT, D_MODEL), EV_OUT),
        'od_w_in': dense(ks[13], (n_odd, D_MODEL, OD_IN), D_MODEL),
        'od_q_norm': gain(ks[14], (n_odd, C_Q_RANK)),
        'od_kv_norm': gain(ks[15], (n_odd, C_KV_RANK)),
        'od_w_uq': dense(ks[16], (n_odd, C_Q_RANK, C_HEADS * (C_DN + C_DR)), C_Q_RANK),
        'od_w_ukv': dense(ks[17], (n_odd, C_KV_RANK, C_HEADS * (C_DN + C_DV)), C_KV_RANK),
        'od_lambda': 0.1 * jax.random.normal(ks[18], (n_odd, 4, D_DH), f32),
        'od_subln': gain(ks[19], (n_odd, D_DV)),
        'od_w_out': dense(ks[20], (n_odd, OD_OUT, D_MODEL), OD_OUT),
        'xa_wq': dense(ks[21], (DEPTH, D_MODEL, X_HEADS * X_DH), D_MODEL),
        'xa_wkv': dense(ks[22], (DEPTH, D_MODEL, 2 * X_HEADS * X_DH), D_MODEL),
        'xa_wo': dense(ks[23], (DEPTH, X_HEADS * X_DH, D_MODEL), X_HEADS * X_DH),
    }


def reference(x, mem, rel_bias_table, norm_pre, norm_post, mem_norm, ffn_wg, ffn_wu, ffn_wd,
              ev_w_in, ev_cmp_pe, ev_cmp_w, ev_w_out, od_w_in, od_q_norm, od_kv_norm, od_w_uq,
              od_w_ukv, od_lambda, od_subln, od_w_out, xa_wq, xa_wkv, xa_wo):
    for i in range(DEPTH):
        g_pre, g_post = norm_pre[i], norm_post[i]
        h = rmsnorm(x, g_pre[0])
        x = x + 0.5 * rmsnorm(swiglu(h, ffn_wg[i, 0], ffn_wu[i, 0], ffn_wd[i, 0]), g_post[0])
        h = rmsnorm(x, g_pre[1])
        if i % 2 == 0:
            e = i // 2
            y = even_mixer(h, ev_w_in[e], ev_w_out[e], ev_cmp_pe[e], ev_cmp_w[e], rel_bias_table)
        else:
            o = i // 2
            lam_init = 0.8 - 0.6 * math.exp(-0.3 * i)
            y = odd_mixer(h, od_w_in[o], od_w_out[o], od_q_norm[o], od_kv_norm[o], od_w_uq[o],
                          od_w_ukv[o], od_lambda[o], od_subln[o], rel_bias_table, lam_init)
        x = x + rmsnorm(y, g_post[1])
        h = rmsnorm(x, g_pre[2])
        m = rmsnorm(mem, mem_norm[i])
        x = x + rmsnorm(mem_xattn(h, m, xa_wq[i], xa_wkv[i], xa_wo[i]), g_post[2])
        h = rmsnorm(x, g_pre[3])
        x = x + 0.5 * rmsnorm(swiglu(h, ffn_wg[i, 1], ffn_wu[i, 1], ffn_wd[i, 1]), g_post[3])
    return x
```

```cpp
#include <hip/hip_runtime.h>
#include <cstdio>
#include <cstdint>
namespace pg8 {
#define PG8_LAS __attribute__((address_space(3)))
typedef unsigned short bf16_t;
typedef short bf16x8 __attribute__((ext_vector_type(8)));
typedef float f32x4 __attribute__((ext_vector_type(4)));
typedef unsigned u32x4 __attribute__((ext_vector_type(4)));
constexpr int BM = 256, BK = 64, HALF = 128, HTB = HALF * BK * 2  , STAGE_BYTES = 8 * HTB, NXCD = 8, WGM = 8;

__host__ __device__ __forceinline__ int lds_byte(int r, int c) { const int st = (r >> 4) * 2 + (c >> 5), rr = r & 15, cc = c & 31, ob = rr * 64 + cc * 2; return st * 1024 + (ob ^ (((ob >> 9) & 1) << 5)); }
__host__ __device__ __forceinline__ void stage_rc(int b, int& R, int& C) { const int st = b / 1024, sb = b % 1024, swz = sb ^ (((sb >> 9) & 1) << 5); R = (st >> 1) * 16 + swz / 64; C = (st & 1) * 32 + (swz % 64) / 2; }
__host__ __device__ __forceinline__ int perm32(int rho) { const int n = rho >> 4, i = rho & 15; return 8 * (i >> 2) + 4 * n + (i & 3); }

struct Unit { int pm, pn; };
struct Gemm { const bf16_t* A; const bf16_t* Bt; int M, N, K; };
typedef int i32x4 __attribute__((ext_vector_type(4)));
typedef int i32x8 __attribute__((ext_vector_type(8)));
__device__ __forceinline__ i32x8 cat8(bf16x8 a, bf16x8 b) { const i32x4 x = __builtin_bit_cast(i32x4, a), y = __builtin_bit_cast(i32x4, b); return __builtin_shufflevector(x, y, 0, 1, 2, 3, 4, 5, 6, 7); }

struct StaticOrder {
    int nM, nN, nwg, G, c;
    __host__ __device__ void init(int M, int N, int G_, int c_) { nM = M / BM; nN = N / BM; nwg = nM * nN; G = G_; c = c_; }
    __host__ __device__ bool next(int i, Unit& u) const {
        const long L = (long)i * G + c; if (L >= nwg) return false;
        int wgid = (int)L; { const int q = nwg / NXCD, r = nwg % NXCD, xcd = wgid % NXCD, off = wgid / NXCD; wgid = (xcd < r ? xcd * (q + 1) : r * (q + 1) + (xcd - r) * q) + off; }
        const int nig = WGM * nN, gid = wgid / nig, fm = gid * WGM, gsz = (nM - fm) < WGM ? (nM - fm) : WGM;
        u.pm = fm + ((wgid % nig) % gsz); u.pn = (wgid % nig) / gsz; return true;
    }
    __device__ __forceinline__ void a_ready(const Unit&) const {}
    __device__ __forceinline__ void done(const Unit&) const {}
};


__device__ __forceinline__ unsigned cvt_pk_bf16(float lo, float hi) { unsigned r; asm volatile("v_cvt_pk_bf16_f32 %0, %1, %2" : "=v"(r) : "v"(lo), "v"(hi)); return r; }

struct EpiF32 {
    static constexpr bool PERM = false, AFTER_DRAIN = false;
    float* C; int ldc;
    __device__ __forceinline__ void operator()(const f32x4 (&acc)[2][2][4][2], const Unit& u, int wr, int wc, int fr, int fq) const {
        const int row0 = u.pm * BM + wr * 64 + fr, col0 = u.pn * BM + wc * 32 + 4 * fq;
#pragma unroll
        for (int ai = 0; ai < 2; ++ai)
#pragma unroll
            for (int m = 0; m < 4; ++m) { float* rowp = C + (size_t)(row0 + ai * HALF + m * 16) * ldc + col0;
#pragma unroll
                for (int bj = 0; bj < 2; ++bj)
#pragma unroll
                    for (int n = 0; n < 2; ++n) *(f32x4*)(rowp + bj * HALF + n * 16) = acc[ai][bj][m][n]; }
    }
};
struct EpiBf16P {
    static constexpr bool PERM = true, AFTER_DRAIN = false;
    bf16_t* O; int ldc;
    __device__ __forceinline__ void operator()(const f32x4 (&acc)[2][2][4][2], const Unit& u, int wr, int wc, int fr, int fq) const {
        const int row0 = u.pm * BM + wr * 64 + fr, col0 = u.pn * BM + wc * 32 + 8 * fq;
#pragma unroll
        for (int ai = 0; ai < 2; ++ai)
#pragma unroll
            for (int m = 0; m < 4; ++m) { bf16_t* rowp = O + (size_t)(row0 + ai * HALF + m * 16) * ldc + col0;
#pragma unroll
                for (int bj = 0; bj < 2; ++bj) { const f32x4 v0 = acc[ai][bj][m][0], v1 = acc[ai][bj][m][1];
                    u32x4 w; w.x = cvt_pk_bf16(v0[0], v0[1]); w.y = cvt_pk_bf16(v0[2], v0[3]); w.z = cvt_pk_bf16(v1[0], v1[1]); w.w = cvt_pk_bf16(v1[2], v1[3]);
                    *(u32x4*)(rowp + bj * HALF) = w; } }
    }
};
__device__ __forceinline__ float silu_mul(float g, float u) { return g * __builtin_amdgcn_rcpf(1.0f + __builtin_amdgcn_exp2f(g * -1.4426950408889634f)) * u; }
struct EpiSwiGLU {
    static constexpr bool PERM = true, AFTER_DRAIN = false;
    bf16_t* O; int ldc;
    __device__ __forceinline__ void operator()(const f32x4 (&acc)[2][2][4][2], const Unit& u, int wr, int wc, int fr, int fq) const {
        const int row0 = u.pm * BM + wr * 64 + fr, col0 = u.pn * HALF + wc * 32 + 8 * fq;
#pragma unroll
        for (int ai = 0; ai < 2; ++ai)
#pragma unroll
            for (int m = 0; m < 4; ++m) { bf16_t* rowp = O + (size_t)(row0 + ai * HALF + m * 16) * ldc + col0;
                const f32x4 g0 = acc[ai][0][m][0], g1 = acc[ai][0][m][1], u0 = acc[ai][1][m][0], u1 = acc[ai][1][m][1];
                u32x4 w; w.x = cvt_pk_bf16(silu_mul(g0[0], u0[0]), silu_mul(g0[1], u0[1])); w.y = cvt_pk_bf16(silu_mul(g0[2], u0[2]), silu_mul(g0[3], u0[3]));
                w.z = cvt_pk_bf16(silu_mul(g1[0], u1[0]), silu_mul(g1[1], u1[1])); w.w = cvt_pk_bf16(silu_mul(g1[2], u1[2]), silu_mul(g1[3], u1[3]));
                *(u32x4*)rowp = w; }
    }
};


__device__ __forceinline__ unsigned pk4_fp8(float a, float b, float c, float d, float S) {
    a = __builtin_amdgcn_fmed3f(a * S, -448.f, 448.f); b = __builtin_amdgcn_fmed3f(b * S, -448.f, 448.f); c = __builtin_amdgcn_fmed3f(c * S, -448.f, 448.f); d = __builtin_amdgcn_fmed3f(d * S, -448.f, 448.f);
    int p = __builtin_amdgcn_cvt_pk_fp8_f32(a, b, 0, false); p = __builtin_amdgcn_cvt_pk_fp8_f32(c, d, p, true); return (unsigned)p;
}
constexpr float F8S_H = 4.f, F8S_HID = 8.f, F8S_W = 64.f;
struct EpiSwiGLU8 {
    static constexpr bool PERM = true, AFTER_DRAIN = false;
    unsigned char* O; int ldc;
    __device__ __forceinline__ void operator()(const f32x4 (&acc)[2][2][4][2], const Unit& u, int wr, int wc, int fr, int fq) const {
        const int row0 = u.pm * BM + wr * 64 + fr, col0 = u.pn * HALF + wc * 32 + 8 * fq;
#pragma unroll
        for (int ai = 0; ai < 2; ++ai)
#pragma unroll
            for (int m = 0; m < 4; ++m) { unsigned char* rowp = O + (size_t)(row0 + ai * HALF + m * 16) * ldc + col0;
                const f32x4 g0 = acc[ai][0][m][0], g1 = acc[ai][0][m][1], u0 = acc[ai][1][m][0], u1 = acc[ai][1][m][1];
                constexpr float GS = 1.f / (F8S_W * F8S_H), C1 = -1.4426950408889634f * GS, C2 = GS * GS * F8S_HID;
                const f32x4 t0 = g0 * C1, t1 = g1 * C1;
                f32x4 e0, e1;
#pragma unroll
                for (int i = 0; i < 4; ++i) { e0[i] = __builtin_amdgcn_rcpf(1.0f + __builtin_amdgcn_exp2f(t0[i])); e1[i] = __builtin_amdgcn_rcpf(1.0f + __builtin_amdgcn_exp2f(t1[i])); }
                const f32x4 h0 = (g0 * e0) * (u0 * C2), h1 = (g1 * e1) * (u1 * C2);
                uint2 w; w.x = pk4_fp8(h0[0], h0[1], h0[2], h0[3], 1.f); w.y = pk4_fp8(h1[0], h1[1], h1[2], h1[3], 1.f);
                *(uint2*)rowp = w; }
    }
};
struct EpiBf16PS {
    static constexpr bool PERM = true, AFTER_DRAIN = false;
    bf16_t* O; int ldc; float sc;
    __device__ __forceinline__ void operator()(const f32x4 (&acc)[2][2][4][2], const Unit& u, int wr, int wc, int fr, int fq) const {
        const int row0 = u.pm * BM + wr * 64 + fr, col0 = u.pn * BM + wc * 32 + 8 * fq;
#pragma unroll
        for (int ai = 0; ai < 2; ++ai)
#pragma unroll
            for (int m = 0; m < 4; ++m) { bf16_t* rowp = O + (size_t)(row0 + ai * HALF + m * 16) * ldc + col0;
#pragma unroll
                for (int bj = 0; bj < 2; ++bj) { const f32x4 v0 = acc[ai][bj][m][0] * sc, v1 = acc[ai][bj][m][1] * sc;
                    u32x4 w; w.x = cvt_pk_bf16(v0[0], v0[1]); w.y = cvt_pk_bf16(v0[2], v0[3]); w.z = cvt_pk_bf16(v1[0], v1[1]); w.w = cvt_pk_bf16(v1[2], v1[3]);
                    *(u32x4*)(rowp + bj * HALF) = w; } }
    }
};
struct EpiBf16PR {
    static constexpr bool PERM = true, AFTER_DRAIN = false;
    bf16_t* O; int ldc; const float* R;
    __device__ __forceinline__ void operator()(const f32x4 (&acc)[2][2][4][2], const Unit& u, int wr, int wc, int fr, int fq) const {
        const int row0 = u.pm * BM + wr * 64 + fr, col0 = u.pn * BM + wc * 32 + 8 * fq;
        float rs[2][4];
#pragma unroll
        for (int ai = 0; ai < 2; ++ai)
#pragma unroll
            for (int m = 0; m < 4; ++m) rs[ai][m] = R[row0 + ai * HALF + m * 16];
#pragma unroll
        for (int ai = 0; ai < 2; ++ai)
#pragma unroll
            for (int m = 0; m < 4; ++m) { bf16_t* rowp = O + (size_t)(row0 + ai * HALF + m * 16) * ldc + col0;
#pragma unroll
                for (int bj = 0; bj < 2; ++bj) { const f32x4 v0 = acc[ai][bj][m][0] * rs[ai][m], v1 = acc[ai][bj][m][1] * rs[ai][m];
                    u32x4 w; w.x = cvt_pk_bf16(v0[0], v0[1]); w.y = cvt_pk_bf16(v0[2], v0[3]); w.z = cvt_pk_bf16(v1[0], v1[1]); w.w = cvt_pk_bf16(v1[2], v1[3]);
                    *(u32x4*)(rowp + bj * HALF) = w; } }
    }
};
struct EpiSwiGLUR {
    static constexpr bool PERM = true, AFTER_DRAIN = false;
    bf16_t* O; int ldc; const float* R;
    __device__ __forceinline__ void operator()(const f32x4 (&acc)[2][2][4][2], const Unit& u, int wr, int wc, int fr, int fq) const {
        const int row0 = u.pm * BM + wr * 64 + fr, col0 = u.pn * HALF + wc * 32 + 8 * fq;
        float rs[2][4];
#pragma unroll
        for (int ai = 0; ai < 2; ++ai)
#pragma unroll
            for (int m = 0; m < 4; ++m) rs[ai][m] = R[row0 + ai * HALF + m * 16];
#pragma unroll
        for (int ai = 0; ai < 2; ++ai)
#pragma unroll
            for (int m = 0; m < 4; ++m) { bf16_t* rowp = O + (size_t)(row0 + ai * HALF + m * 16) * ldc + col0;
                const f32x4 g0 = acc[ai][0][m][0] * rs[ai][m], g1 = acc[ai][0][m][1] * rs[ai][m], u0 = acc[ai][1][m][0] * rs[ai][m], u1 = acc[ai][1][m][1] * rs[ai][m];
                u32x4 w; w.x = cvt_pk_bf16(silu_mul(g0[0], u0[0]), silu_mul(g0[1], u0[1])); w.y = cvt_pk_bf16(silu_mul(g0[2], u0[2]), silu_mul(g0[3], u0[3]));
                w.z = cvt_pk_bf16(silu_mul(g1[0], u1[0]), silu_mul(g1[1], u1[1])); w.w = cvt_pk_bf16(silu_mul(g1[2], u1[2]), silu_mul(g1[3], u1[3]));
                *(u32x4*)rowp = w; }
    }
};
template <class Epi, class Sched, bool ALIGN_EPI = false, bool SP2 = false, bool F8 = false>
__device__ __forceinline__ void gemm_phase(PG8_LAS unsigned char* lds, const Gemm g, const Sched& S, const Epi& E, int tid_in) {
    int tid_l = tid_in; asm volatile("" : "+v"(tid_l));
    const int tid = tid_l, wid = __builtin_amdgcn_readfirstlane(tid >> 6), lane = tid & 63, wr = wid >> 2, wc = wid & 3, fr = lane & 15, fq = lane >> 4;
    const int K = F8 ? g.K / 2 : g.K, nt = K / BK;
    unsigned voffA[2], voffB[2];
#pragma unroll
    for (int i = 0; i < 2; ++i) { int R, C; stage_rc(tid * 16 + i * 8192, R, C); const int Rb = Epi::PERM ? ((R & ~31) + perm32(R & 31)) : R;
        voffA[i] = (unsigned)(R * K + C) * 2u; voffB[i] = (unsigned)(Rb * K + C) * 2u; }
    const size_t kstep = (size_t)(BK * 2);
    const size_t hstep = (size_t)HALF * K * 2;
    const size_t tstep = 2 * hstep;
    const unsigned ldsw = (unsigned)wid * 1024u;
    const int aoff = lds_byte(wr * 64 + fr, fq * 8), boff = lds_byte(wc * 32 + fr, fq * 8);
#define PG8_SA(b, h) (((b) * 2 + (h)) * HTB)
#define PG8_SB(b, h) ((4 + (b) * 2 + (h)) * HTB)
#define PG8_STAGE(bufoff, gbase, voff) do { const char* _gb = (const char*)(gbase); if constexpr (F8) asm volatile("" : "+s"(_gb));     \
        _Pragma("unroll") for (int _i = 0; _i < 2; ++_i) \
        __builtin_amdgcn_global_load_lds((const unsigned*)(_gb + (voff)[_i]), (PG8_LAS unsigned*)(lds + (bufoff) + ldsw + _i * 8192), 16, 0, 0); } while (0)
#define PG8_LDA(dst, b, h) do { _Pragma("unroll") for (int m = 0; m < 4; ++m) _Pragma("unroll") for (int k = 0; k < 2; ++k) dst[m][k] = *(const PG8_LAS bf16x8*)(lds + PG8_SA(b, h) + aoff + m * 2048 + k * 1024); } while (0)
#define PG8_LDB(dst, b, h) do { _Pragma("unroll") for (int n = 0; n < 2; ++n) _Pragma("unroll") for (int k = 0; k < 2; ++k) dst[n][k] = *(const PG8_LAS bf16x8*)(lds + PG8_SB(b, h) + boff + n * 2048 + k * 1024); } while (0)
#define PG8_MMA(ai, bj, At, Bt) do { __builtin_amdgcn_s_setprio(1); _Pragma("unroll") for (int m = 0; m < 4; ++m) _Pragma("unroll") for (int n = 0; n < 2; ++n) _Pragma("unroll") for (int k = 0; k < 2; ++k) \
        acc[ai][bj][m][n] = __builtin_amdgcn_mfma_f32_16x16x32_bf16(Bt[n][k], At[m][k], acc[ai][bj][m][n], 0, 0, 0); __builtin_amdgcn_s_setprio(0); } while (0)
#define PG8_MMA8(ai, bj, At, Bt) do { __builtin_amdgcn_s_setprio(1); _Pragma("unroll") for (int m = 0; m < 4; ++m) _Pragma("unroll") for (int n = 0; n < 2; ++n) \
        acc[ai][bj][m][n] = __builtin_amdgcn_mfma_scale_f32_16x16x128_f8f6f4(cat8(Bt[n][0], Bt[n][1]), cat8(At[m][0], At[m][1]), acc[ai][bj][m][n], 0, 0, 0, 0, 0, 0); __builtin_amdgcn_s_setprio(0); } while (0)
#define PG8_MM(ai, bj, At, Bt) do { if constexpr (F8) PG8_MMA8(ai, bj, At, Bt); else PG8_MMA(ai, bj, At, Bt); } while (0)
#define PG8_WAIT_V(n) asm volatile("s_waitcnt vmcnt(" #n ")" ::: "memory")
#define PG8_WAIT_L(n) asm volatile("s_waitcnt lgkmcnt(" #n ")" ::: "memory")
#define PG8_BAR __builtin_amdgcn_s_barrier()
#define PG8_SCHED __builtin_amdgcn_sched_barrier(0)
    Unit cur, nxt; int ui = 0;
    if (!S.next(0, cur)) return;
    f32x4 acc[2][2][4][2];
#pragma unroll
    for (int a = 0; a < 2; ++a)
#pragma unroll
        for (int b = 0; b < 2; ++b)
#pragma unroll
            for (int m = 0; m < 4; ++m)
#pragma unroll
                for (int n = 0; n < 2; ++n) acc[a][b][m][n] = (f32x4){0.f, 0.f, 0.f, 0.f};
    bf16x8 At[4][2], B0[2][2], B1[2][2];
    const char* cA = (const char*)g.A + (size_t)cur.pm * tstep; const char* cB = (const char*)g.Bt + (size_t)cur.pn * tstep;
    S.a_ready(cur);
    if constexpr (SP2) {
        PG8_STAGE(PG8_SB(0, 0), cB, voffB); PG8_STAGE(PG8_SB(0, 1), cB + hstep, voffB); PG8_STAGE(PG8_SA(0, 0), cA, voffA); PG8_STAGE(PG8_SA(0, 1), cA + hstep, voffA);
        if (wr == 1) PG8_BAR;
        PG8_WAIT_V(2); PG8_BAR;
        PG8_STAGE(PG8_SB(1, 0), cB + kstep, voffB); PG8_STAGE(PG8_SA(1, 0), cA + kstep, voffA); PG8_STAGE(PG8_SB(1, 1), cB + hstep + kstep, voffB);
        PG8_WAIT_V(6); PG8_BAR;
    } else {
        PG8_STAGE(PG8_SB(0, 0), cB, voffB); PG8_STAGE(PG8_SA(0, 0), cA, voffA); PG8_STAGE(PG8_SB(0, 1), cB + hstep, voffB); PG8_STAGE(PG8_SA(0, 1), cA + hstep, voffA);
        if (wr == 1) PG8_BAR;
        PG8_WAIT_V(4); PG8_BAR;
        PG8_STAGE(PG8_SB(1, 0), cB + kstep, voffB); PG8_STAGE(PG8_SA(1, 0), cA + kstep, voffA); PG8_STAGE(PG8_SB(1, 1), cB + hstep + kstep, voffB);
        PG8_WAIT_V(6); PG8_BAR;
    }
    for (;;) {
        const bool has_next = S.next(ui + 1, nxt);
        const char* nA = has_next ? (const char*)g.A + (size_t)nxt.pm * tstep : cA; const char* nB = has_next ? (const char*)g.Bt + (size_t)nxt.pn * tstep : cB;
#pragma unroll 1
        for (int t = 0; t < nt; t += 2) {
            const bool last = (t == nt - 2);
            const char* a1 = cA + (size_t)(t + 1) * kstep;
            const char* a2 = last ? nA : cA + (size_t)(t + 2) * kstep; const char* b2 = last ? nB : cB + (size_t)(t + 2) * kstep;
            const char* a3 = a2 + kstep; const char* b3 = b2 + kstep;
            if (last && has_next) S.a_ready(nxt);
            if constexpr (SP2) {
            PG8_LDB(B0, 0, 0); PG8_LDB(B1, 0, 1); PG8_SCHED; PG8_LDA(At, 0, 0); PG8_STAGE(PG8_SA(1, 1), a1 + hstep, voffA);
            PG8_WAIT_V(8); PG8_WAIT_L(0); PG8_BAR; PG8_MM(0, 0, At, B0); PG8_MM(0, 1, At, B1); PG8_BAR; PG8_SCHED;
            PG8_LDA(At, 0, 1); PG8_STAGE(PG8_SB(0, 0), b2, voffB); PG8_STAGE(PG8_SB(0, 1), b2 + hstep, voffB); PG8_STAGE(PG8_SA(0, 0), a2, voffA);
            PG8_WAIT_V(8); PG8_WAIT_L(0); PG8_BAR; PG8_MM(1, 0, At, B0); PG8_MM(1, 1, At, B1); PG8_BAR; PG8_SCHED;
            PG8_LDB(B0, 1, 0); PG8_LDB(B1, 1, 1); PG8_SCHED; PG8_LDA(At, 1, 0); PG8_STAGE(PG8_SA(0, 1), a2 + hstep, voffA);
            PG8_WAIT_V(8); PG8_WAIT_L(0); PG8_BAR; PG8_MM(0, 0, At, B0); PG8_MM(0, 1, At, B1); PG8_BAR; PG8_SCHED;
            PG8_LDA(At, 1, 1); PG8_STAGE(PG8_SB(1, 0), b3, voffB); PG8_STAGE(PG8_SB(1, 1), b3 + hstep, voffB); PG8_STAGE(PG8_SA(1, 0), a3, voffA);
            PG8_WAIT_V(8); PG8_WAIT_L(0); PG8_BAR; PG8_MM(1, 0, At, B0); PG8_MM(1, 1, At, B1); PG8_BAR; PG8_SCHED;
            } else {
            PG8_LDB(B0, 0, 0); PG8_SCHED; PG8_LDA(At, 0, 0); PG8_STAGE(PG8_SA(1, 1), a1 + hstep, voffA);
            PG8_WAIT_L(8); PG8_BAR; PG8_WAIT_L(0); PG8_MM(0, 0, At, B0); PG8_BAR; PG8_SCHED;
            PG8_LDB(B1, 0, 1); PG8_STAGE(PG8_SB(0, 0), b2, voffB);
            PG8_BAR; PG8_WAIT_L(0); PG8_MM(0, 1, At, B1); PG8_BAR;
            PG8_LDA(At, 0, 1); PG8_STAGE(PG8_SA(0, 0), a2, voffA);
            PG8_BAR; PG8_WAIT_L(0); PG8_MM(1, 0, At, B0); PG8_BAR; PG8_SCHED;
            PG8_STAGE(PG8_SB(0, 1), b2 + hstep, voffB);
            PG8_WAIT_V(6); PG8_BAR; PG8_MM(1, 1, At, B1); PG8_BAR;
            PG8_LDB(B0, 1, 0); PG8_SCHED; PG8_LDA(At, 1, 0); PG8_STAGE(PG8_SA(0, 1), a2 + hstep, voffA);
            PG8_WAIT_L(8); PG8_BAR; PG8_WAIT_L(0); PG8_MM(0, 0, At, B0); PG8_BAR; PG8_SCHED;
            PG8_LDB(B1, 1, 1); PG8_STAGE(PG8_SB(1, 0), b3, voffB);
            PG8_BAR; PG8_WAIT_L(0); PG8_MM(0, 1, At, B1); PG8_BAR;
            PG8_LDA(At, 1, 1); PG8_STAGE(PG8_SA(1, 0), a3, voffA);
            PG8_BAR; PG8_WAIT_L(0); PG8_MM(1, 0, At, B0); PG8_BAR; PG8_SCHED;
            PG8_STAGE(PG8_SB(1, 1), b3 + hstep, voffB);
            PG8_WAIT_V(6); PG8_BAR; PG8_MM(1, 1, At, B1); PG8_BAR;
            }
        }
        if constexpr (ALIGN_EPI) { if (wr == 0) PG8_BAR; }
        if constexpr (!Epi::AFTER_DRAIN) {
            if constexpr (F8) { int l2; asm volatile("v_mbcnt_lo_u32_b32 %0, -1, 0\n\tv_mbcnt_hi_u32_b32 %0, -1, %0" : "=v"(l2)); E(acc, cur, wr, wc, l2 & 15, l2 >> 4); }
            else E(acc, cur, wr, wc, fr, fq);
            S.done(cur); }
        if (!has_next) break;
#pragma unroll
        for (int a = 0; a < 2; ++a)
#pragma unroll
            for (int b = 0; b < 2; ++b)
#pragma unroll
                for (int m = 0; m < 4; ++m)
#pragma unroll
                    for (int n = 0; n < 2; ++n) acc[a][b][m][n] = (f32x4){0.f, 0.f, 0.f, 0.f};
        cur = nxt; cA = nA; cB = nB; ++ui;
        if constexpr (ALIGN_EPI) { if (wr == 1) PG8_BAR; }
    }
    PG8_WAIT_V(0);
    if constexpr (!ALIGN_EPI) { if (wr == 0) PG8_BAR; }
    PG8_BAR;
    if constexpr (Epi::AFTER_DRAIN) { E.fused(acc, cur, wr, wc, fr, fq, lds, wid, lane); S.done(cur); }
#undef PG8_SA
#undef PG8_SB
#undef PG8_STAGE
#undef PG8_LDA
#undef PG8_LDB
#undef PG8_MMA
#undef PG8_MMA8
#undef PG8_MM
#undef PG8_WAIT_V
#undef PG8_WAIT_L
#undef PG8_BAR
#undef PG8_SCHED
}
}

constexpr int DM = 1024, NB = 16, SEQ = 4096, MTOK = NB * SEQ, DFF = 2816, MEML = 256, MROWS = NB * MEML;
constexpr int EV_IN = 2240, EV_INP = 2304, OD_IN = 1952, OD_INP = 2048;
constexpr float RMS_EPS = 1e-6f;
constexpr int NWAVES = 8;

constexpr size_t MiB = 1u << 20;
constexpr size_t WS_CTL = 0, CTL_ZERO_BYTES = 1 * MiB;
constexpr size_t WS_WGU = 2 * MiB;
constexpr size_t WS_WD = 46 * MiB;
constexpr size_t WS_EVIN = 68 * MiB;
constexpr size_t WS_EVOUT = 73 * MiB;
constexpr size_t WS_ODIN = 75 * MiB;
constexpr size_t WS_ODOUT = 79 * MiB;
constexpr size_t WS_WUQ = 81 * MiB;
constexpr size_t WS_WUKV = 82 * MiB;
constexpr size_t WS_XWQ = 83 * MiB;
constexpr size_t WS_XWKV = 85 * MiB;
constexpr size_t WS_XWO = 89 * MiB;
constexpr size_t WS_MN = 92 * MiB;
constexpr size_t WS_KVM = 108 * MiB;
constexpr size_t WS_VMT = 124 * MiB;
constexpr size_t WS_H = 132 * MiB;
constexpr size_t WS_Y = 260 * MiB;
constexpr size_t WS_OV = 516 * MiB;
constexpr size_t WS_END = 1024 * MiB;
constexpr size_t WS_HID = WS_OV;
constexpr size_t WS_XQ = WS_OV;

constexpr int CW_BAR = 4096;
constexpr int RING_BYTES = 131072, LDSCTL_OFF = RING_BYTES, MISC_OFF = LDSCTL_OFF + 320, LDS_BYTES = 147456;

#define GAS __attribute__((address_space(1)))
#define LAS __attribute__((address_space(3)))
typedef unsigned short bf16;
typedef unsigned v4u __attribute__((ext_vector_type(4)));
typedef unsigned v2u __attribute__((ext_vector_type(2)));
typedef float f32x4 __attribute__((ext_vector_type(4)));
typedef short bf16x8 __attribute__((ext_vector_type(8)));
#define LDS_WAIT() asm volatile("s_waitcnt lgkmcnt(0)" ::: "memory")
#define VM_WAIT() asm volatile("s_waitcnt vmcnt(0)" ::: "memory")
__device__ __forceinline__ unsigned f2bf(float f) { unsigned u = __builtin_bit_cast(unsigned, f); return (u + 0x7fffu + ((u >> 16) & 1u)) >> 16; }
__device__ __forceinline__ unsigned pk2(float lo, float hi) { return f2bf(lo) | (f2bf(hi) << 16); }
__device__ __forceinline__ float bf2f(unsigned short b) { return __builtin_bit_cast(float, (unsigned)b << 16); }
template <int K> __device__ __forceinline__ unsigned lx_u(unsigned v) {
    if constexpr (K == 32) { auto rr = __builtin_amdgcn_permlane32_swap(v, v, false, false); return rr[0] ^ rr[1] ^ v; }
    else return (unsigned)__builtin_amdgcn_ds_swizzle((int)v, (K << 10) | 0x1f);
}
template <int K> __device__ __forceinline__ float lx_f(float v) { return __uint_as_float(lx_u<K>(__float_as_uint(v))); }
__device__ __forceinline__ float wave_sum(float v) {
    v += lx_f<1>(v); v += lx_f<2>(v); v += lx_f<4>(v); v += lx_f<8>(v); v += lx_f<16>(v); v += lx_f<32>(v);
    return v;
}
__device__ __forceinline__ float fmx(float a, float b) { return __builtin_elementwise_maximum(a, b); }
__device__ __forceinline__ float fmx3(float a, float b, float c) { return __builtin_elementwise_maximum(__builtin_elementwise_maximum(a, b), c); }
__device__ __forceinline__ float fmn(float a, float b) { return __builtin_elementwise_minimum(a, b); }

#define XB_TMO      128
#define XB_XCNT(j)  (256  + 64 * (j))
#define XB_XSUB(j)  (1280 + 64 * (j))
#define XB_XGEN(j)  (2304 + 64 * (j))
#define XB_TOP      3328
#define XB_TOPGEN   3392
#define XCD_BAR_WORDS 3456
#define XB_SPIN_CAP (1u << 18)

__device__ __forceinline__ unsigned xb_ld(unsigned* p)              { return __hip_atomic_load(p, __ATOMIC_RELAXED, __HIP_MEMORY_SCOPE_AGENT); }
__device__ __forceinline__ unsigned xb_add(unsigned* p, unsigned v) { return __hip_atomic_fetch_add(p, v, __ATOMIC_RELAXED, __HIP_MEMORY_SCOPE_AGENT); }
__device__ __forceinline__ unsigned xb_xcc_id() { return (unsigned)__builtin_amdgcn_s_getreg((3 << 11) | 20) & 0xFu; }
#define XB_SPIN(cond, bar) do { unsigned _sp = 0; while (cond) { __builtin_amdgcn_s_sleep(1); \
    if ((++_sp & 255u) == 0u) { if (xb_ld(&(bar)[XB_TMO])) break; if (_sp > XB_SPIN_CAP) { atomicAdd(&(bar)[XB_TMO], 1u); break; } } } } while (0)

struct XcdBarrier {
    unsigned* bar; unsigned x;
    unsigned w0;
    volatile LAS unsigned* st;
};

__device__ __forceinline__ XcdBarrier xcd_barrier_post(unsigned* bar, volatile LAS unsigned* st) {
    XcdBarrier b; b.bar = bar; b.x = xb_xcc_id(); b.st = st; b.w0 = (unsigned)__builtin_amdgcn_readfirstlane((threadIdx.x >> 6) == 0 ? 1 : 0);
    if (threadIdx.x == 0) (void)xb_add(&bar[XB_XCNT(b.x)], 1u);
    return b;
}
__device__ __forceinline__ void xcd_barrier_complete(unsigned* bar, unsigned x, unsigned& nloc, unsigned& nx) {
    const unsigned G = gridDim.x * gridDim.y * gridDim.z;
    unsigned sum, cnt, mine, sp = 0u;
    for (;;) {
        sum = 0u; cnt = 0u; mine = 0u;
#pragma unroll
        for (unsigned j = 0; j < 16; ++j) { const unsigned c = xb_ld(&bar[XB_XCNT(j)]); sum += c; cnt += (c > 0u) ? 1u : 0u; mine = (j == x) ? c : mine; }
        if (sum == G) break;
        __builtin_amdgcn_s_sleep(1);
        if ((++sp & 255u) == 0u) { if (xb_ld(&bar[XB_TMO])) break; if (sp > XB_SPIN_CAP) { atomicAdd(&bar[XB_TMO], 1u); break; } }
    }
    nloc = mine > 0u ? mine : 1u; nx = cnt > 0u ? cnt : 1u;
}

__device__ __forceinline__ void xcd_barrier(const XcdBarrier& b) {
    asm volatile("s_waitcnt vmcnt(0)" ::: "memory");
    __syncthreads();
    unsigned xb_lane; asm volatile("v_mbcnt_lo_u32_b32 %0, -1, 0\n\tv_mbcnt_hi_u32_b32 %0, -1, %0" : "=v"(xb_lane));
    if (b.w0 != 0u && xb_lane == 0u) {
        unsigned* bar = b.bar;
        __builtin_amdgcn_s_waitcnt(0);
        unsigned nloc = b.st[0], nx = b.st[1];
        if (nloc == 0u) { xcd_barrier_complete(bar, b.x, nloc, nx); b.st[0] = nloc; b.st[1] = nx; }
        const unsigned old = xb_add(&bar[XB_XSUB(b.x)], 1u);
        const unsigned gen = old / nloc;
        if (old + 1u == (gen + 1u) * nloc) {
            __builtin_amdgcn_fence(__ATOMIC_RELEASE, "agent");
            asm volatile("s_waitcnt vmcnt(0)" ::: "memory");
            const unsigned og = xb_add(&bar[XB_TOP], 1u);
            const unsigned tg = og / nx;
            if (og + 1u == (tg + 1u) * nx) xb_add(&bar[XB_TOPGEN], 1u);
            else XB_SPIN(xb_ld(&bar[XB_TOPGEN]) == tg, bar);
            __builtin_amdgcn_fence(__ATOMIC_ACQUIRE, "agent");
            xb_add(&bar[XB_XGEN(b.x)], 1u);
            asm volatile("s_waitcnt vmcnt(0)" ::: "memory");
        } else {
            XB_SPIN(xb_ld(&bar[XB_XGEN(b.x)]) == gen, bar);
            __builtin_amdgcn_fence(__ATOMIC_ACQUIRE, "agent");
            asm volatile("s_waitcnt vmcnt(0)" ::: "memory");
        }
    }
    __syncthreads();
}


#ifndef QK_G64
#define QK_G64 4
#endif
typedef float f32x16 __attribute__((ext_vector_type(16)));
typedef short s16x4 __attribute__((ext_vector_type(4)));
constexpr float NEGBIG = -1e30f, LOG2E = 1.4426950408889634f;
constexpr int KP128 = 272, KBUF_BYTES = 64 * KP128, VBUF_BYTES = 64 * KP128;
constexpr int AT_KBUF = 0, AT_VBUF = 2 * KBUF_BYTES, AT_BT = AT_VBUF + 2 * VBUF_BYTES, BT_STRIDE = 132, AT_WS = AT_BT + 20 * BT_STRIDE * 4, AT_WS_PER_WAVE = 4096;
static_assert(AT_WS + 8 * AT_WS_PER_WAVE <= RING_BYTES, "attention LDS map");
__device__ __forceinline__ int crow(int r, int hi) { return (r & 3) + 8 * (r >> 2) + 4 * hi; }
typedef float f32x2_t __attribute__((ext_vector_type(2))); typedef __bf16 bf16x2_t __attribute__((ext_vector_type(2)));
__device__ __forceinline__ unsigned cvtpk(float lo, float hi) { f32x2_t v = {lo, hi}; bf16x2_t b = __builtin_convertvector(v, bf16x2_t); return __builtin_bit_cast(unsigned, b); }
typedef float f32x8_t __attribute__((ext_vector_type(8)));
typedef float f32x2_t __attribute__((ext_vector_type(2)));
__device__ __forceinline__ float vsum32(const f32x16 (&s)[2]) {
    const f32x16 a = s[0] + s[1]; const f32x8_t b = a.lo + a.hi; const f32x4 c = b.lo + b.hi; const f32x2_t d = c.lo + c.hi; return d.x + d.y;
}
__device__ __forceinline__ float swapmax(float v) { auto rr = __builtin_amdgcn_permlane32_swap(__float_as_uint(v), __float_as_uint(v), false, false); return fmx(__uint_as_float(rr[0]), __uint_as_float(rr[1])); }
__device__ __forceinline__ float swapsum(float v) { auto rr = __builtin_amdgcn_permlane32_swap(__float_as_uint(v), __float_as_uint(v), false, false); return __uint_as_float(rr[0]) + __uint_as_float(rr[1]); }
__device__ __forceinline__ float swapget(float v) { return lx_f<32>(v); }

struct KVSrc {
    const bf16* ka; int kpa;
    const bf16* kb; int kpb;
    const bf16* v; int vp;
};
template <int DQK, int KA, int DV> struct Stage {
    static constexpr int CPR = DQK / 8, NKC = 64 * CPR, NKI = (NKC + 511) / 512, CPV = DV / 8, NVC = 64 * CPV, NVI = (NVC + 511) / 512, KP = DQK * 2 + 16, VP = DV * 2 + 16;
    v4u k[NKI]; v4u v[NVI];
    __device__ __forceinline__ void load(const KVSrc& s, int kt, int tid) {
#pragma unroll
        for (int i = 0; i < NKI; ++i) { const int c = tid + 512 * i; if (NKC % 512 == 0 || c < NKC) { const int row = c / CPR, cc = c % CPR;
            const bf16* p = (KA == DQK || cc < KA / 8) ? s.ka + (size_t)(64 * kt + row) * s.kpa + 8 * cc : s.kb + (size_t)(64 * kt + row) * s.kpb + 8 * (cc - KA / 8);
            k[i] = *(const GAS v4u*)p; } }
#pragma unroll
        for (int i = 0; i < NVI; ++i) { const int c = tid + 512 * i; if (NVC % 512 == 0 || c < NVC) { const int row = c / CPV, cc = c % CPV;
            v[i] = *(const GAS v4u*)(s.v + (size_t)(64 * kt + row) * s.vp + 8 * cc); } }
    }
    __device__ __forceinline__ void store(LAS unsigned char* lds, int buf, int tid) const {
#pragma unroll
        for (int i = 0; i < NKI; ++i) { const int c = tid + 512 * i; if (NKC % 512 == 0 || c < NKC) { const int row = c / CPR, cc = c % CPR;
            *(LAS v4u*)(lds + AT_KBUF + buf * KBUF_BYTES + row * KP + 16 * cc) = k[i]; } }
#pragma unroll
        for (int i = 0; i < NVI; ++i) { const int c = tid + 512 * i; if (NVC % 512 == 0 || c < NVC) { const int row = c / CPV, cc = c % CPV;
            *(LAS v4u*)(lds + AT_VBUF + buf * VBUF_BYTES + row * VP + 16 * cc) = v[i]; } }
    }
};
template <int DQK, int GR = 0> __device__ __forceinline__ void qk_tile(const LAS unsigned char* kbuf, const bf16x8 (&qf)[DQK / 16], f32x16 (&s)[2], int lane, const f32x16 c0 = (f32x16){}) {
    constexpr int KP = DQK * 2 + 16, ND = DQK / 16, G = GR ? GR : (ND == 4 ? QK_G64 : ND == 6 ? 3 : 4);
    const int r32 = lane & 31, hi = lane >> 5;
    s[0] = c0; s[1] = c0;
#pragma unroll
    for (int g = 0; g < ND / G; ++g) {
        bf16x8 kf[2][G];
#pragma unroll
        for (int d = 0; d < G; ++d)
#pragma unroll
            for (int st = 0; st < 2; ++st) kf[st][d] = *(const LAS bf16x8*)(kbuf + (32 * st + r32) * KP + 32 * (g * G + d) + 16 * hi);
        __builtin_amdgcn_sched_barrier(0);
#pragma unroll
        for (int d = 0; d < G; ++d)
#pragma unroll
            for (int st = 0; st < 2; ++st) s[st] = __builtin_amdgcn_mfma_f32_32x32x16_bf16(kf[st][d], qf[g * G + d], s[st], 0, 0, 0);
    }
}
__device__ __forceinline__ float softmax_tile(f32x16 (&s)[2], float& m, float& l) {
    float mx = NEGBIG;
#pragma unroll
    for (int r = 0; r < 16; ++r) mx = fmx3(mx, s[0][r], s[1][r]);
    mx = swapmax(mx);
    const float mn = fmx(m, mx), alpha = __builtin_amdgcn_exp2f(m - mn), ms = fmx(mn, -1e29f);
    m = mn; { const float nms = -ms; s[0] = s[0] + nms; s[1] = s[1] + nms; }
#pragma unroll
    for (int st = 0; st < 2; ++st)
#pragma unroll
        for (int r = 0; r < 16; ++r) s[st][r] = __builtin_amdgcn_exp2f(s[st][r]);
    const float rs = vsum32(s);
    l = l * alpha + rs;
    return alpha;
}
struct VFrag { bf16x8 f[2][4]; };
typedef short v4i16_t __attribute__((ext_vector_type(4)));
template <int VP> __device__ __forceinline__ void pv_load(const LAS unsigned char* vbuf, int dp, VFrag& v, int lane) {
    const int g = lane >> 4, q = (lane & 15) >> 2, p = lane & 3;
    const LAS unsigned char* base = vbuf + (4 * (g >> 1) + q) * VP + (16 * (g & 1) + 4 * p) * 2;
#pragma unroll
    for (int k = 0; k < 4; ++k)
#pragma unroll
        for (int d2 = 0; d2 < 2; ++d2) {
            const v4i16_t lo = __builtin_amdgcn_ds_read_tr16_b64_v4i16((LAS v4i16_t*)(base + (16 * k) * VP + 64 * (2 * dp + d2)));
            const v4i16_t hh = __builtin_amdgcn_ds_read_tr16_b64_v4i16((LAS v4i16_t*)(base + (16 * k + 8) * VP + 64 * (2 * dp + d2)));
            v.f[d2][k] = (bf16x8){lo[0], lo[1], lo[2], lo[3], hh[0], hh[1], hh[2], hh[3]}; }
}
__device__ __forceinline__ void p_pack(const f32x16 (&p)[2], bf16x8 (&pf)[4]) {
#pragma unroll
    for (int k = 0; k < 4; ++k) { const int st = k >> 1, s = k & 1; v4u w; w.x = cvtpk(p[st][8 * s + 0], p[st][8 * s + 1]); w.y = cvtpk(p[st][8 * s + 2], p[st][8 * s + 3]); w.z = cvtpk(p[st][8 * s + 4], p[st][8 * s + 5]); w.w = cvtpk(p[st][8 * s + 6], p[st][8 * s + 7]);
        pf[k] = __builtin_bit_cast(bf16x8, w); }
}
__device__ __forceinline__ void pv_mma(const VFrag& v, const bf16x8 (&pf)[4], f32x16& o0, f32x16& o1) {
#pragma unroll
    for (int k = 0; k < 4; ++k) { o0 = __builtin_amdgcn_mfma_f32_32x32x16_bf16(v.f[0][k], pf[k], o0, 0, 0, 0); o1 = __builtin_amdgcn_mfma_f32_32x32x16_bf16(v.f[1][k], pf[k], o1, 0, 0, 0); }
}
template <int DV> __device__ __forceinline__ void pv_tile(const LAS unsigned char* vbuf, const f32x16 (&p)[2], f32x16 (&o)[DV / 32], int lane) {
    bf16x8 pf[4]; p_pack(p, pf);
#pragma unroll
    for (int dp = 0; dp < DV / 64; ++dp) { VFrag v; pv_load<DV * 2 + 16>(vbuf, dp, v, lane); __builtin_amdgcn_sched_barrier(0); pv_mma(v, pf, o[2 * dp], o[2 * dp + 1]); }
}
constexpr float DEFER_THR = 8.0f;
struct SmState { float mhat, l; bool started; };
template <int DQK, int DV, class F, bool EARLYV>
__device__ __forceinline__ void attn_tile(LAS unsigned char* lds, int buf, int kt, const bf16x8 (&qf)[DQK / 16], F& f, f32x16 (&o)[DV / 32], SmState& S, f32x16& negm, int lane) {
    f32x16 s[2];
    qk_tile<DQK>(lds + AT_KBUF + buf * KBUF_BYTES, qf, s, lane, negm);
    const LAS unsigned char* vbuf = lds + AT_VBUF + buf * VBUF_BYTES;
    VFrag vfr;
    if constexpr (DV == 64 && EARLYV) { pv_load<DV * 2 + 16>(vbuf, 0, vfr, lane); __builtin_amdgcn_sched_barrier(0); }
    f.apply(s, kt);
    float mx = NEGBIG;
#pragma unroll
    for (int r = 0; r < 16; ++r) mx = fmx3(mx, s[0][r], s[1][r]);
    mx = swapmax(mx);
    const bool need = S.started ? (mx > DEFER_THR) : (mx > -1e29f);
    if (__any(need)) {
        const float delta = need ? mx : 0.f, fac = (need && S.started) ? __builtin_amdgcn_exp2f(-delta) : 1.f;
        S.mhat += delta; S.l *= fac; S.started = S.started || need;
#pragma unroll
        for (int st = 0; st < 2; ++st)
#pragma unroll
            for (int r = 0; r < 16; ++r) s[st][r] -= delta;
#pragma unroll
        for (int dt = 0; dt < DV / 32; ++dt) o[dt] = o[dt] * fac;
#pragma unroll
        for (int r = 0; r < 16; ++r) negm[r] = -S.mhat;
    }
#pragma unroll
    for (int st = 0; st < 2; ++st)
#pragma unroll
        for (int r = 0; r < 16; ++r) s[st][r] = __builtin_amdgcn_exp2f(s[st][r]);
    S.l += vsum32(s);
    bf16x8 pf[4]; p_pack(s, pf);
#pragma unroll
    for (int dp = 0; dp < DV / 64; ++dp) {
        if constexpr (!(DV == 64 && EARLYV)) { pv_load<DV * 2 + 16>(vbuf, dp, vfr, lane); __builtin_amdgcn_sched_barrier(0); }
        pv_mma(vfr, pf, o[2 * dp], o[2 * dp + 1]);
    }
}
template <int DQK, int KA, int DV, class F, bool EARLYV = true, bool DEEP = false>
__device__ __forceinline__ void attn_loop(LAS unsigned char* lds, const KVSrc& kv, int kt0, int kt1, const bf16x8 (&qf)[DQK / 16], F& f, f32x16 (&o)[DV / 32], SmState& S, int tid, int lane) {
    if (kt0 >= kt1) return;
    Stage<DQK, KA, DV> sg0;
    __syncthreads();
    sg0.load(kv, kt0, tid); sg0.store(lds, 0, tid);
    f32x16 negm;
#pragma unroll
    for (int r = 0; r < 16; ++r) negm[r] = -S.mhat;
    if constexpr (DEEP) {
        Stage<DQK, KA, DV> sg1;
        if (kt0 + 1 < kt1) sg1.load(kv, kt0 + 1, tid);
        __syncthreads();
        for (int kt = kt0; kt < kt1; kt += 2) {
            if (kt + 2 < kt1) { sg0.load(kv, kt + 2, tid); f.pre(kt + 2); }
            if (!f.skip(kt)) attn_tile<DQK, DV, F, EARLYV>(lds, 0, kt, qf, f, o, S, negm, lane);
            if (kt + 1 < kt1) sg1.store(lds, 1, tid);
            __syncthreads();
            if (kt + 1 < kt1) {
                if (kt + 3 < kt1) { sg1.load(kv, kt + 3, tid); f.pre(kt + 3); }
                if (!f.skip(kt + 1)) attn_tile<DQK, DV, F, EARLYV>(lds, 1, kt + 1, qf, f, o, S, negm, lane);
                if (kt + 2 < kt1) sg0.store(lds, 0, tid);
                __syncthreads();
            }
        }
    } else {
        __syncthreads();
        for (int kt = kt0; kt < kt1; ++kt) {
            const int buf = (kt - kt0) & 1;
            if (kt + 1 < kt1) { sg0.load(kv, kt + 1, tid); f.pre(kt + 1); }
            if (!f.skip(kt)) attn_tile<DQK, DV, F, EARLYV>(lds, buf, kt, qf, f, o, S, negm, lane);
            if (kt + 1 < kt1) sg0.store(lds, buf ^ 1, tid);
            __syncthreads();
        }
    }
}
__device__ __forceinline__ void build_bias_tables(LAS unsigned char* lds, const float* tab, int tid) {
    LAS float* BT = (LAS float*)(lds + AT_BT);
    for (int i = tid; i < 20 * 129; i += NWAVES * 64) { const int h = i / 129, d = i % 129;
        int b = d; if (d >= 16) { b = 16 + (int)(__log2f((float)d * 0.0625f) * (16.0f / 3.0f)); b = b > 31 ? 31 : b; }
        BT[h * BT_STRIDE + d] = (tab[b * 20 + h] - tab[31 * 20 + h]) * LOG2E; }
}
template <int DV> __device__ __forceinline__ void store_ot(bf16* orow, const f32x16 (&o)[DV / 32], float scale, int lane) {
    const int hi = lane >> 5;
#pragma unroll
    for (int dt = 0; dt < DV / 32; ++dt)
#pragma unroll
        for (int r4 = 0; r4 < 4; ++r4) { v2u w; w.x = cvtpk(o[dt][4 * r4 + 0] * scale, o[dt][4 * r4 + 1] * scale); w.y = cvtpk(o[dt][4 * r4 + 2] * scale, o[dt][4 * r4 + 3] * scale);
            *(GAS v2u*)(orow + 32 * dt + 8 * r4 + 4 * hi) = w; }
}
template <int DQK> __device__ __forceinline__ void load_q(const bf16* qrow, bf16x8 (&qf)[DQK / 16], int lane) {
    const int hi = lane >> 5;
#pragma unroll
    for (int d0 = 0; d0 < DQK / 16; ++d0) qf[d0] = *(const GAS bf16x8*)(qrow + 16 * d0 + 8 * hi);
}
__device__ __forceinline__ bf16x8 scale_frag(bf16x8 a, float sc) {
    v4u w;
    w.x = cvtpk(bf2f((unsigned short)a[0]) * sc, bf2f((unsigned short)a[1]) * sc); w.y = cvtpk(bf2f((unsigned short)a[2]) * sc, bf2f((unsigned short)a[3]) * sc);
    w.z = cvtpk(bf2f((unsigned short)a[4]) * sc, bf2f((unsigned short)a[5]) * sc); w.w = cvtpk(bf2f((unsigned short)a[6]) * sc, bf2f((unsigned short)a[7]) * sc);
    return __builtin_bit_cast(bf16x8, w);
}
template <int DQK> __device__ __forceinline__ void load_q_scaled(const bf16* qrow, bf16x8 (&qf)[DQK / 16], float sc, int lane) {
    load_q<DQK>(qrow, qf, lane);
#pragma unroll
    for (int d0 = 0; d0 < DQK / 16; ++d0) qf[d0] = scale_frag(qf[d0], sc);
}

struct FPlain { __device__ __forceinline__ void pre(int) {} __device__ __forceinline__ bool skip(int) const { return false; }
    __device__ __forceinline__ void apply(f32x16 (&)[2], int) {} };
__device__ __forceinline__ void xattn_unit(LAS unsigned char* lds, const bf16* XQ, const bf16* KVM, bf16* O, int b, int h, int qt, int tid_in, int lane_in, int wave) {
    int lane = lane_in; asm volatile("" : "+v"(lane)); const int tid = wave * 64 + lane; (void)tid_in;
    const int t = qt * 256 + wave * 32 + (lane & 31);
    bf16x8 qf[8]; load_q_scaled<128>(XQ + (size_t)(b * SEQ + t) * 512 + h * 128, qf, 0.08838834764831845f * LOG2E, lane);
    KVSrc kv{KVM + (size_t)(b * MEML) * DM + h * 128, DM, nullptr, 0, KVM + (size_t)(b * MEML) * DM + 512 + h * 128, DM};
    f32x16 o[4] = {}; SmState S{0.f, 0.f, false};
    FPlain f;
    attn_loop<128, 128, 128, FPlain>(lds, kv, 0, MEML / 64, qf, f, o, S, tid, lane);
    const float lt = swapsum(S.l);
    store_ot<128>(O + (size_t)(b * SEQ + t) * 512 + h * 128, o, lt > 0.f ? 1.f / lt : 0.f, lane);
}


constexpr int C_QA = 0, C_KVA = 512, C_GA = 1280, C_QB = 1304, C_KB = 1816, C_VB = 1880, C_IQ = 1944, C_IK = 2200, C_IW = 2232;
constexpr size_t WS_CWT = 91 * MiB;
constexpr size_t WS_CBIAS = 91 * MiB + 512 * 1024;
constexpr size_t WS_P0 = WS_OV, WS_KCMP = WS_OV + 288 * MiB, WS_VCMP = WS_OV + 289 * MiB, WS_SEL = WS_OV + 330 * MiB;
static_assert(WS_SEL + 32 * MiB <= WS_END, "even overlay");

__device__ __forceinline__ void nsa_compress_item(const bf16* P0, const bf16* CWT, const float* CBIAS, bf16* KCMP, bf16* VCMP, int item, int lane) {
    const int nt = item & 7, g = (item >> 3) & 1, b = (item >> 4) & 15, c = item >> 8;
    const int r32 = lane & 31, hi = lane >> 5, n = nt * 32 + r32, nc = n > 254 ? 254 : n;
    const bf16* ap = P0 + (size_t)(b * SEQ + 16 * nc) * EV_INP + C_KVA + c * 128 + g * 64 + 8 * hi;
    const bf16* bp = CWT + (size_t)(c * 64 + r32) * 2048 + 8 * hi;
    f32x16 acc[2] = {};
#pragma unroll 4
    for (int kk = 0; kk < 128; ++kk) {
        const bf16x8 a = *(const GAS bf16x8*)(ap + (size_t)(kk >> 2) * EV_INP + (kk & 3) * 16);
        const bf16x8 b0 = *(const GAS bf16x8*)(bp + kk * 16), b1 = *(const GAS bf16x8*)(bp + 32 * 2048 + kk * 16);
        acc[0] = __builtin_amdgcn_mfma_f32_32x32x16_bf16(a, b0, acc[0], 0, 0, 0);
        acc[1] = __builtin_amdgcn_mfma_f32_32x32x16_bf16(a, b1, acc[1], 0, 0, 0);
    }
#pragma unroll
    for (int eh = 0; eh < 2; ++eh) { const int e = 32 * eh + r32; const float bias = CBIAS[c * 64 + e];
        bf16* dst = c == 0 ? KCMP : VCMP;
#pragma unroll
        for (int r = 0; r < 16; ++r) { const int nn = nt * 32 + crow(r, hi); dst[((size_t)(b * 2 + g) * 256 + nn) * 64 + e] = (bf16)(nn > 254 ? 0u : f2bf(acc[eh][r] + bias)); }
    }
}

__device__ __forceinline__ void nsa_compress_pair(LAS unsigned char* lds, const bf16* P0, const bf16* CWT, const float* CBIAS, bf16* KCMP, bf16* VCMP, int it0, int wave, int lane) {
    const int item = it0 + (wave >> 2), ks = wave & 3; const bool live = item < 512;
    const int nt = item & 7, g = (item >> 3) & 1, b = (item >> 4) & 15, c = (item >> 8) & 1;
    const int r32 = lane & 31, hi = lane >> 5, n = nt * 32 + r32, nc = n > 254 ? 254 : n;
    const bf16* ap = P0 + (size_t)(b * SEQ + 16 * nc) * EV_INP + C_KVA + c * 128 + g * 64 + 8 * hi;
    const bf16* bp = CWT + (size_t)(c * 64 + r32) * 2048 + 8 * hi;
    f32x16 acc[2] = {};
    if (live) {
#pragma unroll 8
        for (int kk = 32 * ks; kk < 32 * ks + 32; ++kk) {
            const bf16x8 a = *(const GAS bf16x8*)(ap + (size_t)(kk >> 2) * EV_INP + (kk & 3) * 16);
            const bf16x8 b0 = *(const GAS bf16x8*)(bp + kk * 16), b1 = *(const GAS bf16x8*)(bp + 32 * 2048 + kk * 16);
            acc[0] = __builtin_amdgcn_mfma_f32_32x32x16_bf16(a, b0, acc[0], 0, 0, 0);
            acc[1] = __builtin_amdgcn_mfma_f32_32x32x16_bf16(a, b1, acc[1], 0, 0, 0);
        }
    }
    LAS float* red = (LAS float*)lds + (wave >> 2) * 3 * 2048 + lane;
    if (ks) {
#pragma unroll
        for (int eh = 0; eh < 2; ++eh)
#pragma unroll
            for (int r = 0; r < 16; ++r) red[(ks - 1) * 2048 + (eh * 16 + r) * 64] = acc[eh][r];
    }
    __syncthreads();
    if (!ks && live) {
#pragma unroll
        for (int j = 0; j < 3; ++j)
#pragma unroll
            for (int eh = 0; eh < 2; ++eh)
#pragma unroll
                for (int r = 0; r < 16; ++r) acc[eh][r] += red[j * 2048 + (eh * 16 + r) * 64];
#pragma unroll
        for (int eh = 0; eh < 2; ++eh) { const int e = 32 * eh + r32; const float bias = CBIAS[c * 64 + e];
            bf16* dst = c == 0 ? KCMP : VCMP;
#pragma unroll
            for (int r = 0; r < 16; ++r) { const int nn = nt * 32 + crow(r, hi); dst[((size_t)(b * 2 + g) * 256 + nn) * 64 + e] = (bf16)(nn > 254 ? 0u : f2bf(acc[eh][r] + bias)); }
        }
    }
    __syncthreads();
}

constexpr int IX_MASK = 0, IX_RED = 8192, IX_CNT = IX_RED + 1024, IX_NC = IX_CNT + 1024, IX_CAND = IX_NC + 64, IX_THR = IX_CAND + 8192, IX_LIST = IX_THR + 128;
__device__ __forceinline__ unsigned f2ord(float f) { const unsigned b = __float_as_uint(f); return b ^ ((unsigned)((int)b >> 31) | 0x80000000u); }
__device__ __forceinline__ float ord2f(unsigned u) { return __uint_as_float(u ^ ((u >> 31) ? 0x80000000u : 0xffffffffu)); }
__device__ __forceinline__ void dsa_index_unit(LAS unsigned char* lds, const bf16* P0, unsigned short* SEL, int b, int qt, int tid_in, int lane_in, int wave) {
    int lane = lane_in; asm volatile("" : "+v"(lane)); const int tid = wave * 64 + lane; (void)tid_in;
    const int q = lane & 15, g4 = lane >> 4, t0 = 16 * qt, t = t0 + q, nkt = qt + 1;
    const int ni = nkt > wave ? (nkt - wave + 7) >> 3 : 0, nc4 = (ni + 3) >> 2;
    const bf16* base = P0 + (size_t)(b * SEQ) * EV_INP;
    bf16x8 bq[8]; float w[8];
#pragma unroll
    for (int h = 0; h < 8; ++h) { bq[h] = *(const GAS bf16x8*)(base + (size_t)t * EV_INP + C_IQ + h * 32 + 8 * g4); w[h] = bf2f(base[(size_t)t * EV_INP + C_IW + h]); }
    typedef float f32x4v __attribute__((ext_vector_type(4)));
    const bf16* kbase = base + (size_t)(16 * wave + q) * EV_INP + C_IK + 8 * g4;
    float sc[32][4];
    const float NINF = -__builtin_inff();
#pragma unroll
    for (int g = 0; g < 8; ++g) {
        if (32 * g + wave < nkt) {
            bf16x8 ab[4];
#pragma unroll
            for (int j = 0; j < 4; ++j) if (8 * (4 * g + j) + wave < nkt) { const bf16* kp = kbase; asm volatile("" : "+v"(kp));
                ab[j] = *(const GAS bf16x8*)(kp + (size_t)(4 * g + j) * (128 * EV_INP)); }
            asm volatile("s_waitcnt vmcnt(0)" ::: "memory");
#pragma unroll
            for (int j = 0; j < 4; ++j) {
                const int i = 4 * g + j, kt = 8 * i + wave;
                if (kt < nkt) {
                    const bf16x8 a = ab[j];
                    float a4[4] = {0.f, 0.f, 0.f, 0.f};
#pragma unroll
                    for (int h = 0; h < 8; ++h) { const f32x4v c = __builtin_amdgcn_mfma_f32_16x16x32_bf16(a, bq[h], (f32x4v){0.f, 0.f, 0.f, 0.f}, 0, 0, 0);
#pragma unroll
                        for (int r = 0; r < 4; ++r) a4[r] += w[h] * fmx(c[r], 0.f); }
#pragma unroll
                    for (int r = 0; r < 4; ++r) sc[i][r] = (kt < qt || 4 * g4 + r <= q) ? a4[r] : NINF;
                } else {
#pragma unroll
                    for (int r = 0; r < 4; ++r) sc[i][r] = NINF;
                }
            }
        } else {
#pragma unroll
            for (int j = 0; j < 4; ++j)
#pragma unroll
                for (int r = 0; r < 4; ++r) sc[4 * g + j][r] = NINF;
        }
    }
    LAS float* RED = (LAS float*)(lds + IX_RED); LAS unsigned* CNT = (LAS unsigned*)(lds + IX_CNT); LAS unsigned* MK = (LAS unsigned*)(lds + IX_MASK);
    LAS unsigned* NC = (LAS unsigned*)(lds + IX_NC); LAS unsigned long long* CAND = (LAS unsigned long long*)(lds + IX_CAND); LAS unsigned long long* THR = (LAS unsigned long long*)(lds + IX_THR);
    float lmax = NINF, lmin = __builtin_inff();
#pragma unroll
    for (int c = 0; c < 8; ++c) if (c < nc4) {
#pragma unroll
        for (int j = 0; j < 4; ++j)
#pragma unroll
            for (int r = 0; r < 4; ++r) { const float v = sc[4 * c + j][r]; lmax = fmx(lmax, v); lmin = fmn(lmin, v == NINF ? __builtin_inff() : v); }
    }
    lmax = fmx(lmax, lx_f<16>(lmax)); lmax = fmx(lmax, lx_f<32>(lmax));
    lmin = fmn(lmin, lx_f<16>(lmin)); lmin = fmn(lmin, lx_f<32>(lmin));
    __syncthreads();
    if (g4 == 0) { RED[wave * 16 + q] = lmax; RED[128 + wave * 16 + q] = lmin; }
    for (int i = tid; i < 2048; i += NWAVES * 64) MK[i] = 0u;
    if (tid < 16) NC[tid] = 0u;
    __syncthreads();
    float hiv = NINF, lov = __builtin_inff();
#pragma unroll
    for (int wv = 0; wv < 8; ++wv) { hiv = fmx(hiv, RED[wv * 16 + q]); lov = fmn(lov, RED[128 + wv * 16 + q]); }
    lov = lov - fabsf(lov) * 1e-3f - 1e-6f;
    unsigned clo = (unsigned)(t + 1), chi = 0u;
    bool done = (t + 1 <= 256), fine = false; float thr = NINF; unsigned thk = 0u;
    for (int it = 0; it < 64; ++it) {
        const float mid = 0.5f * (lov + hiv);
        unsigned cnt = 0;
#pragma unroll
        for (int c = 0; c < 8; ++c) if (c < nc4) {
#pragma unroll
            for (int j = 0; j < 4; ++j)
#pragma unroll
                for (int r = 0; r < 4; ++r) cnt += (sc[4 * c + j][r] > mid) ? 1u : 0u;
        }
        cnt += lx_u<16>(cnt); cnt += lx_u<32>(cnt);
        LAS unsigned* cb = CNT + (it & 1) * 128;
        if (g4 == 0) cb[wave * 16 + q] = cnt;
        __syncthreads();
        unsigned tot = 0;
#pragma unroll
        for (int wv = 0; wv < 8; ++wv) tot += cb[wv * 16 + q];
        if (!done && !fine) {
            if (tot == 256u) { thr = mid; done = true; }
            else if (!(mid > lov && mid < hiv)) { thr = lov; done = true; }
            else { if (tot > 256u) { lov = mid; clo = tot; } else { hiv = mid; chi = tot; }
                   if (clo - chi <= 64u) fine = true; }
        }
        if (__all(done || fine)) break;
    }
    const unsigned kinv0 = (unsigned)(4095 - (16 * wave + 4 * g4));
    if (fine) {
#pragma unroll
        for (int c = 0; c < 8; ++c) if (c < nc4) {
#pragma unroll
            for (int j = 0; j < 4; ++j)
#pragma unroll
                for (int r = 0; r < 4; ++r) { const float v = sc[4 * c + j][r];
                    if (v > lov && v <= hiv) { const unsigned pos = __hip_atomic_fetch_add(NC + q, 1u, __ATOMIC_RELAXED, __HIP_MEMORY_SCOPE_WORKGROUP);
                        if (pos < 64u) CAND[q * 64 + pos] = ((unsigned long long)f2ord(v) << 32) | (kinv0 - (unsigned)(128 * (4 * c + j) + r)); } }
        }
    }
    __syncthreads();
#pragma unroll 1
    for (int k = 0; k < 2; ++k) {
        const int qq = 2 * wave + k;
        const int fq = __builtin_amdgcn_readlane((int)fine, qq), need = __builtin_amdgcn_readlane((int)(256u - chi), qq);
        if (fq) {
            const unsigned n = NC[qq]; const unsigned long long comp = (unsigned)lane < n ? CAND[qq * 64 + lane] : 0ull;
            const unsigned c_lo = (unsigned)comp, c_hi = (unsigned)(comp >> 32);
            int rank = 0;
#pragma unroll
            for (int jj = 0; jj < 64; ++jj) { const unsigned long long c2 = ((unsigned long long)(unsigned)__builtin_amdgcn_readlane((int)c_hi, jj) << 32) | (unsigned)__builtin_amdgcn_readlane((int)c_lo, jj); rank += (c2 > comp) ? 1 : 0; }
            if (rank == need - 1) THR[qq] = comp;
        }
    }
    __syncthreads();
    if (fine) { const unsigned long long t64 = THR[q]; thr = ord2f((unsigned)(t64 >> 32)); thk = (unsigned)t64; }
    LAS unsigned* mkw = MK + q * 128 + (wave >> 1); const int mksh = 16 * (wave & 1) + 4 * g4;
#pragma unroll
    for (int c = 0; c < 8; ++c) if (c < nc4) {
#pragma unroll
        for (int j = 0; j < 4; ++j) { const int i = 4 * c + j;
            unsigned nib = 0;
#pragma unroll
            for (int r = 0; r < 4; ++r) { const float v = sc[i][r]; nib |= (v > thr || (fine && v == thr && kinv0 - (unsigned)(128 * i + r) >= thk)) ? (1u << r) : 0u; }
            if (nib) __hip_atomic_fetch_or(mkw + 4 * i, nib << mksh, __ATOMIC_RELAXED, __HIP_MEMORY_SCOPE_WORKGROUP); }
    }
    __syncthreads();
    LAS unsigned short* LST = (LAS unsigned short*)(lds + IX_LIST);
#pragma unroll 1
    for (int k = 0; k < 2; ++k) {
        const int qq = 2 * wave + k;
        unsigned long long wd = *(const LAS unsigned long long*)(lds + IX_MASK + (qq * 64 + lane) * 8);
        const int c = __popcll(wd); int incl = c;
#pragma unroll
        for (int d = 1; d < 64; d <<= 1) { const int n = __builtin_amdgcn_ds_bpermute((lane - d) << 2, incl); if (lane >= d) incl += n; }
        int pos = incl - c; const int total = __builtin_amdgcn_readlane(incl, 63);
        while (wd) { const int bbit = __builtin_ctzll(wd); if (pos < 256) LST[qq * 256 + pos] = (unsigned short)(64 * lane + bbit); ++pos; wd &= wd - 1; }
        for (int p = total + lane; p < 256; p += 64) LST[qq * 256 + p] = (unsigned short)0xffffu;
    }
    __syncthreads();
    { const v4u v = *(const LAS v4u*)(lds + IX_LIST + tid * 16);
      *(GAS v4u*)((unsigned char*)(SEL + (size_t)(b * SEQ + t0) * 256) + tid * 16) = v; }
}

struct FSel {
    unsigned long long selmask; int t, cur, hi; const LAS float* BT;
    __device__ __forceinline__ void pre(int) {}
    __device__ __forceinline__ bool skip(int kt) const { return !__any((int)((selmask >> kt) & 1ull)); }
    __device__ __forceinline__ void apply(f32x16 (&s)[2], int kt) {
        const bool on = (selmask >> kt) & 1ull;
        if (kt + 3 <= cur) {
            if (!__all((int)on)) {
#pragma unroll
                for (int st = 0; st < 2; ++st)
#pragma unroll
                    for (int r = 0; r < 16; ++r) s[st][r] = on ? s[st][r] : NEGBIG; }
        } else {
#pragma unroll
            for (int st = 0; st < 2; ++st)
#pragma unroll
                for (int r = 0; r < 16; ++r) { const int dist = t - (64 * kt + 32 * st + crow(r, hi)); const unsigned di = (unsigned)dist < 128u ? (unsigned)dist : 128u;
                    s[st][r] = (on && dist >= 0) ? s[st][r] + BT[di] : NEGBIG; }
        }
    }
};
struct FWin {
    int t, cur, hi; const LAS float* BT;
    __device__ __forceinline__ void pre(int) {}
    __device__ __forceinline__ bool skip(int) const { return false; }
    __device__ __forceinline__ void apply(f32x16 (&s)[2], int kt) {
        const int dk = cur - kt;
        if (!(dk >= 3 && dk <= 7)) {
#pragma unroll
            for (int st = 0; st < 2; ++st)
#pragma unroll
                for (int r = 0; r < 16; ++r) { const int dist = t - (64 * kt + 32 * st + crow(r, hi)); const unsigned di = (unsigned)dist < 128u ? (unsigned)dist : 128u;
                    s[st][r] = (dist >= 0 && dist < 512) ? s[st][r] + BT[di] : NEGBIG; }
        }
    }
};
__device__ __forceinline__ float sigmoidf_(float x) { return __builtin_amdgcn_rcpf(1.0f + __builtin_amdgcn_exp2f(-x * LOG2E)); }

__device__ __forceinline__ void nsa_unit(LAS unsigned char* lds, const bf16* P0, const bf16* KCMP, const bf16* VCMP, bf16* OC, int b, int g, int qt, int tid_in, int lane_in, int wave) {
    int lane = lane_in; asm volatile("" : "+v"(lane)); const int tid = wave * 64 + lane; (void)tid_in;
    const int r32 = lane & 31, hi = lane >> 5, qi = r32 >> 2, hh = r32 & 3, head = g * 4 + hh;
    const int t0 = qt * 64, t = t0 + wave * 8 + qi, cur = qt;
    const bf16* prow = P0 + (size_t)(b * SEQ + t) * EV_INP;
    bf16x8 qf[4]; load_q_scaled<64>(prow + C_QA + head * 64, qf, 0.125f * LOG2E, lane);
    const LAS float* BT = (const LAS float*)(lds + AT_BT) + head * BT_STRIDE;
    const float g0 = sigmoidf_(bf2f(prow[C_GA + g * 12 + hh * 3 + 0])), g1 = sigmoidf_(bf2f(prow[C_GA + g * 12 + hh * 3 + 1])), g2 = sigmoidf_(bf2f(prow[C_GA + g * 12 + hh * 3 + 2]));
    LAS float* impL = (LAS float*)(lds + AT_WS + wave * AT_WS_PER_WAVE);
    LAS unsigned long long* selL = (LAS unsigned long long*)(lds + AT_WS + wave * AT_WS_PER_WAVE + 2048);
    f32x16 oacc[2];
    {
        f32x16 o[2] = {}; float m = NEGBIG, l = 0.f, carry = 0.f;
        float imp[32];
#pragma unroll
        for (int i = 0; i < 32; ++i) imp[i] = 0.f;
        const int ncv = (t0 + 63 >= 31) ? ((t0 + 63 - 31) >> 4) + 1 : 0;
        const int nkt = ncv >= 256 ? 4 : (ncv + 63) >> 6;
        KVSrc kv{KCMP + (size_t)((b * 2 + g) * 256) * 64, 64, nullptr, 0, VCMP + (size_t)((b * 2 + g) * 256) * 64, 64};
        Stage<64, 64, 64> sg;
        __syncthreads();
        if (nkt > 0) { sg.load(kv, 0, tid); sg.store(lds, 0, tid); }
        __syncthreads();
#pragma unroll
        for (int kt = 0; kt < 4; ++kt) {
            if (kt < nkt) {
                const int buf = kt & 1;
                if (kt + 1 < nkt) sg.load(kv, kt + 1, tid);
                f32x16 s[2];
                qk_tile<64, 2>(lds + AT_KBUF + buf * KBUF_BYTES, qf, s, lane);
#pragma unroll
                for (int st = 0; st < 2; ++st)
#pragma unroll
                    for (int r = 0; r < 16; ++r) { const int dist = t - (16 * (64 * kt + 32 * st + crow(r, hi)) + 31); const unsigned di = (unsigned)dist < 128u ? (unsigned)dist : 128u;
                        s[st][r] = dist >= 0 ? s[st][r] + BT[di] : NEGBIG; }
                const float alpha = softmax_tile(s, m, l);
                o[0] = o[0] * alpha; o[1] = o[1] * alpha; carry *= alpha;
#pragma unroll
                for (int i = 0; i < kt * 8; ++i) imp[i] *= alpha;
                pv_tile<64>(lds + AT_VBUF + buf * VBUF_BYTES, s, o, lane);
                float G[2][4], ol[2][4];
#pragma unroll
                for (int st = 0; st < 2; ++st)
#pragma unroll
                    for (int q4 = 0; q4 < 4; ++q4) { G[st][q4] = (s[st][4 * q4] + s[st][4 * q4 + 1]) + (s[st][4 * q4 + 2] + s[st][4 * q4 + 3]); ol[st][q4] = swapget(s[st][4 * q4 + 3]); }
#pragma unroll
                for (int st = 0; st < 2; ++st)
#pragma unroll
                    for (int q4 = 0; q4 < 4; ++q4) { const float prev = q4 > 0 ? ol[st][q4 - 1] : (st == 1 ? ol[0][3] : carry);
                        imp[kt * 8 + st * 4 + q4] = G[st][q4] + (hi ? ol[st][q4] : prev); }
                carry = ol[1][3];
                if (kt + 1 < nkt) sg.store(lds, buf ^ 1, tid);
                __syncthreads();
            }
        }
        const float lt = swapsum(l), inv = lt > 0.f ? 1.f / lt : 0.f;
        oacc[0] = o[0] * (inv * g0); oacc[1] = o[1] * (inv * g0);
#pragma unroll
        for (int i = 0; i < 32; ++i) { float v = imp[i] * inv; v += lx_f<1>(v); v += lx_f<2>(v);
            if (hh == 0) impL[qi * 64 + 16 * (i >> 3) + 8 * ((i >> 2) & 1) + 2 * (i & 3) + hi] = v; }
    }
    LDS_WAIT(); asm volatile("" ::: "memory");
#pragma unroll 1
    for (int q2 = 0; q2 < 8; ++q2) {
        const int j = lane; const bool valid = j <= cur, forced = (j == 0) || (j == cur) || (j == cur - 1);
        const float val = impL[q2 * 64 + j] + (forced ? 1000.f : 0.f);
        const unsigned long long comp = ((unsigned long long)(valid ? __float_as_uint(val) + 1u : 0u) << 6) | (unsigned long long)(63 - j);
        const unsigned clo = (unsigned)comp, chi = (unsigned)(comp >> 32);
        int rank = 0;
#pragma unroll
        for (int jj = 0; jj < 64; ++jj) { const unsigned long long c2 = ((unsigned long long)(unsigned)__builtin_amdgcn_readlane((int)chi, jj) << 32) | (unsigned)__builtin_amdgcn_readlane((int)clo, jj); rank += (c2 > comp) ? 1 : 0; }
        const unsigned long long mk = __ballot(valid && rank < 16);
        if (lane == 0) selL[q2] = mk;
    }
    LDS_WAIT(); asm volatile("" ::: "memory");
    const unsigned long long selmask = selL[qi];
    {
        f32x16 o[2] = {}; SmState S{0.f, 0.f, false};
        KVSrc kv{P0 + (size_t)(b * SEQ) * EV_INP + C_KVA + 2 * 128 + g * 64, EV_INP, nullptr, 0, P0 + (size_t)(b * SEQ) * EV_INP + C_KVA + 3 * 128 + g * 64, EV_INP};
        FSel f{selmask, t, cur, hi, BT};
        int tid2 = tid; asm volatile("" : "+v"(tid2));
        attn_loop<64, 64, 64, FSel, false>(lds, kv, 0, cur + 1, qf, f, o, S, tid2, lane);
        const float lt = swapsum(S.l), inv = lt > 0.f ? 1.f / lt : 0.f;
        oacc[0] = oacc[0] + o[0] * (inv * g1); oacc[1] = oacc[1] + o[1] * (inv * g1);
    }
    {
        f32x16 o[2] = {}; SmState S{0.f, 0.f, false};
        KVSrc kv{P0 + (size_t)(b * SEQ) * EV_INP + C_KVA + 4 * 128 + g * 64, EV_INP, nullptr, 0, P0 + (size_t)(b * SEQ) * EV_INP + C_KVA + 5 * 128 + g * 64, EV_INP};
        FWin f{t, cur, hi, BT};
        int tid3 = tid; asm volatile("" : "+v"(tid3));
        attn_loop<64, 64, 64, FWin, false>(lds, kv, cur >= 8 ? cur - 8 : 0, cur + 1, qf, f, o, S, tid3, lane);
        const float lt = swapsum(S.l), inv = lt > 0.f ? 1.f / lt : 0.f;
        oacc[0] = oacc[0] + o[0] * (inv * g2); oacc[1] = oacc[1] + o[1] * (inv * g2);
    }
    store_ot<64>(OC + (size_t)(b * SEQ + t) * DM + head * 64, oacc, 1.f, lane);
}
constexpr int DG_VP = 136, DG_VT = 64 * DG_VP;
static_assert(8 * DG_VT <= AT_BT, "DSA gather LDS map");
__device__ __forceinline__ void dsa_unit(LAS unsigned char* lds, const bf16* P0, const unsigned short* SEL, bf16* OC, int b, int qt, int tid_in, int lane_in, int wave) {
    int lane = lane_in; asm volatile("" : "+v"(lane)); (void)tid_in;
    const int r32 = lane & 31, hi = lane >> 5, hh = r32 & 7;
    const LAS float* BT = (const LAS float*)(lds + AT_BT) + (8 + hh) * BT_STRIDE;
    LAS unsigned char* vt = lds + wave * DG_VT;
    LAS unsigned short* lq = (LAS unsigned short*)(lds + AT_WS + wave * AT_WS_PER_WAVE);
    const bf16* kb = P0 + (size_t)(b * SEQ) * EV_INP + C_KB + 8 * hi;
    const bf16* vb = P0 + (size_t)(b * SEQ) * EV_INP + C_VB + 8 * (lane & 7);
#define DG_LOADK(LQ, J) do { _Pragma("unroll") for (int st = 0; st < 2; ++st) { unsigned ik = (LQ)[64 * (J) + 32 * st + r32]; ik = ik > 4095u ? 0u : ik; \
        _Pragma("unroll") for (int d0 = 0; d0 < 4; ++d0) kf[st][d0] = *(const GAS bf16x8*)(kb + (size_t)ik * EV_INP + 16 * d0); } } while (0)
#define DG_LOADV(LQ, J) do { _Pragma("unroll") for (int i = 0; i < 8; ++i) { unsigned iv = (LQ)[64 * (J) + 8 * i + (lane >> 3)]; iv = iv > 4095u ? 0u : iv; vr[i] = *(const GAS v4u*)(vb + (size_t)iv * EV_INP); } } while (0)
    bf16x8 kf[2][4]; v4u vr[8];
    { const int t = qt * 32 + wave * 4; *(LAS v2u*)(lq + 4 * lane) = *(const GAS v2u*)(SEL + (size_t)(b * SEQ + t) * 256 + 4 * lane); }
    DG_LOADK(lq, 0); DG_LOADV(lq, 0);
#pragma unroll 1
    for (int qi = 0; qi < 4; ++qi) {
        const int t = qt * 32 + wave * 4 + qi;
        LAS unsigned short* lqc = lq + 256 * (qi & 1); LAS unsigned short* lqn = lq + 256 * ((qi + 1) & 1);
        if (qi + 1 < 4) *(LAS v2u*)(lqn + 4 * lane) = *(const GAS v2u*)(SEL + (size_t)(b * SEQ + t + 1) * 256 + 4 * lane);
        bf16x8 qf[4]; load_q_scaled<64>(P0 + (size_t)(b * SEQ + t) * EV_INP + C_QB + hh * 64, qf, 0.125f * LOG2E, lane);
        f32x16 o[2] = {}; SmState S{0.f, 0.f, false};
#pragma unroll
        for (int j = 0; j < 4; ++j) {
#pragma unroll
            for (int i = 0; i < 8; ++i) { LAS unsigned char* d = vt + (8 * i + (lane >> 3)) * DG_VP + (lane & 7) * 16; *(LAS v2u*)d = (v2u){vr[i].x, vr[i].y}; *(LAS v2u*)(d + 8) = (v2u){vr[i].z, vr[i].w}; }
            if (j < 3) DG_LOADV(lqc, j + 1); else if (qi + 1 < 4) DG_LOADV(lqn, 0);
            f32x16 s[2];
#pragma unroll
            for (int r = 0; r < 16; ++r) { s[0][r] = -S.mhat; s[1][r] = -S.mhat; }
#pragma unroll
            for (int d0 = 0; d0 < 4; ++d0)
#pragma unroll
                for (int st = 0; st < 2; ++st) s[st] = __builtin_amdgcn_mfma_f32_32x32x16_bf16(kf[st][d0], qf[d0], s[st], 0, 0, 0);
            if (j < 3) DG_LOADK(lqc, j + 1); else if (qi + 1 < 4) DG_LOADK(lqn, 0);
            if (j >= 2 || t < 255) {
#pragma unroll
                for (int st = 0; st < 2; ++st)
#pragma unroll
                    for (int r = 0; r < 16; ++r) { const int ix = lqc[64 * j + 32 * st + crow(r, hi)]; const int dist = t - ix; const unsigned di = (unsigned)dist < 128u ? (unsigned)dist : 128u;
                        s[st][r] = dist >= 0 ? s[st][r] + BT[di] : NEGBIG; }
            }
            float mx = NEGBIG;
#pragma unroll
            for (int r = 0; r < 16; ++r) mx = fmx3(mx, s[0][r], s[1][r]);
            mx = swapmax(mx);
            const bool need = S.started ? (mx > DEFER_THR) : (mx > -1e29f);
            if (__any(need)) {
                const float delta = need ? mx : 0.f, fac = (need && S.started) ? __builtin_amdgcn_exp2f(-delta) : 1.f;
                S.mhat += delta; S.l *= fac; S.started = S.started || need;
#pragma unroll
                for (int st = 0; st < 2; ++st)
#pragma unroll
                    for (int r = 0; r < 16; ++r) s[st][r] -= delta;
                o[0] = o[0] * fac; o[1] = o[1] * fac;
            }
#pragma unroll
            for (int st = 0; st < 2; ++st)
#pragma unroll
                for (int r = 0; r < 16; ++r) s[st][r] = __builtin_amdgcn_exp2f(s[st][r]);
            S.l += vsum32(s);
            bf16x8 pf[4]; p_pack(s, pf);
            VFrag vfr; pv_load<DG_VP>(vt, 0, vfr, lane);
            pv_mma(vfr, pf, o[0], o[1]);
        }
        const float lt = swapsum(S.l);
        if (r32 < 8) store_ot<64>(OC + (size_t)(b * SEQ + t) * DM + 512 + hh * 64, o, lt > 0.f ? 1.f / lt : 0.f, lane);
    }
#undef DG_LOADK
#undef DG_LOADV
}


constexpr int D_CQ = 0, D_CKV = 256, D_KR = 384, D_QD = 416, D_KD = 928, D_VD = 1440;
constexpr size_t WS_ROPE = 91 * MiB + 640 * 1024;
constexpr size_t WS_P1 = WS_OV, WS_CQN = WS_OV + 256 * MiB, WS_CKVN = WS_OV + 288 * MiB, WS_KR = WS_OV + 320 * MiB;
constexpr size_t WS_QMLA = WS_Y, WS_KVMLA = WS_Y + 96 * MiB;
static_assert(WS_KR + 4 * MiB <= WS_END && WS_KVMLA + 128 * MiB <= WS_OV, "odd overlay");
constexpr float LAM_INIT = 0.35550906759097f;

__device__ __forceinline__ void rope_table_phase(float* ROPE, int gt, int NGT) {
    for (int idx = gt; idx < SEQ * 16; idx += NGT) { const int t = idx >> 4, i = idx & 15;
        const float inv = exp2f(-(float)i * (13.287712379549449f / 16.0f));
        const double rev = (double)((float)t * inv) * 0.15915494309189535;
        const float fr = (float)(rev - __builtin_floor(rev));
        ROPE[2 * idx] = __builtin_amdgcn_cosf(fr); ROPE[2 * idx + 1] = __builtin_amdgcn_sinf(fr); }
}
__device__ __forceinline__ void odd_prep_rows(const bf16* P1, const float* qn, const float* kvn, const float* ROPE, bf16* CQN, bf16* CKVN, bf16* KR, int gw, int NGW, int lane) {
    float gq[4], gk[2];
#pragma unroll
    for (int j = 0; j < 4; ++j) gq[j] = qn[4 * lane + j];
    gk[0] = kvn[2 * lane]; gk[1] = kvn[2 * lane + 1];
    for (int m = gw; m < MTOK; m += NGW) {
        const bf16* row = P1 + (size_t)m * OD_INP;
        const v2u cq = *(const GAS v2u*)(row + D_CQ + 4 * lane); const unsigned ck = *(const GAS unsigned*)(row + D_CKV + 2 * lane);
        float x[4] = {bf2f((unsigned short)(cq.x & 0xffff)), bf2f((unsigned short)(cq.x >> 16)), bf2f((unsigned short)(cq.y & 0xffff)), bf2f((unsigned short)(cq.y >> 16))};
        float y[2] = {bf2f((unsigned short)(ck & 0xffff)), bf2f((unsigned short)(ck >> 16))};
        const float r1 = __builtin_amdgcn_rsqf(wave_sum((x[0] * x[0] + x[1] * x[1]) + (x[2] * x[2] + x[3] * x[3])) * (1.f / 256.f) + RMS_EPS);
        const float r2 = __builtin_amdgcn_rsqf(wave_sum(y[0] * y[0] + y[1] * y[1]) * (1.f / 128.f) + RMS_EPS);
        v2u o; o.x = pk2(x[0] * r1 * gq[0], x[1] * r1 * gq[1]); o.y = pk2(x[2] * r1 * gq[2], x[3] * r1 * gq[3]);
        *(GAS v2u*)(CQN + (size_t)m * 256 + 4 * lane) = o;
        *(GAS unsigned*)(CKVN + (size_t)m * 256 + 2 * lane) = pk2(y[0] * r2 * gk[0], y[1] * r2 * gk[1]);
        *(GAS unsigned*)(CKVN + (size_t)m * 256 + 128 + 2 * lane) = 0u;
        if (lane < 16) { const int t = m & (SEQ - 1); const float c = ROPE[(t * 16 + lane) * 2], s = ROPE[(t * 16 + lane) * 2 + 1];
            const float x1 = bf2f(row[D_KR + lane]), x2 = bf2f(row[D_KR + 16 + lane]);
            KR[(size_t)m * 32 + lane] = (bf16)f2bf(x1 * c - x2 * s); KR[(size_t)m * 32 + 16 + lane] = (bf16)f2bf(x1 * s + x2 * c); }
    }
}
template <bool BIAS> struct FCausal {
    int t, tmin, tmax, hi; const LAS float* BT;
    __device__ __forceinline__ void pre(int) {}
    __device__ __forceinline__ bool skip(int kt) const { return 64 * kt > tmax; }
    __device__ __forceinline__ void apply(f32x16 (&s)[2], int kt) {
        if (!(64 * kt + 63 <= tmin && (!BIAS || tmin - (64 * kt + 63) >= 113))) {
#pragma unroll
            for (int st = 0; st < 2; ++st)
#pragma unroll
                for (int r = 0; r < 16; ++r) { const int dist = t - (64 * kt + 32 * st + crow(r, hi)); const unsigned di = (unsigned)dist < 128u ? (unsigned)dist : 128u;
                    s[st][r] = dist >= 0 ? s[st][r] + (BIAS ? BT[di] : 0.f) : NEGBIG; }
        }
    }
};
__device__ __forceinline__ void mla_unit(LAS unsigned char* lds, const bf16* QM, const bf16* KVM_, const bf16* KR, const float* ROPE, bf16* OC, int b, int h, int qt, int tid_in, int lane_in, int wave) {
    int lane = lane_in; asm volatile("" : "+v"(lane)); const int tid = wave * 64 + lane; (void)tid_in;
    const int r32 = lane & 31, hi = lane >> 5, t = qt * 256 + wave * 32 + r32;
    bf16x8 qf[6]; load_q<96>(QM + (size_t)(b * SEQ + t) * 768 + h * 96, qf, lane);
    {
        const float* rp = ROPE + (size_t)(t * 16 + 8 * hi) * 2;
        bf16x8 a = qf[4], c = qf[5];
#pragma unroll
        for (int j = 0; j < 8; ++j) { const float cs = rp[2 * j], sn = rp[2 * j + 1], x1 = bf2f((unsigned short)a[j]), x2 = bf2f((unsigned short)c[j]);
            a[j] = (short)f2bf(x1 * cs - x2 * sn); c[j] = (short)f2bf(x1 * sn + x2 * cs); }
        qf[4] = a; qf[5] = c;
    }
#pragma unroll
    for (int d0 = 0; d0 < 6; ++d0) qf[d0] = scale_frag(qf[d0], 0.10206207261596577f * LOG2E);
    KVSrc kv{KVM_ + (size_t)(b * SEQ) * 1024 + h * 128, 1024, KR + (size_t)(b * SEQ) * 32, 32, KVM_ + (size_t)(b * SEQ) * 1024 + h * 128 + 64, 1024};
    f32x16 o[2] = {}; SmState S{0.f, 0.f, false};
    FCausal<false> f{t, qt * 256 + wave * 32, qt * 256 + wave * 32 + 31, hi, nullptr};
    attn_loop<96, 64, 64, FCausal<false>, false, true>(lds, kv, 0, 4 * qt + 4, qf, f, o, S, tid, lane);
    const float lt = swapsum(S.l);
    store_ot<64>(OC + (size_t)(b * SEQ + t) * DM + h * 64, o, lt > 0.f ? 1.f / lt : 0.f, lane);
}
__device__ __forceinline__ void diff_unit(LAS unsigned char* lds, const bf16* P1, const float* lam, const float* subln, bf16* OC, int b, int h, int qt, int tid_in, int lane_in, int wave) {
    int lane = lane_in; asm volatile("" : "+v"(lane)); const int tid = wave * 64 + lane; (void)tid_in;
    const int r32 = lane & 31, hi = lane >> 5, t = qt * 256 + wave * 32 + r32;
    const LAS float* BT = (const LAS float*)(lds + AT_BT) + (16 + h) * BT_STRIDE;
    float d01 = 0.f, d23 = 0.f;
    { d01 = lam[lane] * lam[64 + lane]; d23 = lam[128 + lane] * lam[192 + lane]; d01 = wave_sum(d01); d23 = wave_sum(d23); }
    const float lam_full = __expf(d01) - __expf(d23) + LAM_INIT;
    unsigned o0p[32];
    f32x16 o[4];
#pragma unroll 1
    for (int e = 0; e < 2; ++e) {
        bf16x8 qf[4]; load_q_scaled<64>(P1 + (size_t)(b * SEQ + t) * OD_INP + D_QD + (h * 2 + e) * 64, qf, 0.125f * LOG2E, lane);
        KVSrc kv{P1 + (size_t)(b * SEQ) * OD_INP + D_KD + (h * 2 + e) * 64, OD_INP, nullptr, 0, P1 + (size_t)(b * SEQ) * OD_INP + D_VD + h * 128, OD_INP};
#pragma unroll
        for (int dt = 0; dt < 4; ++dt) o[dt] = (f32x16){};
        SmState S{0.f, 0.f, false};
        FCausal<true> f{t, qt * 256 + wave * 32, qt * 256 + wave * 32 + 31, hi, BT};
        attn_loop<64, 64, 128, FCausal<true>>(lds, kv, 0, 4 * qt + 4, qf, f, o, S, tid, lane);
        const float lt = swapsum(S.l), inv = lt > 0.f ? 1.f / lt : 0.f;
        if (e == 0) {
#pragma unroll
            for (int dt = 0; dt < 4; ++dt)
#pragma unroll
                for (int k = 0; k < 8; ++k) o0p[dt * 8 + k] = cvtpk(o[dt][2 * k] * inv, o[dt][2 * k + 1] * inv);
        } else {
            float ss = 0.f;
#pragma unroll
            for (int dt = 0; dt < 4; ++dt)
#pragma unroll
                for (int k = 0; k < 8; ++k) { const unsigned w = o0p[dt * 8 + k];
                    const float a0 = __uint_as_float(w << 16) - lam_full * (o[dt][2 * k] * inv), a1 = __uint_as_float(w & 0xffff0000u) - lam_full * (o[dt][2 * k + 1] * inv);
                    o[dt][2 * k] = a0; o[dt][2 * k + 1] = a1; ss += a0 * a0 + a1 * a1; }
            ss = swapsum(ss);
            const float rn = __builtin_amdgcn_rsqf(ss * (1.f / 128.f) + RMS_EPS) * (1.0f - LAM_INIT);
            bf16* orow = OC + (size_t)(b * SEQ + t) * DM + 512 + h * 128;
#pragma unroll
            for (int dt = 0; dt < 4; ++dt)
#pragma unroll
                for (int r4 = 0; r4 < 4; ++r4) { const int d = 32 * dt + 8 * r4 + 4 * hi; const f32x4 gn = *(const GAS f32x4*)(subln + d);
                    v2u w; w.x = cvtpk(o[dt][4 * r4 + 0] * rn * gn.x, o[dt][4 * r4 + 1] * rn * gn.y); w.y = cvtpk(o[dt][4 * r4 + 2] * rn * gn.z, o[dt][4 * r4 + 3] * rn * gn.w);
                    *(GAS v2u*)(orow + d) = w; }
        }
    }
}


__device__ __forceinline__ void tr_item(const float* W, int N, bf16* WT, int ldk, int drow0, LAS float* scr, int k0, int n0, int lane, const float* grow = nullptr) {
#pragma unroll 8
    for (int i = 0; i < 32; ++i) { const int kk = 2 * i + (lane >> 5); float wv = W[(size_t)(k0 + kk) * N + n0 + (lane & 31)]; if (grow) wv *= grow[k0 + kk]; scr[kk * 33 + (lane & 31)] = wv; }
    LDS_WAIT(); asm volatile("" ::: "memory");
    const int c = lane & 7;
#pragma unroll
    for (int j = 0; j < 4; ++j) { const int n = (lane >> 3) + 8 * j; const LAS float* s = scr + (8 * c) * 33 + n;
        v4u o; o.x = pk2(s[0 * 33], s[1 * 33]); o.y = pk2(s[2 * 33], s[3 * 33]); o.z = pk2(s[4 * 33], s[5 * 33]); o.w = pk2(s[6 * 33], s[7 * 33]);
        *(GAS v4u*)(WT + (size_t)(drow0 + n) * ldk + k0 + 8 * c) = o; }
    LDS_WAIT(); asm volatile("" ::: "memory");
}
__device__ __forceinline__ void tr_item8(const float* W, int N, unsigned char* WT, int ldk, int drow0, LAS float* scr, int k0, int n0, int lane) {
#pragma unroll 8
    for (int i = 0; i < 32; ++i) { const int kk = 2 * i + (lane >> 5); scr[kk * 33 + (lane & 31)] = W[(size_t)(k0 + kk) * N + n0 + (lane & 31)]; }
    LDS_WAIT(); asm volatile("" ::: "memory");
    const int c = lane & 7;
#pragma unroll
    for (int j = 0; j < 4; ++j) { const int n = (lane >> 3) + 8 * j; const LAS float* s = scr + (8 * c) * 33 + n;
        v2u o; o.x = pg8::pk4_fp8(s[0 * 33], s[1 * 33], s[2 * 33], s[3 * 33], pg8::F8S_W); o.y = pg8::pk4_fp8(s[4 * 33], s[5 * 33], s[6 * 33], s[7 * 33], pg8::F8S_W);
        *(GAS v2u*)(WT + (size_t)(drow0 + n) * ldk + k0 + 8 * c) = o; }
    LDS_WAIT(); asm volatile("" ::: "memory");
}
constexpr size_t WS_XB = WS_OV + 370 * MiB;
constexpr size_t WS_RS = 1 * MiB;
constexpr int F8_FROM = 1;
__device__ __forceinline__ void rows_norm_phase(const float* xsrc, float* xdst, const bf16* Y, float w, const float* gpost, const float* gpre, bf16* H, int nrows, int gw, int NGW, int lane, bool f8 = false, float ysc = 1.f, const bf16* xsb = nullptr, bf16* xdb = nullptr, float* Rout = nullptr) {
    f32x4 gp[4], gq[4];
#pragma unroll
    for (int j = 0; j < 4; ++j) {
        gp[j] = Y ? ((const GAS f32x4*)gpost)[lane + 64 * j] * w : (f32x4){0.f, 0.f, 0.f, 0.f};
        gq[j] = gpre ? ((const GAS f32x4*)gpre)[lane + 64 * j] : (f32x4){0.f, 0.f, 0.f, 0.f};
    }
    for (int m = gw; m < nrows; m += NGW) {
        f32x4 x[4];
        if (xsb) {
            const GAS v2u* xr = (const GAS v2u*)(xsb + (size_t)m * DM) + lane;
#pragma unroll
            for (int j = 0; j < 4; ++j) { const v2u xv = xr[64 * j]; x[j] = (f32x4){__uint_as_float(xv.x << 16), __uint_as_float(xv.x & 0xffff0000u), __uint_as_float(xv.y << 16), __uint_as_float(xv.y & 0xffff0000u)}; }
        } else {
            const GAS f32x4* xr = (const GAS f32x4*)(xsrc + (size_t)m * DM) + lane;
#pragma unroll
            for (int j = 0; j < 4; ++j) x[j] = xr[64 * j];
        }
        if (Y) {
            const GAS v2u* yr = (const GAS v2u*)(Y + (size_t)m * DM) + lane;
            f32x4 y[4]; float s = 0.f;
#pragma unroll
            for (int j = 0; j < 4; ++j) { const v2u yv = yr[64 * j]; y[j] = (f32x4){__uint_as_float(yv.x << 16), __uint_as_float(yv.x & 0xffff0000u), __uint_as_float(yv.y << 16), __uint_as_float(yv.y & 0xffff0000u)} * ysc;
                s += (y[j].x * y[j].x + y[j].y * y[j].y) + (y[j].z * y[j].z + y[j].w * y[j].w); }
            const float rstd = __builtin_amdgcn_rsqf(wave_sum(s) * (1.f / DM) + RMS_EPS);
#pragma unroll
            for (int j = 0; j < 4; ++j) x[j] = x[j] + y[j] * rstd * gp[j];
        }
        if (xdst) {
            GAS f32x4* xo = (GAS f32x4*)(xdst + (size_t)m * DM) + lane;
#pragma unroll
            for (int j = 0; j < 4; ++j) xo[64 * j] = x[j];
        }
        if (xdb) {
            GAS v2u* xo = (GAS v2u*)(xdb + (size_t)m * DM) + lane;
#pragma unroll
            for (int j = 0; j < 4; ++j) { v2u o; o.x = pk2(x[j].x, x[j].y); o.y = pk2(x[j].z, x[j].w); xo[64 * j] = o; }
        }
        if (gpre || Rout) {
            float s2 = 0.f;
#pragma unroll
            for (int j = 0; j < 4; ++j) s2 += (x[j].x * x[j].x + x[j].y * x[j].y) + (x[j].z * x[j].z + x[j].w * x[j].w);
            const float r2 = __builtin_amdgcn_rsqf(wave_sum(s2) * (1.f / DM) + RMS_EPS);
            if (Rout && lane == 0) Rout[m] = r2;
            if (gpre) {
            if (f8) {
                GAS unsigned* ho = (GAS unsigned*)((unsigned char*)H + (size_t)m * DM) + lane;
#pragma unroll
                for (int j = 0; j < 4; ++j) { const f32x4 h = x[j] * r2 * gq[j]; ho[64 * j] = pg8::pk4_fp8(h.x, h.y, h.z, h.w, pg8::F8S_H); }
            } else {
            GAS v2u* ho = (GAS v2u*)(H + (size_t)m * DM) + lane;
#pragma unroll
            for (int j = 0; j < 4; ++j) { const f32x4 h = x[j] * r2 * gq[j]; v2u o; o.x = pk2(h.x, h.y); o.y = pk2(h.z, h.w); ho[64 * j] = o; }
            }
            }
        }
    }
}
__device__ __forceinline__ void transpose_cols_phase(const bf16* src, int ld, int col0, int ncols, int nb, int S, bf16* dst, LAS unsigned short* scr, int gw, int NGW, int lane, int gsz = 1 << 30, int gstride = 0) {
    const int nct = ncols / 64, nst = S / 64, nitems = nb * nct * nst;
    for (int it = gw; it < nitems; it += NGW) {
        const int st = it % nst, ct = (it / nst) % nct, b = it / (nst * nct);
        const bf16* sp = src + (size_t)(b * S + st * 64) * ld + col0 + ((ct * 64) / gsz) * gstride + (ct * 64) % gsz;
#pragma unroll
        for (int i = 0; i < 8; ++i) { const int r = i * 8 + (lane >> 3), c8 = (lane & 7) * 8;
            const v4u v = *(const GAS v4u*)(sp + (size_t)r * ld + c8);
            LAS unsigned* d = (LAS unsigned*)(scr + r * 66 + c8); d[0] = v.x; d[1] = v.y; d[2] = v.z; d[3] = v.w; }
        LDS_WAIT(); asm volatile("" ::: "memory");
        bf16* dp = dst + ((size_t)(b * ncols + ct * 64)) * S + st * 64;
#pragma unroll
        for (int i = 0; i < 8; ++i) { const int c = i * 8 + (lane >> 3), r8 = (lane & 7) * 8;
            unsigned short e[8];
#pragma unroll
            for (int k = 0; k < 8; ++k) e[k] = scr[(r8 + k) * 66 + c];
            v4u o; o.x = e[0] | ((unsigned)e[1] << 16); o.y = e[2] | ((unsigned)e[3] << 16); o.z = e[4] | ((unsigned)e[5] << 16); o.w = e[6] | ((unsigned)e[7] << 16);
            *(GAS v4u*)(dp + (size_t)c * S + r8) = o; }
        LDS_WAIT(); asm volatile("" ::: "memory");
    }
}

struct Args { const float* in[24]; float* out; unsigned char* ws; int ph_lo, ph_hi, stop, li; };
constexpr int PH_PRO = 0, PH_MEMKV = 1, PH_MEMVT = 2, PH_L0 = 3, PPL = 17, NPHASE = PH_L0 + 2 * PPL;

#define PHASE_IDS unsigned char* ws = args.ws; asm volatile("" : "+s"(ws)); int bx = bx0, vcu = vcu0; asm volatile("" : "+s"(bx), "+s"(vcu)); const int gw = vcu * NWAVES + wave, NGW = G * NWAVES; (void)gw; (void)NGW; (void)bx; int lane_l; asm volatile("v_mbcnt_lo_u32_b32 %0, -1, 0\n\tv_mbcnt_hi_u32_b32 %0, -1, %0" : "=v"(lane_l)); const int lane = lane_l, tid = wave * 64 + lane; bf16* const H = (bf16*)(ws + WS_H); bf16* const Y = (bf16*)(ws + WS_Y); bf16* const XB = (bf16*)(ws + WS_XB); float* const RS = (float*)(ws + WS_RS); (void)H; (void)Y; (void)XB; (void)RS; (void)tid;
#define IN(k) (lo <= (k) && (k) < hi && (k) < stop)
#define SEAM(k) do { if ((k) + 1 < hi && (k) + 1 < stop) { XcdBarrier b2 = bar; asm volatile("" : "+s"(b2.bar), "+s"(b2.x)); xcd_barrier(b2); } } while (0)
template <int L> __device__ __forceinline__ void layer_phases(const Args& args, LAS unsigned char* lds, const XcdBarrier& bar, int wave, int G, int bx0, int vcu0, int lo, int hi, int stop) {
    const float* x_in = args.in[0]; const float* norm_pre = args.in[3]; const float* norm_post = args.in[4]; float* xout = args.out;

        const int base = PH_L0 + L * PPL;
        const float* gpre = norm_pre + (size_t)L * 4 * DM; const float* gpost = norm_post + (size_t)L * 4 * DM;
        if (IN(base + 0)) {
            PHASE_IDS
            pg8::StaticOrder S; S.init(MTOK, 5632, G, bx);
            if constexpr (L * 2 + 0 >= F8_FROM) {
                pg8::Gemm g{H, (const bf16*)(ws + WS_WGU) + (size_t)(L * 2 + 0) * 5632 * DM, MTOK, 5632, DM};
                pg8::EpiSwiGLU8 E{ws + WS_HID, DFF};
                pg8::gemm_phase<pg8::EpiSwiGLU8, pg8::StaticOrder, true, true, true>(lds, g, S, E, tid);
            } else {
                pg8::Gemm g{XB, (const bf16*)(ws + WS_WGU) + (size_t)(L * 2 + 0) * 5632 * DM, MTOK, 5632, DM};
                pg8::EpiSwiGLUR E{(bf16*)(ws + WS_HID), DFF, RS};
                pg8::gemm_phase<pg8::EpiSwiGLUR, pg8::StaticOrder, true, true>(lds, g, S, E, tid);
            }
            SEAM(base + 0);
        }
        if (IN(base + 1)) {
            PHASE_IDS
            pg8::StaticOrder S; S.init(MTOK, DM, G, bx);
            pg8::EpiBf16P E{Y, DM};
            if constexpr (L * 2 + 0 >= F8_FROM) {
                pg8::Gemm g{(const bf16*)(ws + WS_HID), (const bf16*)(ws + WS_WD) + (size_t)(L * 2 + 0) * DM * DFF, MTOK, DM, DFF};
                pg8::gemm_phase<pg8::EpiBf16P, pg8::StaticOrder, true, true, true>(lds, g, S, E, tid);
            } else {
                pg8::Gemm g{(const bf16*)(ws + WS_HID), (const bf16*)(ws + WS_WD) + (size_t)(L * 2 + 0) * DM * DFF, MTOK, DM, DFF};
                pg8::gemm_phase<pg8::EpiBf16P, pg8::StaticOrder, true, true>(lds, g, S, E, tid);
            }
            SEAM(base + 1);
        }
        if (IN(base + 2)) {
            PHASE_IDS
            rows_norm_phase(nullptr, nullptr, Y, 0.5f, gpost, L == 0 ? nullptr : gpre + DM, H, MTOK, gw, NGW, lane, L == 1, L * 2 + 0 >= F8_FROM ? 1.f / (pg8::F8S_W * pg8::F8S_HID) : 1.f, XB, XB, L == 0 ? RS : nullptr);
            SEAM(base + 2);
        }
        if (L == 0 && IN(base + 3)) {
            PHASE_IDS
            pg8::Gemm g{XB, (const bf16*)(ws + WS_EVIN), MTOK, EV_INP, DM};
            pg8::StaticOrder S; S.init(MTOK, EV_INP, G, bx);
            pg8::EpiBf16PR E{(bf16*)(ws + WS_P0), EV_INP, RS};
            pg8::gemm_phase<pg8::EpiBf16PR, pg8::StaticOrder, true, true>(lds, g, S, E, tid);
            SEAM(base + 3);
        }
        if (L == 0 && IN(base + 4)) {
            PHASE_IDS
            if (args.li == 0) { PHASE_IDS
            const bf16* P0 = (const bf16*)(ws + WS_P0);
            for (int it0 = vcu * 2; it0 < 512; it0 += G * 2) nsa_compress_pair(lds, P0, (const bf16*)(ws + WS_CWT), (const float*)(ws + WS_CBIAS), (bf16*)(ws + WS_KCMP), (bf16*)(ws + WS_VCMP), it0, wave, lane);
            }
            __syncthreads();
            { PHASE_IDS
            const bf16* P0 = (const bf16*)(ws + WS_P0);
            for (int u = vcu, i = 0; u < NB * 256; u += G, ++i) {
                int b, qt;
                if (G == 256) { b = vcu >> 4; const int sub = vcu & 15; qt = (i & 1) ? 16 * i + 15 - sub : 16 * i + sub; } else { b = u & 15; qt = u >> 4; }
                dsa_index_unit(lds, P0, (unsigned short*)(ws + WS_SEL), b, qt, tid, lane, wave);
            } }
            SEAM(base + 4);
        }
        if (L == 0 && IN(base + 5)) {
            PHASE_IDS
            build_bias_tables(lds, args.in[2], tid);
            __syncthreads();
            { PHASE_IDS
            const bf16* P0 = (const bf16*)(ws + WS_P0);
            for (int u = vcu, i = 0; u < NB * 2 * 64; u += G, ++i) {
                int bg, qt;
                if (G == 256) { bg = vcu >> 3; const int sub = vcu & 7; qt = (i & 1) ? 8 * i + 7 - sub : 8 * i + sub; } else { bg = u & 31; qt = u >> 5; }
                nsa_unit(lds, P0, (const bf16*)(ws + WS_KCMP), (const bf16*)(ws + WS_VCMP), H, bg >> 1, bg & 1, qt, tid, lane, wave);
            } }
            { PHASE_IDS
            const bf16* P0 = (const bf16*)(ws + WS_P0);
            for (int u = vcu, i = 0; u < NB * 128; u += G, ++i) {
                int b, qt;
                if (G == 256) { b = vcu >> 4; const int sub = vcu & 15; qt = (i & 1) ? 16 * i + 15 - sub : 16 * i + sub; } else { b = u & 15; qt = u >> 4; }
                dsa_unit(lds, P0, (const unsigned short*)(ws + WS_SEL), H, b, qt, tid, lane, wave);
            } }
            SEAM(base + 5);
        }
        if (L == 1 && IN(base + 3)) {
            PHASE_IDS
            pg8::Gemm g{H, (const bf16*)(ws + WS_ODIN), MTOK, OD_INP, DM};
            pg8::StaticOrder S; S.init(MTOK, OD_INP, G, bx);
            pg8::EpiBf16PS E{(bf16*)(ws + WS_P1), OD_INP, 1.f / (pg8::F8S_W * pg8::F8S_H)};
            pg8::gemm_phase<pg8::EpiBf16PS, pg8::StaticOrder, true, true, true>(lds, g, S, E, tid);
            SEAM(base + 3);
        }
        if (L == 1 && IN(base + 4)) {
            PHASE_IDS
            const bf16* P1 = (const bf16*)(ws + WS_P1);
            odd_prep_rows(P1, args.in[14], args.in[15], (const float*)(ws + WS_ROPE), (bf16*)(ws + WS_CQN), (bf16*)(ws + WS_CKVN), (bf16*)(ws + WS_KR), gw, NGW, lane);
            SEAM(base + 4);
        }
        if (L == 1 && IN(base + 5)) {
            PHASE_IDS
            { pg8::Gemm g{(const bf16*)(ws + WS_CQN), (const bf16*)(ws + WS_WUQ), MTOK, 768, 256};
              pg8::StaticOrder S; S.init(MTOK, 768, G, bx);
              pg8::EpiBf16P E{(bf16*)(ws + WS_QMLA), 768};
              pg8::gemm_phase<pg8::EpiBf16P, pg8::StaticOrder, true, true>(lds, g, S, E, tid); }
            __syncthreads();
            { pg8::Gemm g{(const bf16*)(ws + WS_CKVN), (const bf16*)(ws + WS_WUKV), MTOK, 1024, 256};
              pg8::StaticOrder S; S.init(MTOK, 1024, G, bx);
              pg8::EpiBf16P E{(bf16*)(ws + WS_KVMLA), 1024};
              pg8::gemm_phase<pg8::EpiBf16P, pg8::StaticOrder, true, true>(lds, g, S, E, tid); }
            SEAM(base + 5);
        }
        if (L == 1 && IN(base + 7)) {
            { PHASE_IDS
            build_bias_tables(lds, args.in[2], tid);
            __syncthreads();
            for (int u = vcu, i = 0; u < NB * 8 * 16; u += G, ++i) {
                int bh, qt;
                if (G == 256) { bh = vcu >> 1; const int sub = vcu & 1; qt = (i & 1) ? 2 * i + 1 - sub : 2 * i + sub; } else { bh = u & 127; qt = u >> 7; }
                mla_unit(lds, (const bf16*)(ws + WS_QMLA), (const bf16*)(ws + WS_KVMLA), (const bf16*)(ws + WS_KR), (const float*)(ws + WS_ROPE), H, bh >> 3, bh & 7, qt, tid, lane, wave);
            } }
            { PHASE_IDS
            for (int u = vcu, i = 0; u < NB * 4 * 16; u += G, ++i) {
                int bh, qt;
                if (G == 256) { bh = vcu >> 2; const int sub = vcu & 3; qt = (i & 1) ? 4 * i + 3 - sub : 4 * i + sub; } else { bh = u & 63; qt = u >> 6; }
                diff_unit(lds, (const bf16*)(ws + WS_P1), args.in[18], args.in[19], H, bh >> 2, bh & 3, qt, tid, lane, wave);
            } }
            SEAM(base + 7);
        }
        if (IN(base + 8)) {
            PHASE_IDS
            pg8::Gemm g{H, (const bf16*)(ws + (L == 0 ? WS_EVOUT : WS_ODOUT)), MTOK, DM, DM};
            pg8::StaticOrder S; S.init(MTOK, DM, G, bx);
            pg8::EpiBf16P E{Y, DM};
            pg8::gemm_phase<pg8::EpiBf16P, pg8::StaticOrder, true, true>(lds, g, S, E, tid);
            SEAM(base + 8);
        }
        if (IN(base + 9)) {
            PHASE_IDS
            rows_norm_phase(nullptr, nullptr, Y, 1.0f, gpost + DM, nullptr, H, MTOK, gw, NGW, lane, false, 1.f, XB, XB, RS);
            SEAM(base + 9);
        }
        if (IN(base + 10)) {
            PHASE_IDS
            pg8::Gemm g{XB, (const bf16*)(ws + WS_XWQ) + (size_t)L * 512 * DM, MTOK, 512, DM};
            pg8::StaticOrder S; S.init(MTOK, 512, G, bx);
            pg8::EpiBf16PR E{(bf16*)(ws + WS_XQ), 512, RS};
            pg8::gemm_phase<pg8::EpiBf16PR, pg8::StaticOrder, true, true>(lds, g, S, E, tid);
            SEAM(base + 10);
        }
        if (IN(base + 11)) {
            PHASE_IDS
            for (int u = vcu; u < NB * 4 * 16; u += G) {
                const int qt = u & 15, h = (u >> 4) & 3, b = u >> 6;
                xattn_unit(lds, (const bf16*)(ws + WS_XQ), (const bf16*)(ws + WS_KVM) + (size_t)L * MROWS * DM, H, b, h, qt, tid, lane, wave);
            }
            SEAM(base + 11);
        }
        if (IN(base + 12)) {
            PHASE_IDS
            pg8::Gemm g{H, (const bf16*)(ws + WS_XWO) + (size_t)L * DM * 512, MTOK, DM, 512};
            pg8::StaticOrder S; S.init(MTOK, DM, G, bx);
            pg8::EpiBf16P E{Y, DM};
            pg8::gemm_phase<pg8::EpiBf16P, pg8::StaticOrder, true, true>(lds, g, S, E, tid);
            SEAM(base + 12);
        }
        if (IN(base + 13)) {
            PHASE_IDS
            rows_norm_phase(nullptr, nullptr, Y, 1.0f, gpost + 2 * DM, gpre + 3 * DM, H, MTOK, gw, NGW, lane, L * 2 + 1 >= F8_FROM, 1.f, XB, XB);
            SEAM(base + 13);
        }
        if (IN(base + 14)) {
            PHASE_IDS
            pg8::StaticOrder S; S.init(MTOK, 5632, G, bx);
            if constexpr (L * 2 + 1 >= F8_FROM) {
                pg8::Gemm g{H, (const bf16*)(ws + WS_WGU) + (size_t)(L * 2 + 1) * 5632 * DM, MTOK, 5632, DM};
                pg8::EpiSwiGLU8 E{ws + WS_HID, DFF};
                pg8::gemm_phase<pg8::EpiSwiGLU8, pg8::StaticOrder, true, true, true>(lds, g, S, E, tid);
            } else {
                pg8::Gemm g{H, (const bf16*)(ws + WS_WGU) + (size_t)(L * 2 + 1) * 5632 * DM, MTOK, 5632, DM};
                pg8::EpiSwiGLU E{(bf16*)(ws + WS_HID), DFF};
                pg8::gemm_phase<pg8::EpiSwiGLU, pg8::StaticOrder, true, true>(lds, g, S, E, tid);
            }
            SEAM(base + 14);
        }
        if (IN(base + 15)) {
            PHASE_IDS
            pg8::StaticOrder S; S.init(MTOK, DM, G, bx);
            pg8::EpiBf16P E{Y, DM};
            if constexpr (L * 2 + 1 >= F8_FROM) {
                pg8::Gemm g{(const bf16*)(ws + WS_HID), (const bf16*)(ws + WS_WD) + (size_t)(L * 2 + 1) * DM * DFF, MTOK, DM, DFF};
                pg8::gemm_phase<pg8::EpiBf16P, pg8::StaticOrder, true, true, true>(lds, g, S, E, tid);
            } else {
                pg8::Gemm g{(const bf16*)(ws + WS_HID), (const bf16*)(ws + WS_WD) + (size_t)(L * 2 + 1) * DM * DFF, MTOK, DM, DFF};
                pg8::gemm_phase<pg8::EpiBf16P, pg8::StaticOrder, true, true>(lds, g, S, E, tid);
            }
            SEAM(base + 15);
        }
        if (IN(base + 16)) {
            PHASE_IDS
            rows_norm_phase(nullptr, L == 0 ? nullptr : xout, Y, 0.5f, gpost + 3 * DM, L == 0 ? norm_pre + 4 * DM : nullptr, H, MTOK, gw, NGW, lane, L * 2 + 2 >= F8_FROM, L * 2 + 1 >= F8_FROM ? 1.f / (pg8::F8S_W * pg8::F8S_HID) : 1.f, XB, L == 0 ? XB : nullptr);
            SEAM(base + 16);
        }
}


__global__ void __launch_bounds__(NWAVES * 64, 2) fwd_kernel(Args args) {
    extern __shared__ __attribute__((aligned(16))) unsigned char lds_raw[];
    LAS unsigned char* lds = (LAS unsigned char*)lds_raw;
    volatile LAS unsigned* MISC = (volatile LAS unsigned*)(lds + MISC_OFF);
    const int tid0 = threadIdx.x, wave = __builtin_amdgcn_readfirstlane(tid0 >> 6);
    const int G = gridDim.x, bx0 = blockIdx.x;
    const int vcu0 = (G % 8 == 0) ? (bx0 % 8) * (G / 8) + bx0 / 8 : bx0;
    unsigned* ctl = (unsigned*)(args.ws + WS_CTL);
    for (int u = tid0; u < (LDS_BYTES - LDSCTL_OFF) / 4; u += NWAVES * 64) ((LAS unsigned*)(lds + LDSCTL_OFF))[u] = 0u;
    __syncthreads();
    XcdBarrier bar = xcd_barrier_post(ctl + CW_BAR + args.li * XCD_BAR_WORDS, MISC + 8);
    const int lo = args.ph_lo, hi = args.ph_hi, stop = args.stop;

    const float* x_in = args.in[0]; const float* mem = args.in[1];
    const float* norm_pre = args.in[3]; const float* norm_post = args.in[4]; const float* mem_norm = args.in[5];
    float* xout = args.out;

    if (IN(PH_PRO)) {
            PHASE_IDS
        LAS float* scr = (LAS float*)(lds + wave * 16384);
        constexpr int I_GU = (DM / 64) * (DFF / 32), I_D = (DFF / 64) * (DM / 32);
        constexpr int I_EVIN = (DM / 64) * (EV_IN / 32), I_SQ = (DM / 64) * (DM / 32), I_ODIN = (DM / 64) * (OD_IN / 32);
        constexpr int I_UQ = (256 / 64) * (768 / 32), I_UKV = (128 / 64) * (1024 / 32), I_XQ = (DM / 64) * (512 / 32), I_XO = (512 / 64) * (DM / 32);
        constexpr int I_CW = (2048 / 64) * (64 / 32);
        constexpr int NITEMS = 8 * I_GU + 4 * I_D + I_EVIN + I_SQ + I_ODIN + I_SQ + I_UQ + I_UKV + 2 * I_XQ + 2 * I_SQ + 2 * I_XO + 2 * I_CW;
        for (int it = gw; it < NITEMS; it += NGW) {
            int r = it;
            if (r < 8 * I_GU) { const int mat = r / I_GU, rr = r % I_GU, which = mat & 1, ij = mat >> 1, nblk = DFF / 32, k0 = (rr / nblk) * 64, n0 = (rr % nblk) * 32;
                if (ij >= F8_FROM) tr_item8((which ? args.in[7] : args.in[6]) + (size_t)ij * DM * DFF, DFF, ws + WS_WGU + (size_t)ij * 5632 * DM * 2, DM, (n0 / 128) * 256 + which * 128 + (n0 % 128), scr, k0, n0, lane);
                else tr_item((which ? args.in[7] : args.in[6]) + (size_t)ij * DM * DFF, DFF, (bf16*)(ws + WS_WGU) + (size_t)ij * 5632 * DM, DM, (n0 / 128) * 256 + which * 128 + (n0 % 128), scr, k0, n0, lane, norm_pre);
                continue; } r -= 8 * I_GU;
            if (r < 4 * I_D) { const int mat = r / I_D, rr = r % I_D, nblk = DM / 32, k0 = (rr / nblk) * 64, n0 = (rr % nblk) * 32;
                if (mat >= F8_FROM) tr_item8(args.in[8] + (size_t)mat * DFF * DM, DM, ws + WS_WD + (size_t)mat * DM * DFF * 2, DFF, n0, scr, k0, n0, lane);
                else tr_item(args.in[8] + (size_t)mat * DFF * DM, DM, (bf16*)(ws + WS_WD) + (size_t)mat * DM * DFF, DFF, n0, scr, k0, n0, lane);
                continue; } r -= 4 * I_D;
            if (r < I_EVIN) { const int nblk = EV_IN / 32, k0 = (r / nblk) * 64, n0 = (r % nblk) * 32; tr_item(args.in[9], EV_IN, (bf16*)(ws + WS_EVIN), DM, n0, scr, k0, n0, lane, norm_pre + DM); continue; } r -= I_EVIN;
            if (r < I_SQ) { const int nblk = DM / 32, k0 = (r / nblk) * 64, n0 = (r % nblk) * 32; tr_item(args.in[12], DM, (bf16*)(ws + WS_EVOUT), DM, n0, scr, k0, n0, lane); continue; } r -= I_SQ;
            if (r < I_ODIN) { const int nblk = OD_IN / 32, k0 = (r / nblk) * 64, n0 = (r % nblk) * 32; tr_item8(args.in[13], OD_IN, ws + WS_ODIN, DM, n0, scr, k0, n0, lane); continue; } r -= I_ODIN;
            if (r < I_SQ) { const int nblk = DM / 32, k0 = (r / nblk) * 64, n0 = (r % nblk) * 32; tr_item(args.in[20], DM, (bf16*)(ws + WS_ODOUT), DM, n0, scr, k0, n0, lane); continue; } r -= I_SQ;
            if (r < I_UQ) { const int nblk = 768 / 32, k0 = (r / nblk) * 64, n0 = (r % nblk) * 32; tr_item(args.in[16], 768, (bf16*)(ws + WS_WUQ), 256, n0, scr, k0, n0, lane); continue; } r -= I_UQ;
            if (r < I_UKV) { const int nblk = 1024 / 32, k0 = (r / nblk) * 64, n0 = (r % nblk) * 32; tr_item(args.in[17], 1024, (bf16*)(ws + WS_WUKV), 256, n0, scr, k0, n0, lane); continue; } r -= I_UKV;
            if (r < 2 * I_XQ) { const int mat = r / I_XQ, rr = r % I_XQ, nblk = 512 / 32, k0 = (rr / nblk) * 64, n0 = (rr % nblk) * 32;
                tr_item(args.in[21] + (size_t)mat * DM * 512, 512, (bf16*)(ws + WS_XWQ) + (size_t)mat * 512 * DM, DM, n0, scr, k0, n0, lane, norm_pre + (size_t)(mat * 4 + 2) * DM); continue; } r -= 2 * I_XQ;
            if (r < 2 * I_SQ) { const int mat = r / I_SQ, rr = r % I_SQ, nblk = DM / 32, k0 = (rr / nblk) * 64, n0 = (rr % nblk) * 32;
                tr_item(args.in[22] + (size_t)mat * DM * DM, DM, (bf16*)(ws + WS_XWKV) + (size_t)mat * DM * DM, DM, n0, scr, k0, n0, lane); continue; } r -= 2 * I_SQ;
            if (r < 2 * I_XO) { const int mat = r / I_XO, rr = r % I_XO, nblk = DM / 32, k0 = (rr / nblk) * 64, n0 = (rr % nblk) * 32;
                tr_item(args.in[23] + (size_t)mat * 512 * DM, DM, (bf16*)(ws + WS_XWO) + (size_t)mat * DM * 512, 512, n0, scr, k0, n0, lane); continue; } r -= 2 * I_XO;
            { const int mat = r / I_CW, rr = r % I_CW, nblk = 64 / 32, k0 = (rr / nblk) * 64, n0 = (rr % nblk) * 32;
                tr_item(args.in[11] + (size_t)mat * 2048 * 64, 64, (bf16*)(ws + WS_CWT) + (size_t)mat * 64 * 2048, 2048, n0, scr, k0, n0, lane); }
        }
        { const int gt = vcu * (NWAVES * 64) + tid, NGT = G * NWAVES * 64; const v4u z = (v4u){0u, 0u, 0u, 0u};
          for (int i = gt; i < (EV_INP - EV_IN) * DM / 8; i += NGT) ((GAS v4u*)((bf16*)(ws + WS_EVIN) + (size_t)EV_IN * DM))[i] = z;
          for (int i = gt; i < (OD_INP - OD_IN) * DM / 16; i += NGT) ((GAS v4u*)(ws + WS_ODIN + (size_t)OD_IN * DM))[i] = z;
          for (int i = gt; i < 1024 * 16; i += NGT) ((GAS v4u*)((bf16*)(ws + WS_WUKV) + (size_t)(i >> 4) * 256 + 128))[i & 15] = z; }
        if (gw < 128) { const int c = gw >> 6, e = gw & 63; const float* pe = args.in[10] + (size_t)c * 2048; const float* cw = args.in[11] + (size_t)c * 2048 * 64 + e; float a = 0.f;
            for (int k = lane; k < 2048; k += 64) a += pe[k] * cw[(size_t)k * 64];
            a = wave_sum(a); if (lane == 0) ((float*)(ws + WS_CBIAS))[gw] = a; }
        rope_table_phase((float*)(ws + WS_ROPE), vcu * (NWAVES * 64) + tid, G * NWAVES * 64);
        rows_norm_phase(x_in, nullptr, nullptr, 0.f, nullptr, nullptr, H, MTOK, gw, NGW, lane, false, 1.f, nullptr, XB, RS);
        rows_norm_phase(mem, nullptr, nullptr, 0.f, nullptr, mem_norm, (bf16*)(ws + WS_MN), MROWS, gw, NGW, lane);
        rows_norm_phase(mem, nullptr, nullptr, 0.f, nullptr, mem_norm + DM, (bf16*)(ws + WS_MN) + (size_t)MROWS * DM, MROWS, gw, NGW, lane);
        SEAM(PH_PRO);
    }
    if (IN(PH_MEMKV)) {
            PHASE_IDS
#pragma unroll 1
        for (int i = 0; i < 2; ++i) {
            pg8::Gemm g{(const bf16*)(ws + WS_MN) + (size_t)i * MROWS * DM, (const bf16*)(ws + WS_XWKV) + (size_t)i * DM * DM, MROWS, DM, DM};
            pg8::StaticOrder S; S.init(MROWS, DM, G, (bx + 128 * i) % G);
            pg8::EpiBf16P E{(bf16*)(ws + WS_KVM) + (size_t)i * MROWS * DM, DM};
            pg8::gemm_phase<pg8::EpiBf16P, pg8::StaticOrder, true, true>(lds, g, S, E, tid);
            __syncthreads();
        }
        SEAM(PH_MEMKV);
    }
    layer_phases<0>(args, lds, bar, wave, G, bx0, vcu0, lo, hi, stop);
    layer_phases<1>(args, lds, bar, wave, G, bx0, vcu0, lo, hi, stop);
#undef IN
#undef SEAM
}

#ifndef MK_MODE
#define MK_MODE 1
#endif
#ifndef MK_STOP
#define MK_STOP NPHASE
#endif
extern "C" void kernel_launch(void* const* d_in, const int* in_sizes, int n_in, void* d_out, int out_size, void* d_ws, size_t ws_size, hipStream_t stream) {
    static int grid = 0;
    if (grid == 0) {
        if (n_in != 24 || out_size != MTOK * DM || ws_size < WS_END) { fprintf(stderr, "kernel_launch: unexpected shapes: n_in %d out %d ws %zu\n", n_in, out_size, ws_size); grid = -1; return; }
        int dev = 0, cus = 0, per_cu = 0;
        if (hipGetDevice(&dev) != hipSuccess || hipDeviceGetAttribute(&cus, hipDeviceAttributeMultiprocessorCount, dev) != hipSuccess) { grid = -1; return; }
        if (hipFuncSetAttribute((const void*)fwd_kernel, hipFuncAttributeMaxDynamicSharedMemorySize, LDS_BYTES) != hipSuccess) { fprintf(stderr, "kernel_launch: hipFuncSetAttribute failed\n"); grid = -1; return; }
        if (hipOccupancyMaxActiveBlocksPerMultiprocessor(&per_cu, (const void*)fwd_kernel, NWAVES * 64, LDS_BYTES) != hipSuccess || per_cu < 1)
            fprintf(stderr, "kernel_launch: occupancy query reports %d workgroups per CU\n", per_cu);
        (void)hipGetLastError();
        grid = cus;
    }
    if (grid < 0) return;
    if (hipMemsetAsync((char*)d_ws + WS_CTL, 0, CTL_ZERO_BYTES, stream) != hipSuccess) return;
    Args a{};
    for (int i = 0; i < 24; ++i) a.in[i] = (const float*)d_in[i];
    a.out = (float*)d_out; a.ws = (unsigned char*)d_ws; a.stop = MK_STOP;
#if MK_MODE == 1
    a.ph_lo = 0; a.ph_hi = NPHASE; a.li = 0;
    hipLaunchKernelGGL(fwd_kernel, dim3(grid), dim3(NWAVES * 64), LDS_BYTES, stream, a);
#else
    for (int p = 0; p < NPHASE && p < MK_STOP; ++p) {
        a.ph_lo = p; a.ph_hi = p + 1; a.li = 0;
        hipLaunchKernelGGL(fwd_kernel, dim3(grid), dim3(NWAVES * 64), LDS_BYTES, stream, a);
#ifdef MK_REP
        { const int k = p < PH_L0 ? -1 : (p - PH_L0) % PPL, L = p < PH_L0 ? -1 : (p - PH_L0) / PPL; (void)k; (void)L;
          if (MK_REP) { a.li = 1; hipLaunchKernelGGL(fwd_kernel, dim3(grid), dim3(NWAVES * 64), LDS_BYTES, stream, a); a.li = 0; } }
#endif
    }
#endif
}
```

```cpp
#include <hip/hip_runtime.h>
#include <cstdio>
#include <cstdint>
namespace pg8 {
#define PG8_LAS __attribute__((address_space(3)))
typedef unsigned short bf16_t;
typedef short bf16x8 __attribute__((ext_vector_type(8)));
typedef float f32x4 __attribute__((ext_vector_type(4)));
typedef unsigned u32x4 __attribute__((ext_vector_type(4)));
constexpr int BM = 256, BK = 64, HALF = 128, HTB = HALF * BK * 2  , STAGE_BYTES = 8 * HTB, NXCD = 8, WGM = 8;

__host__ __device__ __forceinline__ int lds_byte(int r, int c) { const int st = (r >> 4) * 2 + (c >> 5), rr = r & 15, cc = c & 31, ob = rr * 64 + cc * 2; return st * 1024 + (ob ^ (((ob >> 9) & 1) << 5)); }
__host__ __device__ __forceinline__ void stage_rc(int b, int& R, int& C) { const int st = b / 1024, sb = b % 1024, swz = sb ^ (((sb >> 9) & 1) << 5); R = (st >> 1) * 16 + swz / 64; C = (st & 1) * 32 + (swz % 64) / 2; }
__host__ __device__ __forceinline__ int perm32(int rho) { const int n = rho >> 4, i = rho & 15; return 8 * (i >> 2) + 4 * n + (i & 3); }

struct Unit { int pm, pn; };
struct Gemm { const bf16_t* A; const bf16_t* Bt; int M, N, K; };
typedef int i32x4 __attribute__((ext_vector_type(4)));
typedef int i32x8 __attribute__((ext_vector_type(8)));
__device__ __forceinline__ i32x8 cat8(bf16x8 a, bf16x8 b) { const i32x4 x = __builtin_bit_cast(i32x4, a), y = __builtin_bit_cast(i32x4, b); return __builtin_shufflevector(x, y, 0, 1, 2, 3, 4, 5, 6, 7); }

struct StaticOrder {
    int nM, nN, nwg, G, c;
    __host__ __device__ void init(int M, int N, int G_, int c_) { nM = M / BM; nN = N / BM; nwg = nM * nN; G = G_; c = c_; }
    __host__ __device__ bool next(int i, Unit& u) const {
        const long L = (long)i * G + c; if (L >= nwg) return false;
        int wgid = (int)L; { const int q = nwg / NXCD, r = nwg % NXCD, xcd = wgid % NXCD, off = wgid / NXCD; wgid = (xcd < r ? xcd * (q + 1) : r * (q + 1) + (xcd - r) * q) + off; }
        const int nig = WGM * nN, gid = wgid / nig, fm = gid * WGM, gsz = (nM - fm) < WGM ? (nM - fm) : WGM;
        u.pm = fm + ((wgid % nig) % gsz); u.pn = (wgid % nig) / gsz; return true;
    }
    __device__ __forceinline__ void a_ready(const Unit&) const {}
    __device__ __forceinline__ void done(const Unit&) const {}
};


__device__ __forceinline__ unsigned cvt_pk_bf16(float lo, float hi) { unsigned r; asm volatile("v_cvt_pk_bf16_f32 %0, %1, %2" : "=v"(r) : "v"(lo), "v"(hi)); return r; }

struct EpiF32 {
    static constexpr bool PERM = false, AFTER_DRAIN = false;
    float* C; int ldc;
    __device__ __forceinline__ void operator()(const f32x4 (&acc)[2][2][4][2], const Unit& u, int wr, int wc, int fr, int fq) const {
        const int row0 = u.pm * BM + wr * 64 + fr, col0 = u.pn * BM + wc * 32 + 4 * fq;
#pragma unroll
        for (int ai = 0; ai < 2; ++ai)
#pragma unroll
            for (int m = 0; m < 4; ++m) { float* rowp = C + (size_t)(row0 + ai * HALF + m * 16) * ldc + col0;
#pragma unroll
                for (int bj = 0; bj < 2; ++bj)
#pragma unroll
                    for (int n = 0; n < 2; ++n) *(f32x4*)(rowp + bj * HALF + n * 16) = acc[ai][bj][m][n]; }
    }
};
struct EpiBf16P {
    static constexpr bool PERM = true, AFTER_DRAIN = false;
    bf16_t* O; int ldc;
    __device__ __forceinline__ void operator()(const f32x4 (&acc)[2][2][4][2], const Unit& u, int wr, int wc, int fr, int fq) const {
        const int row0 = u.pm * BM + wr * 64 + fr, col0 = u.pn * BM + wc * 32 + 8 * fq;
#pragma unroll
        for (int ai = 0; ai < 2; ++ai)
#pragma unroll
            for (int m = 0; m < 4; ++m) { bf16_t* rowp = O + (size_t)(row0 + ai * HALF + m * 16) * ldc + col0;
#pragma unroll
                for (int bj = 0; bj < 2; ++bj) { const f32x4 v0 = acc[ai][bj][m][0], v1 = acc[ai][bj][m][1];
                    u32x4 w; w.x = cvt_pk_bf16(v0[0], v0[1]); w.y = cvt_pk_bf16(v0[2], v0[3]); w.z = cvt_pk_bf16(v1[0], v1[1]); w.w = cvt_pk_bf16(v1[2], v1[3]);
                    *(u32x4*)(rowp + bj * HALF) = w; } }
    }
};
__device__ __forceinline__ float silu_mul(float g, float u) { return g * __builtin_amdgcn_rcpf(1.0f + __builtin_amdgcn_exp2f(g * -1.4426950408889634f)) * u; }
struct EpiSwiGLU {
    static constexpr bool PERM = true, AFTER_DRAIN = false;
    bf16_t* O; int ldc;
    __device__ __forceinline__ void operator()(const f32x4 (&acc)[2][2][4][2], const Unit& u, int wr, int wc, int fr, int fq) const {
        const int row0 = u.pm * BM + wr * 64 + fr, col0 = u.pn * HALF + wc * 32 + 8 * fq;
#pragma unroll
        for (int ai = 0; ai < 2; ++ai)
#pragma unroll
            for (int m = 0; m < 4; ++m) { bf16_t* rowp = O + (size_t)(row0 + ai * HALF + m * 16) * ldc + col0;
                const f32x4 g0 = acc[ai][0][m][0], g1 = acc[ai][0][m][1], u0 = acc[ai][1][m][0], u1 = acc[ai][1][m][1];
                u32x4 w; w.x = cvt_pk_bf16(silu_mul(g0[0], u0[0]), silu_mul(g0[1], u0[1])); w.y = cvt_pk_bf16(silu_mul(g0[2], u0[2]), silu_mul(g0[3], u0[3]));
                w.z = cvt_pk_bf16(silu_mul(g1[0], u1[0]), silu_mul(g1[1], u1[1])); w.w = cvt_pk_bf16(silu_mul(g1[2], u1[2]), silu_mul(g1[3], u1[3]));
                *(u32x4*)rowp = w; }
    }
};


__device__ __forceinline__ unsigned pk4_fp8(float a, float b, float c, float d, float S) {
    a = __builtin_amdgcn_fmed3f(a * S, -448.f, 448.f); b = __builtin_amdgcn_fmed3f(b * S, -448.f, 448.f); c = __builtin_amdgcn_fmed3f(c * S, -448.f, 448.f); d = __builtin_amdgcn_fmed3f(d * S, -448.f, 448.f);
    int p = __builtin_amdgcn_cvt_pk_fp8_f32(a, b, 0, false); p = __builtin_amdgcn_cvt_pk_fp8_f32(c, d, p, true); return (unsigned)p;
}
constexpr float F8S_H = 4.f, F8S_HID = 8.f, F8S_W = 64.f;
struct EpiSwiGLU8 {
    static constexpr bool PERM = true, AFTER_DRAIN = false;
    unsigned char* O; int ldc;
    __device__ __forceinline__ void operator()(const f32x4 (&acc)[2][2][4][2], const Unit& u, int wr, int wc, int fr, int fq) const {
        const int row0 = u.pm * BM + wr * 64 + fr, col0 = u.pn * HALF + wc * 32 + 8 * fq;
#pragma unroll
        for (int ai = 0; ai < 2; ++ai)
#pragma unroll
            for (int m = 0; m < 4; ++m) { unsigned char* rowp = O + (size_t)(row0 + ai * HALF + m * 16) * ldc + col0;
                const f32x4 g0 = acc[ai][0][m][0], g1 = acc[ai][0][m][1], u0 = acc[ai][1][m][0], u1 = acc[ai][1][m][1];
                constexpr float GS = 1.f / (F8S_W * F8S_H), C1 = -1.4426950408889634f * GS, C2 = GS * GS * F8S_HID;
                const f32x4 t0 = g0 * C1, t1 = g1 * C1;
                f32x4 e0, e1;
#pragma unroll
                for (int i = 0; i < 4; ++i) { e0[i] = __builtin_amdgcn_rcpf(1.0f + __builtin_amdgcn_exp2f(t0[i])); e1[i] = __builtin_amdgcn_rcpf(1.0f + __builtin_amdgcn_exp2f(t1[i])); }
                const f32x4 h0 = (g0 * e0) * (u0 * C2), h1 = (g1 * e1) * (u1 * C2);
                uint2 w; w.x = pk4_fp8(h0[0], h0[1], h0[2], h0[3], 1.f); w.y = pk4_fp8(h1[0], h1[1], h1[2], h1[3], 1.f);
                *(uint2*)rowp = w; }
    }
};
struct EpiBf16PS {
    static constexpr bool PERM = true, AFTER_DRAIN = false;
    bf16_t* O; int ldc; float sc;
    __device__ __forceinline__ void operator()(const f32x4 (&acc)[2][2][4][2], const Unit& u, int wr, int wc, int fr, int fq) const {
        const int row0 = u.pm * BM + wr * 64 + fr, col0 = u.pn * BM + wc * 32 + 8 * fq;
#pragma unroll
        for (int ai = 0; ai < 2; ++ai)
#pragma unroll
            for (int m = 0; m < 4; ++m) { bf16_t* rowp = O + (size_t)(row0 + ai * HALF + m * 16) * ldc + col0;
#pragma unroll
                for (int bj = 0; bj < 2; ++bj) { const f32x4 v0 = acc[ai][bj][m][0] * sc, v1 = acc[ai][bj][m][1] * sc;
                    u32x4 w; w.x = cvt_pk_bf16(v0[0], v0[1]); w.y = cvt_pk_bf16(v0[2], v0[3]); w.z = cvt_pk_bf16(v1[0], v1[1]); w.w = cvt_pk_bf16(v1[2], v1[3]);
                    *(u32x4*)(rowp + bj * HALF) = w; } }
    }
};
struct EpiBf16PR {
    static constexpr bool PERM = true, AFTER_DRAIN = false;
    bf16_t* O; int ldc; const float* R;
    __device__ __forceinline__ void operator()(const f32x4 (&acc)[2][2][4][2], const Unit& u, int wr, int wc, int fr, int fq) const {
        const int row0 = u.pm * BM + wr * 64 + fr, col0 = u.pn * BM + wc * 32 + 8 * fq;
        float rs[2][4];
#pragma unroll
        for (int ai = 0; ai < 2; ++ai)
#pragma unroll
            for (int m = 0; m < 4; ++m) rs[ai][m] = R[row0 + ai * HALF + m * 16];
#pragma unroll
        for (int ai = 0; ai < 2; ++ai)
#pragma unroll
            for (int m = 0; m < 4; ++m) { bf16_t* rowp = O + (size_t)(row0 + ai * HALF + m * 16) * ldc + col0;
#pragma unroll
                for (int bj = 0; bj < 2; ++bj) { const f32x4 v0 = acc[ai][bj][m][0] * rs[ai][m], v1 = acc[ai][bj][m][1] * rs[ai][m];
                    u32x4 w; w.x = cvt_pk_bf16(v0[0], v0[1]); w.y = cvt_pk_bf16(v0[2], v0[3]); w.z = cvt_pk_bf16(v1[0], v1[1]); w.w = cvt_pk_bf16(v1[2], v1[3]);
                    *(u32x4*)(rowp + bj * HALF) = w; } }
    }
};
struct EpiSwiGLUR {
    static constexpr bool PERM = true, AFTER_DRAIN = false;
    bf16_t* O; int ldc; const float* R;
    __device__ __forceinline__ void operator()(const f32x4 (&acc)[2][2][4][2], const Unit& u, int wr, int wc, int fr, int fq) const {
        const int row0 = u.pm * BM + wr * 64 + fr, col0 = u.pn * HALF + wc * 32 + 8 * fq;
        float rs[2][4];
#pragma unroll
        for (int ai = 0; ai < 2; ++ai)
#pragma unroll
            for (int m = 0; m < 4; ++m) rs[ai][m] = R[row0 + ai * HALF + m * 16];
#pragma unroll
        for (int ai = 0; ai < 2; ++ai)
#pragma unroll
            for (int m = 0; m < 4; ++m) { bf16_t* rowp = O + (size_t)(row0 + ai * HALF + m * 16) * ldc + col0;
                const f32x4 g0 = acc[ai][0][m][0] * rs[ai][m], g1 = acc[ai][0][m][1] * rs[ai][m], u0 = acc[ai][1][m][0] * rs[ai][m], u1 = acc[ai][1][m][1] * rs[ai][m];
                u32x4 w; w.x = cvt_pk_bf16(silu_mul(g0[0], u0[0]), silu_mul(g0[1], u0[1])); w.y = cvt_pk_bf16(silu_mul(g0[2], u0[2]), silu_mul(g0[3], u0[3]));
                w.z = cvt_pk_bf16(silu_mul(g1[0], u1[0]), silu_mul(g1[1], u1[1])); w.w = cvt_pk_bf16(silu_mul(g1[2], u1[2]), silu_mul(g1[3], u1[3]));
                *(u32x4*)rowp = w; }
    }
};
template <class Epi, class Sched, bool ALIGN_EPI = false, bool SP2 = false, bool F8 = false>
__device__ __forceinline__ void gemm_phase(PG8_LAS unsigned char* lds, const Gemm g, const Sched& S, const Epi& E, int tid_in) {
    int tid_l = tid_in; asm volatile("" : "+v"(tid_l));
    const int tid = tid_l, wid = __builtin_amdgcn_readfirstlane(tid >> 6), lane = tid & 63, wr = wid >> 2, wc = wid & 3, fr = lane & 15, fq = lane >> 4;
    const int K = F8 ? g.K / 2 : g.K, nt = K / BK;
    unsigned voffA[2], voffB[2];
#pragma unroll
    for (int i = 0; i < 2; ++i) { int R, C; stage_rc(tid * 16 + i * 8192, R, C); const int Rb = Epi::PERM ? ((R & ~31) + perm32(R & 31)) : R;
        voffA[i] = (unsigned)(R * K + C) * 2u; voffB[i] = (unsigned)(Rb * K + C) * 2u; }
    const size_t kstep = (size_t)(BK * 2);
    const size_t hstep = (size_t)HALF * K * 2;
    const size_t tstep = 2 * hstep;
    const unsigned ldsw = (unsigned)wid * 1024u;
    const int aoff = lds_byte(wr * 64 + fr, fq * 8), boff = lds_byte(wc * 32 + fr, fq * 8);
#define PG8_SA(b, h) (((b) * 2 + (h)) * HTB)
#define PG8_SB(b, h) ((4 + (b) * 2 + (h)) * HTB)
#define PG8_STAGE(bufoff, gbase, voff) do { const char* _gb = (const char*)(gbase); if constexpr (F8) asm volatile("" : "+s"(_gb));     \
        _Pragma("unroll") for (int _i = 0; _i < 2; ++_i) \
        __builtin_amdgcn_global_load_lds((const unsigned*)(_gb + (voff)[_i]), (PG8_LAS unsigned*)(lds + (bufoff) + ldsw + _i * 8192), 16, 0, 0); } while (0)
#define PG8_LDA(dst, b, h) do { _Pragma("unroll") for (int m = 0; m < 4; ++m) _Pragma("unroll") for (int k = 0; k < 2; ++k) dst[m][k] = *(const PG8_LAS bf16x8*)(lds + PG8_SA(b, h) + aoff + m * 2048 + k * 1024); } while (0)
#define PG8_LDB(dst, b, h) do { _Pragma("unroll") for (int n = 0; n < 2; ++n) _Pragma("unroll") for (int k = 0; k < 2; ++k) dst[n][k] = *(const PG8_LAS bf16x8*)(lds + PG8_SB(b, h) + boff + n * 2048 + k * 1024); } while (0)
#define PG8_MMA(ai, bj, At, Bt) do { __builtin_amdgcn_s_setprio(1); _Pragma("unroll") for (int m = 0; m < 4; ++m) _Pragma("unroll") for (int n = 0; n < 2; ++n) _Pragma("unroll") for (int k = 0; k < 2; ++k) \
        acc[ai][bj][m][n] = __builtin_amdgcn_mfma_f32_16x16x32_bf16(Bt[n][k], At[m][k], acc[ai][bj][m][n], 0, 0, 0); __builtin_amdgcn_s_setprio(0); } while (0)
#define PG8_MMA8(ai, bj, At, Bt) do { __builtin_amdgcn_s_setprio(1); _Pragma("unroll") for (int m = 0; m < 4; ++m) _Pragma("unroll") for (int n = 0; n < 2; ++n) \
        acc[ai][bj][m][n] = __builtin_amdgcn_mfma_scale_f32_16x16x128_f8f6f4(cat8(Bt[n][0], Bt[n][1]), cat8(At[m][0], At[m][1]), acc[ai][bj][m][n], 0, 0, 0, 0, 0, 0); __builtin_amdgcn_s_setprio(0); } while (0)
#define PG8_MM(ai, bj, At, Bt) do { if constexpr (F8) PG8_MMA8(ai, bj, At, Bt); else PG8_MMA(ai, bj, At, Bt); } while (0)
#define PG8_WAIT_V(n) asm volatile("s_waitcnt vmcnt(" #n ")" ::: "memory")
#define PG8_WAIT_L(n) asm volatile("s_waitcnt lgkmcnt(" #n ")" ::: "memory")
#define PG8_BAR __builtin_amdgcn_s_barrier()
#define PG8_SCHED __builtin_amdgcn_sched_barrier(0)
    Unit cur, nxt; int ui = 0;
    if (!S.next(0, cur)) return;
    f32x4 acc[2][2][4][2];
#pragma unroll
    for (int a = 0; a < 2; ++a)
#pragma unroll
        for (int b = 0; b < 2; ++b)
#pragma unroll
            for (int m = 0; m < 4; ++m)
#pragma unroll
                for (int n = 0; n < 2; ++n) acc[a][b][m][n] = (f32x4){0.f, 0.f, 0.f, 0.f};
    bf16x8 At[4][2], B0[2][2], B1[2][2];
    const char* cA = (const char*)g.A + (size_t)cur.pm * tstep; const char* cB = (const char*)g.Bt + (size_t)cur.pn * tstep;
    S.a_ready(cur);
    if constexpr (SP2) {
        PG8_STAGE(PG8_SB(0, 0), cB, voffB); PG8_STAGE(PG8_SB(0, 1), cB + hstep, voffB); PG8_STAGE(PG8_SA(0, 0), cA, voffA); PG8_STAGE(PG8_SA(0, 1), cA + hstep, voffA);
        if (wr == 1) PG8_BAR;
        PG8_WAIT_V(2); PG8_BAR;
        PG8_STAGE(PG8_SB(1, 0), cB + kstep, voffB); PG8_STAGE(PG8_SA(1, 0), cA + kstep, voffA); PG8_STAGE(PG8_SB(1, 1), cB + hstep + kstep, voffB);
        PG8_WAIT_V(6); PG8_BAR;
    } else {
        PG8_STAGE(PG8_SB(0, 0), cB, voffB); PG8_STAGE(PG8_SA(0, 0), cA, voffA); PG8_STAGE(PG8_SB(0, 1), cB + hstep, voffB); PG8_STAGE(PG8_SA(0, 1), cA + hstep, voffA);
        if (wr == 1) PG8_BAR;
        PG8_WAIT_V(4); PG8_BAR;
        PG8_STAGE(PG8_SB(1, 0), cB + kstep, voffB); PG8_STAGE(PG8_SA(1, 0), cA + kstep, voffA); PG8_STAGE(PG8_SB(1, 1), cB + hstep + kstep, voffB);
        PG8_WAIT_V(6); PG8_BAR;
    }
    for (;;) {
        const bool has_next = S.next(ui + 1, nxt);
        const char* nA = has_next ? (const char*)g.A + (size_t)nxt.pm * tstep : cA; const char* nB = has_next ? (const char*)g.Bt + (size_t)nxt.pn * tstep : cB;
#pragma unroll 1
        for (int t = 0; t < nt; t += 2) {
            const bool last = (t == nt - 2);
            const char* a1 = cA + (size_t)(t + 1) * kstep;
            const char* a2 = last ? nA : cA + (size_t)(t + 2) * kstep; const char* b2 = last ? nB : cB + (size_t)(t + 2) * kstep;
            const char* a3 = a2 + kstep; const char* b3 = b2 + kstep;
            if (last && has_next) S.a_ready(nxt);
            if constexpr (SP2) {
            PG8_LDB(B0, 0, 0); PG8_LDB(B1, 0, 1); PG8_SCHED; PG8_LDA(At, 0, 0); PG8_STAGE(PG8_SA(1, 1), a1 + hstep, voffA);
            PG8_WAIT_V(8); PG8_WAIT_L(0); PG8_BAR; PG8_MM(0, 0, At, B0); PG8_MM(0, 1, At, B1); PG8_BAR; PG8_SCHED;
            PG8_LDA(At, 0, 1); PG8_STAGE(PG8_SB(0, 0), b2, voffB); PG8_STAGE(PG8_SB(0, 1), b2 + hstep, voffB); PG8_STAGE(PG8_SA(0, 0), a2, voffA);
            PG8_WAIT_V(8); PG8_WAIT_L(0); PG8_BAR; PG8_MM(1, 0, At, B0); PG8_MM(1, 1, At, B1); PG8_BAR; PG8_SCHED;
            PG8_LDB(B0, 1, 0); PG8_LDB(B1, 1, 1); PG8_SCHED; PG8_LDA(At, 1, 0); PG8_STAGE(PG8_SA(0, 1), a2 + hstep, voffA);
            PG8_WAIT_V(8); PG8_WAIT_L(0); PG8_BAR; PG8_MM(0, 0, At, B0); PG8_MM(0, 1, At, B1); PG8_BAR; PG8_SCHED;
            PG8_LDA(At, 1, 1); PG8_STAGE(PG8_SB(1, 0), b3, voffB); PG8_STAGE(PG8_SB(1, 1), b3 + hstep, voffB); PG8_STAGE(PG8_SA(1, 0), a3, voffA);
            PG8_WAIT_V(8); PG8_WAIT_L(0); PG8_BAR; PG8_MM(1, 0, At, B0); PG8_MM(1, 1, At, B1); PG8_BAR; PG8_SCHED;
            } else {
            PG8_LDB(B0, 0, 0); PG8_SCHED; PG8_LDA(At, 0, 0); PG8_STAGE(PG8_SA(1, 1), a1 + hstep, voffA);
            PG8_WAIT_L(8); PG8_BAR; PG8_WAIT_L(0); PG8_MM(0, 0, At, B0); PG8_BAR; PG8_SCHED;
            PG8_LDB(B1, 0, 1); PG8_STAGE(PG8_SB(0, 0), b2, voffB);
            PG8_BAR; PG8_WAIT_L(0); PG8_MM(0, 1, At, B1); PG8_BAR;
            PG8_LDA(At, 0, 1); PG8_STAGE(PG8_SA(0, 0), a2, voffA);
            PG8_BAR; PG8_WAIT_L(0); PG8_MM(1, 0, At, B0); PG8_BAR; PG8_SCHED;
            PG8_STAGE(PG8_SB(0, 1), b2 + hstep, voffB);
            PG8_WAIT_V(6); PG8_BAR; PG8_MM(1, 1, At, B1); PG8_BAR;
            PG8_LDB(B0, 1, 0); PG8_SCHED; PG8_LDA(At, 1, 0); PG8_STAGE(PG8_SA(0, 1), a2 + hstep, voffA);
            PG8_WAIT_L(8); PG8_BAR; PG8_WAIT_L(0); PG8_MM(0, 0, At, B0); PG8_BAR; PG8_SCHED;
            PG8_LDB(B1, 1, 1); PG8_STAGE(PG8_SB(1, 0), b3, voffB);
            PG8_BAR; PG8_WAIT_L(0); PG8_MM(0, 1, At, B1); PG8_BAR;
            PG8_LDA(At, 1, 1); PG8_STAGE(PG8_SA(1, 0), a3, voffA);
            PG8_BAR; PG8_WAIT_L(0); PG8_MM(1, 0, At, B0); PG8_BAR; PG8_SCHED;
            PG8_STAGE(PG8_SB(1, 1), b3 + hstep, voffB);
            PG8_WAIT_V(6); PG8_BAR; PG8_MM(1, 1, At, B1); PG8_BAR;
            }
        }
        if constexpr (ALIGN_EPI) { if (wr == 0) PG8_BAR; }
        if constexpr (!Epi::AFTER_DRAIN) {
            if constexpr (F8) { int l2; asm volatile("v_mbcnt_lo_u32_b32 %0, -1, 0\n\tv_mbcnt_hi_u32_b32 %0, -1, %0" : "=v"(l2)); E(acc, cur, wr, wc, l2 & 15, l2 >> 4); }
            else E(acc, cur, wr, wc, fr, fq);
            S.done(cur); }
        if (!has_next) break;
#pragma unroll
        for (int a = 0; a < 2; ++a)
#pragma unroll
            for (int b = 0; b < 2; ++b)
#pragma unroll
                for (int m = 0; m < 4; ++m)
#pragma unroll
                    for (int n = 0; n < 2; ++n) acc[a][b][m][n] = (f32x4){0.f, 0.f, 0.f, 0.f};
        cur = nxt; cA = nA; cB = nB; ++ui;
        if constexpr (ALIGN_EPI) { if (wr == 1) PG8_BAR; }
    }
    PG8_WAIT_V(0);
    if constexpr (!ALIGN_EPI) { if (wr == 0) PG8_BAR; }
    PG8_BAR;
    if constexpr (Epi::AFTER_DRAIN) { E.fused(acc, cur, wr, wc, fr, fq, lds, wid, lane); S.done(cur); }
#undef PG8_SA
#undef PG8_SB
#undef PG8_STAGE
#undef PG8_LDA
#undef PG8_LDB
#undef PG8_MMA
#undef PG8_MMA8
#undef PG8_MM
#undef PG8_WAIT_V
#undef PG8_WAIT_L
#undef PG8_BAR
#undef PG8_SCHED
}
}

constexpr int DM = 1024, NB = 16, SEQ = 4096, MTOK = NB * SEQ, DFF = 2816, MEML = 256, MROWS = NB * MEML;
constexpr int EV_IN = 2240, EV_INP = 2304, OD_IN = 1952, OD_INP = 2048;
constexpr float RMS_EPS = 1e-6f;
constexpr int NWAVES = 8;

constexpr size_t MiB = 1u << 20;
constexpr size_t WS_CTL = 0, CTL_ZERO_BYTES = 1 * MiB;
constexpr size_t WS_WGU = 2 * MiB;
constexpr size_t WS_WD = 46 * MiB;
constexpr size_t WS_EVIN = 68 * MiB;
constexpr size_t WS_EVOUT = 73 * MiB;
constexpr size_t WS_ODIN = 75 * MiB;
constexpr size_t WS_ODOUT = 79 * MiB;
constexpr size_t WS_WUQ = 81 * MiB;
constexpr size_t WS_WUKV = 82 * MiB;
constexpr size_t WS_XWQ = 83 * MiB;
constexpr size_t WS_XWKV = 85 * MiB;
constexpr size_t WS_XWO = 89 * MiB;
constexpr size_t WS_MN = 92 * MiB;
constexpr size_t WS_KVM = 108 * MiB;
constexpr size_t WS_VMT = 124 * MiB;
constexpr size_t WS_H = 132 * MiB;
constexpr size_t WS_Y = 260 * MiB;
constexpr size_t WS_OV = 516 * MiB;
constexpr size_t WS_END = 1024 * MiB;
constexpr size_t WS_HID = WS_OV;
constexpr size_t WS_XQ = WS_OV;

constexpr int CW_BAR = 4096;
constexpr int RING_BYTES = 131072, LDSCTL_OFF = RING_BYTES, MISC_OFF = LDSCTL_OFF + 320, LDS_BYTES = 147456;

#define GAS __attribute__((address_space(1)))
#define LAS __attribute__((address_space(3)))
typedef unsigned short bf16;
typedef unsigned v4u __attribute__((ext_vector_type(4)));
typedef unsigned v2u __attribute__((ext_vector_type(2)));
typedef float f32x4 __attribute__((ext_vector_type(4)));
typedef short bf16x8 __attribute__((ext_vector_type(8)));
#define LDS_WAIT() asm volatile("s_waitcnt lgkmcnt(0)" ::: "memory")
#define VM_WAIT() asm volatile("s_waitcnt vmcnt(0)" ::: "memory")
__device__ __forceinline__ unsigned f2bf(float f) { unsigned u = __builtin_bit_cast(unsigned, f); return (u + 0x7fffu + ((u >> 16) & 1u)) >> 16; }
__device__ __forceinline__ unsigned pk2(float lo, float hi) { return f2bf(lo) | (f2bf(hi) << 16); }
__device__ __forceinline__ float bf2f(unsigned short b) { return __builtin_bit_cast(float, (unsigned)b << 16); }
template <int K> __device__ __forceinline__ unsigned lx_u(unsigned v) {
    if constexpr (K == 32) { auto rr = __builtin_amdgcn_permlane32_swap(v, v, false, false); return rr[0] ^ rr[1] ^ v; }
    else return (unsigned)__builtin_amdgcn_ds_swizzle((int)v, (K << 10) | 0x1f);
}
template <int K> __device__ __forceinline__ float lx_f(float v) { return __uint_as_float(lx_u<K>(__float_as_uint(v))); }
__device__ __forceinline__ float wave_sum(float v) {
    v += lx_f<1>(v); v += lx_f<2>(v); v += lx_f<4>(v); v += lx_f<8>(v); v += lx_f<16>(v); v += lx_f<32>(v);
    return v;
}
__device__ __forceinline__ float fmx(float a, float b) { return __builtin_elementwise_maximum(a, b); }
__device__ __forceinline__ float fmx3(float a, float b, float c) { return __builtin_elementwise_maximum(__builtin_elementwise_maximum(a, b), c); }
__device__ __forceinline__ float fmn(float a, float b) { return __builtin_elementwise_minimum(a, b); }

#define XB_TMO      128
#define XB_XCNT(j)  (256  + 64 * (j))
#define XB_XSUB(j)  (1280 + 64 * (j))
#define XB_XGEN(j)  (2304 + 64 * (j))
#define XB_TOP      3328
#define XB_TOPGEN   3392
#define XCD_BAR_WORDS 3456
#define XB_SPIN_CAP (1u << 18)

__device__ __forceinline__ unsigned xb_ld(unsigned* p)              { return __hip_atomic_load(p, __ATOMIC_RELAXED, __HIP_MEMORY_SCOPE_AGENT); }
__device__ __forceinline__ unsigned xb_add(unsigned* p, unsigned v) { return __hip_atomic_fetch_add(p, v, __ATOMIC_RELAXED, __HIP_MEMORY_SCOPE_AGENT); }
__device__ __forceinline__ unsigned xb_xcc_id() { return (unsigned)__builtin_amdgcn_s_getreg((3 << 11) | 20) & 0xFu; }
#define XB_SPIN(cond, bar) do { unsigned _sp = 0; while (cond) { __builtin_amdgcn_s_sleep(1); \
    if ((++_sp & 255u) == 0u) { if (xb_ld(&(bar)[XB_TMO])) break; if (_sp > XB_SPIN_CAP) { atomicAdd(&(bar)[XB_TMO], 1u); break; } } } } while (0)

struct XcdBarrier {
    unsigned* bar; unsigned x;
    unsigned w0;
    volatile LAS unsigned* st;
};

__device__ __forceinline__ XcdBarrier xcd_barrier_post(unsigned* bar, volatile LAS unsigned* st) {
    XcdBarrier b; b.bar = bar; b.x = xb_xcc_id(); b.st = st; b.w0 = (unsigned)__builtin_amdgcn_readfirstlane((threadIdx.x >> 6) == 0 ? 1 : 0);
    if (threadIdx.x == 0) (void)xb_add(&bar[XB_XCNT(b.x)], 1u);
    return b;
}
__device__ __forceinline__ void xcd_barrier_complete(unsigned* bar, unsigned x, unsigned& nloc, unsigned& nx) {
    const unsigned G = gridDim.x * gridDim.y * gridDim.z;
    unsigned sum, cnt, mine, sp = 0u;
    for (;;) {
        sum = 0u; cnt = 0u; mine = 0u;
#pragma unroll
        for (unsigned j = 0; j < 16; ++j) { const unsigned c = xb_ld(&bar[XB_XCNT(j)]); sum += c; cnt += (c > 0u) ? 1u : 0u; mine = (j == x) ? c : mine; }
        if (sum == G) break;
        __builtin_amdgcn_s_sleep(1);
        if ((++sp & 255u) == 0u) { if (xb_ld(&bar[XB_TMO])) break; if (sp > XB_SPIN_CAP) { atomicAdd(&bar[XB_TMO], 1u); break; } }
    }
    nloc = mine > 0u ? mine : 1u; nx = cnt > 0u ? cnt : 1u;
}

__device__ __forceinline__ void xcd_barrier(const XcdBarrier& b) {
    asm volatile("s_waitcnt vmcnt(0)" ::: "memory");
    __syncthreads();
    unsigned xb_lane; asm volatile("v_mbcnt_lo_u32_b32 %0, -1, 0\n\tv_mbcnt_hi_u32_b32 %0, -1, %0" : "=v"(xb_lane));
    if (b.w0 != 0u && xb_lane == 0u) {
        unsigned* bar = b.bar;
        __builtin_amdgcn_s_waitcnt(0);
        unsigned nloc = b.st[0], nx = b.st[1];
        if (nloc == 0u) { xcd_barrier_complete(bar, b.x, nloc, nx); b.st[0] = nloc; b.st[1] = nx; }
        const unsigned old = xb_add(&bar[XB_XSUB(b.x)], 1u);
        const unsigned gen = old / nloc;
        if (old + 1u == (gen + 1u) * nloc) {
            __builtin_amdgcn_fence(__ATOMIC_RELEASE, "agent");
            asm volatile("s_waitcnt vmcnt(0)" ::: "memory");
            const unsigned og = xb_add(&bar[XB_TOP], 1u);
            const unsigned tg = og / nx;
            if (og + 1u == (tg + 1u) * nx) xb_add(&bar[XB_TOPGEN], 1u);
            else XB_SPIN(xb_ld(&bar[XB_TOPGEN]) == tg, bar);
            __builtin_amdgcn_fence(__ATOMIC_ACQUIRE, "agent");
            xb_add(&bar[XB_XGEN(b.x)], 1u);
            asm volatile("s_waitcnt vmcnt(0)" ::: "memory");
        } else {
            XB_SPIN(xb_ld(&bar[XB_XGEN(b.x)]) == gen, bar);
            __builtin_amdgcn_fence(__ATOMIC_ACQUIRE, "agent");
            asm volatile("s_waitcnt vmcnt(0)" ::: "memory");
        }
    }
    __syncthreads();
}


typedef float f32x16 __attribute__((ext_vector_type(16)));
typedef short s16x4 __attribute__((ext_vector_type(4)));
constexpr float NEGBIG = -1e30f, LOG2E = 1.4426950408889634f;
constexpr int KP128 = 272, KBUF_BYTES = 64 * KP128, VBUF_BYTES = 64 * KP128;
constexpr int AT_KBUF = 0, AT_VBUF = 2 * KBUF_BYTES, AT_BT = AT_VBUF + 2 * VBUF_BYTES, BT_STRIDE = 132, AT_WS = AT_BT + 20 * BT_STRIDE * 4, AT_WS_PER_WAVE = 4096;
static_assert(AT_WS + 8 * AT_WS_PER_WAVE <= RING_BYTES, "attention LDS map");
__device__ __forceinline__ int crow(int r, int hi) { return (r & 3) + 8 * (r >> 2) + 4 * hi; }
typedef float f32x2_t __attribute__((ext_vector_type(2))); typedef __bf16 bf16x2_t __attribute__((ext_vector_type(2)));
__device__ __forceinline__ unsigned cvtpk(float lo, float hi) { f32x2_t v = {lo, hi}; bf16x2_t b = __builtin_convertvector(v, bf16x2_t); return __builtin_bit_cast(unsigned, b); }
typedef float f32x8_t __attribute__((ext_vector_type(8)));
typedef float f32x2_t __attribute__((ext_vector_type(2)));
__device__ __forceinline__ float vsum32(const f32x16 (&s)[2]) {
    const f32x16 a = s[0] + s[1]; const f32x8_t b = a.lo + a.hi; const f32x4 c = b.lo + b.hi; const f32x2_t d = c.lo + c.hi; return d.x + d.y;
}
__device__ __forceinline__ float swapmax(float v) { auto rr = __builtin_amdgcn_permlane32_swap(__float_as_uint(v), __float_as_uint(v), false, false); return fmx(__uint_as_float(rr[0]), __uint_as_float(rr[1])); }
__device__ __forceinline__ float swapsum(float v) { auto rr = __builtin_amdgcn_permlane32_swap(__float_as_uint(v), __float_as_uint(v), false, false); return __uint_as_float(rr[0]) + __uint_as_float(rr[1]); }
__device__ __forceinline__ float swapget(float v) { return lx_f<32>(v); }

struct KVSrc {
    const bf16* ka; int kpa;
    const bf16* kb; int kpb;
    const bf16* v; int vp;
};
template <int DQK, int KA, int DV> struct Stage {
    static constexpr int CPR = DQK / 8, NKC = 64 * CPR, NKI = (NKC + 511) / 512, CPV = DV / 8, NVC = 64 * CPV, NVI = (NVC + 511) / 512, KP = DQK * 2 + 16, VP = DV * 2 + 16;
    v4u k[NKI]; v4u v[NVI];
    __device__ __forceinline__ void load(const KVSrc& s, int kt, int tid) {
#pragma unroll
        for (int i = 0; i < NKI; ++i) { const int c = tid + 512 * i; if (NKC % 512 == 0 || c < NKC) { const int row = c / CPR, cc = c % CPR;
            const bf16* p = (KA == DQK || cc < KA / 8) ? s.ka + (size_t)(64 * kt + row) * s.kpa + 8 * cc : s.kb + (size_t)(64 * kt + row) * s.kpb + 8 * (cc - KA / 8);
            k[i] = *(const GAS v4u*)p; } }
#pragma unroll
        for (int i = 0; i < NVI; ++i) { const int c = tid + 512 * i; if (NVC % 512 == 0 || c < NVC) { const int row = c / CPV, cc = c % CPV;
            v[i] = *(const GAS v4u*)(s.v + (size_t)(64 * kt + row) * s.vp + 8 * cc); } }
    }
    __device__ __forceinline__ void store(LAS unsigned char* lds, int buf, int tid) const {
#pragma unroll
        for (int i = 0; i < NKI; ++i) { const int c = tid + 512 * i; if (NKC % 512 == 0 || c < NKC) { const int row = c / CPR, cc = c % CPR;
            *(LAS v4u*)(lds + AT_KBUF + buf * KBUF_BYTES + row * KP + 16 * cc) = k[i]; } }
#pragma unroll
        for (int i = 0; i < NVI; ++i) { const int c = tid + 512 * i; if (NVC % 512 == 0 || c < NVC) { const int row = c / CPV, cc = c % CPV;
            *(LAS v4u*)(lds + AT_VBUF + buf * VBUF_BYTES + row * VP + 16 * cc) = v[i]; } }
    }
};
template <int DQK, int GR = 0> __device__ __forceinline__ void qk_tile(const LAS unsigned char* kbuf, const bf16x8 (&qf)[DQK / 16], f32x16 (&s)[2], int lane, const f32x16 c0 = (f32x16){}) {
    constexpr int KP = DQK * 2 + 16, ND = DQK / 16, G = GR ? GR : 2;
    const int r32 = lane & 31, hi = lane >> 5;
    s[0] = c0; s[1] = c0;
#pragma unroll
    for (int g = 0; g < ND / G; ++g) {
        bf16x8 kf[2][G];
#pragma unroll
        for (int d = 0; d < G; ++d)
#pragma unroll
            for (int st = 0; st < 2; ++st) kf[st][d] = *(const LAS bf16x8*)(kbuf + (32 * st + r32) * KP + 32 * (g * G + d) + 16 * hi);
        __builtin_amdgcn_sched_barrier(0);
#pragma unroll
        for (int d = 0; d < G; ++d)
#pragma unroll
            for (int st = 0; st < 2; ++st) s[st] = __builtin_amdgcn_mfma_f32_32x32x16_bf16(kf[st][d], qf[g * G + d], s[st], 0, 0, 0);
    }
}
__device__ __forceinline__ float softmax_tile(f32x16 (&s)[2], float& m, float& l) {
    float mx = NEGBIG;
#pragma unroll
    for (int r = 0; r < 16; ++r) mx = fmx3(mx, s[0][r], s[1][r]);
    mx = swapmax(mx);
    const float mn = fmx(m, mx), alpha = __builtin_amdgcn_exp2f(m - mn), ms = fmx(mn, -1e29f);
    m = mn; { const float nms = -ms; s[0] = s[0] + nms; s[1] = s[1] + nms; }
#pragma unroll
    for (int st = 0; st < 2; ++st)
#pragma unroll
        for (int r = 0; r < 16; ++r) s[st][r] = __builtin_amdgcn_exp2f(s[st][r]);
    const float rs = vsum32(s);
    l = l * alpha + rs;
    return alpha;
}
struct VFrag { bf16x8 f[2][4]; };
typedef short v4i16_t __attribute__((ext_vector_type(4)));
template <int VP> __device__ __forceinline__ void pv_load(const LAS unsigned char* vbuf, int dp, VFrag& v, int lane) {
    const int g = lane >> 4, q = (lane & 15) >> 2, p = lane & 3;
    const LAS unsigned char* base = vbuf + (4 * (g >> 1) + q) * VP + (16 * (g & 1) + 4 * p) * 2;
#pragma unroll
    for (int k = 0; k < 4; ++k)
#pragma unroll
        for (int d2 = 0; d2 < 2; ++d2) {
            const v4i16_t lo = __builtin_amdgcn_ds_read_tr16_b64_v4i16((LAS v4i16_t*)(base + (16 * k) * VP + 64 * (2 * dp + d2)));
            const v4i16_t hh = __builtin_amdgcn_ds_read_tr16_b64_v4i16((LAS v4i16_t*)(base + (16 * k + 8) * VP + 64 * (2 * dp + d2)));
            v.f[d2][k] = (bf16x8){lo[0], lo[1], lo[2], lo[3], hh[0], hh[1], hh[2], hh[3]}; }
}
__device__ __forceinline__ void p_pack(const f32x16 (&p)[2], bf16x8 (&pf)[4]) {
#pragma unroll
    for (int k = 0; k < 4; ++k) { const int st = k >> 1, s = k & 1; v4u w; w.x = cvtpk(p[st][8 * s + 0], p[st][8 * s + 1]); w.y = cvtpk(p[st][8 * s + 2], p[st][8 * s + 3]); w.z = cvtpk(p[st][8 * s + 4], p[st][8 * s + 5]); w.w = cvtpk(p[st][8 * s + 6], p[st][8 * s + 7]);
        pf[k] = __builtin_bit_cast(bf16x8, w); }
}
__device__ __forceinline__ void pv_mma(const VFrag& v, const bf16x8 (&pf)[4], f32x16& o0, f32x16& o1) {
#pragma unroll
    for (int k = 0; k < 4; ++k) { o0 = __builtin_amdgcn_mfma_f32_32x32x16_bf16(v.f[0][k], pf[k], o0, 0, 0, 0); o1 = __builtin_amdgcn_mfma_f32_32x32x16_bf16(v.f[1][k], pf[k], o1, 0, 0, 0); }
}
template <int DV> __device__ __forceinline__ void pv_tile(const LAS unsigned char* vbuf, const f32x16 (&p)[2], f32x16 (&o)[DV / 32], int lane) {
    bf16x8 pf[4]; p_pack(p, pf);
#pragma unroll
    for (int dp = 0; dp < DV / 64; ++dp) { VFrag v; pv_load<DV * 2 + 16>(vbuf, dp, v, lane); __builtin_amdgcn_sched_barrier(0); pv_mma(v, pf, o[2 * dp], o[2 * dp + 1]); }
}
constexpr float DEFER_THR = 8.0f;
struct SmState { float mhat, l; bool started; };
template <int DQK, int DV, class F, bool EARLYV>
__device__ __forceinline__ void attn_tile(LAS unsigned char* lds, int buf, int kt, const bf16x8 (&qf)[DQK / 16], F& f, f32x16 (&o)[DV / 32], SmState& S, f32x16& negm, int lane) {
    f32x16 s[2];
    qk_tile<DQK>(lds + AT_KBUF + buf * KBUF_BYTES, qf, s, lane, negm);
    const LAS unsigned char* vbuf = lds + AT_VBUF + buf * VBUF_BYTES;
    VFrag vfr;
    if constexpr (DV == 64 && EARLYV) { pv_load<DV * 2 + 16>(vbuf, 0, vfr, lane); __builtin_amdgcn_sched_barrier(0); }
    f.apply(s, kt);
    float mx = NEGBIG;
#pragma unroll
    for (int r = 0; r < 16; ++r) mx = fmx3(mx, s[0][r], s[1][r]);
    mx = swapmax(mx);
    const bool need = S.started ? (mx > DEFER_THR) : (mx > -1e29f);
    if (__any(need)) {
        const float delta = need ? mx : 0.f, fac = (need && S.started) ? __builtin_amdgcn_exp2f(-delta) : 1.f;
        S.mhat += delta; S.l *= fac; S.started = S.started || need;
#pragma unroll
        for (int st = 0; st < 2; ++st)
#pragma unroll
            for (int r = 0; r < 16; ++r) s[st][r] -= delta;
#pragma unroll
        for (int dt = 0; dt < DV / 32; ++dt) o[dt] = o[dt] * fac;
#pragma unroll
        for (int r = 0; r < 16; ++r) negm[r] = -S.mhat;
    }
#pragma unroll
    for (int st = 0; st < 2; ++st)
#pragma unroll
        for (int r = 0; r < 16; ++r) s[st][r] = __builtin_amdgcn_exp2f(s[st][r]);
    S.l += vsum32(s);
    bf16x8 pf[4]; p_pack(s, pf);
#pragma unroll
    for (int dp = 0; dp < DV / 64; ++dp) {
        if constexpr (!(DV == 64 && EARLYV)) { pv_load<DV * 2 + 16>(vbuf, dp, vfr, lane); __builtin_amdgcn_sched_barrier(0); }
        pv_mma(vfr, pf, o[2 * dp], o[2 * dp + 1]);
    }
}
template <int DQK, int KA, int DV, class F, bool EARLYV = true, bool DEEP = false>
__device__ __forceinline__ void attn_loop(LAS unsigned char* lds, const KVSrc& kv, int kt0, int kt1, const bf16x8 (&qf)[DQK / 16], F& f, f32x16 (&o)[DV / 32], SmState& S, int tid, int lane) {
    if (kt0 >= kt1) return;
    Stage<DQK, KA, DV> sg0;
    __syncthreads();
    sg0.load(kv, kt0, tid); sg0.store(lds, 0, tid);
    f32x16 negm;
#pragma unroll
    for (int r = 0; r < 16; ++r) negm[r] = -S.mhat;
    if constexpr (DEEP) {
        Stage<DQK, KA, DV> sg1;
        if (kt0 + 1 < kt1) sg1.load(kv, kt0 + 1, tid);
        __syncthreads();
        for (int kt = kt0; kt < kt1; kt += 2) {
            if (kt + 2 < kt1) { sg0.load(kv, kt + 2, tid); f.pre(kt + 2); }
            if (!f.skip(kt)) attn_tile<DQK, DV, F, EARLYV>(lds, 0, kt, qf, f, o, S, negm, lane);
            if (kt + 1 < kt1) sg1.store(lds, 1, tid);
            __syncthreads();
            if (kt + 1 < kt1) {
                if (kt + 3 < kt1) { sg1.load(kv, kt + 3, tid); f.pre(kt + 3); }
                if (!f.skip(kt + 1)) attn_tile<DQK, DV, F, EARLYV>(lds, 1, kt + 1, qf, f, o, S, negm, lane);
                if (kt + 2 < kt1) sg0.store(lds, 0, tid);
                __syncthreads();
            }
        }
    } else {
        __syncthreads();
        for (int kt = kt0; kt < kt1; ++kt) {
            const int buf = (kt - kt0) & 1;
            if (kt + 1 < kt1) { sg0.load(kv, kt + 1, tid); f.pre(kt + 1); }
            if (!f.skip(kt)) attn_tile<DQK, DV, F, EARLYV>(lds, buf, kt, qf, f, o, S, negm, lane);
            if (kt + 1 < kt1) sg0.store(lds, buf ^ 1, tid);
            __syncthreads();
        }
    }
}
__device__ __forceinline__ void build_bias_tables(LAS unsigned char* lds, const float* tab, int tid) {
    LAS float* BT = (LAS float*)(lds + AT_BT);
    for (int i = tid; i < 20 * 129; i += NWAVES * 64) { const int h = i / 129, d = i % 129;
        int b = d; if (d >= 16) { b = 16 + (int)(__log2f((float)d * 0.0625f) * (16.0f / 3.0f)); b = b > 31 ? 31 : b; }
        BT[h * BT_STRIDE + d] = (tab[b * 20 + h] - tab[31 * 20 + h]) * LOG2E; }
}
template <int DV> __device__ __forceinline__ void store_ot(bf16* orow, const f32x16 (&o)[DV / 32], float scale, int lane) {
    const int hi = lane >> 5;
#pragma unroll
    for (int dt = 0; dt < DV / 32; ++dt)
#pragma unroll
        for (int r4 = 0; r4 < 4; ++r4) { v2u w; w.x = cvtpk(o[dt][4 * r4 + 0] * scale, o[dt][4 * r4 + 1] * scale); w.y = cvtpk(o[dt][4 * r4 + 2] * scale, o[dt][4 * r4 + 3] * scale);
            *(GAS v2u*)(orow + 32 * dt + 8 * r4 + 4 * hi) = w; }
}
template <int DQK> __device__ __forceinline__ void load_q(const bf16* qrow, bf16x8 (&qf)[DQK / 16], int lane) {
    const int hi = lane >> 5;
#pragma unroll
    for (int d0 = 0; d0 < DQK / 16; ++d0) qf[d0] = *(const GAS bf16x8*)(qrow + 16 * d0 + 8 * hi);
}
__device__ __forceinline__ bf16x8 scale_frag(bf16x8 a, float sc) {
    v4u w;
    w.x = cvtpk(bf2f((unsigned short)a[0]) * sc, bf2f((unsigned short)a[1]) * sc); w.y = cvtpk(bf2f((unsigned short)a[2]) * sc, bf2f((unsigned short)a[3]) * sc);
    w.z = cvtpk(bf2f((unsigned short)a[4]) * sc, bf2f((unsigned short)a[5]) * sc); w.w = cvtpk(bf2f((unsigned short)a[6]) * sc, bf2f((unsigned short)a[7]) * sc);
    return __builtin_bit_cast(bf16x8, w);
}
template <int DQK> __device__ __forceinline__ void load_q_scaled(const bf16* qrow, bf16x8 (&qf)[DQK / 16], float sc, int lane) {
    load_q<DQK>(qrow, qf, lane);
#pragma unroll
    for (int d0 = 0; d0 < DQK / 16; ++d0) qf[d0] = scale_frag(qf[d0], sc);
}

struct FPlain { __device__ __forceinline__ void pre(int) {} __device__ __forceinline__ bool skip(int) const { return false; }
    __device__ __forceinline__ void apply(f32x16 (&)[2], int) {} };
__device__ __forceinline__ void xattn_unit(LAS unsigned char* lds, const bf16* XQ, const bf16* KVM, bf16* O, int b, int h, int qt, int tid_in, int lane_in, int wave) {
    int lane = lane_in; asm volatile("" : "+v"(lane)); const int tid = wave * 64 + lane; (void)tid_in;
    const int t = qt * 256 + wave * 32 + (lane & 31);
    bf16x8 qf[8]; load_q_scaled<128>(XQ + (size_t)(b * SEQ + t) * 512 + h * 128, qf, 0.08838834764831845f * LOG2E, lane);
    KVSrc kv{KVM + (size_t)(b * MEML) * DM + h * 128, DM, nullptr, 0, KVM + (size_t)(b * MEML) * DM + 512 + h * 128, DM};
    f32x16 o[4] = {}; SmState S{0.f, 0.f, false};
    FPlain f;
    attn_loop<128, 128, 128, FPlain>(lds, kv, 0, MEML / 64, qf, f, o, S, tid, lane);
    const float lt = swapsum(S.l);
    store_ot<128>(O + (size_t)(b * SEQ + t) * 512 + h * 128, o, lt > 0.f ? 1.f / lt : 0.f, lane);
}


constexpr int C_QA = 0, C_KVA = 512, C_GA = 1280, C_QB = 1304, C_KB = 1816, C_VB = 1880, C_IQ = 1944, C_IK = 2200, C_IW = 2232;
constexpr size_t WS_CWT = 91 * MiB;
constexpr size_t WS_CBIAS = 91 * MiB + 512 * 1024;
constexpr size_t WS_P0 = WS_OV, WS_KCMP = WS_OV + 288 * MiB, WS_VCMP = WS_OV + 289 * MiB, WS_SEL = WS_OV + 330 * MiB;
static_assert(WS_SEL + 32 * MiB <= WS_END, "even overlay");

__device__ __forceinline__ void nsa_compress_item(const bf16* P0, const bf16* CWT, const float* CBIAS, bf16* KCMP, bf16* VCMP, int item, int lane) {
    const int nt = item & 7, g = (item >> 3) & 1, b = (item >> 4) & 15, c = item >> 8;
    const int r32 = lane & 31, hi = lane >> 5, n = nt * 32 + r32, nc = n > 254 ? 254 : n;
    const bf16* ap = P0 + (size_t)(b * SEQ + 16 * nc) * EV_INP + C_KVA + c * 128 + g * 64 + 8 * hi;
    const bf16* bp = CWT + (size_t)(c * 64 + r32) * 2048 + 8 * hi;
    f32x16 acc[2] = {};
#pragma unroll 4
    for (int kk = 0; kk < 128; ++kk) {
        const bf16x8 a = *(const GAS bf16x8*)(ap + (size_t)(kk >> 2) * EV_INP + (kk & 3) * 16);
        const bf16x8 b0 = *(const GAS bf16x8*)(bp + kk * 16), b1 = *(const GAS bf16x8*)(bp + 32 * 2048 + kk * 16);
        acc[0] = __builtin_amdgcn_mfma_f32_32x32x16_bf16(a, b0, acc[0], 0, 0, 0);
        acc[1] = __builtin_amdgcn_mfma_f32_32x32x16_bf16(a, b1, acc[1], 0, 0, 0);
    }
#pragma unroll
    for (int eh = 0; eh < 2; ++eh) { const int e = 32 * eh + r32; const float bias = CBIAS[c * 64 + e];
        bf16* dst = c == 0 ? KCMP : VCMP;
#pragma unroll
        for (int r = 0; r < 16; ++r) { const int nn = nt * 32 + crow(r, hi); dst[((size_t)(b * 2 + g) * 256 + nn) * 64 + e] = (bf16)(nn > 254 ? 0u : f2bf(acc[eh][r] + bias)); }
    }
}

__device__ __forceinline__ void nsa_compress_pair(LAS unsigned char* lds, const bf16* P0, const bf16* CWT, const float* CBIAS, bf16* KCMP, bf16* VCMP, int it0, int wave, int lane) {
    const int item = it0 + (wave >> 2), ks = wave & 3; const bool live = item < 512;
    const int nt = item & 7, g = (item >> 3) & 1, b = (item >> 4) & 15, c = (item >> 8) & 1;
    const int r32 = lane & 31, hi = lane >> 5, n = nt * 32 + r32, nc = n > 254 ? 254 : n;
    const bf16* ap = P0 + (size_t)(b * SEQ + 16 * nc) * EV_INP + C_KVA + c * 128 + g * 64 + 8 * hi;
    const bf16* bp = CWT + (size_t)(c * 64 + r32) * 2048 + 8 * hi;
    f32x16 acc[2] = {};
    if (live) {
#pragma unroll 8
        for (int kk = 32 * ks; kk < 32 * ks + 32; ++kk) {
            const bf16x8 a = *(const GAS bf16x8*)(ap + (size_t)(kk >> 2) * EV_INP + (kk & 3) * 16);
            const bf16x8 b0 = *(const GAS bf16x8*)(bp + kk * 16), b1 = *(const GAS bf16x8*)(bp + 32 * 2048 + kk * 16);
            acc[0] = __builtin_amdgcn_mfma_f32_32x32x16_bf16(a, b0, acc[0], 0, 0, 0);
            acc[1] = __builtin_amdgcn_mfma_f32_32x32x16_bf16(a, b1, acc[1], 0, 0, 0);
        }
    }
    LAS float* red = (LAS float*)lds + (wave >> 2) * 3 * 2048 + lane;
    if (ks) {
#pragma unroll
        for (int eh = 0; eh < 2; ++eh)
#pragma unroll
            for (int r = 0; r < 16; ++r) red[(ks - 1) * 2048 + (eh * 16 + r) * 64] = acc[eh][r];
    }
    __syncthreads();
    if (!ks && live) {
#pragma unroll
        for (int j = 0; j < 3; ++j)
#pragma unroll
            for (int eh = 0; eh < 2; ++eh)
#pragma unroll
                for (int r = 0; r < 16; ++r) acc[eh][r] += red[j * 2048 + (eh * 16 + r) * 64];
#pragma unroll
        for (int eh = 0; eh < 2; ++eh) { const int e = 32 * eh + r32; const float bias = CBIAS[c * 64 + e];
            bf16* dst = c == 0 ? KCMP : VCMP;
#pragma unroll
            for (int r = 0; r < 16; ++r) { const int nn = nt * 32 + crow(r, hi); dst[((size_t)(b * 2 + g) * 256 + nn) * 64 + e] = (bf16)(nn > 254 ? 0u : f2bf(acc[eh][r] + bias)); }
        }
    }
    __syncthreads();
}

constexpr int IX_MASK = 0, IX_RED = 8192, IX_CNT = IX_RED + 1024, IX_NC = IX_CNT + 1024, IX_CAND = IX_NC + 64, IX_THR = IX_CAND + 8192, IX_LIST = IX_THR + 128;
__device__ __forceinline__ unsigned f2ord(float f) { const unsigned b = __float_as_uint(f); return b ^ ((unsigned)((int)b >> 31) | 0x80000000u); }
__device__ __forceinline__ float ord2f(unsigned u) { return __uint_as_float(u ^ ((u >> 31) ? 0x80000000u : 0xffffffffu)); }
__device__ __forceinline__ void dsa_index_unit(LAS unsigned char* lds, const bf16* P0, unsigned short* SEL, int b, int qt, int tid_in, int lane_in, int wave) {
    int lane = lane_in; asm volatile("" : "+v"(lane)); const int tid = wave * 64 + lane; (void)tid_in;
    const int q = lane & 15, g4 = lane >> 4, t0 = 16 * qt, t = t0 + q, nkt = qt + 1;
    const int ni = nkt > wave ? (nkt - wave + 7) >> 3 : 0, nc4 = (ni + 3) >> 2;
    const bf16* base = P0 + (size_t)(b * SEQ) * EV_INP;
    bf16x8 bq[8]; float w[8];
#pragma unroll
    for (int h = 0; h < 8; ++h) { bq[h] = *(const GAS bf16x8*)(base + (size_t)t * EV_INP + C_IQ + h * 32 + 8 * g4); w[h] = bf2f(base[(size_t)t * EV_INP + C_IW + h]); }
    typedef float f32x4v __attribute__((ext_vector_type(4)));
    const bf16* kbase = base + (size_t)(16 * wave + q) * EV_INP + C_IK + 8 * g4;
    float sc[32][4];
    const float NINF = -__builtin_inff();
#pragma unroll
    for (int g = 0; g < 8; ++g) {
        if (32 * g + wave < nkt) {
            bf16x8 ab[4];
#pragma unroll
            for (int j = 0; j < 4; ++j) if (8 * (4 * g + j) + wave < nkt) { const bf16* kp = kbase; asm volatile("" : "+v"(kp));
                ab[j] = *(const GAS bf16x8*)(kp + (size_t)(4 * g + j) * (128 * EV_INP)); }
            asm volatile("s_waitcnt vmcnt(0)" ::: "memory");
#pragma unroll
            for (int j = 0; j < 4; ++j) {
                const int i = 4 * g + j, kt = 8 * i + wave;
                if (kt < nkt) {
                    const bf16x8 a = ab[j];
                    float a4[4] = {0.f, 0.f, 0.f, 0.f};
#pragma unroll
                    for (int h = 0; h < 8; ++h) { const f32x4v c = __builtin_amdgcn_mfma_f32_16x16x32_bf16(a, bq[h], (f32x4v){0.f, 0.f, 0.f, 0.f}, 0, 0, 0);
#pragma unroll
                        for (int r = 0; r < 4; ++r) a4[r] += w[h] * fmx(c[r], 0.f); }
#pragma unroll
                    for (int r = 0; r < 4; ++r) sc[i][r] = (kt < qt || 4 * g4 + r <= q) ? a4[r] : NINF;
                } else {
#pragma unroll
                    for (int r = 0; r < 4; ++r) sc[i][r] = NINF;
                }
            }
        } else {
#pragma unroll
            for (int j = 0; j < 4; ++j)
#pragma unroll
                for (int r = 0; r < 4; ++r) sc[4 * g + j][r] = NINF;
        }
    }
    LAS float* RED = (LAS float*)(lds + IX_RED); LAS unsigned* CNT = (LAS unsigned*)(lds + IX_CNT); LAS unsigned* MK = (LAS unsigned*)(lds + IX_MASK);
    LAS unsigned* NC = (LAS unsigned*)(lds + IX_NC); LAS unsigned long long* CAND = (LAS unsigned long long*)(lds + IX_CAND); LAS unsigned long long* THR = (LAS unsigned long long*)(lds + IX_THR);
    float lmax = NINF, lmin = __builtin_inff();
#pragma unroll
    for (int c = 0; c < 8; ++c) if (c < nc4) {
#pragma unroll
        for (int j = 0; j < 4; ++j)
#pragma unroll
            for (int r = 0; r < 4; ++r) { const float v = sc[4 * c + j][r]; lmax = fmx(lmax, v); lmin = fmn(lmin, v == NINF ? __builtin_inff() : v); }
    }
    lmax = fmx(lmax, lx_f<16>(lmax)); lmax = fmx(lmax, lx_f<32>(lmax));
    lmin = fmn(lmin, lx_f<16>(lmin)); lmin = fmn(lmin, lx_f<32>(lmin));
    __syncthreads();
    if (g4 == 0) { RED[wave * 16 + q] = lmax; RED[128 + wave * 16 + q] = lmin; }
    for (int i = tid; i < 2048; i += NWAVES * 64) MK[i] = 0u;
    if (tid < 16) NC[tid] = 0u;
    __syncthreads();
    float hiv = NINF, lov = __builtin_inff();
#pragma unroll
    for (int wv = 0; wv < 8; ++wv) { hiv = fmx(hiv, RED[wv * 16 + q]); lov = fmn(lov, RED[128 + wv * 16 + q]); }
    lov = lov - fabsf(lov) * 1e-3f - 1e-6f;
    unsigned clo = (unsigned)(t + 1), chi = 0u;
    bool done = (t + 1 <= 256), fine = false; float thr = NINF; unsigned thk = 0u;
    for (int it = 0; it < 64; ++it) {
        const float mid = 0.5f * (lov + hiv);
        unsigned cnt = 0;
#pragma unroll
        for (int c = 0; c < 8; ++c) if (c < nc4) {
#pragma unroll
            for (int j = 0; j < 4; ++j)
#pragma unroll
                for (int r = 0; r < 4; ++r) cnt += (sc[4 * c + j][r] > mid) ? 1u : 0u;
        }
        cnt += lx_u<16>(cnt); cnt += lx_u<32>(cnt);
        LAS unsigned* cb = CNT + (it & 1) * 128;
        if (g4 == 0) cb[wave * 16 + q] = cnt;
        __syncthreads();
        unsigned tot = 0;
#pragma unroll
        for (int wv = 0; wv < 8; ++wv) tot += cb[wv * 16 + q];
        if (!done && !fine) {
            if (tot == 256u) { thr = mid; done = true; }
            else if (!(mid > lov && mid < hiv)) { thr = lov; done = true; }
            else { if (tot > 256u) { lov = mid; clo = tot; } else { hiv = mid; chi = tot; }
                   if (clo - chi <= 64u) fine = true; }
        }
        if (__all(done || fine)) break;
    }
    const unsigned kinv0 = (unsigned)(4095 - (16 * wave + 4 * g4));
    if (fine) {
#pragma unroll
        for (int c = 0; c < 8; ++c) if (c < nc4) {
#pragma unroll
            for (int j = 0; j < 4; ++j)
#pragma unroll
                for (int r = 0; r < 4; ++r) { const float v = sc[4 * c + j][r];
                    if (v > lov && v <= hiv) { const unsigned pos = __hip_atomic_fetch_add(NC + q, 1u, __ATOMIC_RELAXED, __HIP_MEMORY_SCOPE_WORKGROUP);
                        if (pos < 64u) CAND[q * 64 + pos] = ((unsigned long long)f2ord(v) << 32) | (kinv0 - (unsigned)(128 * (4 * c + j) + r)); } }
        }
    }
    __syncthreads();
#pragma unroll 1
    for (int k = 0; k < 2; ++k) {
        const int qq = 2 * wave + k;
        const int fq = __builtin_amdgcn_readlane((int)fine, qq), need = __builtin_amdgcn_readlane((int)(256u - chi), qq);
        if (fq) {
            const unsigned n = NC[qq]; const unsigned long long comp = (unsigned)lane < n ? CAND[qq * 64 + lane] : 0ull;
            const unsigned c_lo = (unsigned)comp, c_hi = (unsigned)(comp >> 32);
            int rank = 0;
#pragma unroll
            for (int jj = 0; jj < 64; ++jj) { const unsigned long long c2 = ((unsigned long long)(unsigned)__builtin_amdgcn_readlane((int)c_hi, jj) << 32) | (unsigned)__builtin_amdgcn_readlane((int)c_lo, jj); rank += (c2 > comp) ? 1 : 0; }
            if (rank == need - 1) THR[qq] = comp;
        }
    }
    __syncthreads();
    if (fine) { const unsigned long long t64 = THR[q]; thr = ord2f((unsigned)(t64 >> 32)); thk = (unsigned)t64; }
    LAS unsigned* mkw = MK + q * 128 + (wave >> 1); const int mksh = 16 * (wave & 1) + 4 * g4;
#pragma unroll
    for (int c = 0; c < 8; ++c) if (c < nc4) {
#pragma unroll
        for (int j = 0; j < 4; ++j) { const int i = 4 * c + j;
            unsigned nib = 0;
#pragma unroll
            for (int r = 0; r < 4; ++r) { const float v = sc[i][r]; nib |= (v > thr || (fine && v == thr && kinv0 - (unsigned)(128 * i + r) >= thk)) ? (1u << r) : 0u; }
            if (nib) __hip_atomic_fetch_or(mkw + 4 * i, nib << mksh, __ATOMIC_RELAXED, __HIP_MEMORY_SCOPE_WORKGROUP); }
    }
    __syncthreads();
    LAS unsigned short* LST = (LAS unsigned short*)(lds + IX_LIST);
#pragma unroll 1
    for (int k = 0; k < 2; ++k) {
        const int qq = 2 * wave + k;
        unsigned long long wd = *(const LAS unsigned long long*)(lds + IX_MASK + (qq * 64 + lane) * 8);
        const int c = __popcll(wd); int incl = c;
#pragma unroll
        for (int d = 1; d < 64; d <<= 1) { const int n = __builtin_amdgcn_ds_bpermute((lane - d) << 2, incl); if (lane >= d) incl += n; }
        int pos = incl - c; const int total = __builtin_amdgcn_readlane(incl, 63);
        while (wd) { const int bbit = __builtin_ctzll(wd); if (pos < 256) LST[qq * 256 + pos] = (unsigned short)(64 * lane + bbit); ++pos; wd &= wd - 1; }
        for (int p = total + lane; p < 256; p += 64) LST[qq * 256 + p] = (unsigned short)0xffffu;
    }
    __syncthreads();
    { const v4u v = *(const LAS v4u*)(lds + IX_LIST + tid * 16);
      *(GAS v4u*)((unsigned char*)(SEL + (size_t)(b * SEQ + t0) * 256) + tid * 16) = v; }
}

struct FSel {
    unsigned long long selmask; int t, cur, hi; const LAS float* BT;
    __device__ __forceinline__ void pre(int) {}
    __device__ __forceinline__ bool skip(int kt) const { return !__any((int)((selmask >> kt) & 1ull)); }
    __device__ __forceinline__ void apply(f32x16 (&s)[2], int kt) {
        const bool on = (selmask >> kt) & 1ull;
        if (kt + 3 <= cur) {
            if (!__all((int)on)) {
#pragma unroll
                for (int st = 0; st < 2; ++st)
#pragma unroll
                    for (int r = 0; r < 16; ++r) s[st][r] = on ? s[st][r] : NEGBIG; }
        } else {
#pragma unroll
            for (int st = 0; st < 2; ++st)
#pragma unroll
                for (int r = 0; r < 16; ++r) { const int dist = t - (64 * kt + 32 * st + crow(r, hi)); const unsigned di = (unsigned)dist < 128u ? (unsigned)dist : 128u;
                    s[st][r] = (on && dist >= 0) ? s[st][r] + BT[di] : NEGBIG; }
        }
    }
};
struct FWin {
    int t, cur, hi; const LAS float* BT;
    __device__ __forceinline__ void pre(int) {}
    __device__ __forceinline__ bool skip(int) const { return false; }
    __device__ __forceinline__ void apply(f32x16 (&s)[2], int kt) {
        const int dk = cur - kt;
        if (!(dk >= 3 && dk <= 7)) {
#pragma unroll
            for (int st = 0; st < 2; ++st)
#pragma unroll
                for (int r = 0; r < 16; ++r) { const int dist = t - (64 * kt + 32 * st + crow(r, hi)); const unsigned di = (unsigned)dist < 128u ? (unsigned)dist : 128u;
                    s[st][r] = (dist >= 0 && dist < 512) ? s[st][r] + BT[di] : NEGBIG; }
        }
    }
};
__device__ __forceinline__ float sigmoidf_(float x) { return __builtin_amdgcn_rcpf(1.0f + __builtin_amdgcn_exp2f(-x * LOG2E)); }

__device__ __forceinline__ void nsa_unit(LAS unsigned char* lds, const bf16* P0, const bf16* KCMP, const bf16* VCMP, bf16* OC, int b, int g, int qt, int tid_in, int lane_in, int wave) {
    int lane = lane_in; asm volatile("" : "+v"(lane)); const int tid = wave * 64 + lane; (void)tid_in;
    const int r32 = lane & 31, hi = lane >> 5, qi = r32 >> 2, hh = r32 & 3, head = g * 4 + hh;
    const int t0 = qt * 64, t = t0 + wave * 8 + qi, cur = qt;
    const bf16* prow = P0 + (size_t)(b * SEQ + t) * EV_INP;
    bf16x8 qf[4]; load_q_scaled<64>(prow + C_QA + head * 64, qf, 0.125f * LOG2E, lane);
    const LAS float* BT = (const LAS float*)(lds + AT_BT) + head * BT_STRIDE;
    const float g0 = sigmoidf_(bf2f(prow[C_GA + g * 12 + hh * 3 + 0])), g1 = sigmoidf_(bf2f(prow[C_GA + g * 12 + hh * 3 + 1])), g2 = sigmoidf_(bf2f(prow[C_GA + g * 12 + hh * 3 + 2]));
    LAS float* impL = (LAS float*)(lds + AT_WS + wave * AT_WS_PER_WAVE);
    LAS unsigned long long* selL = (LAS unsigned long long*)(lds + AT_WS + wave * AT_WS_PER_WAVE + 2048);
    f32x16 oacc[2];
    {
        f32x16 o[2] = {}; float m = NEGBIG, l = 0.f, carry = 0.f;
        float imp[32];
#pragma unroll
        for (int i = 0; i < 32; ++i) imp[i] = 0.f;
        const int ncv = (t0 + 63 >= 31) ? ((t0 + 63 - 31) >> 4) + 1 : 0;
        const int nkt = ncv >= 256 ? 4 : (ncv + 63) >> 6;
        KVSrc kv{KCMP + (size_t)((b * 2 + g) * 256) * 64, 64, nullptr, 0, VCMP + (size_t)((b * 2 + g) * 256) * 64, 64};
        Stage<64, 64, 64> sg;
        __syncthreads();
        if (nkt > 0) { sg.load(kv, 0, tid); sg.store(lds, 0, tid); }
        __syncthreads();
#pragma unroll
        for (int kt = 0; kt < 4; ++kt) {
            if (kt < nkt) {
                const int buf = kt & 1;
                if (kt + 1 < nkt) sg.load(kv, kt + 1, tid);
                f32x16 s[2];
                qk_tile<64, 2>(lds + AT_KBUF + buf * KBUF_BYTES, qf, s, lane);
#pragma unroll
                for (int st = 0; st < 2; ++st)
#pragma unroll
                    for (int r = 0; r < 16; ++r) { const int dist = t - (16 * (64 * kt + 32 * st + crow(r, hi)) + 31); const unsigned di = (unsigned)dist < 128u ? (unsigned)dist : 128u;
                        s[st][r] = dist >= 0 ? s[st][r] + BT[di] : NEGBIG; }
                const float alpha = softmax_tile(s, m, l);
                o[0] = o[0] * alpha; o[1] = o[1] * alpha; carry *= alpha;
#pragma unroll
                for (int i = 0; i < kt * 8; ++i) imp[i] *= alpha;
                pv_tile<64>(lds + AT_VBUF + buf * VBUF_BYTES, s, o, lane);
                float G[2][4], ol[2][4];
#pragma unroll
                for (int st = 0; st < 2; ++st)
#pragma unroll
                    for (int q4 = 0; q4 < 4; ++q4) { G[st][q4] = (s[st][4 * q4] + s[st][4 * q4 + 1]) + (s[st][4 * q4 + 2] + s[st][4 * q4 + 3]); ol[st][q4] = swapget(s[st][4 * q4 + 3]); }
#pragma unroll
                for (int st = 0; st < 2; ++st)
#pragma unroll
                    for (int q4 = 0; q4 < 4; ++q4) { const float prev = q4 > 0 ? ol[st][q4 - 1] : (st == 1 ? ol[0][3] : carry);
                        imp[kt * 8 + st * 4 + q4] = G[st][q4] + (hi ? ol[st][q4] : prev); }
                carry = ol[1][3];
                if (kt + 1 < nkt) sg.store(lds, buf ^ 1, tid);
                __syncthreads();
            }
        }
        const float lt = swapsum(l), inv = lt > 0.f ? 1.f / lt : 0.f;
        oacc[0] = o[0] * (inv * g0); oacc[1] = o[1] * (inv * g0);
#pragma unroll
        for (int i = 0; i < 32; ++i) { float v = imp[i] * inv; v += lx_f<1>(v); v += lx_f<2>(v);
            if (hh == 0) impL[qi * 64 + 16 * (i >> 3) + 8 * ((i >> 2) & 1) + 2 * (i & 3) + hi] = v; }
    }
    LDS_WAIT(); asm volatile("" ::: "memory");
#pragma unroll 1
    for (int q2 = 0; q2 < 8; ++q2) {
        const int j = lane; const bool valid = j <= cur, forced = (j == 0) || (j == cur) || (j == cur - 1);
        const float val = impL[q2 * 64 + j] + (forced ? 1000.f : 0.f);
        const unsigned long long comp = ((unsigned long long)(valid ? __float_as_uint(val) + 1u : 0u) << 6) | (unsigned long long)(63 - j);
        const unsigned clo = (unsigned)comp, chi = (unsigned)(comp >> 32);
        int rank = 0;
#pragma unroll
        for (int jj = 0; jj < 64; ++jj) { const unsigned long long c2 = ((unsigned long long)(unsigned)__builtin_amdgcn_readlane((int)chi, jj) << 32) | (unsigned)__builtin_amdgcn_readlane((int)clo, jj); rank += (c2 > comp) ? 1 : 0; }
        const unsigned long long mk = __ballot(valid && rank < 16);
        if (lane == 0) selL[q2] = mk;
    }
    LDS_WAIT(); asm volatile("" ::: "memory");
    const unsigned long long selmask = selL[qi];
    {
        f32x16 o[2] = {}; SmState S{0.f, 0.f, false};
        KVSrc kv{P0 + (size_t)(b * SEQ) * EV_INP + C_KVA + 2 * 128 + g * 64, EV_INP, nullptr, 0, P0 + (size_t)(b * SEQ) * EV_INP + C_KVA + 3 * 128 + g * 64, EV_INP};
        FSel f{selmask, t, cur, hi, BT};
        int tid2 = tid; asm volatile("" : "+v"(tid2));
        attn_loop<64, 64, 64, FSel, false>(lds, kv, 0, cur + 1, qf, f, o, S, tid2, lane);
        const float lt = swapsum(S.l), inv = lt > 0.f ? 1.f / lt : 0.f;
        oacc[0] = oacc[0] + o[0] * (inv * g1); oacc[1] = oacc[1] + o[1] * (inv * g1);
    }
    {
        f32x16 o[2] = {}; SmState S{0.f, 0.f, false};
        KVSrc kv{P0 + (size_t)(b * SEQ) * EV_INP + C_KVA + 4 * 128 + g * 64, EV_INP, nullptr, 0, P0 + (size_t)(b * SEQ) * EV_INP + C_KVA + 5 * 128 + g * 64, EV_INP};
        FWin f{t, cur, hi, BT};
        int tid3 = tid; asm volatile("" : "+v"(tid3));
        attn_loop<64, 64, 64, FWin, false>(lds, kv, cur >= 8 ? cur - 8 : 0, cur + 1, qf, f, o, S, tid3, lane);
        const float lt = swapsum(S.l), inv = lt > 0.f ? 1.f / lt : 0.f;
        oacc[0] = oacc[0] + o[0] * (inv * g2); oacc[1] = oacc[1] + o[1] * (inv * g2);
    }
    store_ot<64>(OC + (size_t)(b * SEQ + t) * DM + head * 64, oacc, 1.f, lane);
}
constexpr int DG_VP = 136, DG_VT = 64 * DG_VP;
static_assert(8 * DG_VT <= AT_BT, "DSA gather LDS map");
__device__ __forceinline__ void dsa_unit(LAS unsigned char* lds, const bf16* P0, const unsigned short* SEL, bf16* OC, int b, int qt, int tid_in, int lane_in, int wave) {
    int lane = lane_in; asm volatile("" : "+v"(lane)); (void)tid_in;
    const int r32 = lane & 31, hi = lane >> 5, hh = r32 & 7;
    const LAS float* BT = (const LAS float*)(lds + AT_BT) + (8 + hh) * BT_STRIDE;
    LAS unsigned char* vt = lds + wave * DG_VT;
    LAS unsigned short* lq = (LAS unsigned short*)(lds + AT_WS + wave * AT_WS_PER_WAVE);
    const bf16* kb = P0 + (size_t)(b * SEQ) * EV_INP + C_KB + 8 * hi;
    const bf16* vb = P0 + (size_t)(b * SEQ) * EV_INP + C_VB + 8 * (lane & 7);
#define DG_LOADK(LQ, J) do { _Pragma("unroll") for (int st = 0; st < 2; ++st) { unsigned ik = (LQ)[64 * (J) + 32 * st + r32]; ik = ik > 4095u ? 0u : ik; \
        _Pragma("unroll") for (int d0 = 0; d0 < 4; ++d0) kf[st][d0] = *(const GAS bf16x8*)(kb + (size_t)ik * EV_INP + 16 * d0); } } while (0)
#define DG_LOADV(LQ, J) do { _Pragma("unroll") for (int i = 0; i < 8; ++i) { unsigned iv = (LQ)[64 * (J) + 8 * i + (lane >> 3)]; iv = iv > 4095u ? 0u : iv; vr[i] = *(const GAS v4u*)(vb + (size_t)iv * EV_INP); } } while (0)
    bf16x8 kf[2][4]; v4u vr[8];
    { const int t = qt * 32 + wave * 4; *(LAS v2u*)(lq + 4 * lane) = *(const GAS v2u*)(SEL + (size_t)(b * SEQ + t) * 256 + 4 * lane); }
    DG_LOADK(lq, 0); DG_LOADV(lq, 0);
#pragma unroll 1
    for (int qi = 0; qi < 4; ++qi) {
        const int t = qt * 32 + wave * 4 + qi;
        LAS unsigned short* lqc = lq + 256 * (qi & 1); LAS unsigned short* lqn = lq + 256 * ((qi + 1) & 1);
        if (qi + 1 < 4) *(LAS v2u*)(lqn + 4 * lane) = *(const GAS v2u*)(SEL + (size_t)(b * SEQ + t + 1) * 256 + 4 * lane);
        bf16x8 qf[4]; load_q_scaled<64>(P0 + (size_t)(b * SEQ + t) * EV_INP + C_QB + hh * 64, qf, 0.125f * LOG2E, lane);
        f32x16 o[2] = {}; SmState S{0.f, 0.f, false};
#pragma unroll
        for (int j = 0; j < 4; ++j) {
#pragma unroll
            for (int i = 0; i < 8; ++i) { LAS unsigned char* d = vt + (8 * i + (lane >> 3)) * DG_VP + (lane & 7) * 16; *(LAS v2u*)d = (v2u){vr[i].x, vr[i].y}; *(LAS v2u*)(d + 8) = (v2u){vr[i].z, vr[i].w}; }
            if (j < 3) DG_LOADV(lqc, j + 1); else if (qi + 1 < 4) DG_LOADV(lqn, 0);
            f32x16 s[2];
#pragma unroll
            for (int r = 0; r < 16; ++r) { s[0][r] = -S.mhat; s[1][r] = -S.mhat; }
#pragma unroll
            for (int d0 = 0; d0 < 4; ++d0)
#pragma unroll
                for (int st = 0; st < 2; ++st) s[st] = __builtin_amdgcn_mfma_f32_32x32x16_bf16(kf[st][d0], qf[d0], s[st], 0, 0, 0);
            if (j < 3) DG_LOADK(lqc, j + 1); else if (qi + 1 < 4) DG_LOADK(lqn, 0);
            if (j >= 2 || t < 255) {
#pragma unroll
                for (int st = 0; st < 2; ++st)
#pragma unroll
                    for (int r = 0; r < 16; ++r) { const int ix = lqc[64 * j + 32 * st + crow(r, hi)]; const int dist = t - ix; const unsigned di = (unsigned)dist < 128u ? (unsigned)dist : 128u;
                        s[st][r] = dist >= 0 ? s[st][r] + BT[di] : NEGBIG; }
            }
            float mx = NEGBIG;
#pragma unroll
            for (int r = 0; r < 16; ++r) mx = fmx3(mx, s[0][r], s[1][r]);
            mx = swapmax(mx);
            const bool need = S.started ? (mx > DEFER_THR) : (mx > -1e29f);
            if (__any(need)) {
                const float delta = need ? mx : 0.f, fac = (need && S.started) ? __builtin_amdgcn_exp2f(-delta) : 1.f;
                S.mhat += delta; S.l *= fac; S.started = S.started || need;
#pragma unroll
                for (int st = 0; st < 2; ++st)
#pragma unroll
                    for (int r = 0; r < 16; ++r) s[st][r] -= delta;
                o[0] = o[0] * fac; o[1] = o[1] * fac;
            }
#pragma unroll
            for (int st = 0; st < 2; ++st)
#pragma unroll
                for (int r = 0; r < 16; ++r) s[st][r] = __builtin_amdgcn_exp2f(s[st][r]);
            S.l += vsum32(s);
            bf16x8 pf[4]; p_pack(s, pf);
            VFrag vfr; pv_load<DG_VP>(vt, 0, vfr, lane);
            pv_mma(vfr, pf, o[0], o[1]);
        }
        const float lt = swapsum(S.l);
        if (r32 < 8) store_ot<64>(OC + (size_t)(b * SEQ + t) * DM + 512 + hh * 64, o, lt > 0.f ? 1.f / lt : 0.f, lane);
    }
#undef DG_LOADK
#undef DG_LOADV
}


constexpr int D_CQ = 0, D_CKV = 256, D_KR = 384, D_QD = 416, D_KD = 928, D_VD = 1440;
constexpr size_t WS_ROPE = 91 * MiB + 640 * 1024;
constexpr size_t WS_P1 = WS_OV, WS_CQN = WS_OV + 256 * MiB, WS_CKVN = WS_OV + 288 * MiB, WS_KR = WS_OV + 320 * MiB;
constexpr size_t WS_QMLA = WS_Y, WS_KVMLA = WS_Y + 96 * MiB;
static_assert(WS_KR + 4 * MiB <= WS_END && WS_KVMLA + 128 * MiB <= WS_OV, "odd overlay");
constexpr float LAM_INIT = 0.35550906759097f;

__device__ __forceinline__ void rope_table_phase(float* ROPE, int gt, int NGT) {
    for (int idx = gt; idx < SEQ * 16; idx += NGT) { const int t = idx >> 4, i = idx & 15;
        const float inv = exp2f(-(float)i * (13.287712379549449f / 16.0f));
        const double rev = (double)((float)t * inv) * 0.15915494309189535;
        const float fr = (float)(rev - __builtin_floor(rev));
        ROPE[2 * idx] = __builtin_amdgcn_cosf(fr); ROPE[2 * idx + 1] = __builtin_amdgcn_sinf(fr); }
}
__device__ __forceinline__ void odd_prep_rows(const bf16* P1, const float* qn, const float* kvn, const float* ROPE, bf16* CQN, bf16* CKVN, bf16* KR, int gw, int NGW, int lane) {
    float gq[4], gk[2];
#pragma unroll
    for (int j = 0; j < 4; ++j) gq[j] = qn[4 * lane + j];
    gk[0] = kvn[2 * lane]; gk[1] = kvn[2 * lane + 1];
    for (int m = gw; m < MTOK; m += NGW) {
        const bf16* row = P1 + (size_t)m * OD_INP;
        const v2u cq = *(const GAS v2u*)(row + D_CQ + 4 * lane); const unsigned ck = *(const GAS unsigned*)(row + D_CKV + 2 * lane);
        float x[4] = {bf2f((unsigned short)(cq.x & 0xffff)), bf2f((unsigned short)(cq.x >> 16)), bf2f((unsigned short)(cq.y & 0xffff)), bf2f((unsigned short)(cq.y >> 16))};
        float y[2] = {bf2f((unsigned short)(ck & 0xffff)), bf2f((unsigned short)(ck >> 16))};
        const float r1 = __builtin_amdgcn_rsqf(wave_sum((x[0] * x[0] + x[1] * x[1]) + (x[2] * x[2] + x[3] * x[3])) * (1.f / 256.f) + RMS_EPS);
        const float r2 = __builtin_amdgcn_rsqf(wave_sum(y[0] * y[0] + y[1] * y[1]) * (1.f / 128.f) + RMS_EPS);
        v2u o; o.x = pk2(x[0] * r1 * gq[0], x[1] * r1 * gq[1]); o.y = pk2(x[2] * r1 * gq[2], x[3] * r1 * gq[3]);
        *(GAS v2u*)(CQN + (size_t)m * 256 + 4 * lane) = o;
        *(GAS unsigned*)(CKVN + (size_t)m * 256 + 2 * lane) = pk2(y[0] * r2 * gk[0], y[1] * r2 * gk[1]);
        *(GAS unsigned*)(CKVN + (size_t)m * 256 + 128 + 2 * lane) = 0u;
        if (lane < 16) { const int t = m & (SEQ - 1); const float c = ROPE[(t * 16 + lane) * 2], s = ROPE[(t * 16 + lane) * 2 + 1];
            const float x1 = bf2f(row[D_KR + lane]), x2 = bf2f(row[D_KR + 16 + lane]);
            KR[(size_t)m * 32 + lane] = (bf16)f2bf(x1 * c - x2 * s); KR[(size_t)m * 32 + 16 + lane] = (bf16)f2bf(x1 * s + x2 * c); }
    }
}
template <bool BIAS> struct FCausal {
    int t, tmin, tmax, hi; const LAS float* BT;
    __device__ __forceinline__ void pre(int) {}
    __device__ __forceinline__ bool skip(int kt) const { return 64 * kt > tmax; }
    __device__ __forceinline__ void apply(f32x16 (&s)[2], int kt) {
        if (!(64 * kt + 63 <= tmin && (!BIAS || tmin - (64 * kt + 63) >= 113))) {
#pragma unroll
            for (int st = 0; st < 2; ++st)
#pragma unroll
                for (int r = 0; r < 16; ++r) { const int dist = t - (64 * kt + 32 * st + crow(r, hi)); const unsigned di = (unsigned)dist < 128u ? (unsigned)dist : 128u;
                    s[st][r] = dist >= 0 ? s[st][r] + (BIAS ? BT[di] : 0.f) : NEGBIG; }
        }
    }
};
__device__ __forceinline__ void mla_unit(LAS unsigned char* lds, const bf16* QM, const bf16* KVM_, const bf16* KR, const float* ROPE, bf16* OC, int b, int h, int qt, int tid_in, int lane_in, int wave) {
    int lane = lane_in; asm volatile("" : "+v"(lane)); const int tid = wave * 64 + lane; (void)tid_in;
    const int r32 = lane & 31, hi = lane >> 5, t = qt * 256 + wave * 32 + r32;
    bf16x8 qf[6]; load_q<96>(QM + (size_t)(b * SEQ + t) * 768 + h * 96, qf, lane);
    {
        const float* rp = ROPE + (size_t)(t * 16 + 8 * hi) * 2;
        bf16x8 a = qf[4], c = qf[5];
#pragma unroll
        for (int j = 0; j < 8; ++j) { const float cs = rp[2 * j], sn = rp[2 * j + 1], x1 = bf2f((unsigned short)a[j]), x2 = bf2f((unsigned short)c[j]);
            a[j] = (short)f2bf(x1 * cs - x2 * sn); c[j] = (short)f2bf(x1 * sn + x2 * cs); }
        qf[4] = a; qf[5] = c;
    }
#pragma unroll
    for (int d0 = 0; d0 < 6; ++d0) qf[d0] = scale_frag(qf[d0], 0.10206207261596577f * LOG2E);
    KVSrc kv{KVM_ + (size_t)(b * SEQ) * 1024 + h * 128, 1024, KR + (size_t)(b * SEQ) * 32, 32, KVM_ + (size_t)(b * SEQ) * 1024 + h * 128 + 64, 1024};
    f32x16 o[2] = {}; SmState S{0.f, 0.f, false};
    FCausal<false> f{t, qt * 256 + wave * 32, qt * 256 + wave * 32 + 31, hi, nullptr};
    attn_loop<96, 64, 64, FCausal<false>, true, false>(lds, kv, 0, 4 * qt + 4, qf, f, o, S, tid, lane);
    const float lt = swapsum(S.l);
    store_ot<64>(OC + (size_t)(b * SEQ + t) * DM + h * 64, o, lt > 0.f ? 1.f / lt : 0.f, lane);
}
__device__ __forceinline__ void diff_unit(LAS unsigned char* lds, const bf16* P1, const float* lam, const float* subln, bf16* OC, int b, int h, int qt, int tid_in, int lane_in, int wave) {
    int lane = lane_in; asm volatile("" : "+v"(lane)); const int tid = wave * 64 + lane; (void)tid_in;
    const int r32 = lane & 31, hi = lane >> 5, t = qt * 256 + wave * 32 + r32;
    const LAS float* BT = (const LAS float*)(lds + AT_BT) + (16 + h) * BT_STRIDE;
    float d01 = 0.f, d23 = 0.f;
    { d01 = lam[lane] * lam[64 + lane]; d23 = lam[128 + lane] * lam[192 + lane]; d01 = wave_sum(d01); d23 = wave_sum(d23); }
    const float lam_full = __expf(d01) - __expf(d23) + LAM_INIT;
    unsigned o0p[32];
    f32x16 o[4];
#pragma unroll 1
    for (int e = 0; e < 2; ++e) {
        bf16x8 qf[4]; load_q_scaled<64>(P1 + (size_t)(b * SEQ + t) * OD_INP + D_QD + (h * 2 + e) * 64, qf, 0.125f * LOG2E, lane);
        KVSrc kv{P1 + (size_t)(b * SEQ) * OD_INP + D_KD + (h * 2 + e) * 64, OD_INP, nullptr, 0, P1 + (size_t)(b * SEQ) * OD_INP + D_VD + h * 128, OD_INP};
#pragma unroll
        for (int dt = 0; dt < 4; ++dt) o[dt] = (f32x16){};
        SmState S{0.f, 0.f, false};
        FCausal<true> f{t, qt * 256 + wave * 32, qt * 256 + wave * 32 + 31, hi, BT};
        attn_loop<64, 64, 128, FCausal<true>>(lds, kv, 0, 4 * qt + 4, qf, f, o, S, tid, lane);
        const float lt = swapsum(S.l), inv = lt > 0.f ? 1.f / lt : 0.f;
        if (e == 0) {
#pragma unroll
            for (int dt = 0; dt < 4; ++dt)
#pragma unroll
                for (int k = 0; k < 8; ++k) o0p[dt * 8 + k] = cvtpk(o[dt][2 * k] * inv, o[dt][2 * k + 1] * inv);
        } else {
            float ss = 0.f;
#pragma unroll
            for (int dt = 0; dt < 4; ++dt)
#pragma unroll
                for (int k = 0; k < 8; ++k) { const unsigned w = o0p[dt * 8 + k];
                    const float a0 = __uint_as_float(w << 16) - lam_full * (o[dt][2 * k] * inv), a1 = __uint_as_float(w & 0xffff0000u) - lam_full * (o[dt][2 * k + 1] * inv);
                    o[dt][2 * k] = a0; o[dt][2 * k + 1] = a1; ss += a0 * a0 + a1 * a1; }
            ss = swapsum(ss);
            const float rn = __builtin_amdgcn_rsqf(ss * (1.f / 128.f) + RMS_EPS) * (1.0f - LAM_INIT);
            bf16* orow = OC + (size_t)(b * SEQ + t) * DM + 512 + h * 128;
#pragma unroll
            for (int dt = 0; dt < 4; ++dt)
#pragma unroll
                for (int r4 = 0; r4 < 4; ++r4) { const int d = 32 * dt + 8 * r4 + 4 * hi; const f32x4 gn = *(const GAS f32x4*)(subln + d);
                    v2u w; w.x = cvtpk(o[dt][4 * r4 + 0] * rn * gn.x, o[dt][4 * r4 + 1] * rn * gn.y); w.y = cvtpk(o[dt][4 * r4 + 2] * rn * gn.z, o[dt][4 * r4 + 3] * rn * gn.w);
                    *(GAS v2u*)(orow + d) = w; }
        }
    }
}


__device__ __forceinline__ void tr_item(const float* W, int N, bf16* WT, int ldk, int drow0, LAS float* scr, int k0, int n0, int lane, const float* grow = nullptr) {
#pragma unroll 8
    for (int i = 0; i < 32; ++i) { const int kk = 2 * i + (lane >> 5); float wv = W[(size_t)(k0 + kk) * N + n0 + (lane & 31)]; if (grow) wv *= grow[k0 + kk]; scr[kk * 33 + (lane & 31)] = wv; }
    LDS_WAIT(); asm volatile("" ::: "memory");
    const int c = lane & 7;
#pragma unroll
    for (int j = 0; j < 4; ++j) { const int n = (lane >> 3) + 8 * j; const LAS float* s = scr + (8 * c) * 33 + n;
        v4u o; o.x = pk2(s[0 * 33], s[1 * 33]); o.y = pk2(s[2 * 33], s[3 * 33]); o.z = pk2(s[4 * 33], s[5 * 33]); o.w = pk2(s[6 * 33], s[7 * 33]);
        *(GAS v4u*)(WT + (size_t)(drow0 + n) * ldk + k0 + 8 * c) = o; }
    LDS_WAIT(); asm volatile("" ::: "memory");
}
__device__ __forceinline__ void tr_item8(const float* W, int N, unsigned char* WT, int ldk, int drow0, LAS float* scr, int k0, int n0, int lane) {
#pragma unroll 8
    for (int i = 0; i < 32; ++i) { const int kk = 2 * i + (lane >> 5); scr[kk * 33 + (lane & 31)] = W[(size_t)(k0 + kk) * N + n0 + (lane & 31)]; }
    LDS_WAIT(); asm volatile("" ::: "memory");
    const int c = lane & 7;
#pragma unroll
    for (int j = 0; j < 4; ++j) { const int n = (lane >> 3) + 8 * j; const LAS float* s = scr + (8 * c) * 33 + n;
        v2u o; o.x = pg8::pk4_fp8(s[0 * 33], s[1 * 33], s[2 * 33], s[3 * 33], pg8::F8S_W); o.y = pg8::pk4_fp8(s[4 * 33], s[5 * 33], s[6 * 33], s[7 * 33], pg8::F8S_W);
        *(GAS v2u*)(WT + (size_t)(drow0 + n) * ldk + k0 + 8 * c) = o; }
    LDS_WAIT(); asm volatile("" ::: "memory");
}
constexpr size_t WS_XB = WS_OV + 370 * MiB;
constexpr size_t WS_RS = 1 * MiB;
constexpr int F8_FROM = 1;
__device__ __forceinline__ void rows_norm_phase(const float* xsrc, float* xdst, const bf16* Y, float w, const float* gpost, const float* gpre, bf16* H, int nrows, int gw, int NGW, int lane, bool f8 = false, float ysc = 1.f, const bf16* xsb = nullptr, bf16* xdb = nullptr, float* Rout = nullptr) {
    f32x4 gp[4], gq[4];
#pragma unroll
    for (int j = 0; j < 4; ++j) {
        gp[j] = Y ? ((const GAS f32x4*)gpost)[lane + 64 * j] * w : (f32x4){0.f, 0.f, 0.f, 0.f};
        gq[j] = gpre ? ((const GAS f32x4*)gpre)[lane + 64 * j] : (f32x4){0.f, 0.f, 0.f, 0.f};
    }
    for (int m = gw; m < nrows; m += NGW) {
        f32x4 x[4];
        if (xsb) {
            const GAS v2u* xr = (const GAS v2u*)(xsb + (size_t)m * DM) + lane;
#pragma unroll
            for (int j = 0; j < 4; ++j) { const v2u xv = xr[64 * j]; x[j] = (f32x4){__uint_as_float(xv.x << 16), __uint_as_float(xv.x & 0xffff0000u), __uint_as_float(xv.y << 16), __uint_as_float(xv.y & 0xffff0000u)}; }
        } else {
            const GAS f32x4* xr = (const GAS f32x4*)(xsrc + (size_t)m * DM) + lane;
#pragma unroll
            for (int j = 0; j < 4; ++j) x[j] = xr[64 * j];
        }
        if (Y) {
            const GAS v2u* yr = (const GAS v2u*)(Y + (size_t)m * DM) + lane;
            f32x4 y[4]; float s = 0.f;
#pragma unroll
            for (int j = 0; j < 4; ++j) { const v2u yv = yr[64 * j]; y[j] = (f32x4){__uint_as_float(yv.x << 16), __uint_as_float(yv.x & 0xffff0000u), __uint_as_float(yv.y << 16), __uint_as_float(yv.y & 0xffff0000u)} * ysc;
                s += (y[j].x * y[j].x + y[j].y * y[j].y) + (y[j].z * y[j].z + y[j].w * y[j].w); }
            const float rstd = __builtin_amdgcn_rsqf(wave_sum(s) * (1.f / DM) + RMS_EPS);
#pragma unroll
            for (int j = 0; j < 4; ++j) x[j] = x[j] + y[j] * rstd * gp[j];
        }
        if (xdst) {
            GAS f32x4* xo = (GAS f32x4*)(xdst + (size_t)m * DM) + lane;
#pragma unroll
            for (int j = 0; j < 4; ++j) xo[64 * j] = x[j];
        }
        if (xdb) {
            GAS v2u* xo = (GAS v2u*)(xdb + (size_t)m * DM) + lane;
#pragma unroll
            for (int j = 0; j < 4; ++j) { v2u o; o.x = pk2(x[j].x, x[j].y); o.y = pk2(x[j].z, x[j].w); xo[64 * j] = o; }
        }
        if (gpre || Rout) {
            float s2 = 0.f;
#pragma unroll
            for (int j = 0; j < 4; ++j) s2 += (x[j].x * x[j].x + x[j].y * x[j].y) + (x[j].z * x[j].z + x[j].w * x[j].w);
            const float r2 = __builtin_amdgcn_rsqf(wave_sum(s2) * (1.f / DM) + RMS_EPS);
            if (Rout && lane == 0) Rout[m] = r2;
            if (gpre) {
            if (f8) {
                GAS unsigned* ho = (GAS unsigned*)((unsigned char*)H + (size_t)m * DM) + lane;
#pragma unroll
                for (int j = 0; j < 4; ++j) { const f32x4 h = x[j] * r2 * gq[j]; ho[64 * j] = pg8::pk4_fp8(h.x, h.y, h.z, h.w, pg8::F8S_H); }
            } else {
            GAS v2u* ho = (GAS v2u*)(H + (size_t)m * DM) + lane;
#pragma unroll
            for (int j = 0; j < 4; ++j) { const f32x4 h = x[j] * r2 * gq[j]; v2u o; o.x = pk2(h.x, h.y); o.y = pk2(h.z, h.w); ho[64 * j] = o; }
            }
            }
        }
    }
}
__device__ __forceinline__ void transpose_cols_phase(const bf16* src, int ld, int col0, int ncols, int nb, int S, bf16* dst, LAS unsigned short* scr, int gw, int NGW, int lane, int gsz = 1 << 30, int gstride = 0) {
    const int nct = ncols / 64, nst = S / 64, nitems = nb * nct * nst;
    for (int it = gw; it < nitems; it += NGW) {
        const int st = it % nst, ct = (it / nst) % nct, b = it / (nst * nct);
        const bf16* sp = src + (size_t)(b * S + st * 64) * ld + col0 + ((ct * 64) / gsz) * gstride + (ct * 64) % gsz;
#pragma unroll
        for (int i = 0; i < 8; ++i) { const int r = i * 8 + (lane >> 3), c8 = (lane & 7) * 8;
            const v4u v = *(const GAS v4u*)(sp + (size_t)r * ld + c8);
            LAS unsigned* d = (LAS unsigned*)(scr + r * 66 + c8); d[0] = v.x; d[1] = v.y; d[2] = v.z; d[3] = v.w; }
        LDS_WAIT(); asm volatile("" ::: "memory");
        bf16* dp = dst + ((size_t)(b * ncols + ct * 64)) * S + st * 64;
#pragma unroll
        for (int i = 0; i < 8; ++i) { const int c = i * 8 + (lane >> 3), r8 = (lane & 7) * 8;
            unsigned short e[8];
#pragma unroll
            for (int k = 0; k < 8; ++k) e[k] = scr[(r8 + k) * 66 + c];
            v4u o; o.x = e[0] | ((unsigned)e[1] << 16); o.y = e[2] | ((unsigned)e[3] << 16); o.z = e[4] | ((unsigned)e[5] << 16); o.w = e[6] | ((unsigned)e[7] << 16);
            *(GAS v4u*)(dp + (size_t)c * S + r8) = o; }
        LDS_WAIT(); asm volatile("" ::: "memory");
    }
}

struct Args { const float* in[24]; float* out; unsigned char* ws; int ph_lo, ph_hi, stop, li; };
constexpr int PH_PRO = 0, PH_MEMKV = 1, PH_MEMVT = 2, PH_L0 = 3, PPL = 17, NPHASE = PH_L0 + 2 * PPL;

#define PHASE_IDS unsigned char* ws = args.ws; asm volatile("" : "+s"(ws)); int bx = bx0, vcu = vcu0; asm volatile("" : "+s"(bx), "+s"(vcu)); const int gw = vcu * NWAVES + wave, NGW = G * NWAVES; (void)gw; (void)NGW; (void)bx; int lane_l; asm volatile("v_mbcnt_lo_u32_b32 %0, -1, 0\n\tv_mbcnt_hi_u32_b32 %0, -1, %0" : "=v"(lane_l)); const int lane = lane_l, tid = wave * 64 + lane; bf16* const H = (bf16*)(ws + WS_H); bf16* const Y = (bf16*)(ws + WS_Y); bf16* const XB = (bf16*)(ws + WS_XB); float* const RS = (float*)(ws + WS_RS); (void)H; (void)Y; (void)XB; (void)RS; (void)tid;
#define IN(k) (lo <= (k) && (k) < hi && (k) < stop)
#define SEAM(k) do { if ((k) + 1 < hi && (k) + 1 < stop) { XcdBarrier b2 = bar; asm volatile("" : "+s"(b2.bar), "+s"(b2.x)); xcd_barrier(b2); } } while (0)
template <int L> __device__ __forceinline__ void layer_phases(const Args& args, LAS unsigned char* lds, const XcdBarrier& bar, int wave, int G, int bx0, int vcu0, int lo, int hi, int stop) {
    const float* x_in = args.in[0]; const float* norm_pre = args.in[3]; const float* norm_post = args.in[4]; float* xout = args.out;

        const int base = PH_L0 + L * PPL;
        const float* gpre = norm_pre + (size_t)L * 4 * DM; const float* gpost = norm_post + (size_t)L * 4 * DM;
        if (IN(base + 0)) {
            PHASE_IDS
            pg8::StaticOrder S; S.init(MTOK, 5632, G, bx);
            if constexpr (L * 2 + 0 >= F8_FROM) {
                pg8::Gemm g{H, (const bf16*)(ws + WS_WGU) + (size_t)(L * 2 + 0) * 5632 * DM, MTOK, 5632, DM};
                pg8::EpiSwiGLU8 E{ws + WS_HID, DFF};
                pg8::gemm_phase<pg8::EpiSwiGLU8, pg8::StaticOrder, true, true, true>(lds, g, S, E, tid);
            } else {
                pg8::Gemm g{XB, (const bf16*)(ws + WS_WGU) + (size_t)(L * 2 + 0) * 5632 * DM, MTOK, 5632, DM};
                pg8::EpiSwiGLUR E{(bf16*)(ws + WS_HID), DFF, RS};
                pg8::gemm_phase<pg8::EpiSwiGLUR, pg8::StaticOrder, true, true>(lds, g, S, E, tid);
            }
            SEAM(base + 0);
        }
        if (IN(base + 1)) {
            PHASE_IDS
            pg8::StaticOrder S; S.init(MTOK, DM, G, bx);
            pg8::EpiBf16P E{Y, DM};
            if constexpr (L * 2 + 0 >= F8_FROM) {
                pg8::Gemm g{(const bf16*)(ws + WS_HID), (const bf16*)(ws + WS_WD) + (size_t)(L * 2 + 0) * DM * DFF, MTOK, DM, DFF};
                pg8::gemm_phase<pg8::EpiBf16P, pg8::StaticOrder, true, true, true>(lds, g, S, E, tid);
            } else {
                pg8::Gemm g{(const bf16*)(ws + WS_HID), (const bf16*)(ws + WS_WD) + (size_t)(L * 2 + 0) * DM * DFF, MTOK, DM, DFF};
                pg8::gemm_phase<pg8::EpiBf16P, pg8::StaticOrder, true, true>(lds, g, S, E, tid);
            }
            SEAM(base + 1);
        }
        if (IN(base + 2)) {
            PHASE_IDS
            rows_norm_phase(nullptr, nullptr, Y, 0.5f, gpost, L == 0 ? nullptr : gpre + DM, H, MTOK, gw, NGW, lane, L == 1, L * 2 + 0 >= F8_FROM ? 1.f / (pg8::F8S_W * pg8::F8S_HID) : 1.f, XB, XB, L == 0 ? RS : nullptr);
            SEAM(base + 2);
        }
        if (L == 0 && IN(base + 3)) {
            PHASE_IDS
            pg8::Gemm g{XB, (const bf16*)(ws + WS_EVIN), MTOK, EV_INP, DM};
            pg8::StaticOrder S; S.init(MTOK, EV_INP, G, bx);
            pg8::EpiBf16PR E{(bf16*)(ws + WS_P0), EV_INP, RS};
            pg8::gemm_phase<pg8::EpiBf16PR, pg8::StaticOrder, true, true>(lds, g, S, E, tid);
            SEAM(base + 3);
        }
        if (L == 0 && IN(base + 4)) {
            PHASE_IDS
            if (args.li == 0) { PHASE_IDS
            const bf16* P0 = (const bf16*)(ws + WS_P0);
            for (int it0 = vcu * 2; it0 < 512; it0 += G * 2) nsa_compress_pair(lds, P0, (const bf16*)(ws + WS_CWT), (const float*)(ws + WS_CBIAS), (bf16*)(ws + WS_KCMP), (bf16*)(ws + WS_VCMP), it0, wave, lane);
            }
            __syncthreads();
            { PHASE_IDS
            const bf16* P0 = (const bf16*)(ws + WS_P0);
            for (int u = vcu, i = 0; u < NB * 256; u += G, ++i) {
                int b, qt;
                if (G == 256) { b = vcu >> 4; const int sub = vcu & 15; qt = (i & 1) ? 16 * i + 15 - sub : 16 * i + sub; } else { b = u & 15; qt = u >> 4; }
                dsa_index_unit(lds, P0, (unsigned short*)(ws + WS_SEL), b, qt, tid, lane, wave);
            } }
            SEAM(base + 4);
        }
        if (L == 0 && IN(base + 5)) {
            PHASE_IDS
            build_bias_tables(lds, args.in[2], tid);
            __syncthreads();
            { PHASE_IDS
            const bf16* P0 = (const bf16*)(ws + WS_P0);
            for (int u = vcu, i = 0; u < NB * 2 * 64; u += G, ++i) {
                int bg, qt;
                if (G == 256) { bg = vcu >> 3; const int sub = vcu & 7; qt = (i & 1) ? 8 * i + 7 - sub : 8 * i + sub; } else { bg = u & 31; qt = u >> 5; }
                nsa_unit(lds, P0, (const bf16*)(ws + WS_KCMP), (const bf16*)(ws + WS_VCMP), H, bg >> 1, bg & 1, qt, tid, lane, wave);
            } }
            { PHASE_IDS
            const bf16* P0 = (const bf16*)(ws + WS_P0);
            for (int u = vcu, i = 0; u < NB * 128; u += G, ++i) {
                int b, qt;
                if (G == 256) { b = vcu >> 4; const int sub = vcu & 15; qt = (i & 1) ? 16 * i + 15 - sub : 16 * i + sub; } else { b = u & 15; qt = u >> 4; }
                dsa_unit(lds, P0, (const unsigned short*)(ws + WS_SEL), H, b, qt, tid, lane, wave);
            } }
            SEAM(base + 5);
        }
        if (L == 1 && IN(base + 3)) {
            PHASE_IDS
            pg8::Gemm g{H, (const bf16*)(ws + WS_ODIN), MTOK, OD_INP, DM};
            pg8::StaticOrder S; S.init(MTOK, OD_INP, G, bx);
            pg8::EpiBf16PS E{(bf16*)(ws + WS_P1), OD_INP, 1.f / (pg8::F8S_W * pg8::F8S_H)};
            pg8::gemm_phase<pg8::EpiBf16PS, pg8::StaticOrder, true, true, true>(lds, g, S, E, tid);
            SEAM(base + 3);
        }
        if (L == 1 && IN(base + 4)) {
            PHASE_IDS
            const bf16* P1 = (const bf16*)(ws + WS_P1);
            odd_prep_rows(P1, args.in[14], args.in[15], (const float*)(ws + WS_ROPE), (bf16*)(ws + WS_CQN), (bf16*)(ws + WS_CKVN), (bf16*)(ws + WS_KR), gw, NGW, lane);
            SEAM(base + 4);
        }
        if (L == 1 && IN(base + 5)) {
            PHASE_IDS
            { pg8::Gemm g{(const bf16*)(ws + WS_CQN), (const bf16*)(ws + WS_WUQ), MTOK, 768, 256};
              pg8::StaticOrder S; S.init(MTOK, 768, G, bx);
              pg8::EpiBf16P E{(bf16*)(ws + WS_QMLA), 768};
              pg8::gemm_phase<pg8::EpiBf16P, pg8::StaticOrder, true, true>(lds, g, S, E, tid); }
            __syncthreads();
            { pg8::Gemm g{(const bf16*)(ws + WS_CKVN), (const bf16*)(ws + WS_WUKV), MTOK, 1024, 256};
              pg8::StaticOrder S; S.init(MTOK, 1024, G, bx);
              pg8::EpiBf16P E{(bf16*)(ws + WS_KVMLA), 1024};
              pg8::gemm_phase<pg8::EpiBf16P, pg8::StaticOrder, true, true>(lds, g, S, E, tid); }
            SEAM(base + 5);
        }
        if (L == 1 && IN(base + 7)) {
            { PHASE_IDS
            build_bias_tables(lds, args.in[2], tid);
            __syncthreads();
            for (int u = vcu, i = 0; u < NB * 8 * 16; u += G, ++i) {
                int bh, qt;
                if (G == 256) { bh = vcu >> 1; const int sub = vcu & 1; qt = (i & 1) ? 2 * i + 1 - sub : 2 * i + sub; } else { bh = u & 127; qt = u >> 7; }
                mla_unit(lds, (const bf16*)(ws + WS_QMLA), (const bf16*)(ws + WS_KVMLA), (const bf16*)(ws + WS_KR), (const float*)(ws + WS_ROPE), H, bh >> 3, bh & 7, qt, tid, lane, wave);
            } }
            { PHASE_IDS
            for (int u = vcu, i = 0; u < NB * 4 * 16; u += G, ++i) {
                int bh, qt;
                if (G == 256) { bh = vcu >> 2; const int sub = vcu & 3; qt = (i & 1) ? 4 * i + 3 - sub : 4 * i + sub; } else { bh = u & 63; qt = u >> 6; }
                diff_unit(lds, (const bf16*)(ws + WS_P1), args.in[18], args.in[19], H, bh >> 2, bh & 3, qt, tid, lane, wave);
            } }
            SEAM(base + 7);
        }
        if (IN(base + 8)) {
            PHASE_IDS
            pg8::Gemm g{H, (const bf16*)(ws + (L == 0 ? WS_EVOUT : WS_ODOUT)), MTOK, DM, DM};
            pg8::StaticOrder S; S.init(MTOK, DM, G, bx);
            pg8::EpiBf16P E{Y, DM};
            pg8::gemm_phase<pg8::EpiBf16P, pg8::StaticOrder, true, true>(lds, g, S, E, tid);
            SEAM(base + 8);
        }
        if (IN(base + 9)) {
            PHASE_IDS
            rows_norm_phase(nullptr, nullptr, Y, 1.0f, gpost + DM, nullptr, H, MTOK, gw, NGW, lane, false, 1.f, XB, XB, RS);
            SEAM(base + 9);
        }
        if (IN(base + 10)) {
            PHASE_IDS
            pg8::Gemm g{XB, (const bf16*)(ws + WS_XWQ) + (size_t)L * 512 * DM, MTOK, 512, DM};
            pg8::StaticOrder S; S.init(MTOK, 512, G, bx);
            pg8::EpiBf16PR E{(bf16*)(ws + WS_XQ), 512, RS};
            pg8::gemm_phase<pg8::EpiBf16PR, pg8::StaticOrder, true, true>(lds, g, S, E, tid);
            SEAM(base + 10);
        }
        if (IN(base + 11)) {
            PHASE_IDS
            for (int u = vcu; u < NB * 4 * 16; u += G) {
                const int qt = u & 15, h = (u >> 4) & 3, b = u >> 6;
                xattn_unit(lds, (const bf16*)(ws + WS_XQ), (const bf16*)(ws + WS_KVM) + (size_t)L * MROWS * DM, H, b, h, qt, tid, lane, wave);
            }
            SEAM(base + 11);
        }
        if (IN(base + 12)) {
            PHASE_IDS
            pg8::Gemm g{H, (const bf16*)(ws + WS_XWO) + (size_t)L * DM * 512, MTOK, DM, 512};
            pg8::StaticOrder S; S.init(MTOK, DM, G, bx);
            pg8::EpiBf16P E{Y, DM};
            pg8::gemm_phase<pg8::EpiBf16P, pg8::StaticOrder, true, true>(lds, g, S, E, tid);
            SEAM(base + 12);
        }
        if (IN(base + 13)) {
            PHASE_IDS
            rows_norm_phase(nullptr, nullptr, Y, 1.0f, gpost + 2 * DM, gpre + 3 * DM, H, MTOK, gw, NGW, lane, L * 2 + 1 >= F8_FROM, 1.f, XB, XB);
            SEAM(base + 13);
        }
        if (IN(base + 14)) {
            PHASE_IDS
            pg8::StaticOrder S; S.init(MTOK, 5632, G, bx);
            if constexpr (L * 2 + 1 >= F8_FROM) {
                pg8::Gemm g{H, (const bf16*)(ws + WS_WGU) + (size_t)(L * 2 + 1) * 5632 * DM, MTOK, 5632, DM};
                pg8::EpiSwiGLU8 E{ws + WS_HID, DFF};
                pg8::gemm_phase<pg8::EpiSwiGLU8, pg8::StaticOrder, true, true, true>(lds, g, S, E, tid);
            } else {
                pg8::Gemm g{H, (const bf16*)(ws + WS_WGU) + (size_t)(L * 2 + 1) * 5632 * DM, MTOK, 5632, DM};
                pg8::EpiSwiGLU E{(bf16*)(ws + WS_HID), DFF};
                pg8::gemm_phase<pg8::EpiSwiGLU, pg8::StaticOrder, true, true>(lds, g, S, E, tid);
            }
            SEAM(base + 14);
        }
        if (IN(base + 15)) {
            PHASE_IDS
            pg8::StaticOrder S; S.init(MTOK, DM, G, bx);
            pg8::EpiBf16P E{Y, DM};
            if constexpr (L * 2 + 1 >= F8_FROM) {
                pg8::Gemm g{(const bf16*)(ws + WS_HID), (const bf16*)(ws + WS_WD) + (size_t)(L * 2 + 1) * DM * DFF, MTOK, DM, DFF};
                pg8::gemm_phase<pg8::EpiBf16P, pg8::StaticOrder, true, true, true>(lds, g, S, E, tid);
            } else {
                pg8::Gemm g{(const bf16*)(ws + WS_HID), (const bf16*)(ws + WS_WD) + (size_t)(L * 2 + 1) * DM * DFF, MTOK, DM, DFF};
                pg8::gemm_phase<pg8::EpiBf16P, pg8::StaticOrder, true, true>(lds, g, S, E, tid);
            }
            SEAM(base + 15);
        }
        if (IN(base + 16)) {
            PHASE_IDS
            rows_norm_phase(nullptr, L == 0 ? nullptr : xout, Y, 0.5f, gpost + 3 * DM, L == 0 ? norm_pre + 4 * DM : nullptr, H, MTOK, gw, NGW, lane, L * 2 + 2 >= F8_FROM, L * 2 + 1 >= F8_FROM ? 1.f / (pg8::F8S_W * pg8::F8S_HID) : 1.f, XB, L == 0 ? XB : nullptr);
            SEAM(base + 16);
        }
}


__global__ void __launch_bounds__(NWAVES * 64, 2) fwd_kernel(Args args) {
    extern __shared__ __attribute__((aligned(16))) unsigned char lds_raw[];
    LAS unsigned char* lds = (LAS unsigned char*)lds_raw;
    volatile LAS unsigned* MISC = (volatile LAS unsigned*)(lds + MISC_OFF);
    const int tid0 = threadIdx.x, wave = __builtin_amdgcn_readfirstlane(tid0 >> 6);
    const int G = gridDim.x, bx0 = blockIdx.x;
    const int vcu0 = (G % 8 == 0) ? (bx0 % 8) * (G / 8) + bx0 / 8 : bx0;
    unsigned* ctl = (unsigned*)(args.ws + WS_CTL);
    for (int u = tid0; u < (LDS_BYTES - LDSCTL_OFF) / 4; u += NWAVES * 64) ((LAS unsigned*)(lds + LDSCTL_OFF))[u] = 0u;
    __syncthreads();
    XcdBarrier bar = xcd_barrier_post(ctl + CW_BAR + args.li * XCD_BAR_WORDS, MISC + 8);
    const int lo = args.ph_lo, hi = args.ph_hi, stop = args.stop;

    const float* x_in = args.in[0]; const float* mem = args.in[1];
    const float* norm_pre = args.in[3]; const float* norm_post = args.in[4]; const float* mem_norm = args.in[5];
    float* xout = args.out;

    if (IN(PH_PRO)) {
            PHASE_IDS
        LAS float* scr = (LAS float*)(lds + wave * 16384);
        constexpr int I_GU = (DM / 64) * (DFF / 32), I_D = (DFF / 64) * (DM / 32);
        constexpr int I_EVIN = (DM / 64) * (EV_IN / 32), I_SQ = (DM / 64) * (DM / 32), I_ODIN = (DM / 64) * (OD_IN / 32);
        constexpr int I_UQ = (256 / 64) * (768 / 32), I_UKV = (128 / 64) * (1024 / 32), I_XQ = (DM / 64) * (512 / 32), I_XO = (512 / 64) * (DM / 32);
        constexpr int I_CW = (2048 / 64) * (64 / 32);
        constexpr int NITEMS = 8 * I_GU + 4 * I_D + I_EVIN + I_SQ + I_ODIN + I_SQ + I_UQ + I_UKV + 2 * I_XQ + 2 * I_SQ + 2 * I_XO + 2 * I_CW;
        for (int it = gw; it < NITEMS; it += NGW) {
            int r = it;
            if (r < 8 * I_GU) { const int mat = r / I_GU, rr = r % I_GU, which = mat & 1, ij = mat >> 1, nblk = DFF / 32, k0 = (rr / nblk) * 64, n0 = (rr % nblk) * 32;
                if (ij >= F8_FROM) tr_item8((which ? args.in[7] : args.in[6]) + (size_t)ij * DM * DFF, DFF, ws + WS_WGU + (size_t)ij * 5632 * DM * 2, DM, (n0 / 128) * 256 + which * 128 + (n0 % 128), scr, k0, n0, lane);
                else tr_item((which ? args.in[7] : args.in[6]) + (size_t)ij * DM * DFF, DFF, (bf16*)(ws + WS_WGU) + (size_t)ij * 5632 * DM, DM, (n0 / 128) * 256 + which * 128 + (n0 % 128), scr, k0, n0, lane, norm_pre);
                continue; } r -= 8 * I_GU;
            if (r < 4 * I_D) { const int mat = r / I_D, rr = r % I_D, nblk = DM / 32, k0 = (rr / nblk) * 64, n0 = (rr % nblk) * 32;
                if (mat >= F8_FROM) tr_item8(args.in[8] + (size_t)mat * DFF * DM, DM, ws + WS_WD + (size_t)mat * DM * DFF * 2, DFF, n0, scr, k0, n0, lane);
                else tr_item(args.in[8] + (size_t)mat * DFF * DM, DM, (bf16*)(ws + WS_WD) + (size_t)mat * DM * DFF, DFF, n0, scr, k0, n0, lane);
                continue; } r -= 4 * I_D;
            if (r < I_EVIN) { const int nblk = EV_IN / 32, k0 = (r / nblk) * 64, n0 = (r % nblk) * 32; tr_item(args.in[9], EV_IN, (bf16*)(ws + WS_EVIN), DM, n0, scr, k0, n0, lane, norm_pre + DM); continue; } r -= I_EVIN;
            if (r < I_SQ) { const int nblk = DM / 32, k0 = (r / nblk) * 64, n0 = (r % nblk) * 32; tr_item(args.in[12], DM, (bf16*)(ws + WS_EVOUT), DM, n0, scr, k0, n0, lane); continue; } r -= I_SQ;
            if (r < I_ODIN) { const int nblk = OD_IN / 32, k0 = (r / nblk) * 64, n0 = (r % nblk) * 32; tr_item8(args.in[13], OD_IN, ws + WS_ODIN, DM, n0, scr, k0, n0, lane); continue; } r -= I_ODIN;
            if (r < I_SQ) { const int nblk = DM / 32, k0 = (r / nblk) * 64, n0 = (r % nblk) * 32; tr_item(args.in[20], DM, (bf16*)(ws + WS_ODOUT), DM, n0, scr, k0, n0, lane); continue; } r -= I_SQ;
            if (r < I_UQ) { const int nblk = 768 / 32, k0 = (r / nblk) * 64, n0 = (r % nblk) * 32; tr_item(args.in[16], 768, (bf16*)(ws + WS_WUQ), 256, n0, scr, k0, n0, lane); continue; } r -= I_UQ;
            if (r < I_UKV) { const int nblk = 1024 / 32, k0 = (r / nblk) * 64, n0 = (r % nblk) * 32; tr_item(args.in[17], 1024, (bf16*)(ws + WS_WUKV), 256, n0, scr, k0, n0, lane); continue; } r -= I_UKV;
            if (r < 2 * I_XQ) { const int mat = r / I_XQ, rr = r % I_XQ, nblk = 512 / 32, k0 = (rr / nblk) * 64, n0 = (rr % nblk) * 32;
                tr_item(args.in[21] + (size_t)mat * DM * 512, 512, (bf16*)(ws + WS_XWQ) + (size_t)mat * 512 * DM, DM, n0, scr, k0, n0, lane, norm_pre + (size_t)(mat * 4 + 2) * DM); continue; } r -= 2 * I_XQ;
            if (r < 2 * I_SQ) { const int mat = r / I_SQ, rr = r % I_SQ, nblk = DM / 32, k0 = (rr / nblk) * 64, n0 = (rr % nblk) * 32;
                tr_item(args.in[22] + (size_t)mat * DM * DM, DM, (bf16*)(ws + WS_XWKV) + (size_t)mat * DM * DM, DM, n0, scr, k0, n0, lane); continue; } r -= 2 * I_SQ;
            if (r < 2 * I_XO) { const int mat = r / I_XO, rr = r % I_XO, nblk = DM / 32, k0 = (rr / nblk) * 64, n0 = (rr % nblk) * 32;
                tr_item(args.in[23] + (size_t)mat * 512 * DM, DM, (bf16*)(ws + WS_XWO) + (size_t)mat * DM * 512, 512, n0, scr, k0, n0, lane); continue; } r -= 2 * I_XO;
            { const int mat = r / I_CW, rr = r % I_CW, nblk = 64 / 32, k0 = (rr / nblk) * 64, n0 = (rr % nblk) * 32;
                tr_item(args.in[11] + (size_t)mat * 2048 * 64, 64, (bf16*)(ws + WS_CWT) + (size_t)mat * 64 * 2048, 2048, n0, scr, k0, n0, lane); }
        }
        { const int gt = vcu * (NWAVES * 64) + tid, NGT = G * NWAVES * 64; const v4u z = (v4u){0u, 0u, 0u, 0u};
          for (int i = gt; i < (EV_INP - EV_IN) * DM / 8; i += NGT) ((GAS v4u*)((bf16*)(ws + WS_EVIN) + (size_t)EV_IN * DM))[i] = z;
          for (int i = gt; i < (OD_INP - OD_IN) * DM / 16; i += NGT) ((GAS v4u*)(ws + WS_ODIN + (size_t)OD_IN * DM))[i] = z;
          for (int i = gt; i < 1024 * 16; i += NGT) ((GAS v4u*)((bf16*)(ws + WS_WUKV) + (size_t)(i >> 4) * 256 + 128))[i & 15] = z; }
        if (gw < 128) { const int c = gw >> 6, e = gw & 63; const float* pe = args.in[10] + (size_t)c * 2048; const float* cw = args.in[11] + (size_t)c * 2048 * 64 + e; float a = 0.f;
            for (int k = lane; k < 2048; k += 64) a += pe[k] * cw[(size_t)k * 64];
            a = wave_sum(a); if (lane == 0) ((float*)(ws + WS_CBIAS))[gw] = a; }
        rope_table_phase((float*)(ws + WS_ROPE), vcu * (NWAVES * 64) + tid, G * NWAVES * 64);
        rows_norm_phase(x_in, nullptr, nullptr, 0.f, nullptr, nullptr, H, MTOK, gw, NGW, lane, false, 1.f, nullptr, XB, RS);
        rows_norm_phase(mem, nullptr, nullptr, 0.f, nullptr, mem_norm, (bf16*)(ws + WS_MN), MROWS, gw, NGW, lane);
        rows_norm_phase(mem, nullptr, nullptr, 0.f, nullptr, mem_norm + DM, (bf16*)(ws + WS_MN) + (size_t)MROWS * DM, MROWS, gw, NGW, lane);
        SEAM(PH_PRO);
    }
    if (IN(PH_MEMKV)) {
            PHASE_IDS
#pragma unroll 1
        for (int i = 0; i < 2; ++i) {
            pg8::Gemm g{(const bf16*)(ws + WS_MN) + (size_t)i * MROWS * DM, (const bf16*)(ws + WS_XWKV) + (size_t)i * DM * DM, MROWS, DM, DM};
            pg8::StaticOrder S; S.init(MROWS, DM, G, (bx + 128 * i) % G);
            pg8::EpiBf16P E{(bf16*)(ws + WS_KVM) + (size_t)i * MROWS * DM, DM};
            pg8::gemm_phase<pg8::EpiBf16P, pg8::StaticOrder, true, true>(lds, g, S, E, tid);
            __syncthreads();
        }
        SEAM(PH_MEMKV);
    }
    layer_phases<0>(args, lds, bar, wave, G, bx0, vcu0, lo, hi, stop);
    layer_phases<1>(args, lds, bar, wave, G, bx0, vcu0, lo, hi, stop);
#undef IN
#undef SEAM
}

#ifndef MK_MODE
#define MK_MODE 1
#endif
#ifndef MK_STOP
#define MK_STOP NPHASE
#endif
extern "C" void kernel_launch(void* const* d_in, const int* in_sizes, int n_in, void* d_out, int out_size, void* d_ws, size_t ws_size, hipStream_t stream) {
    static int grid = 0;
    if (grid == 0) {
        if (n_in != 24 || out_size != MTOK * DM || ws_size < WS_END) { fprintf(stderr, "kernel_launch: unexpected shapes: n_in %d out %d ws %zu\n", n_in, out_size, ws_size); grid = -1; return; }
        int dev = 0, cus = 0, per_cu = 0;
        if (hipGetDevice(&dev) != hipSuccess || hipDeviceGetAttribute(&cus, hipDeviceAttributeMultiprocessorCount, dev) != hipSuccess) { grid = -1; return; }
        if (hipFuncSetAttribute((const void*)fwd_kernel, hipFuncAttributeMaxDynamicSharedMemorySize, LDS_BYTES) != hipSuccess) { fprintf(stderr, "kernel_launch: hipFuncSetAttribute failed\n"); grid = -1; return; }
        if (hipOccupancyMaxActiveBlocksPerMultiprocessor(&per_cu, (const void*)fwd_kernel, NWAVES * 64, LDS_BYTES) != hipSuccess || per_cu < 1)
            fprintf(stderr, "kernel_launch: occupancy query reports %d workgroups per CU\n", per_cu);
        (void)hipGetLastError();
        grid = cus;
    }
    if (grid < 0) return;
    if (hipMemsetAsync((char*)d_ws + WS_CTL, 0, CTL_ZERO_BYTES, stream) != hipSuccess) return;
    Args a{};
    for (int i = 0; i < 24; ++i) a.in[i] = (const float*)d_in[i];
    a.out = (float*)d_out; a.ws = (unsigned char*)d_ws; a.stop = MK_STOP;
#if MK_MODE == 1
    a.ph_lo = 0; a.ph_hi = NPHASE; a.li = 0;
    hipLaunchKernelGGL(fwd_kernel, dim3(grid), dim3(NWAVES * 64), LDS_BYTES, stream, a);
#else
    for (int p = 0; p < NPHASE && p < MK_STOP; ++p) {
        a.ph_lo = p; a.ph_hi = p + 1; a.li = 0;
        hipLaunchKernelGGL(fwd_kernel, dim3(grid), dim3(NWAVES * 64), LDS_BYTES, stream, a);
#ifdef MK_REP
        { const int k = p < PH_L0 ? -1 : (p - PH_L0) % PPL, L = p < PH_L0 ? -1 : (p - PH_L0) / PPL; (void)k; (void)L;
          if (MK_REP) { a.li = 1; hipLaunchKernelGGL(fwd_kernel, dim3(grid), dim3(NWAVES * 64), LDS_BYTES, stream, a); a.li = 0; } }
#endif
    }
#endif
}
```

```cpp
#include <hip/hip_runtime.h>
#include <cstdio>
#include <cstdint>
namespace pg8 {
#define PG8_LAS __attribute__((address_space(3)))
typedef unsigned short bf16_t;
typedef short bf16x8 __attribute__((ext_vector_type(8)));
typedef float f32x4 __attribute__((ext_vector_type(4)));
typedef unsigned u32x4 __attribute__((ext_vector_type(4)));
constexpr int BM = 256, BK = 64, HALF = 128, HTB = HALF * BK * 2  , STAGE_BYTES = 8 * HTB, NXCD = 8, WGM = 8;

__host__ __device__ __forceinline__ int lds_byte(int r, int c) { const int st = (r >> 4) * 2 + (c >> 5), rr = r & 15, cc = c & 31, ob = rr * 64 + cc * 2; return st * 1024 + (ob ^ (((ob >> 9) & 1) << 5)); }
__host__ __device__ __forceinline__ void stage_rc(int b, int& R, int& C) { const int st = b / 1024, sb = b % 1024, swz = sb ^ (((sb >> 9) & 1) << 5); R = (st >> 1) * 16 + swz / 64; C = (st & 1) * 32 + (swz % 64) / 2; }
__host__ __device__ __forceinline__ int perm32(int rho) { const int n = rho >> 4, i = rho & 15; return 8 * (i >> 2) + 4 * n + (i & 3); }

struct Unit { int pm, pn; };
struct Gemm { const bf16_t* A; const bf16_t* Bt; int M, N, K; };
typedef int i32x4 __attribute__((ext_vector_type(4)));
typedef int i32x8 __attribute__((ext_vector_type(8)));
__device__ __forceinline__ i32x8 cat8(bf16x8 a, bf16x8 b) { const i32x4 x = __builtin_bit_cast(i32x4, a), y = __builtin_bit_cast(i32x4, b); return __builtin_shufflevector(x, y, 0, 1, 2, 3, 4, 5, 6, 7); }

struct StaticOrder {
    int nM, nN, nwg, G, c;
    __host__ __device__ void init(int M, int N, int G_, int c_) { nM = M / BM; nN = N / BM; nwg = nM * nN; G = G_; c = c_; }
    __host__ __device__ bool next(int i, Unit& u) const {
        const long L = (long)i * G + c; if (L >= nwg) return false;
        int wgid = (int)L; { const int q = nwg / NXCD, r = nwg % NXCD, xcd = wgid % NXCD, off = wgid / NXCD; wgid = (xcd < r ? xcd * (q + 1) : r * (q + 1) + (xcd - r) * q) + off; }
        const int nig = WGM * nN, gid = wgid / nig, fm = gid * WGM, gsz = (nM - fm) < WGM ? (nM - fm) : WGM;
        u.pm = fm + ((wgid % nig) % gsz); u.pn = (wgid % nig) / gsz; return true;
    }
    __device__ __forceinline__ void a_ready(const Unit&) const {}
    __device__ __forceinline__ void done(const Unit&) const {}
};


__device__ __forceinline__ unsigned cvt_pk_bf16(float lo, float hi) { unsigned r; asm volatile("v_cvt_pk_bf16_f32 %0, %1, %2" : "=v"(r) : "v"(lo), "v"(hi)); return r; }

struct EpiF32 {
    static constexpr bool PERM = false, AFTER_DRAIN = false;
    float* C; int ldc;
    __device__ __forceinline__ void operator()(const f32x4 (&acc)[2][2][4][2], const Unit& u, int wr, int wc, int fr, int fq) const {
        const int row0 = u.pm * BM + wr * 64 + fr, col0 = u.pn * BM + wc * 32 + 4 * fq;
#pragma unroll
        for (int ai = 0; ai < 2; ++ai)
#pragma unroll
            for (int m = 0; m < 4; ++m) { float* rowp = C + (size_t)(row0 + ai * HALF + m * 16) * ldc + col0;
#pragma unroll
                for (int bj = 0; bj < 2; ++bj)
#pragma unroll
                    for (int n = 0; n < 2; ++n) *(f32x4*)(rowp + bj * HALF + n * 16) = acc[ai][bj][m][n]; }
    }
};
struct EpiBf16P {
    static constexpr bool PERM = true, AFTER_DRAIN = false;
    bf16_t* O; int ldc;
    __device__ __forceinline__ void operator()(const f32x4 (&acc)[2][2][4][2], const Unit& u, int wr, int wc, int fr, int fq) const {
        const int row0 = u.pm * BM + wr * 64 + fr, col0 = u.pn * BM + wc * 32 + 8 * fq;
#pragma unroll
        for (int ai = 0; ai < 2; ++ai)
#pragma unroll
            for (int m = 0; m < 4; ++m) { bf16_t* rowp = O + (size_t)(row0 + ai * HALF + m * 16) * ldc + col0;
#pragma unroll
                for (int bj = 0; bj < 2; ++bj) { const f32x4 v0 = acc[ai][bj][m][0], v1 = acc[ai][bj][m][1];
                    u32x4 w; w.x = cvt_pk_bf16(v0[0], v0[1]); w.y = cvt_pk_bf16(v0[2], v0[3]); w.z = cvt_pk_bf16(v1[0], v1[1]); w.w = cvt_pk_bf16(v1[2], v1[3]);
                    *(u32x4*)(rowp + bj * HALF) = w; } }
    }
};
__device__ __forceinline__ float silu_mul(float g, float u) { return g * __builtin_amdgcn_rcpf(1.0f + __builtin_amdgcn_exp2f(g * -1.4426950408889634f)) * u; }
struct EpiSwiGLU {
    static constexpr bool PERM = true, AFTER_DRAIN = false;
    bf16_t* O; int ldc;
    __device__ __forceinline__ void operator()(const f32x4 (&acc)[2][2][4][2], const Unit& u, int wr, int wc, int fr, int fq) const {
        const int row0 = u.pm * BM + wr * 64 + fr, col0 = u.pn * HALF + wc * 32 + 8 * fq;
#pragma unroll
        for (int ai = 0; ai < 2; ++ai)
#pragma unroll
            for (int m = 0; m < 4; ++m) { bf16_t* rowp = O + (size_t)(row0 + ai * HALF + m * 16) * ldc + col0;
                const f32x4 g0 = acc[ai][0][m][0], g1 = acc[ai][0][m][1], u0 = acc[ai][1][m][0], u1 = acc[ai][1][m][1];
                u32x4 w; w.x = cvt_pk_bf16(silu_mul(g0[0], u0[0]), silu_mul(g0[1], u0[1])); w.y = cvt_pk_bf16(silu_mul(g0[2], u0[2]), silu_mul(g0[3], u0[3]));
                w.z = cvt_pk_bf16(silu_mul(g1[0], u1[0]), silu_mul(g1[1], u1[1])); w.w = cvt_pk_bf16(silu_mul(g1[2], u1[2]), silu_mul(g1[3], u1[3]));
                *(u32x4*)rowp = w; }
    }
};


__device__ __forceinline__ unsigned pk4_fp8(float a, float b, float c, float d, float S) {
    a = __builtin_amdgcn_fmed3f(a * S, -448.f, 448.f); b = __builtin_amdgcn_fmed3f(b * S, -448.f, 448.f); c = __builtin_amdgcn_fmed3f(c * S, -448.f, 448.f); d = __builtin_amdgcn_fmed3f(d * S, -448.f, 448.f);
    int p = __builtin_amdgcn_cvt_pk_fp8_f32(a, b, 0, false); p = __builtin_amdgcn_cvt_pk_fp8_f32(c, d, p, true); return (unsigned)p;
}
constexpr float F8S_H = 4.f, F8S_HID = 8.f, F8S_W = 64.f;
struct EpiSwiGLU8 {
    static constexpr bool PERM = true, AFTER_DRAIN = false;
    unsigned char* O; int ldc;
    __device__ __forceinline__ void operator()(const f32x4 (&acc)[2][2][4][2], const Unit& u, int wr, int wc, int fr, int fq) const {
        const int row0 = u.pm * BM + wr * 64 + fr, col0 = u.pn * HALF + wc * 32 + 8 * fq;
#pragma unroll
        for (int ai = 0; ai < 2; ++ai)
#pragma unroll
            for (int m = 0; m < 4; ++m) { unsigned char* rowp = O + (size_t)(row0 + ai * HALF + m * 16) * ldc + col0;
                const f32x4 g0 = acc[ai][0][m][0], g1 = acc[ai][0][m][1], u0 = acc[ai][1][m][0], u1 = acc[ai][1][m][1];
                constexpr float GS = 1.f / (F8S_W * F8S_H), C1 = -1.4426950408889634f * GS, C2 = GS * GS * F8S_HID;
                const f32x4 t0 = g0 * C1, t1 = g1 * C1;
                f32x4 e0, e1;
#pragma unroll
                for (int i = 0; i < 4; ++i) { e0[i] = __builtin_amdgcn_rcpf(1.0f + __builtin_amdgcn_exp2f(t0[i])); e1[i] = __builtin_amdgcn_rcpf(1.0f + __builtin_amdgcn_exp2f(t1[i])); }
                const f32x4 h0 = (g0 * e0) * (u0 * C2), h1 = (g1 * e1) * (u1 * C2);
                uint2 w; w.x = pk4_fp8(h0[0], h0[1], h0[2], h0[3], 1.f); w.y = pk4_fp8(h1[0], h1[1], h1[2], h1[3], 1.f);
                *(uint2*)rowp = w; }
    }
};
struct EpiBf16PS {
    static constexpr bool PERM = true, AFTER_DRAIN = false;
    bf16_t* O; int ldc; float sc;
    __device__ __forceinline__ void operator()(const f32x4 (&acc)[2][2][4][2], const Unit& u, int wr, int wc, int fr, int fq) const {
        const int row0 = u.pm * BM + wr * 64 + fr, col0 = u.pn * BM + wc * 32 + 8 * fq;
#pragma unroll
        for (int ai = 0; ai < 2; ++ai)
#pragma unroll
            for (int m = 0; m < 4; ++m) { bf16_t* rowp = O + (size_t)(row0 + ai * HALF + m * 16) * ldc + col0;
#pragma unroll
                for (int bj = 0; bj < 2; ++bj) { const f32x4 v0 = acc[ai][bj][m][0] * sc, v1 = acc[ai][bj][m][1] * sc;
                    u32x4 w; w.x = cvt_pk_bf16(v0[0], v0[1]); w.y = cvt_pk_bf16(v0[2], v0[3]); w.z = cvt_pk_bf16(v1[0], v1[1]); w.w = cvt_pk_bf16(v1[2], v1[3]);
                    *(u32x4*)(rowp + bj * HALF) = w; } }
    }
};
struct EpiBf16PR {
    static constexpr bool PERM = true, AFTER_DRAIN = false;
    bf16_t* O; int ldc; const float* R;
    __device__ __forceinline__ void operator()(const f32x4 (&acc)[2][2][4][2], const Unit& u, int wr, int wc, int fr, int fq) const {
        const int row0 = u.pm * BM + wr * 64 + fr, col0 = u.pn * BM + wc * 32 + 8 * fq;
        float rs[2][4];
#pragma unroll
        for (int ai = 0; ai < 2; ++ai)
#pragma unroll
            for (int m = 0; m < 4; ++m) rs[ai][m] = R[row0 + ai * HALF + m * 16];
#pragma unroll
        for (int ai = 0; ai < 2; ++ai)
#pragma unroll
            for (int m = 0; m < 4; ++m) { bf16_t* rowp = O + (size_t)(row0 + ai * HALF + m * 16) * ldc + col0;
#pragma unroll
                for (int bj = 0; bj < 2; ++bj) { const f32x4 v0 = acc[ai][bj][m][0] * rs[ai][m], v1 = acc[ai][bj][m][1] * rs[ai][m];
                    u32x4 w; w.x = cvt_pk_bf16(v0[0], v0[1]); w.y = cvt_pk_bf16(v0[2], v0[3]); w.z = cvt_pk_bf16(v1[0], v1[1]); w.w = cvt_pk_bf16(v1[2], v1[3]);
                    *(u32x4*)(rowp + bj * HALF) = w; } }
    }
};
struct EpiSwiGLUR {
    static constexpr bool PERM = true, AFTER_DRAIN = false;
    bf16_t* O; int ldc; const float* R;
    __device__ __forceinline__ void operator()(const f32x4 (&acc)[2][2][4][2], const Unit& u, int wr, int wc, int fr, int fq) const {
        const int row0 = u.pm * BM + wr * 64 + fr, col0 = u.pn * HALF + wc * 32 + 8 * fq;
        float rs[2][4];
#pragma unroll
        for (int ai = 0; ai < 2; ++ai)
#pragma unroll
            for (int m = 0; m < 4; ++m) rs[ai][m] = R[row0 + ai * HALF + m * 16];
#pragma unroll
        for (int ai = 0; ai < 2; ++ai)
#pragma unroll
            for (int m = 0; m < 4; ++m) { bf16_t* rowp = O + (size_t)(row0 + ai * HALF + m * 16) * ldc + col0;
                const f32x4 g0 = acc[ai][0][m][0] * rs[ai][m], g1 = acc[ai][0][m][1] * rs[ai][m], u0 = acc[ai][1][m][0] * rs[ai][m], u1 = acc[ai][1][m][1] * rs[ai][m];
                u32x4 w; w.x = cvt_pk_bf16(silu_mul(g0[0], u0[0]), silu_mul(g0[1], u0[1])); w.y = cvt_pk_bf16(silu_mul(g0[2], u0[2]), silu_mul(g0[3], u0[3]));
                w.z = cvt_pk_bf16(silu_mul(g1[0], u1[0]), silu_mul(g1[1], u1[1])); w.w = cvt_pk_bf16(silu_mul(g1[2], u1[2]), silu_mul(g1[3], u1[3]));
                *(u32x4*)rowp = w; }
    }
};
template <class Epi, class Sched, bool ALIGN_EPI = false, bool SP2 = false, bool F8 = false>
__device__ __forceinline__ void gemm_phase(PG8_LAS unsigned char* lds, const Gemm g, const Sched& S, const Epi& E, int tid_in) {
    int tid_l = tid_in; asm volatile("" : "+v"(tid_l));
    const int tid = tid_l, wid = __builtin_amdgcn_readfirstlane(tid >> 6), lane = tid & 63, wr = wid >> 2, wc = wid & 3, fr = lane & 15, fq = lane >> 4;
    const int K = F8 ? g.K / 2 : g.K, nt = K / BK;
    unsigned voffA[2], voffB[2];
#pragma unroll
    for (int i = 0; i < 2; ++i) { int R, C; stage_rc(tid * 16 + i * 8192, R, C); const int Rb = Epi::PERM ? ((R & ~31) + perm32(R & 31)) : R;
        voffA[i] = (unsigned)(R * K + C) * 2u; voffB[i] = (unsigned)(Rb * K + C) * 2u; }
    const size_t kstep = (size_t)(BK * 2);
    const size_t hstep = (size_t)HALF * K * 2;
    const size_t tstep = 2 * hstep;
    const unsigned ldsw = (unsigned)wid * 1024u;
    const int aoff = lds_byte(wr * 64 + fr, fq * 8), boff = lds_byte(wc * 32 + fr, fq * 8);
#define PG8_SA(b, h) (((b) * 2 + (h)) * HTB)
#define PG8_SB(b, h) ((4 + (b) * 2 + (h)) * HTB)
#define PG8_STAGE(bufoff, gbase, voff) do { const char* _gb = (const char*)(gbase); if constexpr (F8) asm volatile("" : "+s"(_gb));     \
        _Pragma("unroll") for (int _i = 0; _i < 2; ++_i) \
        __builtin_amdgcn_global_load_lds((const unsigned*)(_gb + (voff)[_i]), (PG8_LAS unsigned*)(lds + (bufoff) + ldsw + _i * 8192), 16, 0, 0); } while (0)
#define PG8_LDA(dst, b, h) do { _Pragma("unroll") for (int m = 0; m < 4; ++m) _Pragma("unroll") for (int k = 0; k < 2; ++k) dst[m][k] = *(const PG8_LAS bf16x8*)(lds + PG8_SA(b, h) + aoff + m * 2048 + k * 1024); } while (0)
#define PG8_LDB(dst, b, h) do { _Pragma("unroll") for (int n = 0; n < 2; ++n) _Pragma("unroll") for (int k = 0; k < 2; ++k) dst[n][k] = *(const PG8_LAS bf16x8*)(lds + PG8_SB(b, h) + boff + n * 2048 + k * 1024); } while (0)
#define PG8_MMA(ai, bj, At, Bt) do { __builtin_amdgcn_s_setprio(1); _Pragma("unroll") for (int m = 0; m < 4; ++m) _Pragma("unroll") for (int n = 0; n < 2; ++n) _Pragma("unroll") for (int k = 0; k < 2; ++k) \
        acc[ai][bj][m][n] = __builtin_amdgcn_mfma_f32_16x16x32_bf16(Bt[n][k], At[m][k], acc[ai][bj][m][n], 0, 0, 0); __builtin_amdgcn_s_setprio(0); } while (0)
#define PG8_MMA8(ai, bj, At, Bt) do { __builtin_amdgcn_s_setprio(1); _Pragma("unroll") for (int m = 0; m < 4; ++m) _Pragma("unroll") for (int n = 0; n < 2; ++n) \
        acc[ai][bj][m][n] = __builtin_amdgcn_mfma_scale_f32_16x16x128_f8f6f4(cat8(Bt[n][0], Bt[n][1]), cat8(At[m][0], At[m][1]), acc[ai][bj][m][n], 0, 0, 0, 0, 0, 0); __builtin_amdgcn_s_setprio(0); } while (0)
#define PG8_MM(ai, bj, At, Bt) do { if constexpr (F8) PG8_MMA8(ai, bj, At, Bt); else PG8_MMA(ai, bj, At, Bt); } while (0)
#define PG8_WAIT_V(n) asm volatile("s_waitcnt vmcnt(" #n ")" ::: "memory")
#define PG8_WAIT_L(n) asm volatile("s_waitcnt lgkmcnt(" #n ")" ::: "memory")
#define PG8_BAR __builtin_amdgcn_s_barrier()
#define PG8_SCHED __builtin_amdgcn_sched_barrier(0)
    Unit cur, nxt; int ui = 0;
    if (!S.next(0, cur)) return;
    f32x4 acc[2][2][4][2];
#pragma unroll
    for (int a = 0; a < 2; ++a)
#pragma unroll
        for (int b = 0; b < 2; ++b)
#pragma unroll
            for (int m = 0; m < 4; ++m)
#pragma unroll
                for (int n = 0; n < 2; ++n) acc[a][b][m][n] = (f32x4){0.f, 0.f, 0.f, 0.f};
    bf16x8 At[4][2], B0[2][2], B1[2][2];
    const char* cA = (const char*)g.A + (size_t)cur.pm * tstep; const char* cB = (const char*)g.Bt + (size_t)cur.pn * tstep;
    S.a_ready(cur);
    if constexpr (SP2) {
        PG8_STAGE(PG8_SB(0, 0), cB, voffB); PG8_STAGE(PG8_SB(0, 1), cB + hstep, voffB); PG8_STAGE(PG8_SA(0, 0), cA, voffA); PG8_STAGE(PG8_SA(0, 1), cA + hstep, voffA);
        if (wr == 1) PG8_BAR;
        PG8_WAIT_V(2); PG8_BAR;
        PG8_STAGE(PG8_SB(1, 0), cB + kstep, voffB); PG8_STAGE(PG8_SA(1, 0), cA + kstep, voffA); PG8_STAGE(PG8_SB(1, 1), cB + hstep + kstep, voffB);
        PG8_WAIT_V(6); PG8_BAR;
    } else {
        PG8_STAGE(PG8_SB(0, 0), cB, voffB); PG8_STAGE(PG8_SA(0, 0), cA, voffA); PG8_STAGE(PG8_SB(0, 1), cB + hstep, voffB); PG8_STAGE(PG8_SA(0, 1), cA + hstep, voffA);
        if (wr == 1) PG8_BAR;
        PG8_WAIT_V(4); PG8_BAR;
        PG8_STAGE(PG8_SB(1, 0), cB + kstep, voffB); PG8_STAGE(PG8_SA(1, 0), cA + kstep, voffA); PG8_STAGE(PG8_SB(1, 1), cB + hstep + kstep, voffB);
        PG8_WAIT_V(6); PG8_BAR;
    }
    for (;;) {
        const bool has_next = S.next(ui + 1, nxt);
        const char* nA = has_next ? (const char*)g.A + (size_t)nxt.pm * tstep : cA; const char* nB = has_next ? (const char*)g.Bt + (size_t)nxt.pn * tstep : cB;
#pragma unroll 1
        for (int t = 0; t < nt; t += 2) {
            const bool last = (t == nt - 2);
            const char* a1 = cA + (size_t)(t + 1) * kstep;
            const char* a2 = last ? nA : cA + (size_t)(t + 2) * kstep; const char* b2 = last ? nB : cB + (size_t)(t + 2) * kstep;
            const char* a3 = a2 + kstep; const char* b3 = b2 + kstep;
            if (last && has_next) S.a_ready(nxt);
            if constexpr (SP2) {
            PG8_LDB(B0, 0, 0); PG8_LDB(B1, 0, 1); PG8_SCHED; PG8_LDA(At, 0, 0); PG8_STAGE(PG8_SA(1, 1), a1 + hstep, voffA);
            PG8_WAIT_V(8); PG8_WAIT_L(0); PG8_BAR; PG8_MM(0, 0, At, B0); PG8_MM(0, 1, At, B1); PG8_BAR; PG8_SCHED;
            PG8_LDA(At, 0, 1); PG8_STAGE(PG8_SB(0, 0), b2, voffB); PG8_STAGE(PG8_SB(0, 1), b2 + hstep, voffB); PG8_STAGE(PG8_SA(0, 0), a2, voffA);
            PG8_WAIT_V(8); PG8_WAIT_L(0); PG8_BAR; PG8_MM(1, 0, At, B0); PG8_MM(1, 1, At, B1); PG8_BAR; PG8_SCHED;
            PG8_LDB(B0, 1, 0); PG8_LDB(B1, 1, 1); PG8_SCHED; PG8_LDA(At, 1, 0); PG8_STAGE(PG8_SA(0, 1), a2 + hstep, voffA);
            PG8_WAIT_V(8); PG8_WAIT_L(0); PG8_BAR; PG8_MM(0, 0, At, B0); PG8_MM(0, 1, At, B1); PG8_BAR; PG8_SCHED;
            PG8_LDA(At, 1, 1); PG8_STAGE(PG8_SB(1, 0), b3, voffB); PG8_STAGE(PG8_SB(1, 1), b3 + hstep, voffB); PG8_STAGE(PG8_SA(1, 0), a3, voffA);
            PG8_WAIT_V(8); PG8_WAIT_L(0); PG8_BAR; PG8_MM(1, 0, At, B0); PG8_MM(1, 1, At, B1); PG8_BAR; PG8_SCHED;
            } else {
            PG8_LDB(B0, 0, 0); PG8_SCHED; PG8_LDA(At, 0, 0); PG8_STAGE(PG8_SA(1, 1), a1 + hstep, voffA);
            PG8_WAIT_L(8); PG8_BAR; PG8_WAIT_L(0); PG8_MM(0, 0, At, B0); PG8_BAR; PG8_SCHED;
            PG8_LDB(B1, 0, 1); PG8_STAGE(PG8_SB(0, 0), b2, voffB);
            PG8_BAR; PG8_WAIT_L(0); PG8_MM(0, 1, At, B1); PG8_BAR;
            PG8_LDA(At, 0, 1); PG8_STAGE(PG8_SA(0, 0), a2, voffA);
            PG8_BAR; PG8_WAIT_L(0); PG8_MM(1, 0, At, B0); PG8_BAR; PG8_SCHED;
            PG8_STAGE(PG8_SB(0, 1), b2 + hstep, voffB);
            PG8_WAIT_V(6); PG8_BAR; PG8_MM(1, 1, At, B1); PG8_BAR;
            PG8_LDB(B0, 1, 0); PG8_SCHED; PG8_LDA(At, 1, 0); PG8_STAGE(PG8_SA(0, 1), a2 + hstep, voffA);
            PG8_WAIT_L(8); PG8_BAR; PG8_WAIT_L(0); PG8_MM(0, 0, At, B0); PG8_BAR; PG8_SCHED;
            PG8_LDB(B1, 1, 1); PG8_STAGE(PG8_SB(1, 0), b3, voffB);
            PG8_BAR; PG8_WAIT_L(0); PG8_MM(0, 1, At, B1); PG8_BAR;
            PG8_LDA(At, 1, 1); PG8_STAGE(PG8_SA(1, 0), a3, voffA);
            PG8_BAR; PG8_WAIT_L(0); PG8_MM(1, 0, At, B0); PG8_BAR; PG8_SCHED;
            PG8_STAGE(PG8_SB(1, 1), b3 + hstep, voffB);
            PG8_WAIT_V(6); PG8_BAR; PG8_MM(1, 1, At, B1); PG8_BAR;
            }
        }
        if constexpr (ALIGN_EPI) { if (wr == 0) PG8_BAR; }
        if constexpr (!Epi::AFTER_DRAIN) {
            if constexpr (F8) { int l2; asm volatile("v_mbcnt_lo_u32_b32 %0, -1, 0\n\tv_mbcnt_hi_u32_b32 %0, -1, %0" : "=v"(l2)); E(acc, cur, wr, wc, l2 & 15, l2 >> 4); }
            else E(acc, cur, wr, wc, fr, fq);
            S.done(cur); }
        if (!has_next) break;
#pragma unroll
        for (int a = 0; a < 2; ++a)
#pragma unroll
            for (int b = 0; b < 2; ++b)
#pragma unroll
                for (int m = 0; m < 4; ++m)
#pragma unroll
                    for (int n = 0; n < 2; ++n) acc[a][b][m][n] = (f32x4){0.f, 0.f, 0.f, 0.f};
        cur = nxt; cA = nA; cB = nB; ++ui;
        if constexpr (ALIGN_EPI) { if (wr == 1) PG8_BAR; }
    }
    PG8_WAIT_V(0);
    if constexpr (!ALIGN_EPI) { if (wr == 0) PG8_BAR; }
    PG8_BAR;
    if constexpr (Epi::AFTER_DRAIN) { E.fused(acc, cur, wr, wc, fr, fq, lds, wid, lane); S.done(cur); }
#undef PG8_SA
#undef PG8_SB
#undef PG8_STAGE
#undef PG8_LDA
#undef PG8_LDB
#undef PG8_MMA
#undef PG8_MMA8
#undef PG8_MM
#undef PG8_WAIT_V
#undef PG8_WAIT_L
#undef PG8_BAR
#undef PG8_SCHED
}
}

constexpr int DM = 1024, NB = 16, SEQ = 4096, MTOK = NB * SEQ, DFF = 2816, MEML = 256, MROWS = NB * MEML;
constexpr int EV_IN = 2240, EV_INP = 2304, OD_IN = 1952, OD_INP = 2048;
constexpr float RMS_EPS = 1e-6f;
constexpr int NWAVES = 8;

constexpr size_t MiB = 1u << 20;
constexpr size_t WS_CTL = 0, CTL_ZERO_BYTES = 1 * MiB;
constexpr size_t WS_WGU = 2 * MiB;
constexpr size_t WS_WD = 46 * MiB;
constexpr size_t WS_EVIN = 68 * MiB;
constexpr size_t WS_EVOUT = 73 * MiB;
constexpr size_t WS_ODIN = 75 * MiB;
constexpr size_t WS_ODOUT = 79 * MiB;
constexpr size_t WS_WUQ = 81 * MiB;
constexpr size_t WS_WUKV = 82 * MiB;
constexpr size_t WS_XWQ = 83 * MiB;
constexpr size_t WS_XWKV = 85 * MiB;
constexpr size_t WS_XWO = 89 * MiB;
constexpr size_t WS_MN = 92 * MiB;
constexpr size_t WS_KVM = 108 * MiB;
constexpr size_t WS_VMT = 124 * MiB;
constexpr size_t WS_H = 132 * MiB;
constexpr size_t WS_Y = 260 * MiB;
constexpr size_t WS_OV = 516 * MiB;
constexpr size_t WS_END = 1024 * MiB;
constexpr size_t WS_HID = WS_OV;
constexpr size_t WS_XQ = WS_OV;

constexpr int CW_BAR = 4096;
constexpr int RING_BYTES = 131072, LDSCTL_OFF = RING_BYTES, MISC_OFF = LDSCTL_OFF + 320, LDS_BYTES = 147456;

#define GAS __attribute__((address_space(1)))
#define LAS __attribute__((address_space(3)))
typedef unsigned short bf16;
typedef unsigned v4u __attribute__((ext_vector_type(4)));
typedef unsigned v2u __attribute__((ext_vector_type(2)));
typedef float f32x4 __attribute__((ext_vector_type(4)));
typedef short bf16x8 __attribute__((ext_vector_type(8)));
#define LDS_WAIT() asm volatile("s_waitcnt lgkmcnt(0)" ::: "memory")
#define VM_WAIT() asm volatile("s_waitcnt vmcnt(0)" ::: "memory")
__device__ __forceinline__ unsigned f2bf(float f) { unsigned u = __builtin_bit_cast(unsigned, f); return (u + 0x7fffu + ((u >> 16) & 1u)) >> 16; }
__device__ __forceinline__ unsigned pk2(float lo, float hi) { return f2bf(lo) | (f2bf(hi) << 16); }
__device__ __forceinline__ float bf2f(unsigned short b) { return __builtin_bit_cast(float, (unsigned)b << 16); }
template <int K> __device__ __forceinline__ unsigned lx_u(unsigned v) {
    if constexpr (K == 32) { auto rr = __builtin_amdgcn_permlane32_swap(v, v, false, false); return rr[0] ^ rr[1] ^ v; }
    else return (unsigned)__builtin_amdgcn_ds_swizzle((int)v, (K << 10) | 0x1f);
}
template <int K> __device__ __forceinline__ float lx_f(float v) { return __uint_as_float(lx_u<K>(__float_as_uint(v))); }
__device__ __forceinline__ float wave_sum(float v) {
    v += lx_f<1>(v); v += lx_f<2>(v); v += lx_f<4>(v); v += lx_f<8>(v); v += lx_f<16>(v); v += lx_f<32>(v);
    return v;
}
__device__ __forceinline__ float fmx(float a, float b) { return __builtin_elementwise_maximum(a, b); }
__device__ __forceinline__ float fmx3(float a, float b, float c) { return __builtin_elementwise_maximum(__builtin_elementwise_maximum(a, b), c); }
__device__ __forceinline__ float fmn(float a, float b) { return __builtin_elementwise_minimum(a, b); }

#define XB_TMO      128
#define XB_XCNT(j)  (256  + 64 * (j))
#define XB_XSUB(j)  (1280 + 64 * (j))
#define XB_XGEN(j)  (2304 + 64 * (j))
#define XB_TOP      3328
#define XB_TOPGEN   3392
#define XCD_BAR_WORDS 3456
#define XB_SPIN_CAP (1u << 18)

__device__ __forceinline__ unsigned xb_ld(unsigned* p)              { return __hip_atomic_load(p, __ATOMIC_RELAXED, __HIP_MEMORY_SCOPE_AGENT); }
__device__ __forceinline__ unsigned xb_add(unsigned* p, unsigned v) { return __hip_atomic_fetch_add(p, v, __ATOMIC_RELAXED, __HIP_MEMORY_SCOPE_AGENT); }
__device__ __forceinline__ unsigned xb_xcc_id() { return (unsigned)__builtin_amdgcn_s_getreg((3 << 11) | 20) & 0xFu; }
#define XB_SPIN(cond, bar) do { unsigned _sp = 0; while (cond) { __builtin_amdgcn_s_sleep(1); \
    if ((++_sp & 255u) == 0u) { if (xb_ld(&(bar)[XB_TMO])) break; if (_sp > XB_SPIN_CAP) { atomicAdd(&(bar)[XB_TMO], 1u); break; } } } } while (0)

struct XcdBarrier {
    unsigned* bar; unsigned x;
    unsigned w0;
    volatile LAS unsigned* st;
};

__device__ __forceinline__ XcdBarrier xcd_barrier_post(unsigned* bar, volatile LAS unsigned* st) {
    XcdBarrier b; b.bar = bar; b.x = xb_xcc_id(); b.st = st; b.w0 = (unsigned)__builtin_amdgcn_readfirstlane((threadIdx.x >> 6) == 0 ? 1 : 0);
    if (threadIdx.x == 0) (void)xb_add(&bar[XB_XCNT(b.x)], 1u);
    return b;
}
__device__ __forceinline__ void xcd_barrier_complete(unsigned* bar, unsigned x, unsigned& nloc, unsigned& nx) {
    const unsigned G = gridDim.x * gridDim.y * gridDim.z;
    unsigned sum, cnt, mine, sp = 0u;
    for (;;) {
        sum = 0u; cnt = 0u; mine = 0u;
#pragma unroll
        for (unsigned j = 0; j < 16; ++j) { const unsigned c = xb_ld(&bar[XB_XCNT(j)]); sum += c; cnt += (c > 0u) ? 1u : 0u; mine = (j == x) ? c : mine; }
        if (sum == G) break;
        __builtin_amdgcn_s_sleep(1);
        if ((++sp & 255u) == 0u) { if (xb_ld(&bar[XB_TMO])) break; if (sp > XB_SPIN_CAP) { atomicAdd(&bar[XB_TMO], 1u); break; } }
    }
    nloc = mine > 0u ? mine : 1u; nx = cnt > 0u ? cnt : 1u;
}

__device__ __forceinline__ void xcd_barrier(const XcdBarrier& b) {
    asm volatile("s_waitcnt vmcnt(0)" ::: "memory");
    __syncthreads();
    unsigned xb_lane; asm volatile("v_mbcnt_lo_u32_b32 %0, -1, 0\n\tv_mbcnt_hi_u32_b32 %0, -1, %0" : "=v"(xb_lane));
    if (b.w0 != 0u && xb_lane == 0u) {
        unsigned* bar = b.bar;
        __builtin_amdgcn_s_waitcnt(0);
        unsigned nloc = b.st[0], nx = b.st[1];
        if (nloc == 0u) { xcd_barrier_complete(bar, b.x, nloc, nx); b.st[0] = nloc; b.st[1] = nx; }
        const unsigned old = xb_add(&bar[XB_XSUB(b.x)], 1u);
        const unsigned gen = old / nloc;
        if (old + 1u == (gen + 1u) * nloc) {
            __builtin_amdgcn_fence(__ATOMIC_RELEASE, "agent");
            asm volatile("s_waitcnt vmcnt(0)" ::: "memory");
            const unsigned og = xb_add(&bar[XB_TOP], 1u);
            const unsigned tg = og / nx;
            if (og + 1u == (tg + 1u) * nx) xb_add(&bar[XB_TOPGEN], 1u);
            else XB_SPIN(xb_ld(&bar[XB_TOPGEN]) == tg, bar);
            __builtin_amdgcn_fence(__ATOMIC_ACQUIRE, "agent");
            xb_add(&bar[XB_XGEN(b.x)], 1u);
            asm volatile("s_waitcnt vmcnt(0)" ::: "memory");
        } else {
            XB_SPIN(xb_ld(&bar[XB_XGEN(b.x)]) == gen, bar);
            __builtin_amdgcn_fence(__ATOMIC_ACQUIRE, "agent");
            asm volatile("s_waitcnt vmcnt(0)" ::: "memory");
        }
    }
    __syncthreads();
}


typedef float f32x16 __attribute__((ext_vector_type(16)));
typedef short s16x4 __attribute__((ext_vector_type(4)));
constexpr float NEGBIG = -1e30f, LOG2E = 1.4426950408889634f;
constexpr int KP128 = 272, KBUF_BYTES = 64 * KP128, VBUF_BYTES = 64 * KP128;
constexpr int AT_KBUF = 0, AT_VBUF = 2 * KBUF_BYTES, AT_BT = AT_VBUF + 2 * VBUF_BYTES, BT_STRIDE = 132, AT_WS = AT_BT + 20 * BT_STRIDE * 4, AT_WS_PER_WAVE = 4096;
static_assert(AT_WS + 8 * AT_WS_PER_WAVE <= RING_BYTES, "attention LDS map");
__device__ __forceinline__ int crow(int r, int hi) { return (r & 3) + 8 * (r >> 2) + 4 * hi; }
typedef float f32x2_t __attribute__((ext_vector_type(2))); typedef __bf16 bf16x2_t __attribute__((ext_vector_type(2)));
__device__ __forceinline__ unsigned cvtpk(float lo, float hi) { f32x2_t v = {lo, hi}; bf16x2_t b = __builtin_convertvector(v, bf16x2_t); return __builtin_bit_cast(unsigned, b); }
typedef float f32x8_t __attribute__((ext_vector_type(8)));
typedef float f32x2_t __attribute__((ext_vector_type(2)));
__device__ __forceinline__ float vsum32(const f32x16 (&s)[2]) {
    const f32x16 a = s[0] + s[1]; const f32x8_t b = a.lo + a.hi; const f32x4 c = b.lo + b.hi; const f32x2_t d = c.lo + c.hi; return d.x + d.y;
}
__device__ __forceinline__ float swapmax(float v) { auto rr = __builtin_amdgcn_permlane32_swap(__float_as_uint(v), __float_as_uint(v), false, false); return fmx(__uint_as_float(rr[0]), __uint_as_float(rr[1])); }
__device__ __forceinline__ float swapsum(float v) { auto rr = __builtin_amdgcn_permlane32_swap(__float_as_uint(v), __float_as_uint(v), false, false); return __uint_as_float(rr[0]) + __uint_as_float(rr[1]); }
__device__ __forceinline__ float swapget(float v) { return lx_f<32>(v); }

struct KVSrc {
    const bf16* ka; int kpa;
    const bf16* kb; int kpb;
    const bf16* v; int vp;
};
template <int DQK, int KA, int DV> struct Stage {
    static constexpr int CPR = DQK / 8, NKC = 64 * CPR, NKI = (NKC + 511) / 512, CPV = DV / 8, NVC = 64 * CPV, NVI = (NVC + 511) / 512, KP = DQK * 2 + 16, VP = DV * 2 + 16;
    v4u k[NKI]; v4u v[NVI];
    __device__ __forceinline__ void load(const KVSrc& s, int kt, int tid) {
#pragma unroll
        for (int i = 0; i < NKI; ++i) { const int c = tid + 512 * i; if (NKC % 512 == 0 || c < NKC) { const int row = c / CPR, cc = c % CPR;
            const bf16* p = (KA == DQK || cc < KA / 8) ? s.ka + (size_t)(64 * kt + row) * s.kpa + 8 * cc : s.kb + (size_t)(64 * kt + row) * s.kpb + 8 * (cc - KA / 8);
            k[i] = *(const GAS v4u*)p; } }
#pragma unroll
        for (int i = 0; i < NVI; ++i) { const int c = tid + 512 * i; if (NVC % 512 == 0 || c < NVC) { const int row = c / CPV, cc = c % CPV;
            v[i] = *(const GAS v4u*)(s.v + (size_t)(64 * kt + row) * s.vp + 8 * cc); } }
    }
    __device__ __forceinline__ void store(LAS unsigned char* lds, int buf, int tid) const {
#pragma unroll
        for (int i = 0; i < NKI; ++i) { const int c = tid + 512 * i; if (NKC % 512 == 0 || c < NKC) { const int row = c / CPR, cc = c % CPR;
            *(LAS v4u*)(lds + AT_KBUF + buf * KBUF_BYTES + row * KP + 16 * cc) = k[i]; } }
#pragma unroll
        for (int i = 0; i < NVI; ++i) { const int c = tid + 512 * i; if (NVC % 512 == 0 || c < NVC) { const int row = c / CPV, cc = c % CPV;
            *(LAS v4u*)(lds + AT_VBUF + buf * VBUF_BYTES + row * VP + 16 * cc) = v[i]; } }
    }
};
template <int DQK, int GR = 0> __device__ __forceinline__ void qk_tile(const LAS unsigned char* kbuf, const bf16x8 (&qf)[DQK / 16], f32x16 (&s)[2], int lane, const f32x16 c0 = (f32x16){}) {
    constexpr int KP = DQK * 2 + 16, ND = DQK / 16, G = GR ? GR : 2;
    const int r32 = lane & 31, hi = lane >> 5;
    s[0] = c0; s[1] = c0;
#pragma unroll
    for (int g = 0; g < ND / G; ++g) {
        bf16x8 kf[2][G];
#pragma unroll
        for (int d = 0; d < G; ++d)
#pragma unroll
            for (int st = 0; st < 2; ++st) kf[st][d] = *(const LAS bf16x8*)(kbuf + (32 * st + r32) * KP + 32 * (g * G + d) + 16 * hi);
        __builtin_amdgcn_sched_barrier(0);
#pragma unroll
        for (int d = 0; d < G; ++d)
#pragma unroll
            for (int st = 0; st < 2; ++st) s[st] = __builtin_amdgcn_mfma_f32_32x32x16_bf16(kf[st][d], qf[g * G + d], s[st], 0, 0, 0);
    }
}
__device__ __forceinline__ float softmax_tile(f32x16 (&s)[2], float& m, float& l) {
    float mx = NEGBIG;
#pragma unroll
    for (int r = 0; r < 16; ++r) mx = fmx3(mx, s[0][r], s[1][r]);
    mx = swapmax(mx);
    const float mn = fmx(m, mx), alpha = __builtin_amdgcn_exp2f(m - mn), ms = fmx(mn, -1e29f);
    m = mn; { const float nms = -ms; s[0] = s[0] + nms; s[1] = s[1] + nms; }
#pragma unroll
    for (int st = 0; st < 2; ++st)
#pragma unroll
        for (int r = 0; r < 16; ++r) s[st][r] = __builtin_amdgcn_exp2f(s[st][r]);
    const float rs = vsum32(s);
    l = l * alpha + rs;
    return alpha;
}
struct VFrag { bf16x8 f[2][4]; };
typedef short v4i16_t __attribute__((ext_vector_type(4)));
template <int VP> __device__ __forceinline__ void pv_load(const LAS unsigned char* vbuf, int dp, VFrag& v, int lane) {
    const int g = lane >> 4, q = (lane & 15) >> 2, p = lane & 3;
    const LAS unsigned char* base = vbuf + (4 * (g >> 1) + q) * VP + (16 * (g & 1) + 4 * p) * 2;
#pragma unroll
    for (int k = 0; k < 4; ++k)
#pragma unroll
        for (int d2 = 0; d2 < 2; ++d2) {
            const v4i16_t lo = __builtin_amdgcn_ds_read_tr16_b64_v4i16((LAS v4i16_t*)(base + (16 * k) * VP + 64 * (2 * dp + d2)));
            const v4i16_t hh = __builtin_amdgcn_ds_read_tr16_b64_v4i16((LAS v4i16_t*)(base + (16 * k + 8) * VP + 64 * (2 * dp + d2)));
            v.f[d2][k] = (bf16x8){lo[0], lo[1], lo[2], lo[3], hh[0], hh[1], hh[2], hh[3]}; }
}
__device__ __forceinline__ void p_pack(const f32x16 (&p)[2], bf16x8 (&pf)[4]) {
#pragma unroll
    for (int k = 0; k < 4; ++k) { const int st = k >> 1, s = k & 1; v4u w; w.x = cvtpk(p[st][8 * s + 0], p[st][8 * s + 1]); w.y = cvtpk(p[st][8 * s + 2], p[st][8 * s + 3]); w.z = cvtpk(p[st][8 * s + 4], p[st][8 * s + 5]); w.w = cvtpk(p[st][8 * s + 6], p[st][8 * s + 7]);
        pf[k] = __builtin_bit_cast(bf16x8, w); }
}
__device__ __forceinline__ void pv_mma(const VFrag& v, const bf16x8 (&pf)[4], f32x16& o0, f32x16& o1) {
#pragma unroll
    for (int k = 0; k < 4; ++k) { o0 = __builtin_amdgcn_mfma_f32_32x32x16_bf16(v.f[0][k], pf[k], o0, 0, 0, 0); o1 = __builtin_amdgcn_mfma_f32_32x32x16_bf16(v.f[1][k], pf[k], o1, 0, 0, 0); }
}
template <int DV> __device__ __forceinline__ void pv_tile(const LAS unsigned char* vbuf, const f32x16 (&p)[2], f32x16 (&o)[DV / 32], int lane) {
    bf16x8 pf[4]; p_pack(p, pf);
#pragma unroll
    for (int dp = 0; dp < DV / 64; ++dp) { VFrag v; pv_load<DV * 2 + 16>(vbuf, dp, v, lane); __builtin_amdgcn_sched_barrier(0); pv_mma(v, pf, o[2 * dp], o[2 * dp + 1]); }
}
constexpr float DEFER_THR = 8.0f;
struct SmState { float mhat, l; bool started; };
template <int DQK, int DV, class F, bool EARLYV>
__device__ __forceinline__ void attn_tile(LAS unsigned char* lds, int buf, int kt, const bf16x8 (&qf)[DQK / 16], F& f, f32x16 (&o)[DV / 32], SmState& S, f32x16& negm, int lane) {
    f32x16 s[2];
    qk_tile<DQK>(lds + AT_KBUF + buf * KBUF_BYTES, qf, s, lane, negm);
    const LAS unsigned char* vbuf = lds + AT_VBUF + buf * VBUF_BYTES;
    VFrag vfr;
    if constexpr (DV == 64 && EARLYV) { pv_load<DV * 2 + 16>(vbuf, 0, vfr, lane); __builtin_amdgcn_sched_barrier(0); }
    f.apply(s, kt);
    float mx = NEGBIG;
#pragma unroll
    for (int r = 0; r < 16; ++r) mx = fmx3(mx, s[0][r], s[1][r]);
    mx = swapmax(mx);
    const bool need = S.started ? (mx > DEFER_THR) : (mx > -1e29f);
    if (__any(need)) {
        const float delta = need ? mx : 0.f, fac = (need && S.started) ? __builtin_amdgcn_exp2f(-delta) : 1.f;
        S.mhat += delta; S.l *= fac; S.started = S.started || need;
#pragma unroll
        for (int st = 0; st < 2; ++st)
#pragma unroll
            for (int r = 0; r < 16; ++r) s[st][r] -= delta;
#pragma unroll
        for (int dt = 0; dt < DV / 32; ++dt) o[dt] = o[dt] * fac;
#pragma unroll
        for (int r = 0; r < 16; ++r) negm[r] = -S.mhat;
    }
#pragma unroll
    for (int st = 0; st < 2; ++st)
#pragma unroll
        for (int r = 0; r < 16; ++r) s[st][r] = __builtin_amdgcn_exp2f(s[st][r]);
    S.l += vsum32(s);
    bf16x8 pf[4]; p_pack(s, pf);
#pragma unroll
    for (int dp = 0; dp < DV / 64; ++dp) {
        if constexpr (!(DV == 64 && EARLYV)) { pv_load<DV * 2 + 16>(vbuf, dp, vfr, lane); __builtin_amdgcn_sched_barrier(0); }
        pv_mma(vfr, pf, o[2 * dp], o[2 * dp + 1]);
    }
}
template <int DQK, int KA, int DV, class F, bool EARLYV = true, bool DEEP = false>
__device__ __forceinline__ void attn_loop(LAS unsigned char* lds, const KVSrc& kv, int kt0, int kt1, const bf16x8 (&qf)[DQK / 16], F& f, f32x16 (&o)[DV / 32], SmState& S, int tid, int lane) {
    if (kt0 >= kt1) return;
    Stage<DQK, KA, DV> sg0;
    __syncthreads();
    sg0.load(kv, kt0, tid); sg0.store(lds, 0, tid);
    f32x16 negm;
#pragma unroll
    for (int r = 0; r < 16; ++r) negm[r] = -S.mhat;
    if constexpr (DEEP) {
        Stage<DQK, KA, DV> sg1;
        if (kt0 + 1 < kt1) sg1.load(kv, kt0 + 1, tid);
        __syncthreads();
        for (int kt = kt0; kt < kt1; kt += 2) {
            if (kt + 2 < kt1) { sg0.load(kv, kt + 2, tid); f.pre(kt + 2); }
            if (!f.skip(kt)) attn_tile<DQK, DV, F, EARLYV>(lds, 0, kt, qf, f, o, S, negm, lane);
            if (kt + 1 < kt1) sg1.store(lds, 1, tid);
            __syncthreads();
            if (kt + 1 < kt1) {
                if (kt + 3 < kt1) { sg1.load(kv, kt + 3, tid); f.pre(kt + 3); }
                if (!f.skip(kt + 1)) attn_tile<DQK, DV, F, EARLYV>(lds, 1, kt + 1, qf, f, o, S, negm, lane);
                if (kt + 2 < kt1) sg0.store(lds, 0, tid);
                __syncthreads();
            }
        }
    } else {
        __syncthreads();
        for (int kt = kt0; kt < kt1; ++kt) {
            const int buf = (kt - kt0) & 1;
            if (kt + 1 < kt1) { sg0.load(kv, kt + 1, tid); f.pre(kt + 1); }
            if (!f.skip(kt)) attn_tile<DQK, DV, F, EARLYV>(lds, buf, kt, qf, f, o, S, negm, lane);
            if (kt + 1 < kt1) sg0.store(lds, buf ^ 1, tid);
            __syncthreads();
        }
    }
}
__device__ __forceinline__ void build_bias_tables(LAS unsigned char* lds, const float* tab, int tid) {
    LAS float* BT = (LAS float*)(lds + AT_BT);
    for (int i = tid; i < 20 * 129; i += NWAVES * 64) { const int h = i / 129, d = i % 129;
        int b = d; if (d >= 16) { b = 16 + (int)(__log2f((float)d * 0.0625f) * (16.0f / 3.0f)); b = b > 31 ? 31 : b; }
        BT[h * BT_STRIDE + d] = (tab[b * 20 + h] - tab[31 * 20 + h]) * LOG2E; }
}
__device__ __forceinline__ void swap_pair(v2u& a, v2u& b) {
    { auto r = __builtin_amdgcn_permlane32_swap(a.x, b.x, false, false); a.x = r[0]; b.x = r[1]; }
    { auto r = __builtin_amdgcn_permlane32_swap(a.y, b.y, false, false); a.y = r[0]; b.y = r[1]; }
}
template <int DV> __device__ __forceinline__ void store_ot(bf16* orow, const f32x16 (&o)[DV / 32], float scale, int lane) {
    const int hi = lane >> 5;
    bf16* dst = orow + 8 * hi;
#pragma unroll
    for (int dt = 0; dt < DV / 32; ++dt)
#pragma unroll
        for (int r4 = 0; r4 < 4; r4 += 2) {
            v2u a, b;
            a.x = cvtpk(o[dt][4 * r4 + 0] * scale, o[dt][4 * r4 + 1] * scale); a.y = cvtpk(o[dt][4 * r4 + 2] * scale, o[dt][4 * r4 + 3] * scale);
            b.x = cvtpk(o[dt][4 * r4 + 4] * scale, o[dt][4 * r4 + 5] * scale); b.y = cvtpk(o[dt][4 * r4 + 6] * scale, o[dt][4 * r4 + 7] * scale);
            swap_pair(a, b);
            *(GAS v4u*)(dst + 32 * dt + 8 * r4) = (v4u){a.x, a.y, b.x, b.y}; }
}
template <int DQK> __device__ __forceinline__ void load_q(const bf16* qrow, bf16x8 (&qf)[DQK / 16], int lane) {
    const int hi = lane >> 5;
#pragma unroll
    for (int d0 = 0; d0 < DQK / 16; ++d0) qf[d0] = *(const GAS bf16x8*)(qrow + 16 * d0 + 8 * hi);
}
__device__ __forceinline__ bf16x8 scale_frag(bf16x8 a, float sc) {
    v4u w;
    w.x = cvtpk(bf2f((unsigned short)a[0]) * sc, bf2f((unsigned short)a[1]) * sc); w.y = cvtpk(bf2f((unsigned short)a[2]) * sc, bf2f((unsigned short)a[3]) * sc);
    w.z = cvtpk(bf2f((unsigned short)a[4]) * sc, bf2f((unsigned short)a[5]) * sc); w.w = cvtpk(bf2f((unsigned short)a[6]) * sc, bf2f((unsigned short)a[7]) * sc);
    return __builtin_bit_cast(bf16x8, w);
}
template <int DQK> __device__ __forceinline__ void load_q_scaled(const bf16* qrow, bf16x8 (&qf)[DQK / 16], float sc, int lane) {
    load_q<DQK>(qrow, qf, lane);
#pragma unroll
    for (int d0 = 0; d0 < DQK / 16; ++d0) qf[d0] = scale_frag(qf[d0], sc);
}

struct FPlain { __device__ __forceinline__ void pre(int) {} __device__ __forceinline__ bool skip(int) const { return false; }
    __device__ __forceinline__ void apply(f32x16 (&)[2], int) {} };
__device__ __forceinline__ void xattn_unit(LAS unsigned char* lds, const bf16* XQ, const bf16* KVM, bf16* O, int b, int h, int qt, int tid_in, int lane_in, int wave) {
    int lane = lane_in; asm volatile("" : "+v"(lane)); const int tid = wave * 64 + lane; (void)tid_in;
    const int t = qt * 256 + wave * 32 + (lane & 31);
    bf16x8 qf[8]; load_q_scaled<128>(XQ + (size_t)(b * SEQ + t) * 512 + h * 128, qf, 0.08838834764831845f * LOG2E, lane);
    KVSrc kv{KVM + (size_t)(b * MEML) * DM + h * 128, DM, nullptr, 0, KVM + (size_t)(b * MEML) * DM + 512 + h * 128, DM};
    f32x16 o[4] = {}; SmState S{0.f, 0.f, false};
    FPlain f;
    attn_loop<128, 128, 128, FPlain>(lds, kv, 0, MEML / 64, qf, f, o, S, tid, lane);
    const float lt = swapsum(S.l);
    store_ot<128>(O + (size_t)(b * SEQ + t) * 512 + h * 128, o, lt > 0.f ? 1.f / lt : 0.f, lane);
}


constexpr int C_QA = 0, C_KVA = 512, C_GA = 1280, C_QB = 1304, C_KB = 1816, C_VB = 1880, C_IQ = 1944, C_IK = 2200, C_IW = 2232;
constexpr size_t WS_CWT = 91 * MiB;
constexpr size_t WS_CBIAS = 91 * MiB + 512 * 1024;
constexpr size_t WS_P0 = WS_OV, WS_KCMP = WS_OV + 288 * MiB, WS_VCMP = WS_OV + 289 * MiB, WS_SEL = WS_OV + 330 * MiB;
static_assert(WS_SEL + 32 * MiB <= WS_END, "even overlay");

__device__ __forceinline__ void nsa_compress_item(const bf16* P0, const bf16* CWT, const float* CBIAS, bf16* KCMP, bf16* VCMP, int item, int lane) {
    const int nt = item & 7, g = (item >> 3) & 1, b = (item >> 4) & 15, c = item >> 8;
    const int r32 = lane & 31, hi = lane >> 5, n = nt * 32 + r32, nc = n > 254 ? 254 : n;
    const bf16* ap = P0 + (size_t)(b * SEQ + 16 * nc) * EV_INP + C_KVA + c * 128 + g * 64 + 8 * hi;
    const bf16* bp = CWT + (size_t)(c * 64 + r32) * 2048 + 8 * hi;
    f32x16 acc[2] = {};
#pragma unroll 4
    for (int kk = 0; kk < 128; ++kk) {
        const bf16x8 a = *(const GAS bf16x8*)(ap + (size_t)(kk >> 2) * EV_INP + (kk & 3) * 16);
        const bf16x8 b0 = *(const GAS bf16x8*)(bp + kk * 16), b1 = *(const GAS bf16x8*)(bp + 32 * 2048 + kk * 16);
        acc[0] = __builtin_amdgcn_mfma_f32_32x32x16_bf16(a, b0, acc[0], 0, 0, 0);
        acc[1] = __builtin_amdgcn_mfma_f32_32x32x16_bf16(a, b1, acc[1], 0, 0, 0);
    }
#pragma unroll
    for (int eh = 0; eh < 2; ++eh) { const int e = 32 * eh + r32; const float bias = CBIAS[c * 64 + e];
        bf16* dst = c == 0 ? KCMP : VCMP;
#pragma unroll
        for (int r = 0; r < 16; ++r) { const int nn = nt * 32 + crow(r, hi); dst[((size_t)(b * 2 + g) * 256 + nn) * 64 + e] = (bf16)(nn > 254 ? 0u : f2bf(acc[eh][r] + bias)); }
    }
}

__device__ __forceinline__ void nsa_compress_pair(LAS unsigned char* lds, const bf16* P0, const bf16* CWT, const float* CBIAS, bf16* KCMP, bf16* VCMP, int it0, int wave, int lane) {
    const int item = it0 + (wave >> 2), ks = wave & 3; const bool live = item < 512;
    const int nt = item & 7, g = (item >> 3) & 1, b = (item >> 4) & 15, c = (item >> 8) & 1;
    const int r32 = lane & 31, hi = lane >> 5, n = nt * 32 + r32, nc = n > 254 ? 254 : n;
    const bf16* ap = P0 + (size_t)(b * SEQ + 16 * nc) * EV_INP + C_KVA + c * 128 + g * 64 + 8 * hi;
    const bf16* bp = CWT + (size_t)(c * 64 + r32) * 2048 + 8 * hi;
    f32x16 acc[2] = {};
    if (live) {
#pragma unroll 8
        for (int kk = 32 * ks; kk < 32 * ks + 32; ++kk) {
            const bf16x8 a = *(const GAS bf16x8*)(ap + (size_t)(kk >> 2) * EV_INP + (kk & 3) * 16);
            const bf16x8 b0 = *(const GAS bf16x8*)(bp + kk * 16), b1 = *(const GAS bf16x8*)(bp + 32 * 2048 + kk * 16);
            acc[0] = __builtin_amdgcn_mfma_f32_32x32x16_bf16(a, b0, acc[0], 0, 0, 0);
            acc[1] = __builtin_amdgcn_mfma_f32_32x32x16_bf16(a, b1, acc[1], 0, 0, 0);
        }
    }
    LAS float* red = (LAS float*)lds + (wave >> 2) * 3 * 2048 + lane;
    if (ks) {
#pragma unroll
        for (int eh = 0; eh < 2; ++eh)
#pragma unroll
            for (int r = 0; r < 16; ++r) red[(ks - 1) * 2048 + (eh * 16 + r) * 64] = acc[eh][r];
    }
    __syncthreads();
    if (!ks && live) {
#pragma unroll
        for (int j = 0; j < 3; ++j)
#pragma unroll
            for (int eh = 0; eh < 2; ++eh)
#pragma unroll
                for (int r = 0; r < 16; ++r) acc[eh][r] += red[j * 2048 + (eh * 16 + r) * 64];
#pragma unroll
        for (int eh = 0; eh < 2; ++eh) { const int e = 32 * eh + r32; const float bias = CBIAS[c * 64 + e];
            bf16* dst = c == 0 ? KCMP : VCMP;
#pragma unroll
            for (int r = 0; r < 16; ++r) { const int nn = nt * 32 + crow(r, hi); dst[((size_t)(b * 2 + g) * 256 + nn) * 64 + e] = (bf16)(nn > 254 ? 0u : f2bf(acc[eh][r] + bias)); }
        }
    }
    __syncthreads();
}

constexpr int IX_MASK = 0, IX_RED = 8192, IX_CNT = IX_RED + 1024, IX_NC = IX_CNT + 1024, IX_CAND = IX_NC + 64, IX_THR = IX_CAND + 8192, IX_LIST = IX_THR + 128;
__device__ __forceinline__ unsigned f2ord(float f) { const unsigned b = __float_as_uint(f); return b ^ ((unsigned)((int)b >> 31) | 0x80000000u); }
__device__ __forceinline__ float ord2f(unsigned u) { return __uint_as_float(u ^ ((u >> 31) ? 0x80000000u : 0xffffffffu)); }
__device__ __forceinline__ void dsa_index_unit(LAS unsigned char* lds, const bf16* P0, unsigned short* SEL, int b, int qt, int tid_in, int lane_in, int wave) {
    int lane = lane_in; asm volatile("" : "+v"(lane)); const int tid = wave * 64 + lane; (void)tid_in;
    const int q = lane & 15, g4 = lane >> 4, t0 = 16 * qt, t = t0 + q, nkt = qt + 1;
    const int ni = nkt > wave ? (nkt - wave + 7) >> 3 : 0, nc4 = (ni + 3) >> 2;
    const bf16* base = P0 + (size_t)(b * SEQ) * EV_INP;
    bf16x8 bq[8]; float w[8];
#pragma unroll
    for (int h = 0; h < 8; ++h) { bq[h] = *(const GAS bf16x8*)(base + (size_t)t * EV_INP + C_IQ + h * 32 + 8 * g4); w[h] = bf2f(base[(size_t)t * EV_INP + C_IW + h]); }
    typedef float f32x4v __attribute__((ext_vector_type(4)));
    const bf16* kbase = base + (size_t)(16 * wave + q) * EV_INP + C_IK + 8 * g4;
    float sc[32][4];
    const float NINF = -__builtin_inff();
#pragma unroll
    for (int g = 0; g < 8; ++g) {
        if (32 * g + wave < nkt) {
            bf16x8 ab[4];
#pragma unroll
            for (int j = 0; j < 4; ++j) if (8 * (4 * g + j) + wave < nkt) { const bf16* kp = kbase; asm volatile("" : "+v"(kp));
                ab[j] = *(const GAS bf16x8*)(kp + (size_t)(4 * g + j) * (128 * EV_INP)); }
            asm volatile("s_waitcnt vmcnt(0)" ::: "memory");
#pragma unroll
            for (int j = 0; j < 4; ++j) {
                const int i = 4 * g + j, kt = 8 * i + wave;
                if (kt < nkt) {
                    const bf16x8 a = ab[j];
                    float a4[4] = {0.f, 0.f, 0.f, 0.f};
#pragma unroll
                    for (int h = 0; h < 8; ++h) { const f32x4v c = __builtin_amdgcn_mfma_f32_16x16x32_bf16(a, bq[h], (f32x4v){0.f, 0.f, 0.f, 0.f}, 0, 0, 0);
#pragma unroll
                        for (int r = 0; r < 4; ++r) a4[r] += w[h] * fmx(c[r], 0.f); }
#pragma unroll
                    for (int r = 0; r < 4; ++r) sc[i][r] = (kt < qt || 4 * g4 + r <= q) ? a4[r] : NINF;
                } else {
#pragma unroll
                    for (int r = 0; r < 4; ++r) sc[i][r] = NINF;
                }
            }
        } else {
#pragma unroll
            for (int j = 0; j < 4; ++j)
#pragma unroll
                for (int r = 0; r < 4; ++r) sc[4 * g + j][r] = NINF;
        }
    }
    LAS float* RED = (LAS float*)(lds + IX_RED); LAS unsigned* CNT = (LAS unsigned*)(lds + IX_CNT); LAS unsigned* MK = (LAS unsigned*)(lds + IX_MASK);
    LAS unsigned* NC = (LAS unsigned*)(lds + IX_NC); LAS unsigned long long* CAND = (LAS unsigned long long*)(lds + IX_CAND); LAS unsigned long long* THR = (LAS unsigned long long*)(lds + IX_THR);
    float lmax = NINF, lmin = __builtin_inff();
#pragma unroll
    for (int c = 0; c < 8; ++c) if (c < nc4) {
#pragma unroll
        for (int j = 0; j < 4; ++j)
#pragma unroll
            for (int r = 0; r < 4; ++r) { const float v = sc[4 * c + j][r]; lmax = fmx(lmax, v); lmin = fmn(lmin, v == NINF ? __builtin_inff() : v); }
    }
    lmax = fmx(lmax, lx_f<16>(lmax)); lmax = fmx(lmax, lx_f<32>(lmax));
    lmin = fmn(lmin, lx_f<16>(lmin)); lmin = fmn(lmin, lx_f<32>(lmin));
    __syncthreads();
    if (g4 == 0) { RED[wave * 16 + q] = lmax; RED[128 + wave * 16 + q] = lmin; }
    for (int i = tid; i < 2048; i += NWAVES * 64) MK[i] = 0u;
    if (tid < 16) NC[tid] = 0u;
    __syncthreads();
    float hiv = NINF, lov = __builtin_inff();
#pragma unroll
    for (int wv = 0; wv < 8; ++wv) { hiv = fmx(hiv, RED[wv * 16 + q]); lov = fmn(lov, RED[128 + wv * 16 + q]); }
    lov = lov - fabsf(lov) * 1e-3f - 1e-6f;
    unsigned clo = (unsigned)(t + 1), chi = 0u;
    bool done = (t + 1 <= 256), fine = false; float thr = NINF; unsigned thk = 0u;
    for (int it = 0; it < 64; ++it) {
        const float mid = 0.5f * (lov + hiv);
        unsigned cnt = 0;
#pragma unroll
        for (int c = 0; c < 8; ++c) if (c < nc4) {
#pragma unroll
            for (int j = 0; j < 4; ++j)
#pragma unroll
                for (int r = 0; r < 4; ++r) cnt += (sc[4 * c + j][r] > mid) ? 1u : 0u;
        }
        cnt += lx_u<16>(cnt); cnt += lx_u<32>(cnt);
        LAS unsigned* cb = CNT + (it & 1) * 128;
        if (g4 == 0) cb[wave * 16 + q] = cnt;
        __syncthreads();
        unsigned tot = 0;
#pragma unroll
        for (int wv = 0; wv < 8; ++wv) tot += cb[wv * 16 + q];
        if (!done && !fine) {
            if (tot == 256u) { thr = mid; done = true; }
            else if (!(mid > lov && mid < hiv)) { thr = lov; done = true; }
            else { if (tot > 256u) { lov = mid; clo = tot; } else { hiv = mid; chi = tot; }
                   if (clo - chi <= 64u) fine = true; }
        }
        if (__all(done || fine)) break;
    }
    const unsigned kinv0 = (unsigned)(4095 - (16 * wave + 4 * g4));
    if (fine) {
#pragma unroll
        for (int c = 0; c < 8; ++c) if (c < nc4) {
#pragma unroll
            for (int j = 0; j < 4; ++j)
#pragma unroll
                for (int r = 0; r < 4; ++r) { const float v = sc[4 * c + j][r];
                    if (v > lov && v <= hiv) { const unsigned pos = __hip_atomic_fetch_add(NC + q, 1u, __ATOMIC_RELAXED, __HIP_MEMORY_SCOPE_WORKGROUP);
                        if (pos < 64u) CAND[q * 64 + pos] = ((unsigned long long)f2ord(v) << 32) | (kinv0 - (unsigned)(128 * (4 * c + j) + r)); } }
        }
    }
    __syncthreads();
#pragma unroll 1
    for (int k = 0; k < 2; ++k) {
        const int qq = 2 * wave + k;
        const int fq = __builtin_amdgcn_readlane((int)fine, qq), need = __builtin_amdgcn_readlane((int)(256u - chi), qq);
        if (fq) {
            const unsigned n = NC[qq]; const unsigned long long comp = (unsigned)lane < n ? CAND[qq * 64 + lane] : 0ull;
            const unsigned c_lo = (unsigned)comp, c_hi = (unsigned)(comp >> 32);
            int rank = 0;
#pragma unroll
            for (int jj = 0; jj < 64; ++jj) { const unsigned long long c2 = ((unsigned long long)(unsigned)__builtin_amdgcn_readlane((int)c_hi, jj) << 32) | (unsigned)__builtin_amdgcn_readlane((int)c_lo, jj); rank += (c2 > comp) ? 1 : 0; }
            if (rank == need - 1) THR[qq] = comp;
        }
    }
    __syncthreads();
    if (fine) { const unsigned long long t64 = THR[q]; thr = ord2f((unsigned)(t64 >> 32)); thk = (unsigned)t64; }
    LAS unsigned* mkw = MK + q * 128 + (wave >> 1); const int mksh = 16 * (wave & 1) + 4 * g4;
#pragma unroll
    for (int c = 0; c < 8; ++c) if (c < nc4) {
#pragma unroll
        for (int j = 0; j < 4; ++j) { const int i = 4 * c + j;
            unsigned nib = 0;
#pragma unroll
            for (int r = 0; r < 4; ++r) { const float v = sc[i][r]; nib |= (v > thr || (fine && v == thr && kinv0 - (unsigned)(128 * i + r) >= thk)) ? (1u << r) : 0u; }
            if (nib) __hip_atomic_fetch_or(mkw + 4 * i, nib << mksh, __ATOMIC_RELAXED, __HIP_MEMORY_SCOPE_WORKGROUP); }
    }
    __syncthreads();
    LAS unsigned short* LST = (LAS unsigned short*)(lds + IX_LIST);
#pragma unroll 1
    for (int k = 0; k < 2; ++k) {
        const int qq = 2 * wave + k;
        unsigned long long wd = *(const LAS unsigned long long*)(lds + IX_MASK + (qq * 64 + lane) * 8);
        const int c = __popcll(wd); int incl = c;
#pragma unroll
        for (int d = 1; d < 64; d <<= 1) { const int n = __builtin_amdgcn_ds_bpermute((lane - d) << 2, incl); if (lane >= d) incl += n; }
        int pos = incl - c; const int total = __builtin_amdgcn_readlane(incl, 63);
        while (wd) { const int bbit = __builtin_ctzll(wd); if (pos < 256) LST[qq * 256 + pos] = (unsigned short)(64 * lane + bbit); ++pos; wd &= wd - 1; }
        for (int p = total + lane; p < 256; p += 64) LST[qq * 256 + p] = (unsigned short)0xffffu;
    }
    __syncthreads();
    { const v4u v = *(const LAS v4u*)(lds + IX_LIST + tid * 16);
      *(GAS v4u*)((unsigned char*)(SEL + (size_t)(b * SEQ + t0) * 256) + tid * 16) = v; }
}

struct FSel {
    unsigned long long selmask; int t, cur, hi; const LAS float* BT;
    __device__ __forceinline__ void pre(int) {}
    __device__ __forceinline__ bool skip(int kt) const { return !__any((int)((selmask >> kt) & 1ull)); }
    __device__ __forceinline__ void apply(f32x16 (&s)[2], int kt) {
        const bool on = (selmask >> kt) & 1ull;
        if (kt + 3 <= cur) {
            if (!__all((int)on)) {
#pragma unroll
                for (int st = 0; st < 2; ++st)
#pragma unroll
                    for (int r = 0; r < 16; ++r) s[st][r] = on ? s[st][r] : NEGBIG; }
        } else {
#pragma unroll
            for (int st = 0; st < 2; ++st)
#pragma unroll
                for (int r = 0; r < 16; ++r) { const int dist = t - (64 * kt + 32 * st + crow(r, hi)); const unsigned di = (unsigned)dist < 128u ? (unsigned)dist : 128u;
                    s[st][r] = (on && dist >= 0) ? s[st][r] + BT[di] : NEGBIG; }
        }
    }
};
struct FWin {
    int t, cur, hi; const LAS float* BT;
    __device__ __forceinline__ void pre(int) {}
    __device__ __forceinline__ bool skip(int) const { return false; }
    __device__ __forceinline__ void apply(f32x16 (&s)[2], int kt) {
        const int dk = cur - kt;
        if (!(dk >= 3 && dk <= 7)) {
#pragma unroll
            for (int st = 0; st < 2; ++st)
#pragma unroll
                for (int r = 0; r < 16; ++r) { const int dist = t - (64 * kt + 32 * st + crow(r, hi)); const unsigned di = (unsigned)dist < 128u ? (unsigned)dist : 128u;
                    s[st][r] = (dist >= 0 && dist < 512) ? s[st][r] + BT[di] : NEGBIG; }
        }
    }
};
__device__ __forceinline__ float sigmoidf_(float x) { return __builtin_amdgcn_rcpf(1.0f + __builtin_amdgcn_exp2f(-x * LOG2E)); }

__device__ __forceinline__ void nsa_unit(LAS unsigned char* lds, const bf16* P0, const bf16* KCMP, const bf16* VCMP, bf16* OC, int b, int g, int qt, int tid_in, int lane_in, int wave) {
    int lane = lane_in; asm volatile("" : "+v"(lane)); const int tid = wave * 64 + lane; (void)tid_in;
    const int r32 = lane & 31, hi = lane >> 5, qi = r32 >> 2, hh = r32 & 3, head = g * 4 + hh;
    const int t0 = qt * 64, t = t0 + wave * 8 + qi, cur = qt;
    const bf16* prow = P0 + (size_t)(b * SEQ + t) * EV_INP;
    bf16x8 qf[4]; load_q_scaled<64>(prow + C_QA + head * 64, qf, 0.125f * LOG2E, lane);
    const LAS float* BT = (const LAS float*)(lds + AT_BT) + head * BT_STRIDE;
    const float g0 = sigmoidf_(bf2f(prow[C_GA + g * 12 + hh * 3 + 0])), g1 = sigmoidf_(bf2f(prow[C_GA + g * 12 + hh * 3 + 1])), g2 = sigmoidf_(bf2f(prow[C_GA + g * 12 + hh * 3 + 2]));
    LAS float* impL = (LAS float*)(lds + AT_WS + wave * AT_WS_PER_WAVE);
    LAS unsigned long long* selL = (LAS unsigned long long*)(lds + AT_WS + wave * AT_WS_PER_WAVE + 2048);
    f32x16 oacc[2];
    {
        f32x16 o[2] = {}; float m = NEGBIG, l = 0.f, carry = 0.f;
        float imp[32];
#pragma unroll
        for (int i = 0; i < 32; ++i) imp[i] = 0.f;
        const int ncv = (t0 + 63 >= 31) ? ((t0 + 63 - 31) >> 4) + 1 : 0;
        const int nkt = ncv >= 256 ? 4 : (ncv + 63) >> 6;
        KVSrc kv{KCMP + (size_t)((b * 2 + g) * 256) * 64, 64, nullptr, 0, VCMP + (size_t)((b * 2 + g) * 256) * 64, 64};
        Stage<64, 64, 64> sg;
        __syncthreads();
        if (nkt > 0) { sg.load(kv, 0, tid); sg.store(lds, 0, tid); }
        __syncthreads();
#pragma unroll
        for (int kt = 0; kt < 4; ++kt) {
            if (kt < nkt) {
                const int buf = kt & 1;
                if (kt + 1 < nkt) sg.load(kv, kt + 1, tid);
                f32x16 s[2];
                qk_tile<64, 2>(lds + AT_KBUF + buf * KBUF_BYTES, qf, s, lane);
#pragma unroll
                for (int st = 0; st < 2; ++st)
#pragma unroll
                    for (int r = 0; r < 16; ++r) { const int dist = t - (16 * (64 * kt + 32 * st + crow(r, hi)) + 31); const unsigned di = (unsigned)dist < 128u ? (unsigned)dist : 128u;
                        s[st][r] = dist >= 0 ? s[st][r] + BT[di] : NEGBIG; }
                const float alpha = softmax_tile(s, m, l);
                o[0] = o[0] * alpha; o[1] = o[1] * alpha; carry *= alpha;
#pragma unroll
                for (int i = 0; i < kt * 8; ++i) imp[i] *= alpha;
                pv_tile<64>(lds + AT_VBUF + buf * VBUF_BYTES, s, o, lane);
                float G[2][4], ol[2][4];
#pragma unroll
                for (int st = 0; st < 2; ++st)
#pragma unroll
                    for (int q4 = 0; q4 < 4; ++q4) { G[st][q4] = (s[st][4 * q4] + s[st][4 * q4 + 1]) + (s[st][4 * q4 + 2] + s[st][4 * q4 + 3]); ol[st][q4] = swapget(s[st][4 * q4 + 3]); }
#pragma unroll
                for (int st = 0; st < 2; ++st)
#pragma unroll
                    for (int q4 = 0; q4 < 4; ++q4) { const float prev = q4 > 0 ? ol[st][q4 - 1] : (st == 1 ? ol[0][3] : carry);
                        imp[kt * 8 + st * 4 + q4] = G[st][q4] + (hi ? ol[st][q4] : prev); }
                carry = ol[1][3];
                if (kt + 1 < nkt) sg.store(lds, buf ^ 1, tid);
                __syncthreads();
            }
        }
        const float lt = swapsum(l), inv = lt > 0.f ? 1.f / lt : 0.f;
        oacc[0] = o[0] * (inv * g0); oacc[1] = o[1] * (inv * g0);
#pragma unroll
        for (int i = 0; i < 32; ++i) { float v = imp[i] * inv; v += lx_f<1>(v); v += lx_f<2>(v);
            if (hh == 0) impL[qi * 64 + 16 * (i >> 3) + 8 * ((i >> 2) & 1) + 2 * (i & 3) + hi] = v; }
    }
    LDS_WAIT(); asm volatile("" ::: "memory");
#pragma unroll 1
    for (int q2 = 0; q2 < 8; ++q2) {
        const int j = lane; const bool valid = j <= cur, forced = (j == 0) || (j == cur) || (j == cur - 1);
        const float val = impL[q2 * 64 + j] + (forced ? 1000.f : 0.f);
        const unsigned long long comp = ((unsigned long long)(valid ? __float_as_uint(val) + 1u : 0u) << 6) | (unsigned long long)(63 - j);
        const unsigned clo = (unsigned)comp, chi = (unsigned)(comp >> 32);
        int rank = 0;
#pragma unroll
        for (int jj = 0; jj < 64; ++jj) { const unsigned long long c2 = ((unsigned long long)(unsigned)__builtin_amdgcn_readlane((int)chi, jj) << 32) | (unsigned)__builtin_amdgcn_readlane((int)clo, jj); rank += (c2 > comp) ? 1 : 0; }
        const unsigned long long mk = __ballot(valid && rank < 16);
        if (lane == 0) selL[q2] = mk;
    }
    LDS_WAIT(); asm volatile("" ::: "memory");
    const unsigned long long selmask = selL[qi];
    {
        f32x16 o[2] = {}; SmState S{0.f, 0.f, false};
        KVSrc kv{P0 + (size_t)(b * SEQ) * EV_INP + C_KVA + 2 * 128 + g * 64, EV_INP, nullptr, 0, P0 + (size_t)(b * SEQ) * EV_INP + C_KVA + 3 * 128 + g * 64, EV_INP};
        FSel f{selmask, t, cur, hi, BT};
        int tid2 = tid; asm volatile("" : "+v"(tid2));
        attn_loop<64, 64, 64, FSel, false>(lds, kv, 0, cur + 1, qf, f, o, S, tid2, lane);
        const float lt = swapsum(S.l), inv = lt > 0.f ? 1.f / lt : 0.f;
        oacc[0] = oacc[0] + o[0] * (inv * g1); oacc[1] = oacc[1] + o[1] * (inv * g1);
    }
    {
        f32x16 o[2] = {}; SmState S{0.f, 0.f, false};
        KVSrc kv{P0 + (size_t)(b * SEQ) * EV_INP + C_KVA + 4 * 128 + g * 64, EV_INP, nullptr, 0, P0 + (size_t)(b * SEQ) * EV_INP + C_KVA + 5 * 128 + g * 64, EV_INP};
        FWin f{t, cur, hi, BT};
        int tid3 = tid; asm volatile("" : "+v"(tid3));
        attn_loop<64, 64, 64, FWin, false>(lds, kv, cur >= 8 ? cur - 8 : 0, cur + 1, qf, f, o, S, tid3, lane);
        const float lt = swapsum(S.l), inv = lt > 0.f ? 1.f / lt : 0.f;
        oacc[0] = oacc[0] + o[0] * (inv * g2); oacc[1] = oacc[1] + o[1] * (inv * g2);
    }
    store_ot<64>(OC + (size_t)(b * SEQ + t) * DM + head * 64, oacc, 1.f, lane);
}
constexpr int DG_VP = 136, DG_VT = 64 * DG_VP;
static_assert(8 * DG_VT <= AT_BT, "DSA gather LDS map");
__device__ __forceinline__ void dsa_unit(LAS unsigned char* lds, const bf16* P0, const unsigned short* SEL, bf16* OC, int b, int qt, int tid_in, int lane_in, int wave) {
    int lane = lane_in; asm volatile("" : "+v"(lane)); (void)tid_in;
    const int r32 = lane & 31, hi = lane >> 5, hh = r32 & 7;
    const LAS float* BT = (const LAS float*)(lds + AT_BT) + (8 + hh) * BT_STRIDE;
    LAS unsigned char* vt = lds + wave * DG_VT;
    LAS unsigned short* lq = (LAS unsigned short*)(lds + AT_WS + wave * AT_WS_PER_WAVE);
    const bf16* kb = P0 + (size_t)(b * SEQ) * EV_INP + C_KB + 8 * hi;
    const bf16* vb = P0 + (size_t)(b * SEQ) * EV_INP + C_VB + 8 * (lane & 7);
#define DG_LOADK(LQ, J) do { _Pragma("unroll") for (int st = 0; st < 2; ++st) { unsigned ik = (LQ)[64 * (J) + 32 * st + r32]; ik = ik > 4095u ? 0u : ik; \
        _Pragma("unroll") for (int d0 = 0; d0 < 4; ++d0) kf[st][d0] = *(const GAS bf16x8*)(kb + (size_t)ik * EV_INP + 16 * d0); } } while (0)
#define DG_LOADV(LQ, J) do { _Pragma("unroll") for (int i = 0; i < 8; ++i) { unsigned iv = (LQ)[64 * (J) + 8 * i + (lane >> 3)]; iv = iv > 4095u ? 0u : iv; vr[i] = *(const GAS v4u*)(vb + (size_t)iv * EV_INP); } } while (0)
    bf16x8 kf[2][4]; v4u vr[8];
    { const int t = qt * 32 + wave * 4; *(LAS v2u*)(lq + 4 * lane) = *(const GAS v2u*)(SEL + (size_t)(b * SEQ + t) * 256 + 4 * lane); }
    DG_LOADK(lq, 0); DG_LOADV(lq, 0);
#pragma unroll 1
    for (int qi = 0; qi < 4; ++qi) {
        const int t = qt * 32 + wave * 4 + qi;
        LAS unsigned short* lqc = lq + 256 * (qi & 1); LAS unsigned short* lqn = lq + 256 * ((qi + 1) & 1);
        if (qi + 1 < 4) *(LAS v2u*)(lqn + 4 * lane) = *(const GAS v2u*)(SEL + (size_t)(b * SEQ + t + 1) * 256 + 4 * lane);
        bf16x8 qf[4]; load_q_scaled<64>(P0 + (size_t)(b * SEQ + t) * EV_INP + C_QB + hh * 64, qf, 0.125f * LOG2E, lane);
        f32x16 o[2] = {}; SmState S{0.f, 0.f, false};
#pragma unroll
        for (int j = 0; j < 4; ++j) {
#pragma unroll
            for (int i = 0; i < 8; ++i) { LAS unsigned char* d = vt + (8 * i + (lane >> 3)) * DG_VP + (lane & 7) * 16; *(LAS v2u*)d = (v2u){vr[i].x, vr[i].y}; *(LAS v2u*)(d + 8) = (v2u){vr[i].z, vr[i].w}; }
            if (j < 3) DG_LOADV(lqc, j + 1); else if (qi + 1 < 4) DG_LOADV(lqn, 0);
            f32x16 s[2];
#pragma unroll
            for (int r = 0; r < 16; ++r) { s[0][r] = -S.mhat; s[1][r] = -S.mhat; }
#pragma unroll
            for (int d0 = 0; d0 < 4; ++d0)
#pragma unroll
                for (int st = 0; st < 2; ++st) s[st] = __builtin_amdgcn_mfma_f32_32x32x16_bf16(kf[st][d0], qf[d0], s[st], 0, 0, 0);
            if (j < 3) DG_LOADK(lqc, j + 1); else if (qi + 1 < 4) DG_LOADK(lqn, 0);
            if (j >= 2 || t < 255) {
#pragma unroll
                for (int st = 0; st < 2; ++st)
#pragma unroll
                    for (int r = 0; r < 16; ++r) { const int ix = lqc[64 * j + 32 * st + crow(r, hi)]; const int dist = t - ix; const unsigned di = (unsigned)dist < 128u ? (unsigned)dist : 128u;
                        s[st][r] = dist >= 0 ? s[st][r] + BT[di] : NEGBIG; }
            }
            float mx = NEGBIG;
#pragma unroll
            for (int r = 0; r < 16; ++r) mx = fmx3(mx, s[0][r], s[1][r]);
            mx = swapmax(mx);
            const bool need = S.started ? (mx > DEFER_THR) : (mx > -1e29f);
            if (__any(need)) {
                const float delta = need ? mx : 0.f, fac = (need && S.started) ? __builtin_amdgcn_exp2f(-delta) : 1.f;
                S.mhat += delta; S.l *= fac; S.started = S.started || need;
#pragma unroll
                for (int st = 0; st < 2; ++st)
#pragma unroll
                    for (int r = 0; r < 16; ++r) s[st][r] -= delta;
                o[0] = o[0] * fac; o[1] = o[1] * fac;
            }
#pragma unroll
            for (int st = 0; st < 2; ++st)
#pragma unroll
                for (int r = 0; r < 16; ++r) s[st][r] = __builtin_amdgcn_exp2f(s[st][r]);
            S.l += vsum32(s);
            bf16x8 pf[4]; p_pack(s, pf);
            VFrag vfr; pv_load<DG_VP>(vt, 0, vfr, lane);
            pv_mma(vfr, pf, o[0], o[1]);
        }
        const float lt = swapsum(S.l);
        if (r32 < 8) store_ot<64>(OC + (size_t)(b * SEQ + t) * DM + 512 + hh * 64, o, lt > 0.f ? 1.f / lt : 0.f, lane);
    }
#undef DG_LOADK
#undef DG_LOADV
}


constexpr int D_CQ = 0, D_CKV = 256, D_KR = 384, D_QD = 416, D_KD = 928, D_VD = 1440;
constexpr size_t WS_ROPE = 91 * MiB + 640 * 1024;
constexpr size_t WS_P1 = WS_OV, WS_CQN = WS_OV + 256 * MiB, WS_CKVN = WS_OV + 288 * MiB, WS_KR = WS_OV + 320 * MiB;
constexpr size_t WS_QMLA = WS_Y, WS_KVMLA = WS_Y + 96 * MiB;
static_assert(WS_KR + 4 * MiB <= WS_END && WS_KVMLA + 128 * MiB <= WS_OV, "odd overlay");
constexpr float LAM_INIT = 0.35550906759097f;

__device__ __forceinline__ void rope_table_phase(float* ROPE, int gt, int NGT) {
    for (int idx = gt; idx < SEQ * 16; idx += NGT) { const int t = idx >> 4, i = idx & 15;
        const float inv = exp2f(-(float)i * (13.287712379549449f / 16.0f));
        const double rev = (double)((float)t * inv) * 0.15915494309189535;
        const float fr = (float)(rev - __builtin_floor(rev));
        ROPE[2 * idx] = __builtin_amdgcn_cosf(fr); ROPE[2 * idx + 1] = __builtin_amdgcn_sinf(fr); }
}
__device__ __forceinline__ void odd_prep_rows(const bf16* P1, const float* qn, const float* kvn, const float* ROPE, bf16* CQN, bf16* CKVN, bf16* KR, int gw, int NGW, int lane) {
    float gq[4], gk[2];
#pragma unroll
    for (int j = 0; j < 4; ++j) gq[j] = qn[4 * lane + j];
    gk[0] = kvn[2 * lane]; gk[1] = kvn[2 * lane + 1];
    for (int m = gw; m < MTOK; m += NGW) {
        const bf16* row = P1 + (size_t)m * OD_INP;
        const v2u cq = *(const GAS v2u*)(row + D_CQ + 4 * lane); const unsigned ck = *(const GAS unsigned*)(row + D_CKV + 2 * lane);
        float x[4] = {bf2f((unsigned short)(cq.x & 0xffff)), bf2f((unsigned short)(cq.x >> 16)), bf2f((unsigned short)(cq.y & 0xffff)), bf2f((unsigned short)(cq.y >> 16))};
        float y[2] = {bf2f((unsigned short)(ck & 0xffff)), bf2f((unsigned short)(ck >> 16))};
        const float r1 = __builtin_amdgcn_rsqf(wave_sum((x[0] * x[0] + x[1] * x[1]) + (x[2] * x[2] + x[3] * x[3])) * (1.f / 256.f) + RMS_EPS);
        const float r2 = __builtin_amdgcn_rsqf(wave_sum(y[0] * y[0] + y[1] * y[1]) * (1.f / 128.f) + RMS_EPS);
        v2u o; o.x = pk2(x[0] * r1 * gq[0], x[1] * r1 * gq[1]); o.y = pk2(x[2] * r1 * gq[2], x[3] * r1 * gq[3]);
        *(GAS v2u*)(CQN + (size_t)m * 256 + 4 * lane) = o;
        *(GAS unsigned*)(CKVN + (size_t)m * 256 + 2 * lane) = pk2(y[0] * r2 * gk[0], y[1] * r2 * gk[1]);
        *(GAS unsigned*)(CKVN + (size_t)m * 256 + 128 + 2 * lane) = 0u;
        if (lane < 16) { const int t = m & (SEQ - 1); const float c = ROPE[(t * 16 + lane) * 2], s = ROPE[(t * 16 + lane) * 2 + 1];
            const float x1 = bf2f(row[D_KR + lane]), x2 = bf2f(row[D_KR + 16 + lane]);
            KR[(size_t)m * 32 + lane] = (bf16)f2bf(x1 * c - x2 * s); KR[(size_t)m * 32 + 16 + lane] = (bf16)f2bf(x1 * s + x2 * c); }
    }
}
template <bool BIAS> struct FCausal {
    int t, tmin, tmax, hi; const LAS float* BT;
    __device__ __forceinline__ void pre(int) {}
    __device__ __forceinline__ bool skip(int kt) const { return 64 * kt > tmax; }
    __device__ __forceinline__ void apply(f32x16 (&s)[2], int kt) {
        if (!(64 * kt + 63 <= tmin && (!BIAS || tmin - (64 * kt + 63) >= 113))) {
#pragma unroll
            for (int st = 0; st < 2; ++st)
#pragma unroll
                for (int r = 0; r < 16; ++r) { const int dist = t - (64 * kt + 32 * st + crow(r, hi)); const unsigned di = (unsigned)dist < 128u ? (unsigned)dist : 128u;
                    s[st][r] = dist >= 0 ? s[st][r] + (BIAS ? BT[di] : 0.f) : NEGBIG; }
        }
    }
};
__device__ __forceinline__ void mla_unit(LAS unsigned char* lds, const bf16* QM, const bf16* KVM_, const bf16* KR, const float* ROPE, bf16* OC, int b, int h, int qt, int tid_in, int lane_in, int wave) {
    int lane = lane_in; asm volatile("" : "+v"(lane)); const int tid = wave * 64 + lane; (void)tid_in;
    const int r32 = lane & 31, hi = lane >> 5, t = qt * 256 + wave * 32 + r32;
    bf16x8 qf[6]; load_q<96>(QM + (size_t)(b * SEQ + t) * 768 + h * 96, qf, lane);
    {
        const float* rp = ROPE + (size_t)(t * 16 + 8 * hi) * 2;
        bf16x8 a = qf[4], c = qf[5];
#pragma unroll
        for (int j = 0; j < 8; ++j) { const float cs = rp[2 * j], sn = rp[2 * j + 1], x1 = bf2f((unsigned short)a[j]), x2 = bf2f((unsigned short)c[j]);
            a[j] = (short)f2bf(x1 * cs - x2 * sn); c[j] = (short)f2bf(x1 * sn + x2 * cs); }
        qf[4] = a; qf[5] = c;
    }
#pragma unroll
    for (int d0 = 0; d0 < 6; ++d0) qf[d0] = scale_frag(qf[d0], 0.10206207261596577f * LOG2E);
    KVSrc kv{KVM_ + (size_t)(b * SEQ) * 1024 + h * 128, 1024, KR + (size_t)(b * SEQ) * 32, 32, KVM_ + (size_t)(b * SEQ) * 1024 + h * 128 + 64, 1024};
    f32x16 o[2] = {}; SmState S{0.f, 0.f, false};
    FCausal<false> f{t, qt * 256 + wave * 32, qt * 256 + wave * 32 + 31, hi, nullptr};
    attn_loop<96, 64, 64, FCausal<false>, false, true>(lds, kv, 0, 4 * qt + 4, qf, f, o, S, tid, lane);
    const float lt = swapsum(S.l);
    store_ot<64>(OC + (size_t)(b * SEQ + t) * DM + h * 64, o, lt > 0.f ? 1.f / lt : 0.f, lane);
}
__device__ __forceinline__ void diff_unit(LAS unsigned char* lds, const bf16* P1, const float* lam, const float* subln, bf16* OC, int b, int h, int qt, int tid_in, int lane_in, int wave) {
    int lane = lane_in; asm volatile("" : "+v"(lane)); const int tid = wave * 64 + lane; (void)tid_in;
    const int r32 = lane & 31, hi = lane >> 5, t = qt * 256 + wave * 32 + r32;
    const LAS float* BT = (const LAS float*)(lds + AT_BT) + (16 + h) * BT_STRIDE;
    float d01 = 0.f, d23 = 0.f;
    { d01 = lam[lane] * lam[64 + lane]; d23 = lam[128 + lane] * lam[192 + lane]; d01 = wave_sum(d01); d23 = wave_sum(d23); }
    const float lam_full = __expf(d01) - __expf(d23) + LAM_INIT;
    unsigned o0p[32];
    f32x16 o[4];
#pragma unroll 1
    for (int e = 0; e < 2; ++e) {
        bf16x8 qf[4]; load_q_scaled<64>(P1 + (size_t)(b * SEQ + t) * OD_INP + D_QD + (h * 2 + e) * 64, qf, 0.125f * LOG2E, lane);
        KVSrc kv{P1 + (size_t)(b * SEQ) * OD_INP + D_KD + (h * 2 + e) * 64, OD_INP, nullptr, 0, P1 + (size_t)(b * SEQ) * OD_INP + D_VD + h * 128, OD_INP};
#pragma unroll
        for (int dt = 0; dt < 4; ++dt) o[dt] = (f32x16){};
        SmState S{0.f, 0.f, false};
        FCausal<true> f{t, qt * 256 + wave * 32, qt * 256 + wave * 32 + 31, hi, BT};
        attn_loop<64, 64, 128, FCausal<true>>(lds, kv, 0, 4 * qt + 4, qf, f, o, S, tid, lane);
        const float lt = swapsum(S.l), inv = lt > 0.f ? 1.f / lt : 0.f;
        if (e == 0) {
#pragma unroll
            for (int dt = 0; dt < 4; ++dt)
#pragma unroll
                for (int k = 0; k < 8; ++k) o0p[dt * 8 + k] = cvtpk(o[dt][2 * k] * inv, o[dt][2 * k + 1] * inv);
        } else {
            float ss = 0.f;
#pragma unroll
            for (int dt = 0; dt < 4; ++dt)
#pragma unroll
                for (int k = 0; k < 8; ++k) { const unsigned w = o0p[dt * 8 + k];
                    const float a0 = __uint_as_float(w << 16) - lam_full * (o[dt][2 * k] * inv), a1 = __uint_as_float(w & 0xffff0000u) - lam_full * (o[dt][2 * k + 1] * inv);
                    o[dt][2 * k] = a0; o[dt][2 * k + 1] = a1; ss += a0 * a0 + a1 * a1; }
            ss = swapsum(ss);
            const float rn = __builtin_amdgcn_rsqf(ss * (1.f / 128.f) + RMS_EPS) * (1.0f - LAM_INIT);
            bf16* orow = OC + (size_t)(b * SEQ + t) * DM + 512 + h * 128;
#pragma unroll
            for (int dt = 0; dt < 4; ++dt)
#pragma unroll
                for (int r4 = 0; r4 < 4; r4 += 2) { const int d = 32 * dt + 8 * r4 + 4 * hi; const f32x4 gn = *(const GAS f32x4*)(subln + d), gm = *(const GAS f32x4*)(subln + d + 8);
                    v2u wa, wb; wa.x = cvtpk(o[dt][4 * r4 + 0] * rn * gn.x, o[dt][4 * r4 + 1] * rn * gn.y); wa.y = cvtpk(o[dt][4 * r4 + 2] * rn * gn.z, o[dt][4 * r4 + 3] * rn * gn.w);
                    wb.x = cvtpk(o[dt][4 * r4 + 4] * rn * gm.x, o[dt][4 * r4 + 5] * rn * gm.y); wb.y = cvtpk(o[dt][4 * r4 + 6] * rn * gm.z, o[dt][4 * r4 + 7] * rn * gm.w);
                    swap_pair(wa, wb);
                    *(GAS v4u*)(orow + 32 * dt + 8 * r4 + 8 * hi) = (v4u){wa.x, wa.y, wb.x, wb.y}; }
        }
    }
}


__device__ __forceinline__ void tr_item(const float* W, int N, bf16* WT, int ldk, int drow0, LAS float* scr, int k0, int n0, int lane, const float* grow = nullptr) {
#pragma unroll 8
    for (int i = 0; i < 32; ++i) { const int kk = 2 * i + (lane >> 5); float wv = W[(size_t)(k0 + kk) * N + n0 + (lane & 31)]; if (grow) wv *= grow[k0 + kk]; scr[kk * 33 + (lane & 31)] = wv; }
    LDS_WAIT(); asm volatile("" ::: "memory");
    const int c = lane & 7;
#pragma unroll
    for (int j = 0; j < 4; ++j) { const int n = (lane >> 3) + 8 * j; const LAS float* s = scr + (8 * c) * 33 + n;
        v4u o; o.x = pk2(s[0 * 33], s[1 * 33]); o.y = pk2(s[2 * 33], s[3 * 33]); o.z = pk2(s[4 * 33], s[5 * 33]); o.w = pk2(s[6 * 33], s[7 * 33]);
        *(GAS v4u*)(WT + (size_t)(drow0 + n) * ldk + k0 + 8 * c) = o; }
    LDS_WAIT(); asm volatile("" ::: "memory");
}
__device__ __forceinline__ void tr_item8(const float* W, int N, unsigned char* WT, int ldk, int drow0, LAS float* scr, int k0, int n0, int lane) {
#pragma unroll 8
    for (int i = 0; i < 32; ++i) { const int kk = 2 * i + (lane >> 5); scr[kk * 33 + (lane & 31)] = W[(size_t)(k0 + kk) * N + n0 + (lane & 31)]; }
    LDS_WAIT(); asm volatile("" ::: "memory");
    const int c = lane & 7;
#pragma unroll
    for (int j = 0; j < 4; ++j) { const int n = (lane >> 3) + 8 * j; const LAS float* s = scr + (8 * c) * 33 + n;
        v2u o; o.x = pg8::pk4_fp8(s[0 * 33], s[1 * 33], s[2 * 33], s[3 * 33], pg8::F8S_W); o.y = pg8::pk4_fp8(s[4 * 33], s[5 * 33], s[6 * 33], s[7 * 33], pg8::F8S_W);
        *(GAS v2u*)(WT + (size_t)(drow0 + n) * ldk + k0 + 8 * c) = o; }
    LDS_WAIT(); asm volatile("" ::: "memory");
}
constexpr size_t WS_XB = WS_OV + 370 * MiB;
constexpr size_t WS_RS = 1 * MiB;
constexpr int F8_FROM = 1;
__device__ __forceinline__ void rows_norm_phase(const float* xsrc, float* xdst, const bf16* Y, float w, const float* gpost, const float* gpre, bf16* H, int nrows, int gw, int NGW, int lane, bool f8 = false, float ysc = 1.f, const bf16* xsb = nullptr, bf16* xdb = nullptr, float* Rout = nullptr) {
    f32x4 gp[4], gq[4];
#pragma unroll
    for (int j = 0; j < 4; ++j) {
        gp[j] = Y ? ((const GAS f32x4*)gpost)[lane + 64 * j] * w : (f32x4){0.f, 0.f, 0.f, 0.f};
        gq[j] = gpre ? ((const GAS f32x4*)gpre)[lane + 64 * j] : (f32x4){0.f, 0.f, 0.f, 0.f};
    }
    for (int m = gw; m < nrows; m += NGW) {
        f32x4 x[4];
        if (xsb) {
            const GAS v2u* xr = (const GAS v2u*)(xsb + (size_t)m * DM) + lane;
#pragma unroll
            for (int j = 0; j < 4; ++j) { const v2u xv = xr[64 * j]; x[j] = (f32x4){__uint_as_float(xv.x << 16), __uint_as_float(xv.x & 0xffff0000u), __uint_as_float(xv.y << 16), __uint_as_float(xv.y & 0xffff0000u)}; }
        } else {
            const GAS f32x4* xr = (const GAS f32x4*)(xsrc + (size_t)m * DM) + lane;
#pragma unroll
            for (int j = 0; j < 4; ++j) x[j] = xr[64 * j];
        }
        if (Y) {
            const GAS v2u* yr = (const GAS v2u*)(Y + (size_t)m * DM) + lane;
            f32x4 y[4]; float s = 0.f;
#pragma unroll
            for (int j = 0; j < 4; ++j) { const v2u yv = yr[64 * j]; y[j] = (f32x4){__uint_as_float(yv.x << 16), __uint_as_float(yv.x & 0xffff0000u), __uint_as_float(yv.y << 16), __uint_as_float(yv.y & 0xffff0000u)} * ysc;
                s += (y[j].x * y[j].x + y[j].y * y[j].y) + (y[j].z * y[j].z + y[j].w * y[j].w); }
            const float rstd = __builtin_amdgcn_rsqf(wave_sum(s) * (1.f / DM) + RMS_EPS);
#pragma unroll
            for (int j = 0; j < 4; ++j) x[j] = x[j] + y[j] * rstd * gp[j];
        }
        if (xdst) {
            GAS f32x4* xo = (GAS f32x4*)(xdst + (size_t)m * DM) + lane;
#pragma unroll
            for (int j = 0; j < 4; ++j) xo[64 * j] = x[j];
        }
        if (xdb) {
            GAS v2u* xo = (GAS v2u*)(xdb + (size_t)m * DM) + lane;
#pragma unroll
            for (int j = 0; j < 4; ++j) { v2u o; o.x = pk2(x[j].x, x[j].y); o.y = pk2(x[j].z, x[j].w); xo[64 * j] = o; }
        }
        if (gpre || Rout) {
            float s2 = 0.f;
#pragma unroll
            for (int j = 0; j < 4; ++j) s2 += (x[j].x * x[j].x + x[j].y * x[j].y) + (x[j].z * x[j].z + x[j].w * x[j].w);
            const float r2 = __builtin_amdgcn_rsqf(wave_sum(s2) * (1.f / DM) + RMS_EPS);
            if (Rout && lane == 0) Rout[m] = r2;
            if (gpre) {
            if (f8) {
                GAS unsigned* ho = (GAS unsigned*)((unsigned char*)H + (size_t)m * DM) + lane;
#pragma unroll
                for (int j = 0; j < 4; ++j) { const f32x4 h = x[j] * r2 * gq[j]; ho[64 * j] = pg8::pk4_fp8(h.x, h.y, h.z, h.w, pg8::F8S_H); }
            } else {
            GAS v2u* ho = (GAS v2u*)(H + (size_t)m * DM) + lane;
#pragma unroll
            for (int j = 0; j < 4; ++j) { const f32x4 h = x[j] * r2 * gq[j]; v2u o; o.x = pk2(h.x, h.y); o.y = pk2(h.z, h.w); ho[64 * j] = o; }
            }
            }
        }
    }
}
__device__ __forceinline__ void transpose_cols_phase(const bf16* src, int ld, int col0, int ncols, int nb, int S, bf16* dst, LAS unsigned short* scr, int gw, int NGW, int lane, int gsz = 1 << 30, int gstride = 0) {
    const int nct = ncols / 64, nst = S / 64, nitems = nb * nct * nst;
    for (int it = gw; it < nitems; it += NGW) {
        const int st = it % nst, ct = (it / nst) % nct, b = it / (nst * nct);
        const bf16* sp = src + (size_t)(b * S + st * 64) * ld + col0 + ((ct * 64) / gsz) * gstride + (ct * 64) % gsz;
#pragma unroll
        for (int i = 0; i < 8; ++i) { const int r = i * 8 + (lane >> 3), c8 = (lane & 7) * 8;
            const v4u v = *(const GAS v4u*)(sp + (size_t)r * ld + c8);
            LAS unsigned* d = (LAS unsigned*)(scr + r * 66 + c8); d[0] = v.x; d[1] = v.y; d[2] = v.z; d[3] = v.w; }
        LDS_WAIT(); asm volatile("" ::: "memory");
        bf16* dp = dst + ((size_t)(b * ncols + ct * 64)) * S + st * 64;
#pragma unroll
        for (int i = 0; i < 8; ++i) { const int c = i * 8 + (lane >> 3), r8 = (lane & 7) * 8;
            unsigned short e[8];
#pragma unroll
            for (int k = 0; k < 8; ++k) e[k] = scr[(r8 + k) * 66 + c];
            v4u o; o.x = e[0] | ((unsigned)e[1] << 16); o.y = e[2] | ((unsigned)e[3] << 16); o.z = e[4] | ((unsigned)e[5] << 16); o.w = e[6] | ((unsigned)e[7] << 16);
            *(GAS v4u*)(dp + (size_t)c * S + r8) = o; }
        LDS_WAIT(); asm volatile("" ::: "memory");
    }
}

struct Args { const float* in[24]; float* out; unsigned char* ws; int ph_lo, ph_hi, stop, li; };
constexpr int PH_PRO = 0, PH_MEMKV = 1, PH_MEMVT = 2, PH_L0 = 3, PPL = 17, NPHASE = PH_L0 + 2 * PPL;

#define PHASE_IDS unsigned char* ws = args.ws; asm volatile("" : "+s"(ws)); int bx = bx0, vcu = vcu0; asm volatile("" : "+s"(bx), "+s"(vcu)); const int gw = vcu * NWAVES + wave, NGW = G * NWAVES; (void)gw; (void)NGW; (void)bx; int lane_l; asm volatile("v_mbcnt_lo_u32_b32 %0, -1, 0\n\tv_mbcnt_hi_u32_b32 %0, -1, %0" : "=v"(lane_l)); const int lane = lane_l, tid = wave * 64 + lane; bf16* const H = (bf16*)(ws + WS_H); bf16* const Y = (bf16*)(ws + WS_Y); bf16* const XB = (bf16*)(ws + WS_XB); float* const RS = (float*)(ws + WS_RS); (void)H; (void)Y; (void)XB; (void)RS; (void)tid;
#define IN(k) (lo <= (k) && (k) < hi && (k) < stop)
#define SEAM(k) do { if ((k) + 1 < hi && (k) + 1 < stop) { XcdBarrier b2 = bar; asm volatile("" : "+s"(b2.bar), "+s"(b2.x)); xcd_barrier(b2); } } while (0)
template <int L> __device__ __forceinline__ void layer_phases(const Args& args, LAS unsigned char* lds, const XcdBarrier& bar, int wave, int G, int bx0, int vcu0, int lo, int hi, int stop) {
    const float* x_in = args.in[0]; const float* norm_pre = args.in[3]; const float* norm_post = args.in[4]; float* xout = args.out;

        const int base = PH_L0 + L * PPL;
        const float* gpre = norm_pre + (size_t)L * 4 * DM; const float* gpost = norm_post + (size_t)L * 4 * DM;
        if (IN(base + 0)) {
            PHASE_IDS
            pg8::StaticOrder S; S.init(MTOK, 5632, G, bx);
            if constexpr (L * 2 + 0 >= F8_FROM) {
                pg8::Gemm g{H, (const bf16*)(ws + WS_WGU) + (size_t)(L * 2 + 0) * 5632 * DM, MTOK, 5632, DM};
                pg8::EpiSwiGLU8 E{ws + WS_HID, DFF};
                pg8::gemm_phase<pg8::EpiSwiGLU8, pg8::StaticOrder, true, true, true>(lds, g, S, E, tid);
            } else {
                pg8::Gemm g{XB, (const bf16*)(ws + WS_WGU) + (size_t)(L * 2 + 0) * 5632 * DM, MTOK, 5632, DM};
                pg8::EpiSwiGLUR E{(bf16*)(ws + WS_HID), DFF, RS};
                pg8::gemm_phase<pg8::EpiSwiGLUR, pg8::StaticOrder, true, true>(lds, g, S, E, tid);
            }
            SEAM(base + 0);
        }
        if (IN(base + 1)) {
            PHASE_IDS
            pg8::StaticOrder S; S.init(MTOK, DM, G, bx);
            pg8::EpiBf16P E{Y, DM};
            if constexpr (L * 2 + 0 >= F8_FROM) {
                pg8::Gemm g{(const bf16*)(ws + WS_HID), (const bf16*)(ws + WS_WD) + (size_t)(L * 2 + 0) * DM * DFF, MTOK, DM, DFF};
                pg8::gemm_phase<pg8::EpiBf16P, pg8::StaticOrder, true, true, true>(lds, g, S, E, tid);
            } else {
                pg8::Gemm g{(const bf16*)(ws + WS_HID), (const bf16*)(ws + WS_WD) + (size_t)(L * 2 + 0) * DM * DFF, MTOK, DM, DFF};
                pg8::gemm_phase<pg8::EpiBf16P, pg8::StaticOrder, true, true>(lds, g, S, E, tid);
            }
            SEAM(base + 1);
        }
        if (IN(base + 2)) {
            PHASE_IDS
            rows_norm_phase(nullptr, nullptr, Y, 0.5f, gpost, L == 0 ? nullptr : gpre + DM, H, MTOK, gw, NGW, lane, L == 1, L * 2 + 0 >= F8_FROM ? 1.f / (pg8::F8S_W * pg8::F8S_HID) : 1.f, XB, XB, L == 0 ? RS : nullptr);
            SEAM(base + 2);
        }
        if (L == 0 && IN(base + 3)) {
            PHASE_IDS
            pg8::Gemm g{XB, (const bf16*)(ws + WS_EVIN), MTOK, EV_INP, DM};
            pg8::StaticOrder S; S.init(MTOK, EV_INP, G, bx);
            pg8::EpiBf16PR E{(bf16*)(ws + WS_P0), EV_INP, RS};
            pg8::gemm_phase<pg8::EpiBf16PR, pg8::StaticOrder, true, true>(lds, g, S, E, tid);
            SEAM(base + 3);
        }
        if (L == 0 && IN(base + 4)) {
            PHASE_IDS
            if (args.li == 0) { PHASE_IDS
            const bf16* P0 = (const bf16*)(ws + WS_P0);
            for (int it0 = vcu * 2; it0 < 512; it0 += G * 2) nsa_compress_pair(lds, P0, (const bf16*)(ws + WS_CWT), (const float*)(ws + WS_CBIAS), (bf16*)(ws + WS_KCMP), (bf16*)(ws + WS_VCMP), it0, wave, lane);
            }
            __syncthreads();
            { PHASE_IDS
            const bf16* P0 = (const bf16*)(ws + WS_P0);
            for (int u = vcu, i = 0; u < NB * 256; u += G, ++i) {
                int b, qt;
                if (G == 256) { b = vcu >> 4; const int sub = vcu & 15; qt = (i & 1) ? 16 * i + 15 - sub : 16 * i + sub; } else { b = u & 15; qt = u >> 4; }
                dsa_index_unit(lds, P0, (unsigned short*)(ws + WS_SEL), b, qt, tid, lane, wave);
            } }
            SEAM(base + 4);
        }
        if (L == 0 && IN(base + 5)) {
            PHASE_IDS
            build_bias_tables(lds, args.in[2], tid);
            __syncthreads();
            { PHASE_IDS
            const bf16* P0 = (const bf16*)(ws + WS_P0);
            for (int u = vcu, i = 0; u < NB * 2 * 64; u += G, ++i) {
                int bg, qt;
                if (G == 256) { bg = vcu >> 3; const int sub = vcu & 7; qt = (i & 1) ? 8 * i + 7 - sub : 8 * i + sub; } else { bg = u & 31; qt = u >> 5; }
                nsa_unit(lds, P0, (const bf16*)(ws + WS_KCMP), (const bf16*)(ws + WS_VCMP), H, bg >> 1, bg & 1, qt, tid, lane, wave);
            } }
            { PHASE_IDS
            const bf16* P0 = (const bf16*)(ws + WS_P0);
            for (int u = vcu, i = 0; u < NB * 128; u += G, ++i) {
                int b, qt;
                if (G == 256) { b = vcu >> 4; const int sub = vcu & 15; qt = (i & 1) ? 16 * i + 15 - sub : 16 * i + sub; } else { b = u & 15; qt = u >> 4; }
                dsa_unit(lds, P0, (const unsigned short*)(ws + WS_SEL), H, b, qt, tid, lane, wave);
            } }
            SEAM(base + 5);
        }
        if (L == 1 && IN(base + 3)) {
            PHASE_IDS
            pg8::Gemm g{H, (const bf16*)(ws + WS_ODIN), MTOK, OD_INP, DM};
            pg8::StaticOrder S; S.init(MTOK, OD_INP, G, bx);
            pg8::EpiBf16PS E{(bf16*)(ws + WS_P1), OD_INP, 1.f / (pg8::F8S_W * pg8::F8S_H)};
            pg8::gemm_phase<pg8::EpiBf16PS, pg8::StaticOrder, true, true, true>(lds, g, S, E, tid);
            SEAM(base + 3);
        }
        if (L == 1 && IN(base + 4)) {
            PHASE_IDS
            const bf16* P1 = (const bf16*)(ws + WS_P1);
            odd_prep_rows(P1, args.in[14], args.in[15], (const float*)(ws + WS_ROPE), (bf16*)(ws + WS_CQN), (bf16*)(ws + WS_CKVN), (bf16*)(ws + WS_KR), gw, NGW, lane);
            SEAM(base + 4);
        }
        if (L == 1 && IN(base + 5)) {
            PHASE_IDS
            { pg8::Gemm g{(const bf16*)(ws + WS_CQN), (const bf16*)(ws + WS_WUQ), MTOK, 768, 256};
              pg8::StaticOrder S; S.init(MTOK, 768, G, bx);
              pg8::EpiBf16P E{(bf16*)(ws + WS_QMLA), 768};
              pg8::gemm_phase<pg8::EpiBf16P, pg8::StaticOrder, true, true>(lds, g, S, E, tid); }
            __syncthreads();
            { pg8::Gemm g{(const bf16*)(ws + WS_CKVN), (const bf16*)(ws + WS_WUKV), MTOK, 1024, 256};
              pg8::StaticOrder S; S.init(MTOK, 1024, G, bx);
              pg8::EpiBf16P E{(bf16*)(ws + WS_KVMLA), 1024};
              pg8::gemm_phase<pg8::EpiBf16P, pg8::StaticOrder, true, true>(lds, g, S, E, tid); }
            SEAM(base + 5);
        }
        if (L == 1 && IN(base + 7)) {
            { PHASE_IDS
            build_bias_tables(lds, args.in[2], tid);
            __syncthreads();
            for (int u = vcu, i = 0; u < NB * 8 * 16; u += G, ++i) {
                int bh, qt;
                if (G == 256) { bh = vcu >> 1; const int sub = vcu & 1; qt = (i & 1) ? 2 * i + 1 - sub : 2 * i + sub; } else { bh = u & 127; qt = u >> 7; }
                mla_unit(lds, (const bf16*)(ws + WS_QMLA), (const bf16*)(ws + WS_KVMLA), (const bf16*)(ws + WS_KR), (const float*)(ws + WS_ROPE), H, bh >> 3, bh & 7, qt, tid, lane, wave);
            } }
            { PHASE_IDS
            for (int u = vcu, i = 0; u < NB * 4 * 16; u += G, ++i) {
                int bh, qt;
                if (G == 256) { bh = vcu >> 2; const int sub = vcu & 3; qt = (i & 1) ? 4 * i + 3 - sub : 4 * i + sub; } else { bh = u & 63; qt = u >> 6; }
                diff_unit(lds, (const bf16*)(ws + WS_P1), args.in[18], args.in[19], H, bh >> 2, bh & 3, qt, tid, lane, wave);
            } }
            SEAM(base + 7);
        }
        if (IN(base + 8)) {
            PHASE_IDS
            pg8::Gemm g{H, (const bf16*)(ws + (L == 0 ? WS_EVOUT : WS_ODOUT)), MTOK, DM, DM};
            pg8::StaticOrder S; S.init(MTOK, DM, G, bx);
            pg8::EpiBf16P E{Y, DM};
            pg8::gemm_phase<pg8::EpiBf16P, pg8::StaticOrder, true, true>(lds, g, S, E, tid);
            SEAM(base + 8);
        }
        if (IN(base + 9)) {
            PHASE_IDS
            rows_norm_phase(nullptr, nullptr, Y, 1.0f, gpost + DM, nullptr, H, MTOK, gw, NGW, lane, false, 1.f, XB, XB, RS);
            SEAM(base + 9);
        }
        if (IN(base + 10)) {
            PHASE_IDS
            pg8::Gemm g{XB, (const bf16*)(ws + WS_XWQ) + (size_t)L * 512 * DM, MTOK, 512, DM};
            pg8::StaticOrder S; S.init(MTOK, 512, G, bx);
            pg8::EpiBf16PR E{(bf16*)(ws + WS_XQ), 512, RS};
            pg8::gemm_phase<pg8::EpiBf16PR, pg8::StaticOrder, true, true>(lds, g, S, E, tid);
            SEAM(base + 10);
        }
        if (IN(base + 11)) {
            PHASE_IDS
            for (int u = vcu; u < NB * 4 * 16; u += G) {
                const int qt = u & 15, h = (u >> 4) & 3, b = u >> 6;
                xattn_unit(lds, (const bf16*)(ws + WS_XQ), (const bf16*)(ws + WS_KVM) + (size_t)L * MROWS * DM, H, b, h, qt, tid, lane, wave);
            }
            SEAM(base + 11);
        }
        if (IN(base + 12)) {
            PHASE_IDS
            pg8::Gemm g{H, (const bf16*)(ws + WS_XWO) + (size_t)L * DM * 512, MTOK, DM, 512};
            pg8::StaticOrder S; S.init(MTOK, DM, G, bx);
            pg8::EpiBf16P E{Y, DM};
            pg8::gemm_phase<pg8::EpiBf16P, pg8::StaticOrder, true, true>(lds, g, S, E, tid);
            SEAM(base + 12);
        }
        if (IN(base + 13)) {
            PHASE_IDS
            rows_norm_phase(nullptr, nullptr, Y, 1.0f, gpost + 2 * DM, gpre + 3 * DM, H, MTOK, gw, NGW, lane, L * 2 + 1 >= F8_FROM, 1.f, XB, XB);
            SEAM(base + 13);
        }
        if (IN(base + 14)) {
            PHASE_IDS
            pg8::StaticOrder S; S.init(MTOK, 5632, G, bx);
            if constexpr (L * 2 + 1 >= F8_FROM) {
                pg8::Gemm g{H, (const bf16*)(ws + WS_WGU) + (size_t)(L * 2 + 1) * 5632 * DM, MTOK, 5632, DM};
                pg8::EpiSwiGLU8 E{ws + WS_HID, DFF};
                pg8::gemm_phase<pg8::EpiSwiGLU8, pg8::StaticOrder, true, true, true>(lds, g, S, E, tid);
            } else {
                pg8::Gemm g{H, (const bf16*)(ws + WS_WGU) + (size_t)(L * 2 + 1) * 5632 * DM, MTOK, 5632, DM};
                pg8::EpiSwiGLU E{(bf16*)(ws + WS_HID), DFF};
                pg8::gemm_phase<pg8::EpiSwiGLU, pg8::StaticOrder, true, true>(lds, g, S, E, tid);
            }
            SEAM(base + 14);
        }
        if (IN(base + 15)) {
            PHASE_IDS
            pg8::StaticOrder S; S.init(MTOK, DM, G, bx);
            pg8::EpiBf16P E{Y, DM};
            if constexpr (L * 2 + 1 >= F8_FROM) {
                pg8::Gemm g{(const bf16*)(ws + WS_HID), (const bf16*)(ws + WS_WD) + (size_t)(L * 2 + 1) * DM * DFF, MTOK, DM, DFF};
                pg8::gemm_phase<pg8::EpiBf16P, pg8::StaticOrder, true, true, true>(lds, g, S, E, tid);
            } else {
                pg8::Gemm g{(const bf16*)(ws + WS_HID), (const bf16*)(ws + WS_WD) + (size_t)(L * 2 + 1) * DM * DFF, MTOK, DM, DFF};
                pg8::gemm_phase<pg8::EpiBf16P, pg8::StaticOrder, true, true>(lds, g, S, E, tid);
            }
            SEAM(base + 15);
        }
        if (IN(base + 16)) {
            PHASE_IDS
            rows_norm_phase(nullptr, L == 0 ? nullptr : xout, Y, 0.5f, gpost + 3 * DM, L == 0 ? norm_pre + 4 * DM : nullptr, H, MTOK, gw, NGW, lane, L * 2 + 2 >= F8_FROM, L * 2 + 1 >= F8_FROM ? 1.f / (pg8::F8S_W * pg8::F8S_HID) : 1.f, XB, L == 0 ? XB : nullptr);
            SEAM(base + 16);
        }
}


__global__ void __launch_bounds__(NWAVES * 64, 2) fwd_kernel(Args args) {
    extern __shared__ __attribute__((aligned(16))) unsigned char lds_raw[];
    LAS unsigned char* lds = (LAS unsigned char*)lds_raw;
    volatile LAS unsigned* MISC = (volatile LAS unsigned*)(lds + MISC_OFF);
    const int tid0 = threadIdx.x, wave = __builtin_amdgcn_readfirstlane(tid0 >> 6);
    const int G = gridDim.x, bx0 = blockIdx.x;
    const int vcu0 = (G % 8 == 0) ? (bx0 % 8) * (G / 8) + bx0 / 8 : bx0;
    unsigned* ctl = (unsigned*)(args.ws + WS_CTL);
    for (int u = tid0; u < (LDS_BYTES - LDSCTL_OFF) / 4; u += NWAVES * 64) ((LAS unsigned*)(lds + LDSCTL_OFF))[u] = 0u;
    __syncthreads();
    XcdBarrier bar = xcd_barrier_post(ctl + CW_BAR + args.li * XCD_BAR_WORDS, MISC + 8);
    const int lo = args.ph_lo, hi = args.ph_hi, stop = args.stop;

    const float* x_in = args.in[0]; const float* mem = args.in[1];
    const float* norm_pre = args.in[3]; const float* norm_post = args.in[4]; const float* mem_norm = args.in[5];
    float* xout = args.out;

    if (IN(PH_PRO)) {
            PHASE_IDS
        LAS float* scr = (LAS float*)(lds + wave * 16384);
        constexpr int I_GU = (DM / 64) * (DFF / 32), I_D = (DFF / 64) * (DM / 32);
        constexpr int I_EVIN = (DM / 64) * (EV_IN / 32), I_SQ = (DM / 64) * (DM / 32), I_ODIN = (DM / 64) * (OD_IN / 32);
        constexpr int I_UQ = (256 / 64) * (768 / 32), I_UKV = (128 / 64) * (1024 / 32), I_XQ = (DM / 64) * (512 / 32), I_XO = (512 / 64) * (DM / 32);
        constexpr int I_CW = (2048 / 64) * (64 / 32);
        constexpr int NITEMS = 8 * I_GU + 4 * I_D + I_EVIN + I_SQ + I_ODIN + I_SQ + I_UQ + I_UKV + 2 * I_XQ + 2 * I_SQ + 2 * I_XO + 2 * I_CW;
        for (int it = gw; it < NITEMS; it += NGW) {
            int r = it;
            if (r < 8 * I_GU) { const int mat = r / I_GU, rr = r % I_GU, which = mat & 1, ij = mat >> 1, nblk = DFF / 32, k0 = (rr / nblk) * 64, n0 = (rr % nblk) * 32;
                if (ij >= F8_FROM) tr_item8((which ? args.in[7] : args.in[6]) + (size_t)ij * DM * DFF, DFF, ws + WS_WGU + (size_t)ij * 5632 * DM * 2, DM, (n0 / 128) * 256 + which * 128 + (n0 % 128), scr, k0, n0, lane);
                else tr_item((which ? args.in[7] : args.in[6]) + (size_t)ij * DM * DFF, DFF, (bf16*)(ws + WS_WGU) + (size_t)ij * 5632 * DM, DM, (n0 / 128) * 256 + which * 128 + (n0 % 128), scr, k0, n0, lane, norm_pre);
                continue; } r -= 8 * I_GU;
            if (r < 4 * I_D) { const int mat = r / I_D, rr = r % I_D, nblk = DM / 32, k0 = (rr / nblk) * 64, n0 = (rr % nblk) * 32;
                if (mat >= F8_FROM) tr_item8(args.in[8] + (size_t)mat * DFF * DM, DM, ws + WS_WD + (size_t)mat * DM * DFF * 2, DFF, n0, scr, k0, n0, lane);
                else tr_item(args.in[8] + (size_t)mat * DFF * DM, DM, (bf16*)(ws + WS_WD) + (size_t)mat * DM * DFF, DFF, n0, scr, k0, n0, lane);
                continue; } r -= 4 * I_D;
            if (r < I_EVIN) { const int nblk = EV_IN / 32, k0 = (r / nblk) * 64, n0 = (r % nblk) * 32; tr_item(args.in[9], EV_IN, (bf16*)(ws + WS_EVIN), DM, n0, scr, k0, n0, lane, norm_pre + DM); continue; } r -= I_EVIN;
            if (r < I_SQ) { const int nblk = DM / 32, k0 = (r / nblk) * 64, n0 = (r % nblk) * 32; tr_item(args.in[12], DM, (bf16*)(ws + WS_EVOUT), DM, n0, scr, k0, n0, lane); continue; } r -= I_SQ;
            if (r < I_ODIN) { const int nblk = OD_IN / 32, k0 = (r / nblk) * 64, n0 = (r % nblk) * 32; tr_item8(args.in[13], OD_IN, ws + WS_ODIN, DM, n0, scr, k0, n0, lane); continue; } r -= I_ODIN;
            if (r < I_SQ) { const int nblk = DM / 32, k0 = (r / nblk) * 64, n0 = (r % nblk) * 32; tr_item(args.in[20], DM, (bf16*)(ws + WS_ODOUT), DM, n0, scr, k0, n0, lane); continue; } r -= I_SQ;
            if (r < I_UQ) { const int nblk = 768 / 32, k0 = (r / nblk) * 64, n0 = (r % nblk) * 32; tr_item(args.in[16], 768, (bf16*)(ws + WS_WUQ), 256, n0, scr, k0, n0, lane); continue; } r -= I_UQ;
            if (r < I_UKV) { const int nblk = 1024 / 32, k0 = (r / nblk) * 64, n0 = (r % nblk) * 32; tr_item(args.in[17], 1024, (bf16*)(ws + WS_WUKV), 256, n0, scr, k0, n0, lane); continue; } r -= I_UKV;
            if (r < 2 * I_XQ) { const int mat = r / I_XQ, rr = r % I_XQ, nblk = 512 / 32, k0 = (rr / nblk) * 64, n0 = (rr % nblk) * 32;
                tr_item(args.in[21] + (size_t)mat * DM * 512, 512, (bf16*)(ws + WS_XWQ) + (size_t)mat * 512 * DM, DM, n0, scr, k0, n0, lane, norm_pre + (size_t)(mat * 4 + 2) * DM); continue; } r -= 2 * I_XQ;
            if (r < 2 * I_SQ) { const int mat = r / I_SQ, rr = r % I_SQ, nblk = DM / 32, k0 = (rr / nblk) * 64, n0 = (rr % nblk) * 32;
                tr_item(args.in[22] + (size_t)mat * DM * DM, DM, (bf16*)(ws + WS_XWKV) + (size_t)mat * DM * DM, DM, n0, scr, k0, n0, lane); continue; } r -= 2 * I_SQ;
            if (r < 2 * I_XO) { const int mat = r / I_XO, rr = r % I_XO, nblk = DM / 32, k0 = (rr / nblk) * 64, n0 = (rr % nblk) * 32;
                tr_item(args.in[23] + (size_t)mat * 512 * DM, DM, (bf16*)(ws + WS_XWO) + (size_t)mat * DM * 512, 512, n0, scr, k0, n0, lane); continue; } r -= 2 * I_XO;
            { const int mat = r / I_CW, rr = r % I_CW, nblk = 64 / 32, k0 = (rr / nblk) * 64, n0 = (rr % nblk) * 32;
                tr_item(args.in[11] + (size_t)mat * 2048 * 64, 64, (bf16*)(ws + WS_CWT) + (size_t)mat * 64 * 2048, 2048, n0, scr, k0, n0, lane); }
        }
        { const int gt = vcu * (NWAVES * 64) + tid, NGT = G * NWAVES * 64; const v4u z = (v4u){0u, 0u, 0u, 0u};
          for (int i = gt; i < (EV_INP - EV_IN) * DM / 8; i += NGT) ((GAS v4u*)((bf16*)(ws + WS_EVIN) + (size_t)EV_IN * DM))[i] = z;
          for (int i = gt; i < (OD_INP - OD_IN) * DM / 16; i += NGT) ((GAS v4u*)(ws + WS_ODIN + (size_t)OD_IN * DM))[i] = z;
          for (int i = gt; i < 1024 * 16; i += NGT) ((GAS v4u*)((bf16*)(ws + WS_WUKV) + (size_t)(i >> 4) * 256 + 128))[i & 15] = z; }
        if (gw < 128) { const int c = gw >> 6, e = gw & 63; const float* pe = args.in[10] + (size_t)c * 2048; const float* cw = args.in[11] + (size_t)c * 2048 * 64 + e; float a = 0.f;
            for (int k = lane; k < 2048; k += 64) a += pe[k] * cw[(size_t)k * 64];
            a = wave_sum(a); if (lane == 0) ((float*)(ws + WS_CBIAS))[gw] = a; }
        rope_table_phase((float*)(ws + WS_ROPE), vcu * (NWAVES * 64) + tid, G * NWAVES * 64);
        rows_norm_phase(x_in, nullptr, nullptr, 0.f, nullptr, nullptr, H, MTOK, gw, NGW, lane, false, 1.f, nullptr, XB, RS);
        rows_norm_phase(mem, nullptr, nullptr, 0.f, nullptr, mem_norm, (bf16*)(ws + WS_MN), MROWS, gw, NGW, lane);
        rows_norm_phase(mem, nullptr, nullptr, 0.f, nullptr, mem_norm + DM, (bf16*)(ws + WS_MN) + (size_t)MROWS * DM, MROWS, gw, NGW, lane);
        SEAM(PH_PRO);
    }
    if (IN(PH_MEMKV)) {
            PHASE_IDS
#pragma unroll 1
        for (int i = 0; i < 2; ++i) {
            pg8::Gemm g{(const bf16*)(ws + WS_MN) + (size_t)i * MROWS * DM, (const bf16*)(ws + WS_XWKV) + (size_t)i * DM * DM, MROWS, DM, DM};
            pg8::StaticOrder S; S.init(MROWS, DM, G, (bx + 128 * i) % G);
            pg8::EpiBf16P E{(bf16*)(ws + WS_KVM) + (size_t)i * MROWS * DM, DM};
            pg8::gemm_phase<pg8::EpiBf16P, pg8::StaticOrder, true, true>(lds, g, S, E, tid);
            __syncthreads();
        }
        SEAM(PH_MEMKV);
    }
    layer_phases<0>(args, lds, bar, wave, G, bx0, vcu0, lo, hi, stop);
    layer_phases<1>(args, lds, bar, wave, G, bx0, vcu0, lo, hi, stop);
#undef IN
#undef SEAM
}

#ifndef MK_MODE
#define MK_MODE 1
#endif
#ifndef MK_STOP
#define MK_STOP NPHASE
#endif
extern "C" void kernel_launch(void* const* d_in, const int* in_sizes, int n_in, void* d_out, int out_size, void* d_ws, size_t ws_size, hipStream_t stream) {
    static int grid = 0;
    if (grid == 0) {
        if (n_in != 24 || out_size != MTOK * DM || ws_size < WS_END) { fprintf(stderr, "kernel_launch: unexpected shapes: n_in %d out %d ws %zu\n", n_in, out_size, ws_size); grid = -1; return; }
        int dev = 0, cus = 0, per_cu = 0;
        if (hipGetDevice(&dev) != hipSuccess || hipDeviceGetAttribute(&cus, hipDeviceAttributeMultiprocessorCount, dev) != hipSuccess) { grid = -1; return; }
        if (hipFuncSetAttribute((const void*)fwd_kernel, hipFuncAttributeMaxDynamicSharedMemorySize, LDS_BYTES) != hipSuccess) { fprintf(stderr, "kernel_launch: hipFuncSetAttribute failed\n"); grid = -1; return; }
        if (hipOccupancyMaxActiveBlocksPerMultiprocessor(&per_cu, (const void*)fwd_kernel, NWAVES * 64, LDS_BYTES) != hipSuccess || per_cu < 1)
            fprintf(stderr, "kernel_launch: occupancy query reports %d workgroups per CU\n", per_cu);
        (void)hipGetLastError();
        grid = cus;
    }
    if (grid < 0) return;
    if (hipMemsetAsync((char*)d_ws + WS_CTL, 0, CTL_ZERO_BYTES, stream) != hipSuccess) return;
    Args a{};
    for (int i = 0; i < 24; ++i) a.in[i] = (const float*)d_in[i];
    a.out = (float*)d_out; a.ws = (unsigned char*)d_ws; a.stop = MK_STOP;
#if MK_MODE == 1
    a.ph_lo = 0; a.ph_hi = NPHASE; a.li = 0;
    hipLaunchKernelGGL(fwd_kernel, dim3(grid), dim3(NWAVES * 64), LDS_BYTES, stream, a);
#else
    for (int p = 0; p < NPHASE && p < MK_STOP; ++p) {
        a.ph_lo = p; a.ph_hi = p + 1; a.li = 0;
        hipLaunchKernelGGL(fwd_kernel, dim3(grid), dim3(NWAVES * 64), LDS_BYTES, stream, a);
#ifdef MK_REP
        { const int k = p < PH_L0 ? -1 : (p - PH_L0) % PPL, L = p < PH_L0 ? -1 : (p - PH_L0) / PPL; (void)k; (void)L;
          if (MK_REP) { a.li = 1; hipLaunchKernelGGL(fwd_kernel, dim3(grid), dim3(NWAVES * 64), LDS_BYTES, stream, a); a.li = 0; } }
#endif
    }
#endif
}
```

```cpp
#include <hip/hip_runtime.h>
#include <cstdio>
#include <cstdint>
namespace pg8 {
#define PG8_LAS __attribute__((address_space(3)))
typedef unsigned short bf16_t;
typedef short bf16x8 __attribute__((ext_vector_type(8)));
typedef float f32x4 __attribute__((ext_vector_type(4)));
typedef unsigned u32x4 __attribute__((ext_vector_type(4)));
constexpr int BM = 256, BK = 64, HALF = 128, HTB = HALF * BK * 2  , STAGE_BYTES = 8 * HTB, NXCD = 8, WGM = 8;

__host__ __device__ __forceinline__ int lds_byte(int r, int c) { const int st = (r >> 4) * 2 + (c >> 5), rr = r & 15, cc = c & 31, ob = rr * 64 + cc * 2; return st * 1024 + (ob ^ (((ob >> 9) & 1) << 5)); }
__host__ __device__ __forceinline__ void stage_rc(int b, int& R, int& C) { const int st = b / 1024, sb = b % 1024, swz = sb ^ (((sb >> 9) & 1) << 5); R = (st >> 1) * 16 + swz / 64; C = (st & 1) * 32 + (swz % 64) / 2; }
__host__ __device__ __forceinline__ int perm32(int rho) { const int n = rho >> 4, i = rho & 15; return 8 * (i >> 2) + 4 * n + (i & 3); }

struct Unit { int pm, pn; };
struct Gemm { const bf16_t* A; const bf16_t* Bt; int M, N, K; };
typedef int i32x4 __attribute__((ext_vector_type(4)));
typedef int i32x8 __attribute__((ext_vector_type(8)));
__device__ __forceinline__ i32x8 cat8(bf16x8 a, bf16x8 b) { const i32x4 x = __builtin_bit_cast(i32x4, a), y = __builtin_bit_cast(i32x4, b); return __builtin_shufflevector(x, y, 0, 1, 2, 3, 4, 5, 6, 7); }

struct StaticOrder {
    int nM, nN, nwg, G, c;
    __host__ __device__ void init(int M, int N, int G_, int c_) { nM = M / BM; nN = N / BM; nwg = nM * nN; G = G_; c = c_; }
    __host__ __device__ bool next(int i, Unit& u) const {
        const long L = (long)i * G + c; if (L >= nwg) return false;
        int wgid = (int)L; { const int q = nwg / NXCD, r = nwg % NXCD, xcd = wgid % NXCD, off = wgid / NXCD; wgid = (xcd < r ? xcd * (q + 1) : r * (q + 1) + (xcd - r) * q) + off; }
        const int nig = WGM * nN, gid = wgid / nig, fm = gid * WGM, gsz = (nM - fm) < WGM ? (nM - fm) : WGM;
        u.pm = fm + ((wgid % nig) % gsz); u.pn = (wgid % nig) / gsz; return true;
    }
    __device__ __forceinline__ void a_ready(const Unit&) const {}
    __device__ __forceinline__ void done(const Unit&) const {}
};


__device__ __forceinline__ unsigned cvt_pk_bf16(float lo, float hi) { unsigned r; asm volatile("v_cvt_pk_bf16_f32 %0, %1, %2" : "=v"(r) : "v"(lo), "v"(hi)); return r; }

struct EpiF32 {
    static constexpr bool PERM = false, AFTER_DRAIN = false;
    float* C; int ldc;
    __device__ __forceinline__ void operator()(const f32x4 (&acc)[2][2][4][2], const Unit& u, int wr, int wc, int fr, int fq) const {
        const int row0 = u.pm * BM + wr * 64 + fr, col0 = u.pn * BM + wc * 32 + 4 * fq;
#pragma unroll
        for (int ai = 0; ai < 2; ++ai)
#pragma unroll
            for (int m = 0; m < 4; ++m) { float* rowp = C + (size_t)(row0 + ai * HALF + m * 16) * ldc + col0;
#pragma unroll
                for (int bj = 0; bj < 2; ++bj)
#pragma unroll
                    for (int n = 0; n < 2; ++n) *(f32x4*)(rowp + bj * HALF + n * 16) = acc[ai][bj][m][n]; }
    }
};
struct EpiBf16P {
    static constexpr bool PERM = true, AFTER_DRAIN = false;
    bf16_t* O; int ldc;
    __device__ __forceinline__ void operator()(const f32x4 (&acc)[2][2][4][2], const Unit& u, int wr, int wc, int fr, int fq) const {
        const int row0 = u.pm * BM + wr * 64 + fr, col0 = u.pn * BM + wc * 32 + 8 * fq;
#pragma unroll
        for (int ai = 0; ai < 2; ++ai)
#pragma unroll
            for (int m = 0; m < 4; ++m) { bf16_t* rowp = O + (size_t)(row0 + ai * HALF + m * 16) * ldc + col0;
#pragma unroll
                for (int bj = 0; bj < 2; ++bj) { const f32x4 v0 = acc[ai][bj][m][0], v1 = acc[ai][bj][m][1];
                    u32x4 w; w.x = cvt_pk_bf16(v0[0], v0[1]); w.y = cvt_pk_bf16(v0[2], v0[3]); w.z = cvt_pk_bf16(v1[0], v1[1]); w.w = cvt_pk_bf16(v1[2], v1[3]);
                    *(u32x4*)(rowp + bj * HALF) = w; } }
    }
};
__device__ __forceinline__ float silu_mul(float g, float u) { return g * __builtin_amdgcn_rcpf(1.0f + __builtin_amdgcn_exp2f(g * -1.4426950408889634f)) * u; }
struct EpiSwiGLU {
    static constexpr bool PERM = true, AFTER_DRAIN = false;
    bf16_t* O; int ldc;
    __device__ __forceinline__ void operator()(const f32x4 (&acc)[2][2][4][2], const Unit& u, int wr, int wc, int fr, int fq) const {
        const int row0 = u.pm * BM + wr * 64 + fr, col0 = u.pn * HALF + wc * 32 + 8 * fq;
#pragma unroll
        for (int ai = 0; ai < 2; ++ai)
#pragma unroll
            for (int m = 0; m < 4; ++m) { bf16_t* rowp = O + (size_t)(row0 + ai * HALF + m * 16) * ldc + col0;
                const f32x4 g0 = acc[ai][0][m][0], g1 = acc[ai][0][m][1], u0 = acc[ai][1][m][0], u1 = acc[ai][1][m][1];
                u32x4 w; w.x = cvt_pk_bf16(silu_mul(g0[0], u0[0]), silu_mul(g0[1], u0[1])); w.y = cvt_pk_bf16(silu_mul(g0[2], u0[2]), silu_mul(g0[3], u0[3]));
                w.z = cvt_pk_bf16(silu_mul(g1[0], u1[0]), silu_mul(g1[1], u1[1])); w.w = cvt_pk_bf16(silu_mul(g1[2], u1[2]), silu_mul(g1[3], u1[3]));
                *(u32x4*)rowp = w; }
    }
};


__device__ __forceinline__ unsigned pk4_fp8(float a, float b, float c, float d, float S) {
    a = __builtin_amdgcn_fmed3f(a * S, -448.f, 448.f); b = __builtin_amdgcn_fmed3f(b * S, -448.f, 448.f); c = __builtin_amdgcn_fmed3f(c * S, -448.f, 448.f); d = __builtin_amdgcn_fmed3f(d * S, -448.f, 448.f);
    int p = __builtin_amdgcn_cvt_pk_fp8_f32(a, b, 0, false); p = __builtin_amdgcn_cvt_pk_fp8_f32(c, d, p, true); return (unsigned)p;
}
constexpr float F8S_H = 4.f, F8S_HID = 8.f, F8S_W = 64.f;
struct EpiSwiGLU8 {
    static constexpr bool PERM = true, AFTER_DRAIN = false;
    unsigned char* O; int ldc;
    __device__ __forceinline__ static uint2 hid8(const f32x4 g0, const f32x4 g1, const f32x4 u0, const f32x4 u1) {
        constexpr float GS = 1.f / (F8S_W * F8S_H), C1 = -1.4426950408889634f * GS, C2 = GS * GS * F8S_HID;
        const f32x4 t0 = g0 * C1, t1 = g1 * C1;
        f32x4 e0, e1;
#pragma unroll
        for (int i = 0; i < 4; ++i) { e0[i] = __builtin_amdgcn_rcpf(1.0f + __builtin_amdgcn_exp2f(t0[i])); e1[i] = __builtin_amdgcn_rcpf(1.0f + __builtin_amdgcn_exp2f(t1[i])); }
        const f32x4 h0 = (g0 * e0) * (u0 * C2), h1 = (g1 * e1) * (u1 * C2);
        uint2 w; w.x = pk4_fp8(h0[0], h0[1], h0[2], h0[3], 1.f); w.y = pk4_fp8(h1[0], h1[1], h1[2], h1[3], 1.f); return w;
    }
    __device__ __forceinline__ void operator()(const f32x4 (&acc)[2][2][4][2], const Unit& u, int wr, int wc, int fr, int fq) const {
        const int row0 = u.pm * BM + wr * 64 + fr, col0 = u.pn * HALF + wc * 32 + 8 * fq, odd = fq & 1;
#pragma unroll
        for (int ai = 0; ai < 2; ++ai)
#pragma unroll
            for (int m = 0; m < 4; m += 2) {
                uint2 a = hid8(acc[ai][0][m][0], acc[ai][0][m][1], acc[ai][1][m][0], acc[ai][1][m][1]);
                uint2 b = hid8(acc[ai][0][m + 1][0], acc[ai][0][m + 1][1], acc[ai][1][m + 1][0], acc[ai][1][m + 1][1]);
                { auto r = __builtin_amdgcn_permlane16_swap(a.x, b.x, false, false); a.x = r[0]; b.x = r[1]; }
                { auto r = __builtin_amdgcn_permlane16_swap(a.y, b.y, false, false); a.y = r[0]; b.y = r[1]; }
                unsigned char* rowp = O + (size_t)(row0 + ai * HALF + (m + odd) * 16) * ldc + col0 - 8 * odd;
                *(uint4*)rowp = make_uint4(a.x, a.y, b.x, b.y); }
    }
};
struct EpiBf16PS {
    static constexpr bool PERM = true, AFTER_DRAIN = false;
    bf16_t* O; int ldc; float sc;
    __device__ __forceinline__ void operator()(const f32x4 (&acc)[2][2][4][2], const Unit& u, int wr, int wc, int fr, int fq) const {
        const int row0 = u.pm * BM + wr * 64 + fr, col0 = u.pn * BM + wc * 32 + 8 * fq;
#pragma unroll
        for (int ai = 0; ai < 2; ++ai)
#pragma unroll
            for (int m = 0; m < 4; ++m) { bf16_t* rowp = O + (size_t)(row0 + ai * HALF + m * 16) * ldc + col0;
#pragma unroll
                for (int bj = 0; bj < 2; ++bj) { const f32x4 v0 = acc[ai][bj][m][0] * sc, v1 = acc[ai][bj][m][1] * sc;
                    u32x4 w; w.x = cvt_pk_bf16(v0[0], v0[1]); w.y = cvt_pk_bf16(v0[2], v0[3]); w.z = cvt_pk_bf16(v1[0], v1[1]); w.w = cvt_pk_bf16(v1[2], v1[3]);
                    *(u32x4*)(rowp + bj * HALF) = w; } }
    }
};
struct EpiBf16PR {
    static constexpr bool PERM = true, AFTER_DRAIN = false;
    bf16_t* O; int ldc; const float* R;
    __device__ __forceinline__ void operator()(const f32x4 (&acc)[2][2][4][2], const Unit& u, int wr, int wc, int fr, int fq) const {
        const int row0 = u.pm * BM + wr * 64 + fr, col0 = u.pn * BM + wc * 32 + 8 * fq;
        float rs[2][4];
#pragma unroll
        for (int ai = 0; ai < 2; ++ai)
#pragma unroll
            for (int m = 0; m < 4; ++m) rs[ai][m] = R[row0 + ai * HALF + m * 16];
#pragma unroll
        for (int ai = 0; ai < 2; ++ai)
#pragma unroll
            for (int m = 0; m < 4; ++m) { bf16_t* rowp = O + (size_t)(row0 + ai * HALF + m * 16) * ldc + col0;
#pragma unroll
                for (int bj = 0; bj < 2; ++bj) { const f32x4 v0 = acc[ai][bj][m][0] * rs[ai][m], v1 = acc[ai][bj][m][1] * rs[ai][m];
                    u32x4 w; w.x = cvt_pk_bf16(v0[0], v0[1]); w.y = cvt_pk_bf16(v0[2], v0[3]); w.z = cvt_pk_bf16(v1[0], v1[1]); w.w = cvt_pk_bf16(v1[2], v1[3]);
                    *(u32x4*)(rowp + bj * HALF) = w; } }
    }
};
struct EpiSwiGLUR {
    static constexpr bool PERM = true, AFTER_DRAIN = false;
    bf16_t* O; int ldc; const float* R;
    __device__ __forceinline__ void operator()(const f32x4 (&acc)[2][2][4][2], const Unit& u, int wr, int wc, int fr, int fq) const {
        const int row0 = u.pm * BM + wr * 64 + fr, col0 = u.pn * HALF + wc * 32 + 8 * fq;
        float rs[2][4];
#pragma unroll
        for (int ai = 0; ai < 2; ++ai)
#pragma unroll
            for (int m = 0; m < 4; ++m) rs[ai][m] = R[row0 + ai * HALF + m * 16];
#pragma unroll
        for (int ai = 0; ai < 2; ++ai)
#pragma unroll
            for (int m = 0; m < 4; ++m) { bf16_t* rowp = O + (size_t)(row0 + ai * HALF + m * 16) * ldc + col0;
                const f32x4 g0 = acc[ai][0][m][0] * rs[ai][m], g1 = acc[ai][0][m][1] * rs[ai][m], u0 = acc[ai][1][m][0] * rs[ai][m], u1 = acc[ai][1][m][1] * rs[ai][m];
                u32x4 w; w.x = cvt_pk_bf16(silu_mul(g0[0], u0[0]), silu_mul(g0[1], u0[1])); w.y = cvt_pk_bf16(silu_mul(g0[2], u0[2]), silu_mul(g0[3], u0[3]));
                w.z = cvt_pk_bf16(silu_mul(g1[0], u1[0]), silu_mul(g1[1], u1[1])); w.w = cvt_pk_bf16(silu_mul(g1[2], u1[2]), silu_mul(g1[3], u1[3]));
                *(u32x4*)rowp = w; }
    }
};
template <class Epi, class Sched, bool ALIGN_EPI = false, bool SP2 = false, bool F8 = false>
__device__ __forceinline__ void gemm_phase(PG8_LAS unsigned char* lds, const Gemm g, const Sched& S, const Epi& E, int tid_in) {
    int tid_l = tid_in; asm volatile("" : "+v"(tid_l));
    const int tid = tid_l, wid = __builtin_amdgcn_readfirstlane(tid >> 6), lane = tid & 63, wr = wid >> 2, wc = wid & 3, fr = lane & 15, fq = lane >> 4;
    const int K = F8 ? g.K / 2 : g.K, nt = K / BK;
    unsigned voffA[2], voffB[2];
#pragma unroll
    for (int i = 0; i < 2; ++i) { int R, C; stage_rc(tid * 16 + i * 8192, R, C); const int Rb = Epi::PERM ? ((R & ~31) + perm32(R & 31)) : R;
        voffA[i] = (unsigned)(R * K + C) * 2u; voffB[i] = (unsigned)(Rb * K + C) * 2u; }
    const size_t kstep = (size_t)(BK * 2);
    const size_t hstep = (size_t)HALF * K * 2;
    const size_t tstep = 2 * hstep;
    const unsigned ldsw = (unsigned)wid * 1024u;
    const int aoff = lds_byte(wr * 64 + fr, fq * 8), boff = lds_byte(wc * 32 + fr, fq * 8);
#define PG8_SA(b, h) (((b) * 2 + (h)) * HTB)
#define PG8_SB(b, h) ((4 + (b) * 2 + (h)) * HTB)
#define PG8_STAGE(bufoff, gbase, voff) do { const char* _gb = (const char*)(gbase); if constexpr (F8) asm volatile("" : "+s"(_gb));     \
        _Pragma("unroll") for (int _i = 0; _i < 2; ++_i) \
        __builtin_amdgcn_global_load_lds((const unsigned*)(_gb + (voff)[_i]), (PG8_LAS unsigned*)(lds + (bufoff) + ldsw + _i * 8192), 16, 0, 0); } while (0)
#define PG8_LDA(dst, b, h) do { _Pragma("unroll") for (int m = 0; m < 4; ++m) _Pragma("unroll") for (int k = 0; k < 2; ++k) dst[m][k] = *(const PG8_LAS bf16x8*)(lds + PG8_SA(b, h) + aoff + m * 2048 + k * 1024); } while (0)
#define PG8_LDB(dst, b, h) do { _Pragma("unroll") for (int n = 0; n < 2; ++n) _Pragma("unroll") for (int k = 0; k < 2; ++k) dst[n][k] = *(const PG8_LAS bf16x8*)(lds + PG8_SB(b, h) + boff + n * 2048 + k * 1024); } while (0)
#define PG8_MMA(ai, bj, At, Bt) do { __builtin_amdgcn_s_setprio(1); _Pragma("unroll") for (int m = 0; m < 4; ++m) _Pragma("unroll") for (int n = 0; n < 2; ++n) _Pragma("unroll") for (int k = 0; k < 2; ++k) \
        acc[ai][bj][m][n] = __builtin_amdgcn_mfma_f32_16x16x32_bf16(Bt[n][k], At[m][k], acc[ai][bj][m][n], 0, 0, 0); __builtin_amdgcn_s_setprio(0); } while (0)
#define PG8_MMA8(ai, bj, At, Bt) do { __builtin_amdgcn_s_setprio(1); _Pragma("unroll") for (int m = 0; m < 4; ++m) _Pragma("unroll") for (int n = 0; n < 2; ++n) \
        acc[ai][bj][m][n] = __builtin_amdgcn_mfma_scale_f32_16x16x128_f8f6f4(cat8(Bt[n][0], Bt[n][1]), cat8(At[m][0], At[m][1]), acc[ai][bj][m][n], 0, 0, 0, 0, 0, 0); __builtin_amdgcn_s_setprio(0); } while (0)
#define PG8_MM(ai, bj, At, Bt) do { if constexpr (F8) PG8_MMA8(ai, bj, At, Bt); else PG8_MMA(ai, bj, At, Bt); } while (0)
#define PG8_WAIT_V(n) asm volatile("s_waitcnt vmcnt(" #n ")" ::: "memory")
#define PG8_WAIT_L(n) asm volatile("s_waitcnt lgkmcnt(" #n ")" ::: "memory")
#define PG8_BAR __builtin_amdgcn_s_barrier()
#define PG8_SCHED __builtin_amdgcn_sched_barrier(0)
    Unit cur, nxt; int ui = 0;
    if (!S.next(0, cur)) return;
    f32x4 acc[2][2][4][2];
#pragma unroll
    for (int a = 0; a < 2; ++a)
#pragma unroll
        for (int b = 0; b < 2; ++b)
#pragma unroll
            for (int m = 0; m < 4; ++m)
#pragma unroll
                for (int n = 0; n < 2; ++n) acc[a][b][m][n] = (f32x4){0.f, 0.f, 0.f, 0.f};
    bf16x8 At[4][2], B0[2][2], B1[2][2];
    const char* cA = (const char*)g.A + (size_t)cur.pm * tstep; const char* cB = (const char*)g.Bt + (size_t)cur.pn * tstep;
    S.a_ready(cur);
    if constexpr (SP2) {
        PG8_STAGE(PG8_SB(0, 0), cB, voffB); PG8_STAGE(PG8_SB(0, 1), cB + hstep, voffB); PG8_STAGE(PG8_SA(0, 0), cA, voffA); PG8_STAGE(PG8_SA(0, 1), cA + hstep, voffA);
        if (wr == 1) PG8_BAR;
        PG8_WAIT_V(2); PG8_BAR;
        PG8_STAGE(PG8_SB(1, 0), cB + kstep, voffB); PG8_STAGE(PG8_SA(1, 0), cA + kstep, voffA); PG8_STAGE(PG8_SB(1, 1), cB + hstep + kstep, voffB);
        PG8_WAIT_V(6); PG8_BAR;
    } else {
        PG8_STAGE(PG8_SB(0, 0), cB, voffB); PG8_STAGE(PG8_SA(0, 0), cA, voffA); PG8_STAGE(PG8_SB(0, 1), cB + hstep, voffB); PG8_STAGE(PG8_SA(0, 1), cA + hstep, voffA);
        if (wr == 1) PG8_BAR;
        PG8_WAIT_V(4); PG8_BAR;
        PG8_STAGE(PG8_SB(1, 0), cB + kstep, voffB); PG8_STAGE(PG8_SA(1, 0), cA + kstep, voffA); PG8_STAGE(PG8_SB(1, 1), cB + hstep + kstep, voffB);
        PG8_WAIT_V(6); PG8_BAR;
    }
    for (;;) {
        const bool has_next = S.next(ui + 1, nxt);
        const char* nA = has_next ? (const char*)g.A + (size_t)nxt.pm * tstep : cA; const char* nB = has_next ? (const char*)g.Bt + (size_t)nxt.pn * tstep : cB;
#pragma unroll 1
        for (int t = 0; t < nt; t += 2) {
            const bool last = (t == nt - 2);
            const char* a1 = cA + (size_t)(t + 1) * kstep;
            const char* a2 = last ? nA : cA + (size_t)(t + 2) * kstep; const char* b2 = last ? nB : cB + (size_t)(t + 2) * kstep;
            const char* a3 = a2 + kstep; const char* b3 = b2 + kstep;
            if (last && has_next) S.a_ready(nxt);
            if constexpr (SP2) {
            PG8_LDB(B0, 0, 0); PG8_LDB(B1, 0, 1); PG8_SCHED; PG8_LDA(At, 0, 0); PG8_STAGE(PG8_SA(1, 1), a1 + hstep, voffA);
            PG8_WAIT_V(8); PG8_WAIT_L(0); PG8_BAR; PG8_MM(0, 0, At, B0); PG8_MM(0, 1, At, B1); PG8_BAR; PG8_SCHED;
            PG8_LDA(At, 0, 1); PG8_STAGE(PG8_SB(0, 0), b2, voffB); PG8_STAGE(PG8_SB(0, 1), b2 + hstep, voffB); PG8_STAGE(PG8_SA(0, 0), a2, voffA);
            PG8_WAIT_V(8); PG8_WAIT_L(0); PG8_BAR; PG8_MM(1, 0, At, B0); PG8_MM(1, 1, At, B1); PG8_BAR; PG8_SCHED;
            PG8_LDB(B0, 1, 0); PG8_LDB(B1, 1, 1); PG8_SCHED; PG8_LDA(At, 1, 0); PG8_STAGE(PG8_SA(0, 1), a2 + hstep, voffA);
            PG8_WAIT_V(8); PG8_WAIT_L(0); PG8_BAR; PG8_MM(0, 0, At, B0); PG8_MM(0, 1, At, B1); PG8_BAR; PG8_SCHED;
            PG8_LDA(At, 1, 1); PG8_STAGE(PG8_SB(1, 0), b3, voffB); PG8_STAGE(PG8_SB(1, 1), b3 + hstep, voffB); PG8_STAGE(PG8_SA(1, 0), a3, voffA);
            PG8_WAIT_V(8); PG8_WAIT_L(0); PG8_BAR; PG8_MM(1, 0, At, B0); PG8_MM(1, 1, At, B1); PG8_BAR; PG8_SCHED;
            } else {
            PG8_LDB(B0, 0, 0); PG8_SCHED; PG8_LDA(At, 0, 0); PG8_STAGE(PG8_SA(1, 1), a1 + hstep, voffA);
            PG8_WAIT_L(8); PG8_BAR; PG8_WAIT_L(0); PG8_MM(0, 0, At, B0); PG8_BAR; PG8_SCHED;
            PG8_LDB(B1, 0, 1); PG8_STAGE(PG8_SB(0, 0), b2, voffB);
            PG8_BAR; PG8_WAIT_L(0); PG8_MM(0, 1, At, B1); PG8_BAR;
            PG8_LDA(At, 0, 1); PG8_STAGE(PG8_SA(0, 0), a2, voffA);
            PG8_BAR; PG8_WAIT_L(0); PG8_MM(1, 0, At, B0); PG8_BAR; PG8_SCHED;
            PG8_STAGE(PG8_SB(0, 1), b2 + hstep, voffB);
            PG8_WAIT_V(6); PG8_BAR; PG8_MM(1, 1, At, B1); PG8_BAR;
            PG8_LDB(B0, 1, 0); PG8_SCHED; PG8_LDA(At, 1, 0); PG8_STAGE(PG8_SA(0, 1), a2 + hstep, voffA);
            PG8_WAIT_L(8); PG8_BAR; PG8_WAIT_L(0); PG8_MM(0, 0, At, B0); PG8_BAR; PG8_SCHED;
            PG8_LDB(B1, 1, 1); PG8_STAGE(PG8_SB(1, 0), b3, voffB);
            PG8_BAR; PG8_WAIT_L(0); PG8_MM(0, 1, At, B1); PG8_BAR;
            PG8_LDA(At, 1, 1); PG8_STAGE(PG8_SA(1, 0), a3, voffA);
            PG8_BAR; PG8_WAIT_L(0); PG8_MM(1, 0, At, B0); PG8_BAR; PG8_SCHED;
            PG8_STAGE(PG8_SB(1, 1), b3 + hstep, voffB);
            PG8_WAIT_V(6); PG8_BAR; PG8_MM(1, 1, At, B1); PG8_BAR;
            }
        }
        if constexpr (ALIGN_EPI) { if (wr == 0) PG8_BAR; }
        if constexpr (!Epi::AFTER_DRAIN) {
            if constexpr (F8) { int l2; asm volatile("v_mbcnt_lo_u32_b32 %0, -1, 0\n\tv_mbcnt_hi_u32_b32 %0, -1, %0" : "=v"(l2)); E(acc, cur, wr, wc, l2 & 15, l2 >> 4); }
            else E(acc, cur, wr, wc, fr, fq);
            S.done(cur); }
        if (!has_next) break;
#pragma unroll
        for (int a = 0; a < 2; ++a)
#pragma unroll
            for (int b = 0; b < 2; ++b)
#pragma unroll
                for (int m = 0; m < 4; ++m)
#pragma unroll
                    for (int n = 0; n < 2; ++n) acc[a][b][m][n] = (f32x4){0.f, 0.f, 0.f, 0.f};
        cur = nxt; cA = nA; cB = nB; ++ui;
        if constexpr (ALIGN_EPI) { if (wr == 1) PG8_BAR; }
    }
    PG8_WAIT_V(0);
    if constexpr (!ALIGN_EPI) { if (wr == 0) PG8_BAR; }
    PG8_BAR;
    if constexpr (Epi::AFTER_DRAIN) { E.fused(acc, cur, wr, wc, fr, fq, lds, wid, lane); S.done(cur); }
#undef PG8_SA
#undef PG8_SB
#undef PG8_STAGE
#undef PG8_LDA
#undef PG8_LDB
#undef PG8_MMA
#undef PG8_MMA8
#undef PG8_MM
#undef PG8_WAIT_V
#undef PG8_WAIT_L
#undef PG8_BAR
#undef PG8_SCHED
}
}

constexpr int DM = 1024, NB = 16, SEQ = 4096, MTOK = NB * SEQ, DFF = 2816, MEML = 256, MROWS = NB * MEML;
constexpr int EV_IN = 2240, EV_INP = 2304, OD_IN = 1952, OD_INP = 2048;
constexpr float RMS_EPS = 1e-6f;
constexpr int NWAVES = 8;

constexpr size_t MiB = 1u << 20;
constexpr size_t WS_CTL = 0, CTL_ZERO_BYTES = 1 * MiB;
constexpr size_t WS_WGU = 2 * MiB;
constexpr size_t WS_WD = 46 * MiB;
constexpr size_t WS_EVIN = 68 * MiB;
constexpr size_t WS_EVOUT = 73 * MiB;
constexpr size_t WS_ODIN = 75 * MiB;
constexpr size_t WS_ODOUT = 79 * MiB;
constexpr size_t WS_WUQ = 81 * MiB;
constexpr size_t WS_WUKV = 82 * MiB;
constexpr size_t WS_XWQ = 83 * MiB;
constexpr size_t WS_XWKV = 85 * MiB;
constexpr size_t WS_XWO = 89 * MiB;
constexpr size_t WS_MN = 92 * MiB;
constexpr size_t WS_KVM = 108 * MiB;
constexpr size_t WS_VMT = 124 * MiB;
constexpr size_t WS_H = 132 * MiB;
constexpr size_t WS_Y = 260 * MiB;
constexpr size_t WS_OV = 516 * MiB;
constexpr size_t WS_END = 1024 * MiB;
constexpr size_t WS_HID = WS_OV;
constexpr size_t WS_XQ = WS_OV;

constexpr int CW_BAR = 4096;
constexpr int RING_BYTES = 131072, LDSCTL_OFF = RING_BYTES, MISC_OFF = LDSCTL_OFF + 320, LDS_BYTES = 147456;

#define GAS __attribute__((address_space(1)))
#define LAS __attribute__((address_space(3)))
typedef unsigned short bf16;
typedef unsigned v4u __attribute__((ext_vector_type(4)));
typedef unsigned v2u __attribute__((ext_vector_type(2)));
typedef float f32x4 __attribute__((ext_vector_type(4)));
typedef short bf16x8 __attribute__((ext_vector_type(8)));
#define LDS_WAIT() asm volatile("s_waitcnt lgkmcnt(0)" ::: "memory")
#define VM_WAIT() asm volatile("s_waitcnt vmcnt(0)" ::: "memory")
__device__ __forceinline__ unsigned f2bf(float f) { unsigned u = __builtin_bit_cast(unsigned, f); return (u + 0x7fffu + ((u >> 16) & 1u)) >> 16; }
__device__ __forceinline__ unsigned pk2(float lo, float hi) { return f2bf(lo) | (f2bf(hi) << 16); }
__device__ __forceinline__ float bf2f(unsigned short b) { return __builtin_bit_cast(float, (unsigned)b << 16); }
template <int K> __device__ __forceinline__ unsigned lx_u(unsigned v) {
    if constexpr (K == 32) { auto rr = __builtin_amdgcn_permlane32_swap(v, v, false, false); return rr[0] ^ rr[1] ^ v; }
    else return (unsigned)__builtin_amdgcn_ds_swizzle((int)v, (K << 10) | 0x1f);
}
template <int K> __device__ __forceinline__ float lx_f(float v) { return __uint_as_float(lx_u<K>(__float_as_uint(v))); }
__device__ __forceinline__ float wave_sum(float v) {
    v += lx_f<1>(v); v += lx_f<2>(v); v += lx_f<4>(v); v += lx_f<8>(v); v += lx_f<16>(v); v += lx_f<32>(v);
    return v;
}
__device__ __forceinline__ float fmx(float a, float b) { return __builtin_elementwise_maximum(a, b); }
__device__ __forceinline__ float fmx3(float a, float b, float c) { return __builtin_elementwise_maximum(__builtin_elementwise_maximum(a, b), c); }
__device__ __forceinline__ float fmn(float a, float b) { return __builtin_elementwise_minimum(a, b); }

#define XB_TMO      128
#define XB_XCNT(j)  (256  + 64 * (j))
#define XB_XSUB(j)  (1280 + 64 * (j))
#define XB_XGEN(j)  (2304 + 64 * (j))
#define XB_TOP      3328
#define XB_TOPGEN   3392
#define XCD_BAR_WORDS 3456
#define XB_SPIN_CAP (1u << 18)

__device__ __forceinline__ unsigned xb_ld(unsigned* p)              { return __hip_atomic_load(p, __ATOMIC_RELAXED, __HIP_MEMORY_SCOPE_AGENT); }
__device__ __forceinline__ unsigned xb_add(unsigned* p, unsigned v) { return __hip_atomic_fetch_add(p, v, __ATOMIC_RELAXED, __HIP_MEMORY_SCOPE_AGENT); }
__device__ __forceinline__ unsigned xb_xcc_id() { return (unsigned)__builtin_amdgcn_s_getreg((3 << 11) | 20) & 0xFu; }
#define XB_SPIN(cond, bar) do { unsigned _sp = 0; while (cond) { __builtin_amdgcn_s_sleep(1); \
    if ((++_sp & 255u) == 0u) { if (xb_ld(&(bar)[XB_TMO])) break; if (_sp > XB_SPIN_CAP) { atomicAdd(&(bar)[XB_TMO], 1u); break; } } } } while (0)

struct XcdBarrier {
    unsigned* bar; unsigned x;
    unsigned w0;
    volatile LAS unsigned* st;
};

__device__ __forceinline__ XcdBarrier xcd_barrier_post(unsigned* bar, volatile LAS unsigned* st) {
    XcdBarrier b; b.bar = bar; b.x = xb_xcc_id(); b.st = st; b.w0 = (unsigned)__builtin_amdgcn_readfirstlane((threadIdx.x >> 6) == 0 ? 1 : 0);
    if (threadIdx.x == 0) (void)xb_add(&bar[XB_XCNT(b.x)], 1u);
    return b;
}
__device__ __forceinline__ void xcd_barrier_complete(unsigned* bar, unsigned x, unsigned& nloc, unsigned& nx) {
    const unsigned G = gridDim.x * gridDim.y * gridDim.z;
    unsigned sum, cnt, mine, sp = 0u;
    for (;;) {
        sum = 0u; cnt = 0u; mine = 0u;
#pragma unroll
        for (unsigned j = 0; j < 16; ++j) { const unsigned c = xb_ld(&bar[XB_XCNT(j)]); sum += c; cnt += (c > 0u) ? 1u : 0u; mine = (j == x) ? c : mine; }
        if (sum == G) break;
        __builtin_amdgcn_s_sleep(1);
        if ((++sp & 255u) == 0u) { if (xb_ld(&bar[XB_TMO])) break; if (sp > XB_SPIN_CAP) { atomicAdd(&bar[XB_TMO], 1u); break; } }
    }
    nloc = mine > 0u ? mine : 1u; nx = cnt > 0u ? cnt : 1u;
}

__device__ __forceinline__ void xcd_barrier(const XcdBarrier& b) {
    asm volatile("s_waitcnt vmcnt(0)" ::: "memory");
    __syncthreads();
    unsigned xb_lane; asm volatile("v_mbcnt_lo_u32_b32 %0, -1, 0\n\tv_mbcnt_hi_u32_b32 %0, -1, %0" : "=v"(xb_lane));
    if (b.w0 != 0u && xb_lane == 0u) {
        unsigned* bar = b.bar;
        __builtin_amdgcn_s_waitcnt(0);
        unsigned nloc = b.st[0], nx = b.st[1];
        if (nloc == 0u) { xcd_barrier_complete(bar, b.x, nloc, nx); b.st[0] = nloc; b.st[1] = nx; }
        const unsigned old = xb_add(&bar[XB_XSUB(b.x)], 1u);
        const unsigned gen = old / nloc;
        if (old + 1u == (gen + 1u) * nloc) {
            __builtin_amdgcn_fence(__ATOMIC_RELEASE, "agent");
            asm volatile("s_waitcnt vmcnt(0)" ::: "memory");
            const unsigned og = xb_add(&bar[XB_TOP], 1u);
            const unsigned tg = og / nx;
            if (og + 1u == (tg + 1u) * nx) xb_add(&bar[XB_TOPGEN], 1u);
            else XB_SPIN(xb_ld(&bar[XB_TOPGEN]) == tg, bar);
            __builtin_amdgcn_fence(__ATOMIC_ACQUIRE, "agent");
            xb_add(&bar[XB_XGEN(b.x)], 1u);
            asm volatile("s_waitcnt vmcnt(0)" ::: "memory");
        } else {
            XB_SPIN(xb_ld(&bar[XB_XGEN(b.x)]) == gen, bar);
            __builtin_amdgcn_fence(__ATOMIC_ACQUIRE, "agent");
            asm volatile("s_waitcnt vmcnt(0)" ::: "memory");
        }
    }
    __syncthreads();
}


typedef float f32x16 __attribute__((ext_vector_type(16)));
typedef short s16x4 __attribute__((ext_vector_type(4)));
constexpr float NEGBIG = -1e30f, LOG2E = 1.4426950408889634f;
constexpr int KP128 = 272, KBUF_BYTES = 64 * KP128, VBUF_BYTES = 64 * KP128;
constexpr int AT_KBUF = 0, AT_VBUF = 2 * KBUF_BYTES, AT_BT = AT_VBUF + 2 * VBUF_BYTES, BT_STRIDE = 132, AT_WS = AT_BT + 20 * BT_STRIDE * 4, AT_WS_PER_WAVE = 4096;
static_assert(AT_WS + 8 * AT_WS_PER_WAVE <= RING_BYTES, "attention LDS map");
__device__ __forceinline__ int crow(int r, int hi) { return (r & 3) + 8 * (r >> 2) + 4 * hi; }
typedef float f32x2_t __attribute__((ext_vector_type(2))); typedef __bf16 bf16x2_t __attribute__((ext_vector_type(2)));
__device__ __forceinline__ unsigned cvtpk(float lo, float hi) { f32x2_t v = {lo, hi}; bf16x2_t b = __builtin_convertvector(v, bf16x2_t); return __builtin_bit_cast(unsigned, b); }
typedef float f32x8_t __attribute__((ext_vector_type(8)));
typedef float f32x2_t __attribute__((ext_vector_type(2)));
__device__ __forceinline__ float vsum32(const f32x16 (&s)[2]) {
    const f32x16 a = s[0] + s[1]; const f32x8_t b = a.lo + a.hi; const f32x4 c = b.lo + b.hi; const f32x2_t d = c.lo + c.hi; return d.x + d.y;
}
__device__ __forceinline__ float swapmax(float v) { auto rr = __builtin_amdgcn_permlane32_swap(__float_as_uint(v), __float_as_uint(v), false, false); return fmx(__uint_as_float(rr[0]), __uint_as_float(rr[1])); }
__device__ __forceinline__ float swapsum(float v) { auto rr = __builtin_amdgcn_permlane32_swap(__float_as_uint(v), __float_as_uint(v), false, false); return __uint_as_float(rr[0]) + __uint_as_float(rr[1]); }
__device__ __forceinline__ float swapget(float v) { return lx_f<32>(v); }

struct KVSrc {
    const bf16* ka; int kpa;
    const bf16* kb; int kpb;
    const bf16* v; int vp;
};
template <int DQK, int KA, int DV> struct Stage {
    static constexpr int CPR = DQK / 8, NKC = 64 * CPR, NKI = (NKC + 511) / 512, CPV = DV / 8, NVC = 64 * CPV, NVI = (NVC + 511) / 512, KP = DQK * 2 + 16, VP = DV * 2 + 16;
    v4u k[NKI]; v4u v[NVI];
    __device__ __forceinline__ void load(const KVSrc& s, int kt, int tid) {
#pragma unroll
        for (int i = 0; i < NKI; ++i) { const int c = tid + 512 * i; if (NKC % 512 == 0 || c < NKC) { const int row = c / CPR, cc = c % CPR;
            const bf16* p = (KA == DQK || cc < KA / 8) ? s.ka + (size_t)(64 * kt + row) * s.kpa + 8 * cc : s.kb + (size_t)(64 * kt + row) * s.kpb + 8 * (cc - KA / 8);
            k[i] = *(const GAS v4u*)p; } }
#pragma unroll
        for (int i = 0; i < NVI; ++i) { const int c = tid + 512 * i; if (NVC % 512 == 0 || c < NVC) { const int row = c / CPV, cc = c % CPV;
            v[i] = *(const GAS v4u*)(s.v + (size_t)(64 * kt + row) * s.vp + 8 * cc); } }
    }
    __device__ __forceinline__ void store(LAS unsigned char* lds, int buf, int tid) const {
#pragma unroll
        for (int i = 0; i < NKI; ++i) { const int c = tid + 512 * i; if (NKC % 512 == 0 || c < NKC) { const int row = c / CPR, cc = c % CPR;
            *(LAS v4u*)(lds + AT_KBUF + buf * KBUF_BYTES + row * KP + 16 * cc) = k[i]; } }
#pragma unroll
        for (int i = 0; i < NVI; ++i) { const int c = tid + 512 * i; if (NVC % 512 == 0 || c < NVC) { const int row = c / CPV, cc = c % CPV;
            *(LAS v4u*)(lds + AT_VBUF + buf * VBUF_BYTES + row * VP + 16 * cc) = v[i]; } }
    }
};
template <int DQK, int GR = 0> __device__ __forceinline__ void qk_tile(const LAS unsigned char* kbuf, const bf16x8 (&qf)[DQK / 16], f32x16 (&s)[2], int lane, const f32x16 c0 = (f32x16){}) {
    constexpr int KP = DQK * 2 + 16, ND = DQK / 16, G = GR ? GR : 2;
    const int r32 = lane & 31, hi = lane >> 5;
    s[0] = c0; s[1] = c0;
#pragma unroll
    for (int g = 0; g < ND / G; ++g) {
        bf16x8 kf[2][G];
#pragma unroll
        for (int d = 0; d < G; ++d)
#pragma unroll
            for (int st = 0; st < 2; ++st) kf[st][d] = *(const LAS bf16x8*)(kbuf + (32 * st + r32) * KP + 32 * (g * G + d) + 16 * hi);
        __builtin_amdgcn_sched_barrier(0);
#pragma unroll
        for (int d = 0; d < G; ++d)
#pragma unroll
            for (int st = 0; st < 2; ++st) s[st] = __builtin_amdgcn_mfma_f32_32x32x16_bf16(kf[st][d], qf[g * G + d], s[st], 0, 0, 0);
    }
}
__device__ __forceinline__ float softmax_tile(f32x16 (&s)[2], float& m, float& l) {
    float mx = NEGBIG;
#pragma unroll
    for (int r = 0; r < 16; ++r) mx = fmx3(mx, s[0][r], s[1][r]);
    mx = swapmax(mx);
    const float mn = fmx(m, mx), alpha = __builtin_amdgcn_exp2f(m - mn), ms = fmx(mn, -1e29f);
    m = mn; { const float nms = -ms; s[0] = s[0] + nms; s[1] = s[1] + nms; }
#pragma unroll
    for (int st = 0; st < 2; ++st)
#pragma unroll
        for (int r = 0; r < 16; ++r) s[st][r] = __builtin_amdgcn_exp2f(s[st][r]);
    const float rs = vsum32(s);
    l = l * alpha + rs;
    return alpha;
}
struct VFrag { bf16x8 f[2][4]; };
typedef short v4i16_t __attribute__((ext_vector_type(4)));
template <int VP> __device__ __forceinline__ void pv_load(const LAS unsigned char* vbuf, int dp, VFrag& v, int lane) {
    const int g = lane >> 4, q = (lane & 15) >> 2, p = lane & 3;
    const LAS unsigned char* base = vbuf + (4 * (g >> 1) + q) * VP + (16 * (g & 1) + 4 * p) * 2;
#pragma unroll
    for (int k = 0; k < 4; ++k)
#pragma unroll
        for (int d2 = 0; d2 < 2; ++d2) {
            const v4i16_t lo = __builtin_amdgcn_ds_read_tr16_b64_v4i16((LAS v4i16_t*)(base + (16 * k) * VP + 64 * (2 * dp + d2)));
            const v4i16_t hh = __builtin_amdgcn_ds_read_tr16_b64_v4i16((LAS v4i16_t*)(base + (16 * k + 8) * VP + 64 * (2 * dp + d2)));
            v.f[d2][k] = (bf16x8){lo[0], lo[1], lo[2], lo[3], hh[0], hh[1], hh[2], hh[3]}; }
}
__device__ __forceinline__ void p_pack(const f32x16 (&p)[2], bf16x8 (&pf)[4]) {
#pragma unroll
    for (int k = 0; k < 4; ++k) { const int st = k >> 1, s = k & 1; v4u w; w.x = cvtpk(p[st][8 * s + 0], p[st][8 * s + 1]); w.y = cvtpk(p[st][8 * s + 2], p[st][8 * s + 3]); w.z = cvtpk(p[st][8 * s + 4], p[st][8 * s + 5]); w.w = cvtpk(p[st][8 * s + 6], p[st][8 * s + 7]);
        pf[k] = __builtin_bit_cast(bf16x8, w); }
}
__device__ __forceinline__ void pv_mma(const VFrag& v, const bf16x8 (&pf)[4], f32x16& o0, f32x16& o1) {
#pragma unroll
    for (int k = 0; k < 4; ++k) { o0 = __builtin_amdgcn_mfma_f32_32x32x16_bf16(v.f[0][k], pf[k], o0, 0, 0, 0); o1 = __builtin_amdgcn_mfma_f32_32x32x16_bf16(v.f[1][k], pf[k], o1, 0, 0, 0); }
}
template <int DV> __device__ __forceinline__ void pv_tile(const LAS unsigned char* vbuf, const f32x16 (&p)[2], f32x16 (&o)[DV / 32], int lane) {
    bf16x8 pf[4]; p_pack(p, pf);
#pragma unroll
    for (int dp = 0; dp < DV / 64; ++dp) { VFrag v; pv_load<DV * 2 + 16>(vbuf, dp, v, lane); __builtin_amdgcn_sched_barrier(0); pv_mma(v, pf, o[2 * dp], o[2 * dp + 1]); }
}
constexpr float DEFER_THR = 8.0f;
struct SmState { float mhat, l; bool started; };
template <int DQK, int DV, class F, bool EARLYV>
__device__ __forceinline__ void attn_tile(LAS unsigned char* lds, int buf, int kt, const bf16x8 (&qf)[DQK / 16], F& f, f32x16 (&o)[DV / 32], SmState& S, f32x16& negm, int lane) {
    f32x16 s[2];
    qk_tile<DQK>(lds + AT_KBUF + buf * KBUF_BYTES, qf, s, lane, negm);
    const LAS unsigned char* vbuf = lds + AT_VBUF + buf * VBUF_BYTES;
    VFrag vfr;
    if constexpr (DV == 64 && EARLYV) { pv_load<DV * 2 + 16>(vbuf, 0, vfr, lane); __builtin_amdgcn_sched_barrier(0); }
    f.apply(s, kt);
    float mx = NEGBIG;
#pragma unroll
    for (int r = 0; r < 16; ++r) mx = fmx3(mx, s[0][r], s[1][r]);
    mx = swapmax(mx);
    const bool need = S.started ? (mx > DEFER_THR) : (mx > -1e29f);
    if (__any(need)) {
        const float delta = need ? mx : 0.f, fac = (need && S.started) ? __builtin_amdgcn_exp2f(-delta) : 1.f;
        S.mhat += delta; S.l *= fac; S.started = S.started || need;
#pragma unroll
        for (int st = 0; st < 2; ++st)
#pragma unroll
            for (int r = 0; r < 16; ++r) s[st][r] -= delta;
#pragma unroll
        for (int dt = 0; dt < DV / 32; ++dt) o[dt] = o[dt] * fac;
#pragma unroll
        for (int r = 0; r < 16; ++r) negm[r] = -S.mhat;
    }
#pragma unroll
    for (int st = 0; st < 2; ++st)
#pragma unroll
        for (int r = 0; r < 16; ++r) s[st][r] = __builtin_amdgcn_exp2f(s[st][r]);
    S.l += vsum32(s);
    bf16x8 pf[4]; p_pack(s, pf);
#pragma unroll
    for (int dp = 0; dp < DV / 64; ++dp) {
        if constexpr (!(DV == 64 && EARLYV)) { pv_load<DV * 2 + 16>(vbuf, dp, vfr, lane); __builtin_amdgcn_sched_barrier(0); }
        pv_mma(vfr, pf, o[2 * dp], o[2 * dp + 1]);
    }
}
template <int DQK, int KA, int DV, class F, bool EARLYV = true, bool DEEP = false>
__device__ __forceinline__ void attn_loop(LAS unsigned char* lds, const KVSrc& kv, int kt0, int kt1, const bf16x8 (&qf)[DQK / 16], F& f, f32x16 (&o)[DV / 32], SmState& S, int tid, int lane) {
    if (kt0 >= kt1) return;
    Stage<DQK, KA, DV> sg0;
    __syncthreads();
    sg0.load(kv, kt0, tid); sg0.store(lds, 0, tid);
    f32x16 negm;
#pragma unroll
    for (int r = 0; r < 16; ++r) negm[r] = -S.mhat;
    if constexpr (DEEP) {
        Stage<DQK, KA, DV> sg1;
        if (kt0 + 1 < kt1) sg1.load(kv, kt0 + 1, tid);
        __syncthreads();
        for (int kt = kt0; kt < kt1; kt += 2) {
            if (kt + 2 < kt1) { sg0.load(kv, kt + 2, tid); f.pre(kt + 2); }
            if (!f.skip(kt)) attn_tile<DQK, DV, F, EARLYV>(lds, 0, kt, qf, f, o, S, negm, lane);
            if (kt + 1 < kt1) sg1.store(lds, 1, tid);
            __syncthreads();
            if (kt + 1 < kt1) {
                if (kt + 3 < kt1) { sg1.load(kv, kt + 3, tid); f.pre(kt + 3); }
                if (!f.skip(kt + 1)) attn_tile<DQK, DV, F, EARLYV>(lds, 1, kt + 1, qf, f, o, S, negm, lane);
                if (kt + 2 < kt1) sg0.store(lds, 0, tid);
                __syncthreads();
            }
        }
    } else {
        __syncthreads();
        for (int kt = kt0; kt < kt1; ++kt) {
            const int buf = (kt - kt0) & 1;
            if (kt + 1 < kt1) { sg0.load(kv, kt + 1, tid); f.pre(kt + 1); }
            if (!f.skip(kt)) attn_tile<DQK, DV, F, EARLYV>(lds, buf, kt, qf, f, o, S, negm, lane);
            if (kt + 1 < kt1) sg0.store(lds, buf ^ 1, tid);
            __syncthreads();
        }
    }
}
__device__ __forceinline__ void build_bias_tables(LAS unsigned char* lds, const float* tab, int tid) {
    LAS float* BT = (LAS float*)(lds + AT_BT);
    for (int i = tid; i < 20 * 129; i += NWAVES * 64) { const int h = i / 129, d = i % 129;
        int b = d; if (d >= 16) { b = 16 + (int)(__log2f((float)d * 0.0625f) * (16.0f / 3.0f)); b = b > 31 ? 31 : b; }
        BT[h * BT_STRIDE + d] = (tab[b * 20 + h] - tab[31 * 20 + h]) * LOG2E; }
}
__device__ __forceinline__ void swap_pair(v2u& a, v2u& b) {
    { auto r = __builtin_amdgcn_permlane32_swap(a.x, b.x, false, false); a.x = r[0]; b.x = r[1]; }
    { auto r = __builtin_amdgcn_permlane32_swap(a.y, b.y, false, false); a.y = r[0]; b.y = r[1]; }
}
template <int DV> __device__ __forceinline__ void store_ot(bf16* orow, const f32x16 (&o)[DV / 32], float scale, int lane) {
    const int hi = lane >> 5;
    bf16* dst = orow + 8 * hi;
#pragma unroll
    for (int dt = 0; dt < DV / 32; ++dt)
#pragma unroll
        for (int r4 = 0; r4 < 4; r4 += 2) {
            v2u a, b;
            a.x = cvtpk(o[dt][4 * r4 + 0] * scale, o[dt][4 * r4 + 1] * scale); a.y = cvtpk(o[dt][4 * r4 + 2] * scale, o[dt][4 * r4 + 3] * scale);
            b.x = cvtpk(o[dt][4 * r4 + 4] * scale, o[dt][4 * r4 + 5] * scale); b.y = cvtpk(o[dt][4 * r4 + 6] * scale, o[dt][4 * r4 + 7] * scale);
            swap_pair(a, b);
            *(GAS v4u*)(dst + 32 * dt + 8 * r4) = (v4u){a.x, a.y, b.x, b.y}; }
}
template <int DQK> __device__ __forceinline__ void load_q(const bf16* qrow, bf16x8 (&qf)[DQK / 16], int lane) {
    const int hi = lane >> 5;
#pragma unroll
    for (int d0 = 0; d0 < DQK / 16; ++d0) qf[d0] = *(const GAS bf16x8*)(qrow + 16 * d0 + 8 * hi);
}
__device__ __forceinline__ bf16x8 scale_frag(bf16x8 a, float sc) {
    v4u w;
    w.x = cvtpk(bf2f((unsigned short)a[0]) * sc, bf2f((unsigned short)a[1]) * sc); w.y = cvtpk(bf2f((unsigned short)a[2]) * sc, bf2f((unsigned short)a[3]) * sc);
    w.z = cvtpk(bf2f((unsigned short)a[4]) * sc, bf2f((unsigned short)a[5]) * sc); w.w = cvtpk(bf2f((unsigned short)a[6]) * sc, bf2f((unsigned short)a[7]) * sc);
    return __builtin_bit_cast(bf16x8, w);
}
template <int DQK> __device__ __forceinline__ void load_q_scaled(const bf16* qrow, bf16x8 (&qf)[DQK / 16], float sc, int lane) {
    load_q<DQK>(qrow, qf, lane);
#pragma unroll
    for (int d0 = 0; d0 < DQK / 16; ++d0) qf[d0] = scale_frag(qf[d0], sc);
}

struct FPlain { __device__ __forceinline__ void pre(int) {} __device__ __forceinline__ bool skip(int) const { return false; }
    __device__ __forceinline__ void apply(f32x16 (&)[2], int) {} };
__device__ __forceinline__ void xattn_unit(LAS unsigned char* lds, const bf16* XQ, const bf16* KVM, bf16* O, int b, int h, int qt, int tid_in, int lane_in, int wave) {
    int lane = lane_in; asm volatile("" : "+v"(lane)); const int tid = wave * 64 + lane; (void)tid_in;
    const int t = qt * 256 + wave * 32 + (lane & 31);
    bf16x8 qf[8]; load_q_scaled<128>(XQ + (size_t)(b * SEQ + t) * 512 + h * 128, qf, 0.08838834764831845f * LOG2E, lane);
    KVSrc kv{KVM + (size_t)(b * MEML) * DM + h * 128, DM, nullptr, 0, KVM + (size_t)(b * MEML) * DM + 512 + h * 128, DM};
    f32x16 o[4] = {}; SmState S{0.f, 0.f, false};
    FPlain f;
    attn_loop<128, 128, 128, FPlain>(lds, kv, 0, MEML / 64, qf, f, o, S, tid, lane);
    const float lt = swapsum(S.l);
    store_ot<128>(O + (size_t)(b * SEQ + t) * 512 + h * 128, o, lt > 0.f ? 1.f / lt : 0.f, lane);
}


constexpr int C_QA = 0, C_KVA = 512, C_GA = 1280, C_QB = 1304, C_KB = 1816, C_VB = 1880, C_IQ = 1944, C_IK = 2200, C_IW = 2232;
constexpr size_t WS_CWT = 91 * MiB;
constexpr size_t WS_CBIAS = 91 * MiB + 512 * 1024;
constexpr size_t WS_P0 = WS_OV, WS_KCMP = WS_OV + 288 * MiB, WS_VCMP = WS_OV + 289 * MiB, WS_SEL = WS_OV + 330 * MiB;
static_assert(WS_SEL + 32 * MiB <= WS_END, "even overlay");

__device__ __forceinline__ void nsa_compress_item(const bf16* P0, const bf16* CWT, const float* CBIAS, bf16* KCMP, bf16* VCMP, int item, int lane) {
    const int nt = item & 7, g = (item >> 3) & 1, b = (item >> 4) & 15, c = item >> 8;
    const int r32 = lane & 31, hi = lane >> 5, n = nt * 32 + r32, nc = n > 254 ? 254 : n;
    const bf16* ap = P0 + (size_t)(b * SEQ + 16 * nc) * EV_INP + C_KVA + c * 128 + g * 64 + 8 * hi;
    const bf16* bp = CWT + (size_t)(c * 64 + r32) * 2048 + 8 * hi;
    f32x16 acc[2] = {};
#pragma unroll 4
    for (int kk = 0; kk < 128; ++kk) {
        const bf16x8 a = *(const GAS bf16x8*)(ap + (size_t)(kk >> 2) * EV_INP + (kk & 3) * 16);
        const bf16x8 b0 = *(const GAS bf16x8*)(bp + kk * 16), b1 = *(const GAS bf16x8*)(bp + 32 * 2048 + kk * 16);
        acc[0] = __builtin_amdgcn_mfma_f32_32x32x16_bf16(a, b0, acc[0], 0, 0, 0);
        acc[1] = __builtin_amdgcn_mfma_f32_32x32x16_bf16(a, b1, acc[1], 0, 0, 0);
    }
#pragma unroll
    for (int eh = 0; eh < 2; ++eh) { const int e = 32 * eh + r32; const float bias = CBIAS[c * 64 + e];
        bf16* dst = c == 0 ? KCMP : VCMP;
#pragma unroll
        for (int r = 0; r < 16; ++r) { const int nn = nt * 32 + crow(r, hi); dst[((size_t)(b * 2 + g) * 256 + nn) * 64 + e] = (bf16)(nn > 254 ? 0u : f2bf(acc[eh][r] + bias)); }
    }
}

__device__ __forceinline__ void nsa_compress_pair(LAS unsigned char* lds, const bf16* P0, const bf16* CWT, const float* CBIAS, bf16* KCMP, bf16* VCMP, int it0, int wave, int lane) {
    const int item = it0 + (wave >> 2), ks = wave & 3; const bool live = item < 512;
    const int nt = item & 7, g = (item >> 3) & 1, b = (item >> 4) & 15, c = (item >> 8) & 1;
    const int r32 = lane & 31, hi = lane >> 5, n = nt * 32 + r32, nc = n > 254 ? 254 : n;
    const bf16* ap = P0 + (size_t)(b * SEQ + 16 * nc) * EV_INP + C_KVA + c * 128 + g * 64 + 8 * hi;
    const bf16* bp = CWT + (size_t)(c * 64 + r32) * 2048 + 8 * hi;
    f32x16 acc[2] = {};
    if (live) {
#pragma unroll 8
        for (int kk = 32 * ks; kk < 32 * ks + 32; ++kk) {
            const bf16x8 a = *(const GAS bf16x8*)(ap + (size_t)(kk >> 2) * EV_INP + (kk & 3) * 16);
            const bf16x8 b0 = *(const GAS bf16x8*)(bp + kk * 16), b1 = *(const GAS bf16x8*)(bp + 32 * 2048 + kk * 16);
            acc[0] = __builtin_amdgcn_mfma_f32_32x32x16_bf16(a, b0, acc[0], 0, 0, 0);
            acc[1] = __builtin_amdgcn_mfma_f32_32x32x16_bf16(a, b1, acc[1], 0, 0, 0);
        }
    }
    LAS float* red = (LAS float*)lds + (wave >> 2) * 3 * 2048 + lane;
    if (ks) {
#pragma unroll
        for (int eh = 0; eh < 2; ++eh)
#pragma unroll
            for (int r = 0; r < 16; ++r) red[(ks - 1) * 2048 + (eh * 16 + r) * 64] = acc[eh][r];
    }
    __syncthreads();
    if (!ks && live) {
#pragma unroll
        for (int j = 0; j < 3; ++j)
#pragma unroll
            for (int eh = 0; eh < 2; ++eh)
#pragma unroll
                for (int r = 0; r < 16; ++r) acc[eh][r] += red[j * 2048 + (eh * 16 + r) * 64];
#pragma unroll
        for (int eh = 0; eh < 2; ++eh) { const int e = 32 * eh + r32; const float bias = CBIAS[c * 64 + e];
            bf16* dst = c == 0 ? KCMP : VCMP;
#pragma unroll
            for (int r = 0; r < 16; ++r) { const int nn = nt * 32 + crow(r, hi); dst[((size_t)(b * 2 + g) * 256 + nn) * 64 + e] = (bf16)(nn > 254 ? 0u : f2bf(acc[eh][r] + bias)); }
        }
    }
    __syncthreads();
}

constexpr int IX_MASK = 0, IX_RED = 8192, IX_CNT = IX_RED + 1024, IX_NC = IX_CNT + 1024, IX_CAND = IX_NC + 64, IX_THR = IX_CAND + 8192, IX_LIST = IX_THR + 128;
__device__ __forceinline__ unsigned f2ord(float f) { const unsigned b = __float_as_uint(f); return b ^ ((unsigned)((int)b >> 31) | 0x80000000u); }
__device__ __forceinline__ float ord2f(unsigned u) { return __uint_as_float(u ^ ((u >> 31) ? 0x80000000u : 0xffffffffu)); }
__device__ __forceinline__ void dsa_index_unit(LAS unsigned char* lds, const bf16* P0, unsigned short* SEL, int b, int qt, int tid_in, int lane_in, int wave) {
    int lane = lane_in; asm volatile("" : "+v"(lane)); const int tid = wave * 64 + lane; (void)tid_in;
    const int q = lane & 15, g4 = lane >> 4, t0 = 16 * qt, t = t0 + q, nkt = qt + 1;
    const int ni = nkt > wave ? (nkt - wave + 7) >> 3 : 0, nc4 = (ni + 3) >> 2;
    const bf16* base = P0 + (size_t)(b * SEQ) * EV_INP;
    bf16x8 bq[8]; float w[8];
#pragma unroll
    for (int h = 0; h < 8; ++h) { bq[h] = *(const GAS bf16x8*)(base + (size_t)t * EV_INP + C_IQ + h * 32 + 8 * g4); w[h] = bf2f(base[(size_t)t * EV_INP + C_IW + h]); }
    typedef float f32x4v __attribute__((ext_vector_type(4)));
    const bf16* kbase = base + (size_t)(16 * wave + q) * EV_INP + C_IK + 8 * g4;
    float sc[32][4];
    const float NINF = -__builtin_inff();
#pragma unroll
    for (int g = 0; g < 8; ++g) {
        if (32 * g + wave < nkt) {
            bf16x8 ab[4];
#pragma unroll
            for (int j = 0; j < 4; ++j) if (8 * (4 * g + j) + wave < nkt) { const bf16* kp = kbase; asm volatile("" : "+v"(kp));
                ab[j] = *(const GAS bf16x8*)(kp + (size_t)(4 * g + j) * (128 * EV_INP)); }
            asm volatile("s_waitcnt vmcnt(0)" ::: "memory");
#pragma unroll
            for (int j = 0; j < 4; ++j) {
                const int i = 4 * g + j, kt = 8 * i + wave;
                if (kt < nkt) {
                    const bf16x8 a = ab[j];
                    float a4[4] = {0.f, 0.f, 0.f, 0.f};
#pragma unroll
                    for (int h = 0; h < 8; ++h) { const f32x4v c = __builtin_amdgcn_mfma_f32_16x16x32_bf16(a, bq[h], (f32x4v){0.f, 0.f, 0.f, 0.f}, 0, 0, 0);
#pragma unroll
                        for (int r = 0; r < 4; ++r) a4[r] += w[h] * fmx(c[r], 0.f); }
#pragma unroll
                    for (int r = 0; r < 4; ++r) sc[i][r] = (kt < qt || 4 * g4 + r <= q) ? a4[r] : NINF;
                } else {
#pragma unroll
                    for (int r = 0; r < 4; ++r) sc[i][r] = NINF;
                }
            }
        } else {
#pragma unroll
            for (int j = 0; j < 4; ++j)
#pragma unroll
                for (int r = 0; r < 4; ++r) sc[4 * g + j][r] = NINF;
        }
    }
    LAS float* RED = (LAS float*)(lds + IX_RED); LAS unsigned* CNT = (LAS unsigned*)(lds + IX_CNT); LAS unsigned* MK = (LAS unsigned*)(lds + IX_MASK);
    LAS unsigned* NC = (LAS unsigned*)(lds + IX_NC); LAS unsigned long long* CAND = (LAS unsigned long long*)(lds + IX_CAND); LAS unsigned long long* THR = (LAS unsigned long long*)(lds + IX_THR);
    float lmax = NINF, lmin = __builtin_inff();
#pragma unroll
    for (int c = 0; c < 8; ++c) if (c < nc4) {
#pragma unroll
        for (int j = 0; j < 4; ++j)
#pragma unroll
            for (int r = 0; r < 4; ++r) { const float v = sc[4 * c + j][r]; lmax = fmx(lmax, v); lmin = fmn(lmin, v == NINF ? __builtin_inff() : v); }
    }
    lmax = fmx(lmax, lx_f<16>(lmax)); lmax = fmx(lmax, lx_f<32>(lmax));
    lmin = fmn(lmin, lx_f<16>(lmin)); lmin = fmn(lmin, lx_f<32>(lmin));
    __syncthreads();
    if (g4 == 0) { RED[wave * 16 + q] = lmax; RED[128 + wave * 16 + q] = lmin; }
    for (int i = tid; i < 2048; i += NWAVES * 64) MK[i] = 0u;
    if (tid < 16) NC[tid] = 0u;
    __syncthreads();
    float hiv = NINF, lov = __builtin_inff();
#pragma unroll
    for (int wv = 0; wv < 8; ++wv) { hiv = fmx(hiv, RED[wv * 16 + q]); lov = fmn(lov, RED[128 + wv * 16 + q]); }
    lov = lov - fabsf(lov) * 1e-3f - 1e-6f;
    unsigned clo = (unsigned)(t + 1), chi = 0u;
    bool done = (t + 1 <= 256), fine = false; float thr = NINF; unsigned thk = 0u;
    for (int it = 0; it < 64; ++it) {
        const float mid = 0.5f * (lov + hiv);
        unsigned cnt = 0;
#pragma unroll
        for (int c = 0; c < 8; ++c) if (c < nc4) {
#pragma unroll
            for (int j = 0; j < 4; ++j)
#pragma unroll
                for (int r = 0; r < 4; ++r) cnt += (sc[4 * c + j][r] > mid) ? 1u : 0u;
        }
        cnt += lx_u<16>(cnt); cnt += lx_u<32>(cnt);
        LAS unsigned* cb = CNT + (it & 1) * 128;
        if (g4 == 0) cb[wave * 16 + q] = cnt;
        __syncthreads();
        unsigned tot = 0;
#pragma unroll
        for (int wv = 0; wv < 8; ++wv) tot += cb[wv * 16 + q];
        if (!done && !fine) {
            if (tot == 256u) { thr = mid; done = true; }
            else if (!(mid > lov && mid < hiv)) { thr = lov; done = true; }
            else { if (tot > 256u) { lov = mid; clo = tot; } else { hiv = mid; chi = tot; }
                   if (clo - chi <= 64u) fine = true; }
        }
        if (__all(done || fine)) break;
    }
    const unsigned kinv0 = (unsigned)(4095 - (16 * wave + 4 * g4));
    if (fine) {
#pragma unroll
        for (int c = 0; c < 8; ++c) if (c < nc4) {
#pragma unroll
            for (int j = 0; j < 4; ++j)
#pragma unroll
                for (int r = 0; r < 4; ++r) { const float v = sc[4 * c + j][r];
                    if (v > lov && v <= hiv) { const unsigned pos = __hip_atomic_fetch_add(NC + q, 1u, __ATOMIC_RELAXED, __HIP_MEMORY_SCOPE_WORKGROUP);
                        if (pos < 64u) CAND[q * 64 + pos] = ((unsigned long long)f2ord(v) << 32) | (kinv0 - (unsigned)(128 * (4 * c + j) + r)); } }
        }
    }
    __syncthreads();
#pragma unroll 1
    for (int k = 0; k < 2; ++k) {
        const int qq = 2 * wave + k;
        const int fq = __builtin_amdgcn_readlane((int)fine, qq), need = __builtin_amdgcn_readlane((int)(256u - chi), qq);
        if (fq) {
            const unsigned n = NC[qq]; const unsigned long long comp = (unsigned)lane < n ? CAND[qq * 64 + lane] : 0ull;
            const unsigned c_lo = (unsigned)comp, c_hi = (unsigned)(comp >> 32);
            int rank = 0;
#pragma unroll
            for (int jj = 0; jj < 64; ++jj) { const unsigned long long c2 = ((unsigned long long)(unsigned)__builtin_amdgcn_readlane((int)c_hi, jj) << 32) | (unsigned)__builtin_amdgcn_readlane((int)c_lo, jj); rank += (c2 > comp) ? 1 : 0; }
            if (rank == need - 1) THR[qq] = comp;
        }
    }
    __syncthreads();
    if (fine) { const unsigned long long t64 = THR[q]; thr = ord2f((unsigned)(t64 >> 32)); thk = (unsigned)t64; }
    LAS unsigned* mkw = MK + q * 128 + (wave >> 1); const int mksh = 16 * (wave & 1) + 4 * g4;
#pragma unroll
    for (int c = 0; c < 8; ++c) if (c < nc4) {
#pragma unroll
        for (int j = 0; j < 4; ++j) { const int i = 4 * c + j;
            unsigned nib = 0;
#pragma unroll
            for (int r = 0; r < 4; ++r) { const float v = sc[i][r]; nib |= (v > thr || (fine && v == thr && kinv0 - (unsigned)(128 * i + r) >= thk)) ? (1u << r) : 0u; }
            if (nib) __hip_atomic_fetch_or(mkw + 4 * i, nib << mksh, __ATOMIC_RELAXED, __HIP_MEMORY_SCOPE_WORKGROUP); }
    }
    __syncthreads();
    LAS unsigned short* LST = (LAS unsigned short*)(lds + IX_LIST);
#pragma unroll 1
    for (int k = 0; k < 2; ++k) {
        const int qq = 2 * wave + k;
        unsigned long long wd = *(const LAS unsigned long long*)(lds + IX_MASK + (qq * 64 + lane) * 8);
        const int c = __popcll(wd); int incl = c;
#pragma unroll
        for (int d = 1; d < 64; d <<= 1) { const int n = __builtin_amdgcn_ds_bpermute((lane - d) << 2, incl); if (lane >= d) incl += n; }
        int pos = incl - c; const int total = __builtin_amdgcn_readlane(incl, 63);
        while (wd) { const int bbit = __builtin_ctzll(wd); if (pos < 256) LST[qq * 256 + pos] = (unsigned short)(64 * lane + bbit); ++pos; wd &= wd - 1; }
        for (int p = total + lane; p < 256; p += 64) LST[qq * 256 + p] = (unsigned short)0xffffu;
    }
    __syncthreads();
    { const v4u v = *(const LAS v4u*)(lds + IX_LIST + tid * 16);
      *(GAS v4u*)((unsigned char*)(SEL + (size_t)(b * SEQ + t0) * 256) + tid * 16) = v; }
}

struct FSel {
    unsigned long long selmask; int t, cur, hi; const LAS float* BT;
    __device__ __forceinline__ void pre(int) {}
    __device__ __forceinline__ bool skip(int kt) const { return !__any((int)((selmask >> kt) & 1ull)); }
    __device__ __forceinline__ void apply(f32x16 (&s)[2], int kt) {
        const bool on = (selmask >> kt) & 1ull;
        if (kt + 3 <= cur) {
            if (!__all((int)on)) {
#pragma unroll
                for (int st = 0; st < 2; ++st)
#pragma unroll
                    for (int r = 0; r < 16; ++r) s[st][r] = on ? s[st][r] : NEGBIG; }
        } else {
#pragma unroll
            for (int st = 0; st < 2; ++st)
#pragma unroll
                for (int r = 0; r < 16; ++r) { const int dist = t - (64 * kt + 32 * st + crow(r, hi)); const unsigned di = (unsigned)dist < 128u ? (unsigned)dist : 128u;
                    s[st][r] = (on && dist >= 0) ? s[st][r] + BT[di] : NEGBIG; }
        }
    }
};
struct FWin {
    int t, cur, hi; const LAS float* BT;
    __device__ __forceinline__ void pre(int) {}
    __device__ __forceinline__ bool skip(int) const { return false; }
    __device__ __forceinline__ void apply(f32x16 (&s)[2], int kt) {
        const int dk = cur - kt;
        if (!(dk >= 3 && dk <= 7)) {
#pragma unroll
            for (int st = 0; st < 2; ++st)
#pragma unroll
                for (int r = 0; r < 16; ++r) { const int dist = t - (64 * kt + 32 * st + crow(r, hi)); const unsigned di = (unsigned)dist < 128u ? (unsigned)dist : 128u;
                    s[st][r] = (dist >= 0 && dist < 512) ? s[st][r] + BT[di] : NEGBIG; }
        }
    }
};
__device__ __forceinline__ float sigmoidf_(float x) { return __builtin_amdgcn_rcpf(1.0f + __builtin_amdgcn_exp2f(-x * LOG2E)); }

__device__ __forceinline__ void nsa_unit(LAS unsigned char* lds, const bf16* P0, const bf16* KCMP, const bf16* VCMP, bf16* OC, int b, int g, int qt, int tid_in, int lane_in, int wave) {
    int lane = lane_in; asm volatile("" : "+v"(lane)); const int tid = wave * 64 + lane; (void)tid_in;
    const int r32 = lane & 31, hi = lane >> 5, qi = r32 >> 2, hh = r32 & 3, head = g * 4 + hh;
    const int t0 = qt * 64, t = t0 + wave * 8 + qi, cur = qt;
    const bf16* prow = P0 + (size_t)(b * SEQ + t) * EV_INP;
    bf16x8 qf[4]; load_q_scaled<64>(prow + C_QA + head * 64, qf, 0.125f * LOG2E, lane);
    const LAS float* BT = (const LAS float*)(lds + AT_BT) + head * BT_STRIDE;
    const float g0 = sigmoidf_(bf2f(prow[C_GA + g * 12 + hh * 3 + 0])), g1 = sigmoidf_(bf2f(prow[C_GA + g * 12 + hh * 3 + 1])), g2 = sigmoidf_(bf2f(prow[C_GA + g * 12 + hh * 3 + 2]));
    LAS float* impL = (LAS float*)(lds + AT_WS + wave * AT_WS_PER_WAVE);
    LAS unsigned long long* selL = (LAS unsigned long long*)(lds + AT_WS + wave * AT_WS_PER_WAVE + 2048);
    f32x16 oacc[2];
    {
        f32x16 o[2] = {}; float m = NEGBIG, l = 0.f, carry = 0.f;
        float imp[32];
#pragma unroll
        for (int i = 0; i < 32; ++i) imp[i] = 0.f;
        const int ncv = (t0 + 63 >= 31) ? ((t0 + 63 - 31) >> 4) + 1 : 0;
        const int nkt = ncv >= 256 ? 4 : (ncv + 63) >> 6;
        KVSrc kv{KCMP + (size_t)((b * 2 + g) * 256) * 64, 64, nullptr, 0, VCMP + (size_t)((b * 2 + g) * 256) * 64, 64};
        Stage<64, 64, 64> sg;
        __syncthreads();
        if (nkt > 0) { sg.load(kv, 0, tid); sg.store(lds, 0, tid); }
        __syncthreads();
#pragma unroll
        for (int kt = 0; kt < 4; ++kt) {
            if (kt < nkt) {
                const int buf = kt & 1;
                if (kt + 1 < nkt) sg.load(kv, kt + 1, tid);
                f32x16 s[2];
                qk_tile<64, 2>(lds + AT_KBUF + buf * KBUF_BYTES, qf, s, lane);
#pragma unroll
                for (int st = 0; st < 2; ++st)
#pragma unroll
                    for (int r = 0; r < 16; ++r) { const int dist = t - (16 * (64 * kt + 32 * st + crow(r, hi)) + 31); const unsigned di = (unsigned)dist < 128u ? (unsigned)dist : 128u;
                        s[st][r] = dist >= 0 ? s[st][r] + BT[di] : NEGBIG; }
                const float alpha = softmax_tile(s, m, l);
                o[0] = o[0] * alpha; o[1] = o[1] * alpha; carry *= alpha;
#pragma unroll
                for (int i = 0; i < kt * 8; ++i) imp[i] *= alpha;
                pv_tile<64>(lds + AT_VBUF + buf * VBUF_BYTES, s, o, lane);
                float G[2][4], ol[2][4];
#pragma unroll
                for (int st = 0; st < 2; ++st)
#pragma unroll
                    for (int q4 = 0; q4 < 4; ++q4) { G[st][q4] = (s[st][4 * q4] + s[st][4 * q4 + 1]) + (s[st][4 * q4 + 2] + s[st][4 * q4 + 3]); ol[st][q4] = swapget(s[st][4 * q4 + 3]); }
#pragma unroll
                for (int st = 0; st < 2; ++st)
#pragma unroll
                    for (int q4 = 0; q4 < 4; ++q4) { const float prev = q4 > 0 ? ol[st][q4 - 1] : (st == 1 ? ol[0][3] : carry);
                        imp[kt * 8 + st * 4 + q4] = G[st][q4] + (hi ? ol[st][q4] : prev); }
                carry = ol[1][3];
                if (kt + 1 < nkt) sg.store(lds, buf ^ 1, tid);
                __syncthreads();
            }
        }
        const float lt = swapsum(l), inv = lt > 0.f ? 1.f / lt : 0.f;
        oacc[0] = o[0] * (inv * g0); oacc[1] = o[1] * (inv * g0);
#pragma unroll
        for (int i = 0; i < 32; ++i) { float v = imp[i] * inv; v += lx_f<1>(v); v += lx_f<2>(v);
            if (hh == 0) impL[qi * 64 + 16 * (i >> 3) + 8 * ((i >> 2) & 1) + 2 * (i & 3) + hi] = v; }
    }
    LDS_WAIT(); asm volatile("" ::: "memory");
#pragma unroll 1
    for (int q2 = 0; q2 < 8; ++q2) {
        const int j = lane; const bool valid = j <= cur, forced = (j == 0) || (j == cur) || (j == cur - 1);
        const float val = impL[q2 * 64 + j] + (forced ? 1000.f : 0.f);
        const unsigned long long comp = ((unsigned long long)(valid ? __float_as_uint(val) + 1u : 0u) << 6) | (unsigned long long)(63 - j);
        const unsigned clo = (unsigned)comp, chi = (unsigned)(comp >> 32);
        int rank = 0;
#pragma unroll
        for (int jj = 0; jj < 64; ++jj) { const unsigned long long c2 = ((unsigned long long)(unsigned)__builtin_amdgcn_readlane((int)chi, jj) << 32) | (unsigned)__builtin_amdgcn_readlane((int)clo, jj); rank += (c2 > comp) ? 1 : 0; }
        const unsigned long long mk = __ballot(valid && rank < 16);
        if (lane == 0) selL[q2] = mk;
    }
    LDS_WAIT(); asm volatile("" ::: "memory");
    const unsigned long long selmask = selL[qi];
    {
        f32x16 o[2] = {}; SmState S{0.f, 0.f, false};
        KVSrc kv{P0 + (size_t)(b * SEQ) * EV_INP + C_KVA + 2 * 128 + g * 64, EV_INP, nullptr, 0, P0 + (size_t)(b * SEQ) * EV_INP + C_KVA + 3 * 128 + g * 64, EV_INP};
        FSel f{selmask, t, cur, hi, BT};
        int tid2 = tid; asm volatile("" : "+v"(tid2));
        attn_loop<64, 64, 64, FSel, false>(lds, kv, 0, cur + 1, qf, f, o, S, tid2, lane);
        const float lt = swapsum(S.l), inv = lt > 0.f ? 1.f / lt : 0.f;
        oacc[0] = oacc[0] + o[0] * (inv * g1); oacc[1] = oacc[1] + o[1] * (inv * g1);
    }
    {
        f32x16 o[2] = {}; SmState S{0.f, 0.f, false};
        KVSrc kv{P0 + (size_t)(b * SEQ) * EV_INP + C_KVA + 4 * 128 + g * 64, EV_INP, nullptr, 0, P0 + (size_t)(b * SEQ) * EV_INP + C_KVA + 5 * 128 + g * 64, EV_INP};
        FWin f{t, cur, hi, BT};
        int tid3 = tid; asm volatile("" : "+v"(tid3));
        attn_loop<64, 64, 64, FWin, false>(lds, kv, cur >= 8 ? cur - 8 : 0, cur + 1, qf, f, o, S, tid3, lane);
        const float lt = swapsum(S.l), inv = lt > 0.f ? 1.f / lt : 0.f;
        oacc[0] = oacc[0] + o[0] * (inv * g2); oacc[1] = oacc[1] + o[1] * (inv * g2);
    }
    store_ot<64>(OC + (size_t)(b * SEQ + t) * DM + head * 64, oacc, 1.f, lane);
}
constexpr int DG_VP = 136, DG_VT = 64 * DG_VP;
static_assert(8 * DG_VT <= AT_BT, "DSA gather LDS map");
__device__ __forceinline__ void dsa_unit(LAS unsigned char* lds, const bf16* P0, const unsigned short* SEL, bf16* OC, int b, int qt, int tid_in, int lane_in, int wave) {
    int lane = lane_in; asm volatile("" : "+v"(lane)); (void)tid_in;
    const int r32 = lane & 31, hi = lane >> 5, hh = r32 & 7;
    const LAS float* BT = (const LAS float*)(lds + AT_BT) + (8 + hh) * BT_STRIDE;
    LAS unsigned char* vt = lds + wave * DG_VT;
    LAS unsigned short* lq = (LAS unsigned short*)(lds + AT_WS + wave * AT_WS_PER_WAVE);
    const bf16* kb = P0 + (size_t)(b * SEQ) * EV_INP + C_KB + 8 * hi;
    const bf16* vb = P0 + (size_t)(b * SEQ) * EV_INP + C_VB + 8 * (lane & 7);
#define DG_LOADK(LQ, J) do { _Pragma("unroll") for (int st = 0; st < 2; ++st) { unsigned ik = (LQ)[64 * (J) + 32 * st + r32]; ik = ik > 4095u ? 0u : ik; \
        _Pragma("unroll") for (int d0 = 0; d0 < 4; ++d0) kf[st][d0] = *(const GAS bf16x8*)(kb + (size_t)ik * EV_INP + 16 * d0); } } while (0)
#define DG_LOADV(LQ, J) do { _Pragma("unroll") for (int i = 0; i < 8; ++i) { unsigned iv = (LQ)[64 * (J) + 8 * i + (lane >> 3)]; iv = iv > 4095u ? 0u : iv; vr[i] = *(const GAS v4u*)(vb + (size_t)iv * EV_INP); } } while (0)
    bf16x8 kf[2][4]; v4u vr[8];
    { const int t = qt * 32 + wave * 4; *(LAS v2u*)(lq + 4 * lane) = *(const GAS v2u*)(SEL + (size_t)(b * SEQ + t) * 256 + 4 * lane); }
    DG_LOADK(lq, 0); DG_LOADV(lq, 0);
#pragma unroll 1
    for (int qi = 0; qi < 4; ++qi) {
        const int t = qt * 32 + wave * 4 + qi;
        LAS unsigned short* lqc = lq + 256 * (qi & 1); LAS unsigned short* lqn = lq + 256 * ((qi + 1) & 1);
        if (qi + 1 < 4) *(LAS v2u*)(lqn + 4 * lane) = *(const GAS v2u*)(SEL + (size_t)(b * SEQ + t + 1) * 256 + 4 * lane);
        bf16x8 qf[4]; load_q_scaled<64>(P0 + (size_t)(b * SEQ + t) * EV_INP + C_QB + hh * 64, qf, 0.125f * LOG2E, lane);
        f32x16 o[2] = {}; SmState S{0.f, 0.f, false};
#pragma unroll
        for (int j = 0; j < 4; ++j) {
#pragma unroll
            for (int i = 0; i < 8; ++i) { LAS unsigned char* d = vt + (8 * i + (lane >> 3)) * DG_VP + (lane & 7) * 16; *(LAS v2u*)d = (v2u){vr[i].x, vr[i].y}; *(LAS v2u*)(d + 8) = (v2u){vr[i].z, vr[i].w}; }
            if (j < 3) DG_LOADV(lqc, j + 1); else if (qi + 1 < 4) DG_LOADV(lqn, 0);
            f32x16 s[2];
#pragma unroll
            for (int r = 0; r < 16; ++r) { s[0][r] = -S.mhat; s[1][r] = -S.mhat; }
#pragma unroll
            for (int d0 = 0; d0 < 4; ++d0)
#pragma unroll
                for (int st = 0; st < 2; ++st) s[st] = __builtin_amdgcn_mfma_f32_32x32x16_bf16(kf[st][d0], qf[d0], s[st], 0, 0, 0);
            if (j < 3) DG_LOADK(lqc, j + 1); else if (qi + 1 < 4) DG_LOADK(lqn, 0);
            if (j >= 2 || t < 255) {
#pragma unroll
                for (int st = 0; st < 2; ++st)
#pragma unroll
                    for (int r = 0; r < 16; ++r) { const int ix = lqc[64 * j + 32 * st + crow(r, hi)]; const int dist = t - ix; const unsigned di = (unsigned)dist < 128u ? (unsigned)dist : 128u;
                        s[st][r] = dist >= 0 ? s[st][r] + BT[di] : NEGBIG; }
            }
            float mx = NEGBIG;
#pragma unroll
            for (int r = 0; r < 16; ++r) mx = fmx3(mx, s[0][r], s[1][r]);
            mx = swapmax(mx);
            const bool need = S.started ? (mx > DEFER_THR) : (mx > -1e29f);
            if (__any(need)) {
                const float delta = need ? mx : 0.f, fac = (need && S.started) ? __builtin_amdgcn_exp2f(-delta) : 1.f;
                S.mhat += delta; S.l *= fac; S.started = S.started || need;
#pragma unroll
                for (int st = 0; st < 2; ++st)
#pragma unroll
                    for (int r = 0; r < 16; ++r) s[st][r] -= delta;
                o[0] = o[0] * fac; o[1] = o[1] * fac;
            }
#pragma unroll
            for (int st = 0; st < 2; ++st)
#pragma unroll
                for (int r = 0; r < 16; ++r) s[st][r] = __builtin_amdgcn_exp2f(s[st][r]);
            S.l += vsum32(s);
            bf16x8 pf[4]; p_pack(s, pf);
            VFrag vfr; pv_load<DG_VP>(vt, 0, vfr, lane);
            pv_mma(vfr, pf, o[0], o[1]);
        }
        const float lt = swapsum(S.l);
        if (r32 < 8) store_ot<64>(OC + (size_t)(b * SEQ + t) * DM + 512 + hh * 64, o, lt > 0.f ? 1.f / lt : 0.f, lane);
    }
#undef DG_LOADK
#undef DG_LOADV
}


constexpr int D_CQ = 0, D_CKV = 256, D_KR = 384, D_QD = 416, D_KD = 928, D_VD = 1440;
constexpr size_t WS_ROPE = 91 * MiB + 640 * 1024;
constexpr size_t WS_P1 = WS_OV, WS_CQN = WS_OV + 256 * MiB, WS_CKVN = WS_OV + 288 * MiB, WS_KR = WS_OV + 320 * MiB;
constexpr size_t WS_QMLA = WS_Y, WS_KVMLA = WS_Y + 96 * MiB;
static_assert(WS_KR + 4 * MiB <= WS_END && WS_KVMLA + 128 * MiB <= WS_OV, "odd overlay");
constexpr float LAM_INIT = 0.35550906759097f;

__device__ __forceinline__ void rope_table_phase(float* ROPE, int gt, int NGT) {
    for (int idx = gt; idx < SEQ * 16; idx += NGT) { const int t = idx >> 4, i = idx & 15;
        const float inv = exp2f(-(float)i * (13.287712379549449f / 16.0f));
        const double rev = (double)((float)t * inv) * 0.15915494309189535;
        const float fr = (float)(rev - __builtin_floor(rev));
        ROPE[2 * idx] = __builtin_amdgcn_cosf(fr); ROPE[2 * idx + 1] = __builtin_amdgcn_sinf(fr); }
}
__device__ __forceinline__ void odd_prep_rows(const bf16* P1, const float* qn, const float* kvn, const float* ROPE, bf16* CQN, bf16* CKVN, bf16* KR, int gw, int NGW, int lane) {
    float gq[4], gk[2];
#pragma unroll
    for (int j = 0; j < 4; ++j) gq[j] = qn[4 * lane + j];
    gk[0] = kvn[2 * lane]; gk[1] = kvn[2 * lane + 1];
    for (int m = gw; m < MTOK; m += NGW) {
        const bf16* row = P1 + (size_t)m * OD_INP;
        const v2u cq = *(const GAS v2u*)(row + D_CQ + 4 * lane); const unsigned ck = *(const GAS unsigned*)(row + D_CKV + 2 * lane);
        float x[4] = {bf2f((unsigned short)(cq.x & 0xffff)), bf2f((unsigned short)(cq.x >> 16)), bf2f((unsigned short)(cq.y & 0xffff)), bf2f((unsigned short)(cq.y >> 16))};
        float y[2] = {bf2f((unsigned short)(ck & 0xffff)), bf2f((unsigned short)(ck >> 16))};
        const float r1 = __builtin_amdgcn_rsqf(wave_sum((x[0] * x[0] + x[1] * x[1]) + (x[2] * x[2] + x[3] * x[3])) * (1.f / 256.f) + RMS_EPS);
        const float r2 = __builtin_amdgcn_rsqf(wave_sum(y[0] * y[0] + y[1] * y[1]) * (1.f / 128.f) + RMS_EPS);
        v2u o; o.x = pk2(x[0] * r1 * gq[0], x[1] * r1 * gq[1]); o.y = pk2(x[2] * r1 * gq[2], x[3] * r1 * gq[3]);
        *(GAS v2u*)(CQN + (size_t)m * 256 + 4 * lane) = o;
        *(GAS unsigned*)(CKVN + (size_t)m * 256 + 2 * lane) = pk2(y[0] * r2 * gk[0], y[1] * r2 * gk[1]);
        *(GAS unsigned*)(CKVN + (size_t)m * 256 + 128 + 2 * lane) = 0u;
        if (lane < 16) { const int t = m & (SEQ - 1); const float c = ROPE[(t * 16 + lane) * 2], s = ROPE[(t * 16 + lane) * 2 + 1];
            const float x1 = bf2f(row[D_KR + lane]), x2 = bf2f(row[D_KR + 16 + lane]);
            KR[(size_t)m * 32 + lane] = (bf16)f2bf(x1 * c - x2 * s); KR[(size_t)m * 32 + 16 + lane] = (bf16)f2bf(x1 * s + x2 * c); }
    }
}
template <bool BIAS> struct FCausal {
    int t, tmin, tmax, hi; const LAS float* BT;
    __device__ __forceinline__ void pre(int) {}
    __device__ __forceinline__ bool skip(int kt) const { return 64 * kt > tmax; }
    __device__ __forceinline__ void apply(f32x16 (&s)[2], int kt) {
        if (!(64 * kt + 63 <= tmin && (!BIAS || tmin - (64 * kt + 63) >= 113))) {
#pragma unroll
            for (int st = 0; st < 2; ++st)
#pragma unroll
                for (int r = 0; r < 16; ++r) { const int dist = t - (64 * kt + 32 * st + crow(r, hi)); const unsigned di = (unsigned)dist < 128u ? (unsigned)dist : 128u;
                    s[st][r] = dist >= 0 ? s[st][r] + (BIAS ? BT[di] : 0.f) : NEGBIG; }
        }
    }
};
__device__ __forceinline__ void mla_unit(LAS unsigned char* lds, const bf16* QM, const bf16* KVM_, const bf16* KR, const float* ROPE, bf16* OC, int b, int h, int qt, int tid_in, int lane_in, int wave) {
    int lane = lane_in; asm volatile("" : "+v"(lane)); const int tid = wave * 64 + lane; (void)tid_in;
    const int r32 = lane & 31, hi = lane >> 5, t = qt * 256 + wave * 32 + r32;
    bf16x8 qf[6]; load_q<96>(QM + (size_t)(b * SEQ + t) * 768 + h * 96, qf, lane);
    {
        const float* rp = ROPE + (size_t)(t * 16 + 8 * hi) * 2;
        bf16x8 a = qf[4], c = qf[5];
#pragma unroll
        for (int j = 0; j < 8; ++j) { const float cs = rp[2 * j], sn = rp[2 * j + 1], x1 = bf2f((unsigned short)a[j]), x2 = bf2f((unsigned short)c[j]);
            a[j] = (short)f2bf(x1 * cs - x2 * sn); c[j] = (short)f2bf(x1 * sn + x2 * cs); }
        qf[4] = a; qf[5] = c;
    }
#pragma unroll
    for (int d0 = 0; d0 < 6; ++d0) qf[d0] = scale_frag(qf[d0], 0.10206207261596577f * LOG2E);
    KVSrc kv{KVM_ + (size_t)(b * SEQ) * 1024 + h * 128, 1024, KR + (size_t)(b * SEQ) * 32, 32, KVM_ + (size_t)(b * SEQ) * 1024 + h * 128 + 64, 1024};
    f32x16 o[2] = {}; SmState S{0.f, 0.f, false};
    FCausal<false> f{t, qt * 256 + wave * 32, qt * 256 + wave * 32 + 31, hi, nullptr};
    attn_loop<96, 64, 64, FCausal<false>, false, true>(lds, kv, 0, 4 * qt + 4, qf, f, o, S, tid, lane);
    const float lt = swapsum(S.l);
    store_ot<64>(OC + (size_t)(b * SEQ + t) * DM + h * 64, o, lt > 0.f ? 1.f / lt : 0.f, lane);
}
__device__ __forceinline__ void diff_unit(LAS unsigned char* lds, const bf16* P1, const float* lam, const float* subln, bf16* OC, int b, int h, int qt, int tid_in, int lane_in, int wave) {
    int lane = lane_in; asm volatile("" : "+v"(lane)); const int tid = wave * 64 + lane; (void)tid_in;
    const int r32 = lane & 31, hi = lane >> 5, t = qt * 256 + wave * 32 + r32;
    const LAS float* BT = (const LAS float*)(lds + AT_BT) + (16 + h) * BT_STRIDE;
    float d01 = 0.f, d23 = 0.f;
    { d01 = lam[lane] * lam[64 + lane]; d23 = lam[128 + lane] * lam[192 + lane]; d01 = wave_sum(d01); d23 = wave_sum(d23); }
    const float lam_full = __expf(d01) - __expf(d23) + LAM_INIT;
    unsigned o0p[32];
    f32x16 o[4];
#pragma unroll 1
    for (int e = 0; e < 2; ++e) {
        bf16x8 qf[4]; load_q_scaled<64>(P1 + (size_t)(b * SEQ + t) * OD_INP + D_QD + (h * 2 + e) * 64, qf, 0.125f * LOG2E, lane);
        KVSrc kv{P1 + (size_t)(b * SEQ) * OD_INP + D_KD + (h * 2 + e) * 64, OD_INP, nullptr, 0, P1 + (size_t)(b * SEQ) * OD_INP + D_VD + h * 128, OD_INP};
#pragma unroll
        for (int dt = 0; dt < 4; ++dt) o[dt] = (f32x16){};
        SmState S{0.f, 0.f, false};
        FCausal<true> f{t, qt * 256 + wave * 32, qt * 256 + wave * 32 + 31, hi, BT};
        attn_loop<64, 64, 128, FCausal<true>>(lds, kv, 0, 4 * qt + 4, qf, f, o, S, tid, lane);
        const float lt = swapsum(S.l), inv = lt > 0.f ? 1.f / lt : 0.f;
        if (e == 0) {
#pragma unroll
            for (int dt = 0; dt < 4; ++dt)
#pragma unroll
                for (int k = 0; k < 8; ++k) o0p[dt * 8 + k] = cvtpk(o[dt][2 * k] * inv, o[dt][2 * k + 1] * inv);
        } else {
            float ss = 0.f;
#pragma unroll
            for (int dt = 0; dt < 4; ++dt)
#pragma unroll
                for (int k = 0; k < 8; ++k) { const unsigned w = o0p[dt * 8 + k];
                    const float a0 = __uint_as_float(w << 16) - lam_full * (o[dt][2 * k] * inv), a1 = __uint_as_float(w & 0xffff0000u) - lam_full * (o[dt][2 * k + 1] * inv);
                    o[dt][2 * k] = a0; o[dt][2 * k + 1] = a1; ss += a0 * a0 + a1 * a1; }
            ss = swapsum(ss);
            const float rn = __builtin_amdgcn_rsqf(ss * (1.f / 128.f) + RMS_EPS) * (1.0f - LAM_INIT);
            bf16* orow = OC + (size_t)(b * SEQ + t) * DM + 512 + h * 128;
#pragma unroll
            for (int dt = 0; dt < 4; ++dt)
#pragma unroll
                for (int r4 = 0; r4 < 4; r4 += 2) { const int d = 32 * dt + 8 * r4 + 4 * hi; const f32x4 gn = *(const GAS f32x4*)(subln + d), gm = *(const GAS f32x4*)(subln + d + 8);
                    v2u wa, wb; wa.x = cvtpk(o[dt][4 * r4 + 0] * rn * gn.x, o[dt][4 * r4 + 1] * rn * gn.y); wa.y = cvtpk(o[dt][4 * r4 + 2] * rn * gn.z, o[dt][4 * r4 + 3] * rn * gn.w);
                    wb.x = cvtpk(o[dt][4 * r4 + 4] * rn * gm.x, o[dt][4 * r4 + 5] * rn * gm.y); wb.y = cvtpk(o[dt][4 * r4 + 6] * rn * gm.z, o[dt][4 * r4 + 7] * rn * gm.w);
                    swap_pair(wa, wb);
                    *(GAS v4u*)(orow + 32 * dt + 8 * r4 + 8 * hi) = (v4u){wa.x, wa.y, wb.x, wb.y}; }
        }
    }
}


__device__ __forceinline__ void tr_item(const float* W, int N, bf16* WT, int ldk, int drow0, LAS float* scr, int k0, int n0, int lane, const float* grow = nullptr) {
#pragma unroll 8
    for (int i = 0; i < 32; ++i) { const int kk = 2 * i + (lane >> 5); float wv = W[(size_t)(k0 + kk) * N + n0 + (lane & 31)]; if (grow) wv *= grow[k0 + kk]; scr[kk * 33 + (lane & 31)] = wv; }
    LDS_WAIT(); asm volatile("" ::: "memory");
    const int c = lane & 7;
#pragma unroll
    for (int j = 0; j < 4; ++j) { const int n = (lane >> 3) + 8 * j; const LAS float* s = scr + (8 * c) * 33 + n;
        v4u o; o.x = pk2(s[0 * 33], s[1 * 33]); o.y = pk2(s[2 * 33], s[3 * 33]); o.z = pk2(s[4 * 33], s[5 * 33]); o.w = pk2(s[6 * 33], s[7 * 33]);
        *(GAS v4u*)(WT + (size_t)(drow0 + n) * ldk + k0 + 8 * c) = o; }
    LDS_WAIT(); asm volatile("" ::: "memory");
}
__device__ __forceinline__ void tr_item8(const float* W, int N, unsigned char* WT, int ldk, int drow0, LAS float* scr, int k0, int n0, int lane) {
#pragma unroll 8
    for (int i = 0; i < 32; ++i) { const int kk = 2 * i + (lane >> 5); scr[kk * 33 + (lane & 31)] = W[(size_t)(k0 + kk) * N + n0 + (lane & 31)]; }
    LDS_WAIT(); asm volatile("" ::: "memory");
    const int c = lane & 7;
#pragma unroll
    for (int j = 0; j < 4; ++j) { const int n = (lane >> 3) + 8 * j; const LAS float* s = scr + (8 * c) * 33 + n;
        v2u o; o.x = pg8::pk4_fp8(s[0 * 33], s[1 * 33], s[2 * 33], s[3 * 33], pg8::F8S_W); o.y = pg8::pk4_fp8(s[4 * 33], s[5 * 33], s[6 * 33], s[7 * 33], pg8::F8S_W);
        *(GAS v2u*)(WT + (size_t)(drow0 + n) * ldk + k0 + 8 * c) = o; }
    LDS_WAIT(); asm volatile("" ::: "memory");
}
constexpr size_t WS_XB = WS_OV + 370 * MiB;
constexpr size_t WS_RS = 1 * MiB;
constexpr int F8_FROM = 1;
__device__ __forceinline__ void rows_norm_phase(const float* xsrc, float* xdst, const bf16* Y, float w, const float* gpost, const float* gpre, bf16* H, int nrows, int gw, int NGW, int lane, bool f8 = false, float ysc = 1.f, const bf16* xsb = nullptr, bf16* xdb = nullptr, float* Rout = nullptr) {
    f32x4 gp[4], gq[4];
#pragma unroll
    for (int j = 0; j < 4; ++j) {
        gp[j] = Y ? ((const GAS f32x4*)gpost)[lane + 64 * j] * w : (f32x4){0.f, 0.f, 0.f, 0.f};
        gq[j] = gpre ? ((const GAS f32x4*)gpre)[lane + 64 * j] : (f32x4){0.f, 0.f, 0.f, 0.f};
    }
    for (int m = gw; m < nrows; m += NGW) {
        f32x4 x[4];
        if (xsb) {
            const GAS v2u* xr = (const GAS v2u*)(xsb + (size_t)m * DM) + lane;
#pragma unroll
            for (int j = 0; j < 4; ++j) { const v2u xv = xr[64 * j]; x[j] = (f32x4){__uint_as_float(xv.x << 16), __uint_as_float(xv.x & 0xffff0000u), __uint_as_float(xv.y << 16), __uint_as_float(xv.y & 0xffff0000u)}; }
        } else {
            const GAS f32x4* xr = (const GAS f32x4*)(xsrc + (size_t)m * DM) + lane;
#pragma unroll
            for (int j = 0; j < 4; ++j) x[j] = xr[64 * j];
        }
        if (Y) {
            const GAS v2u* yr = (const GAS v2u*)(Y + (size_t)m * DM) + lane;
            f32x4 y[4]; float s = 0.f;
#pragma unroll
            for (int j = 0; j < 4; ++j) { const v2u yv = yr[64 * j]; y[j] = (f32x4){__uint_as_float(yv.x << 16), __uint_as_float(yv.x & 0xffff0000u), __uint_as_float(yv.y << 16), __uint_as_float(yv.y & 0xffff0000u)} * ysc;
                s += (y[j].x * y[j].x + y[j].y * y[j].y) + (y[j].z * y[j].z + y[j].w * y[j].w); }
            const float rstd = __builtin_amdgcn_rsqf(wave_sum(s) * (1.f / DM) + RMS_EPS);
#pragma unroll
            for (int j = 0; j < 4; ++j) x[j] = x[j] + y[j] * rstd * gp[j];
        }
        if (xdst) {
            GAS f32x4* xo = (GAS f32x4*)(xdst + (size_t)m * DM) + lane;
#pragma unroll
            for (int j = 0; j < 4; ++j) xo[64 * j] = x[j];
        }
        if (xdb) {
            GAS v2u* xo = (GAS v2u*)(xdb + (size_t)m * DM) + lane;
#pragma unroll
            for (int j = 0; j < 4; ++j) { v2u o; o.x = pk2(x[j].x, x[j].y); o.y = pk2(x[j].z, x[j].w); xo[64 * j] = o; }
        }
        if (gpre || Rout) {
            float s2 = 0.f;
#pragma unroll
            for (int j = 0; j < 4; ++j) s2 += (x[j].x * x[j].x + x[j].y * x[j].y) + (x[j].z * x[j].z + x[j].w * x[j].w);
            const float r2 = __builtin_amdgcn_rsqf(wave_sum(s2) * (1.f / DM) + RMS_EPS);
            if (Rout && lane == 0) Rout[m] = r2;
            if (gpre) {
            if (f8) {
                GAS unsigned* ho = (GAS unsigned*)((unsigned char*)H + (size_t)m * DM) + lane;
#pragma unroll
                for (int j = 0; j < 4; ++j) { const f32x4 h = x[j] * r2 * gq[j]; ho[64 * j] = pg8::pk4_fp8(h.x, h.y, h.z, h.w, pg8::F8S_H); }
            } else {
            GAS v2u* ho = (GAS v2u*)(H + (size_t)m * DM) + lane;
#pragma unroll
            for (int j = 0; j < 4; ++j) { const f32x4 h = x[j] * r2 * gq[j]; v2u o; o.x = pk2(h.x, h.y); o.y = pk2(h.z, h.w); ho[64 * j] = o; }
            }
            }
        }
    }
}
__device__ __forceinline__ void transpose_cols_phase(const bf16* src, int ld, int col0, int ncols, int nb, int S, bf16* dst, LAS unsigned short* scr, int gw, int NGW, int lane, int gsz = 1 << 30, int gstride = 0) {
    const int nct = ncols / 64, nst = S / 64, nitems = nb * nct * nst;
    for (int it = gw; it < nitems; it += NGW) {
        const int st = it % nst, ct = (it / nst) % nct, b = it / (nst * nct);
        const bf16* sp = src + (size_t)(b * S + st * 64) * ld + col0 + ((ct * 64) / gsz) * gstride + (ct * 64) % gsz;
#pragma unroll
        for (int i = 0; i < 8; ++i) { const int r = i * 8 + (lane >> 3), c8 = (lane & 7) * 8;
            const v4u v = *(const GAS v4u*)(sp + (size_t)r * ld + c8);
            LAS unsigned* d = (LAS unsigned*)(scr + r * 66 + c8); d[0] = v.x; d[1] = v.y; d[2] = v.z; d[3] = v.w; }
        LDS_WAIT(); asm volatile("" ::: "memory");
        bf16* dp = dst + ((size_t)(b * ncols + ct * 64)) * S + st * 64;
#pragma unroll
        for (int i = 0; i < 8; ++i) { const int c = i * 8 + (lane >> 3), r8 = (lane & 7) * 8;
            unsigned short e[8];
#pragma unroll
            for (int k = 0; k < 8; ++k) e[k] = scr[(r8 + k) * 66 + c];
            v4u o; o.x = e[0] | ((unsigned)e[1] << 16); o.y = e[2] | ((unsigned)e[3] << 16); o.z = e[4] | ((unsigned)e[5] << 16); o.w = e[6] | ((unsigned)e[7] << 16);
            *(GAS v4u*)(dp + (size_t)c * S + r8) = o; }
        LDS_WAIT(); asm volatile("" ::: "memory");
    }
}

struct Args { const float* in[24]; float* out; unsigned char* ws; int ph_lo, ph_hi, stop, li; };
constexpr int PH_PRO = 0, PH_MEMKV = 1, PH_MEMVT = 2, PH_L0 = 3, PPL = 17, NPHASE = PH_L0 + 2 * PPL;

#define PHASE_IDS unsigned char* ws = args.ws; asm volatile("" : "+s"(ws)); int bx = bx0, vcu = vcu0; asm volatile("" : "+s"(bx), "+s"(vcu)); const int gw = vcu * NWAVES + wave, NGW = G * NWAVES; (void)gw; (void)NGW; (void)bx; int lane_l; asm volatile("v_mbcnt_lo_u32_b32 %0, -1, 0\n\tv_mbcnt_hi_u32_b32 %0, -1, %0" : "=v"(lane_l)); const int lane = lane_l, tid = wave * 64 + lane; bf16* const H = (bf16*)(ws + WS_H); bf16* const Y = (bf16*)(ws + WS_Y); bf16* const XB = (bf16*)(ws + WS_XB); float* const RS = (float*)(ws + WS_RS); (void)H; (void)Y; (void)XB; (void)RS; (void)tid;
#define IN(k) (lo <= (k) && (k) < hi && (k) < stop)
#define SEAM(k) do { if ((k) + 1 < hi && (k) + 1 < stop) { XcdBarrier b2 = bar; asm volatile("" : "+s"(b2.bar), "+s"(b2.x)); xcd_barrier(b2); } } while (0)
template <int L> __device__ __forceinline__ void layer_phases(const Args& args, LAS unsigned char* lds, const XcdBarrier& bar, int wave, int G, int bx0, int vcu0, int lo, int hi, int stop) {
    const float* x_in = args.in[0]; const float* norm_pre = args.in[3]; const float* norm_post = args.in[4]; float* xout = args.out;

        const int base = PH_L0 + L * PPL;
        const float* gpre = norm_pre + (size_t)L * 4 * DM; const float* gpost = norm_post + (size_t)L * 4 * DM;
        if (IN(base + 0)) {
            PHASE_IDS
            pg8::StaticOrder S; S.init(MTOK, 5632, G, bx);
            if constexpr (L * 2 + 0 >= F8_FROM) {
                pg8::Gemm g{H, (const bf16*)(ws + WS_WGU) + (size_t)(L * 2 + 0) * 5632 * DM, MTOK, 5632, DM};
                pg8::EpiSwiGLU8 E{ws + WS_HID, DFF};
                pg8::gemm_phase<pg8::EpiSwiGLU8, pg8::StaticOrder, true, true, true>(lds, g, S, E, tid);
            } else {
                pg8::Gemm g{XB, (const bf16*)(ws + WS_WGU) + (size_t)(L * 2 + 0) * 5632 * DM, MTOK, 5632, DM};
                pg8::EpiSwiGLUR E{(bf16*)(ws + WS_HID), DFF, RS};
                pg8::gemm_phase<pg8::EpiSwiGLUR, pg8::StaticOrder, true, true>(lds, g, S, E, tid);
            }
            SEAM(base + 0);
        }
        if (IN(base + 1)) {
            PHASE_IDS
            pg8::StaticOrder S; S.init(MTOK, DM, G, bx);
            pg8::EpiBf16P E{Y, DM};
            if constexpr (L * 2 + 0 >= F8_FROM) {
                pg8::Gemm g{(const bf16*)(ws + WS_HID), (const bf16*)(ws + WS_WD) + (size_t)(L * 2 + 0) * DM * DFF, MTOK, DM, DFF};
                pg8::gemm_phase<pg8::EpiBf16P, pg8::StaticOrder, true, true, true>(lds, g, S, E, tid);
            } else {
                pg8::Gemm g{(const bf16*)(ws + WS_HID), (const bf16*)(ws + WS_WD) + (size_t)(L * 2 + 0) * DM * DFF, MTOK, DM, DFF};
                pg8::gemm_phase<pg8::EpiBf16P, pg8::StaticOrder, true, true>(lds, g, S, E, tid);
            }
            SEAM(base + 1);
        }
        if (IN(base + 2)) {
            PHASE_IDS
            rows_norm_phase(nullptr, nullptr, Y, 0.5f, gpost, L == 0 ? nullptr : gpre + DM, H, MTOK, gw, NGW, lane, L == 1, L * 2 + 0 >= F8_FROM ? 1.f / (pg8::F8S_W * pg8::F8S_HID) : 1.f, XB, XB, L == 0 ? RS : nullptr);
            SEAM(base + 2);
        }
        if (L == 0 && IN(base + 3)) {
            PHASE_IDS
            pg8::Gemm g{XB, (const bf16*)(ws + WS_EVIN), MTOK, EV_INP, DM};
            pg8::StaticOrder S; S.init(MTOK, EV_INP, G, bx);
            pg8::EpiBf16PR E{(bf16*)(ws + WS_P0), EV_INP, RS};
            pg8::gemm_phase<pg8::EpiBf16PR, pg8::StaticOrder, true, true>(lds, g, S, E, tid);
            SEAM(base + 3);
        }
        if (L == 0 && IN(base + 4)) {
            PHASE_IDS
            if (args.li == 0) { PHASE_IDS
            const bf16* P0 = (const bf16*)(ws + WS_P0);
            for (int it0 = vcu * 2; it0 < 512; it0 += G * 2) nsa_compress_pair(lds, P0, (const bf16*)(ws + WS_CWT), (const float*)(ws + WS_CBIAS), (bf16*)(ws + WS_KCMP), (bf16*)(ws + WS_VCMP), it0, wave, lane);
            }
            __syncthreads();
            { PHASE_IDS
            const bf16* P0 = (const bf16*)(ws + WS_P0);
            for (int u = vcu, i = 0; u < NB * 256; u += G, ++i) {
                int b, qt;
                if (G == 256) { b = vcu >> 4; const int sub = vcu & 15; qt = (i & 1) ? 16 * i + 15 - sub : 16 * i + sub; } else { b = u & 15; qt = u >> 4; }
                dsa_index_unit(lds, P0, (unsigned short*)(ws + WS_SEL), b, qt, tid, lane, wave);
            } }
            SEAM(base + 4);
        }
        if (L == 0 && IN(base + 5)) {
            PHASE_IDS
            build_bias_tables(lds, args.in[2], tid);
            __syncthreads();
            { PHASE_IDS
            const bf16* P0 = (const bf16*)(ws + WS_P0);
            for (int u = vcu, i = 0; u < NB * 2 * 64; u += G, ++i) {
                int bg, qt;
                if (G == 256) { bg = vcu >> 3; const int sub = vcu & 7; qt = (i & 1) ? 8 * i + 7 - sub : 8 * i + sub; } else { bg = u & 31; qt = u >> 5; }
                nsa_unit(lds, P0, (const bf16*)(ws + WS_KCMP), (const bf16*)(ws + WS_VCMP), H, bg >> 1, bg & 1, qt, tid, lane, wave);
            } }
            { PHASE_IDS
            const bf16* P0 = (const bf16*)(ws + WS_P0);
            for (int u = vcu, i = 0; u < NB * 128; u += G, ++i) {
                int b, qt;
                if (G == 256) { b = vcu >> 4; const int sub = vcu & 15; qt = (i & 1) ? 16 * i + 15 - sub : 16 * i + sub; } else { b = u & 15; qt = u >> 4; }
                dsa_unit(lds, P0, (const unsigned short*)(ws + WS_SEL), H, b, qt, tid, lane, wave);
            } }
            SEAM(base + 5);
        }
        if (L == 1 && IN(base + 3)) {
            PHASE_IDS
            pg8::Gemm g{H, (const bf16*)(ws + WS_ODIN), MTOK, OD_INP, DM};
            pg8::StaticOrder S; S.init(MTOK, OD_INP, G, bx);
            pg8::EpiBf16PS E{(bf16*)(ws + WS_P1), OD_INP, 1.f / (pg8::F8S_W * pg8::F8S_H)};
            pg8::gemm_phase<pg8::EpiBf16PS, pg8::StaticOrder, true, true, true>(lds, g, S, E, tid);
            SEAM(base + 3);
        }
        if (L == 1 && IN(base + 4)) {
            PHASE_IDS
            const bf16* P1 = (const bf16*)(ws + WS_P1);
            odd_prep_rows(P1, args.in[14], args.in[15], (const float*)(ws + WS_ROPE), (bf16*)(ws + WS_CQN), (bf16*)(ws + WS_CKVN), (bf16*)(ws + WS_KR), gw, NGW, lane);
            SEAM(base + 4);
        }
        if (L == 1 && IN(base + 5)) {
            PHASE_IDS
            { pg8::Gemm g{(const bf16*)(ws + WS_CQN), (const bf16*)(ws + WS_WUQ), MTOK, 768, 256};
              pg8::StaticOrder S; S.init(MTOK, 768, G, bx);
              pg8::EpiBf16P E{(bf16*)(ws + WS_QMLA), 768};
              pg8::gemm_phase<pg8::EpiBf16P, pg8::StaticOrder, true, true>(lds, g, S, E, tid); }
            __syncthreads();
            { pg8::Gemm g{(const bf16*)(ws + WS_CKVN), (const bf16*)(ws + WS_WUKV), MTOK, 1024, 256};
              pg8::StaticOrder S; S.init(MTOK, 1024, G, bx);
              pg8::EpiBf16P E{(bf16*)(ws + WS_KVMLA), 1024};
              pg8::gemm_phase<pg8::EpiBf16P, pg8::StaticOrder, true, true>(lds, g, S, E, tid); }
            SEAM(base + 5);
        }
        if (L == 1 && IN(base + 7)) {
            { PHASE_IDS
            build_bias_tables(lds, args.in[2], tid);
            __syncthreads();
            for (int u = vcu, i = 0; u < NB * 8 * 16; u += G, ++i) {
                int bh, qt;
                if (G == 256) { bh = vcu >> 1; const int sub = vcu & 1; qt = (i & 1) ? 2 * i + 1 - sub : 2 * i + sub; } else { bh = u & 127; qt = u >> 7; }
                mla_unit(lds, (const bf16*)(ws + WS_QMLA), (const bf16*)(ws + WS_KVMLA), (const bf16*)(ws + WS_KR), (const float*)(ws + WS_ROPE), H, bh >> 3, bh & 7, qt, tid, lane, wave);
            } }
            { PHASE_IDS
            for (int u = vcu, i = 0; u < NB * 4 * 16; u += G, ++i) {
                int bh, qt;
                if (G == 256) { bh = vcu >> 2; const int sub = vcu & 3; qt = (i & 1) ? 4 * i + 3 - sub : 4 * i + sub; } else { bh = u & 63; qt = u >> 6; }
                diff_unit(lds, (const bf16*)(ws + WS_P1), args.in[18], args.in[19], H, bh >> 2, bh & 3, qt, tid, lane, wave);
            } }
            SEAM(base + 7);
        }
        if (IN(base + 8)) {
            PHASE_IDS
            pg8::Gemm g{H, (const bf16*)(ws + (L == 0 ? WS_EVOUT : WS_ODOUT)), MTOK, DM, DM};
            pg8::StaticOrder S; S.init(MTOK, DM, G, bx);
            pg8::EpiBf16P E{Y, DM};
            pg8::gemm_phase<pg8::EpiBf16P, pg8::StaticOrder, true, true>(lds, g, S, E, tid);
            SEAM(base + 8);
        }
        if (IN(base + 9)) {
            PHASE_IDS
            rows_norm_phase(nullptr, nullptr, Y, 1.0f, gpost + DM, nullptr, H, MTOK, gw, NGW, lane, false, 1.f, XB, XB, RS);
            SEAM(base + 9);
        }
        if (IN(base + 10)) {
            PHASE_IDS
            pg8::Gemm g{XB, (const bf16*)(ws + WS_XWQ) + (size_t)L * 512 * DM, MTOK, 512, DM};
            pg8::StaticOrder S; S.init(MTOK, 512, G, bx);
            pg8::EpiBf16PR E{(bf16*)(ws + WS_XQ), 512, RS};
            pg8::gemm_phase<pg8::EpiBf16PR, pg8::StaticOrder, true, true>(lds, g, S, E, tid);
            SEAM(base + 10);
        }
        if (IN(base + 11)) {
            PHASE_IDS
            for (int u = vcu; u < NB * 4 * 16; u += G) {
                const int qt = u & 15, h = (u >> 4) & 3, b = u >> 6;
                xattn_unit(lds, (const bf16*)(ws + WS_XQ), (const bf16*)(ws + WS_KVM) + (size_t)L * MROWS * DM, H, b, h, qt, tid, lane, wave);
            }
            SEAM(base + 11);
        }
        if (IN(base + 12)) {
            PHASE_IDS
            pg8::Gemm g{H, (const bf16*)(ws + WS_XWO) + (size_t)L * DM * 512, MTOK, DM, 512};
            pg8::StaticOrder S; S.init(MTOK, DM, G, bx);
            pg8::EpiBf16P E{Y, DM};
            pg8::gemm_phase<pg8::EpiBf16P, pg8::StaticOrder, true, true>(lds, g, S, E, tid);
            SEAM(base + 12);
        }
        if (IN(base + 13)) {
            PHASE_IDS
            rows_norm_phase(nullptr, nullptr, Y, 1.0f, gpost + 2 * DM, gpre + 3 * DM, H, MTOK, gw, NGW, lane, L * 2 + 1 >= F8_FROM, 1.f, XB, XB);
            SEAM(base + 13);
        }
        if (IN(base + 14)) {
            PHASE_IDS
            pg8::StaticOrder S; S.init(MTOK, 5632, G, bx);
            if constexpr (L * 2 + 1 >= F8_FROM) {
                pg8::Gemm g{H, (const bf16*)(ws + WS_WGU) + (size_t)(L * 2 + 1) * 5632 * DM, MTOK, 5632, DM};
                pg8::EpiSwiGLU8 E{ws + WS_HID, DFF};
                pg8::gemm_phase<pg8::EpiSwiGLU8, pg8::StaticOrder, true, true, true>(lds, g, S, E, tid);
            } else {
                pg8::Gemm g{H, (const bf16*)(ws + WS_WGU) + (size_t)(L * 2 + 1) * 5632 * DM, MTOK, 5632, DM};
                pg8::EpiSwiGLU E{(bf16*)(ws + WS_HID), DFF};
                pg8::gemm_phase<pg8::EpiSwiGLU, pg8::StaticOrder, true, true>(lds, g, S, E, tid);
            }
            SEAM(base + 14);
        }
        if (IN(base + 15)) {
            PHASE_IDS
            pg8::StaticOrder S; S.init(MTOK, DM, G, bx);
            pg8::EpiBf16P E{Y, DM};
            if constexpr (L * 2 + 1 >= F8_FROM) {
                pg8::Gemm g{(const bf16*)(ws + WS_HID), (const bf16*)(ws + WS_WD) + (size_t)(L * 2 + 1) * DM * DFF, MTOK, DM, DFF};
                pg8::gemm_phase<pg8::EpiBf16P, pg8::StaticOrder, true, true, true>(lds, g, S, E, tid);
            } else {
                pg8::Gemm g{(const bf16*)(ws + WS_HID), (const bf16*)(ws + WS_WD) + (size_t)(L * 2 + 1) * DM * DFF, MTOK, DM, DFF};
                pg8::gemm_phase<pg8::EpiBf16P, pg8::StaticOrder, true, true>(lds, g, S, E, tid);
            }
            SEAM(base + 15);
        }
        if (IN(base + 16)) {
            PHASE_IDS
            rows_norm_phase(nullptr, L == 0 ? nullptr : xout, Y, 0.5f, gpost + 3 * DM, L == 0 ? norm_pre + 4 * DM : nullptr, H, MTOK, gw, NGW, lane, L * 2 + 2 >= F8_FROM, L * 2 + 1 >= F8_FROM ? 1.f / (pg8::F8S_W * pg8::F8S_HID) : 1.f, XB, L == 0 ? XB : nullptr);
            SEAM(base + 16);
        }
}


__global__ void __launch_bounds__(NWAVES * 64, 2) fwd_kernel(Args args) {
    extern __shared__ __attribute__((aligned(16))) unsigned char lds_raw[];
    LAS unsigned char* lds = (LAS unsigned char*)lds_raw;
    volatile LAS unsigned* MISC = (volatile LAS unsigned*)(lds + MISC_OFF);
    const int tid0 = threadIdx.x, wave = __builtin_amdgcn_readfirstlane(tid0 >> 6);
    const int G = gridDim.x, bx0 = blockIdx.x;
    const int vcu0 = (G % 8 == 0) ? (bx0 % 8) * (G / 8) + bx0 / 8 : bx0;
    unsigned* ctl = (unsigned*)(args.ws + WS_CTL);
    for (int u = tid0; u < (LDS_BYTES - LDSCTL_OFF) / 4; u += NWAVES * 64) ((LAS unsigned*)(lds + LDSCTL_OFF))[u] = 0u;
    __syncthreads();
    XcdBarrier bar = xcd_barrier_post(ctl + CW_BAR + args.li * XCD_BAR_WORDS, MISC + 8);
    const int lo = args.ph_lo, hi = args.ph_hi, stop = args.stop;

    const float* x_in = args.in[0]; const float* mem = args.in[1];
    const float* norm_pre = args.in[3]; const float* norm_post = args.in[4]; const float* mem_norm = args.in[5];
    float* xout = args.out;

    if (IN(PH_PRO)) {
            PHASE_IDS
        LAS float* scr = (LAS float*)(lds + wave * 16384);
        constexpr int I_GU = (DM / 64) * (DFF / 32), I_D = (DFF / 64) * (DM / 32);
        constexpr int I_EVIN = (DM / 64) * (EV_IN / 32), I_SQ = (DM / 64) * (DM / 32), I_ODIN = (DM / 64) * (OD_IN / 32);
        constexpr int I_UQ = (256 / 64) * (768 / 32), I_UKV = (128 / 64) * (1024 / 32), I_XQ = (DM / 64) * (512 / 32), I_XO = (512 / 64) * (DM / 32);
        constexpr int I_CW = (2048 / 64) * (64 / 32);
        constexpr int NITEMS = 8 * I_GU + 4 * I_D + I_EVIN + I_SQ + I_ODIN + I_SQ + I_UQ + I_UKV + 2 * I_XQ + 2 * I_SQ + 2 * I_XO + 2 * I_CW;
        for (int it = gw; it < NITEMS; it += NGW) {
            int r = it;
            if (r < 8 * I_GU) { const int mat = r / I_GU, rr = r % I_GU, which = mat & 1, ij = mat >> 1, nblk = DFF / 32, k0 = (rr / nblk) * 64, n0 = (rr % nblk) * 32;
                if (ij >= F8_FROM) tr_item8((which ? args.in[7] : args.in[6]) + (size_t)ij * DM * DFF, DFF, ws + WS_WGU + (size_t)ij * 5632 * DM * 2, DM, (n0 / 128) * 256 + which * 128 + (n0 % 128), scr, k0, n0, lane);
                else tr_item((which ? args.in[7] : args.in[6]) + (size_t)ij * DM * DFF, DFF, (bf16*)(ws + WS_WGU) + (size_t)ij * 5632 * DM, DM, (n0 / 128) * 256 + which * 128 + (n0 % 128), scr, k0, n0, lane, norm_pre);
                continue; } r -= 8 * I_GU;
            if (r < 4 * I_D) { const int mat = r / I_D, rr = r % I_D, nblk = DM / 32, k0 = (rr / nblk) * 64, n0 = (rr % nblk) * 32;
                if (mat >= F8_FROM) tr_item8(args.in[8] + (size_t)mat * DFF * DM, DM, ws + WS_WD + (size_t)mat * DM * DFF * 2, DFF, n0, scr, k0, n0, lane);
                else tr_item(args.in[8] + (size_t)mat * DFF * DM, DM, (bf16*)(ws + WS_WD) + (size_t)mat * DM * DFF, DFF, n0, scr, k0, n0, lane);
                continue; } r -= 4 * I_D;
            if (r < I_EVIN) { const int nblk = EV_IN / 32, k0 = (r / nblk) * 64, n0 = (r % nblk) * 32; tr_item(args.in[9], EV_IN, (bf16*)(ws + WS_EVIN), DM, n0, scr, k0, n0, lane, norm_pre + DM); continue; } r -= I_EVIN;
            if (r < I_SQ) { const int nblk = DM / 32, k0 = (r / nblk) * 64, n0 = (r % nblk) * 32; tr_item(args.in[12], DM, (bf16*)(ws + WS_EVOUT), DM, n0, scr, k0, n0, lane); continue; } r -= I_SQ;
            if (r < I_ODIN) { const int nblk = OD_IN / 32, k0 = (r / nblk) * 64, n0 = (r % nblk) * 32; tr_item8(args.in[13], OD_IN, ws + WS_ODIN, DM, n0, scr, k0, n0, lane); continue; } r -= I_ODIN;
            if (r < I_SQ) { const int nblk = DM / 32, k0 = (r / nblk) * 64, n0 = (r % nblk) * 32; tr_item(args.in[20], DM, (bf16*)(ws + WS_ODOUT), DM, n0, scr, k0, n0, lane); continue; } r -= I_SQ;
            if (r < I_UQ) { const int nblk = 768 / 32, k0 = (r / nblk) * 64, n0 = (r % nblk) * 32; tr_item(args.in[16], 768, (bf16*)(ws + WS_WUQ), 256, n0, scr, k0, n0, lane); continue; } r -= I_UQ;
            if (r < I_UKV) { const int nblk = 1024 / 32, k0 = (r / nblk) * 64, n0 = (r % nblk) * 32; tr_item(args.in[17], 1024, (bf16*)(ws + WS_WUKV), 256, n0, scr, k0, n0, lane); continue; } r -= I_UKV;
            if (r < 2 * I_XQ) { const int mat = r / I_XQ, rr = r % I_XQ, nblk = 512 / 32, k0 = (rr / nblk) * 64, n0 = (rr % nblk) * 32;
                tr_item(args.in[21] + (size_t)mat * DM * 512, 512, (bf16*)(ws + WS_XWQ) + (size_t)mat * 512 * DM, DM, n0, scr, k0, n0, lane, norm_pre + (size_t)(mat * 4 + 2) * DM); continue; } r -= 2 * I_XQ;
            if (r < 2 * I_SQ) { const int mat = r / I_SQ, rr = r % I_SQ, nblk = DM / 32, k0 = (rr / nblk) * 64, n0 = (rr % nblk) * 32;
                tr_item(args.in[22] + (size_t)mat * DM * DM, DM, (bf16*)(ws + WS_XWKV) + (size_t)mat * DM * DM, DM, n0, scr, k0, n0, lane); continue; } r -= 2 * I_SQ;
            if (r < 2 * I_XO) { const int mat = r / I_XO, rr = r % I_XO, nblk = DM / 32, k0 = (rr / nblk) * 64, n0 = (rr % nblk) * 32;
                tr_item(args.in[23] + (size_t)mat * 512 * DM, DM, (bf16*)(ws + WS_XWO) + (size_t)mat * DM * 512, 512, n0, scr, k0, n0, lane); continue; } r -= 2 * I_XO;
            { const int mat = r / I_CW, rr = r % I_CW, nblk = 64 / 32, k0 = (rr / nblk) * 64, n0 = (rr % nblk) * 32;
                tr_item(args.in[11] + (size_t)mat * 2048 * 64, 64, (bf16*)(ws + WS_CWT) + (size_t)mat * 64 * 2048, 2048, n0, scr, k0, n0, lane); }
        }
        { const int gt = vcu * (NWAVES * 64) + tid, NGT = G * NWAVES * 64; const v4u z = (v4u){0u, 0u, 0u, 0u};
          for (int i = gt; i < (EV_INP - EV_IN) * DM / 8; i += NGT) ((GAS v4u*)((bf16*)(ws + WS_EVIN) + (size_t)EV_IN * DM))[i] = z;
          for (int i = gt; i < (OD_INP - OD_IN) * DM / 16; i += NGT) ((GAS v4u*)(ws + WS_ODIN + (size_t)OD_IN * DM))[i] = z;
          for (int i = gt; i < 1024 * 16; i += NGT) ((GAS v4u*)((bf16*)(ws + WS_WUKV) + (size_t)(i >> 4) * 256 + 128))[i & 15] = z; }
        if (gw < 128) { const int c = gw >> 6, e = gw & 63; const float* pe = args.in[10] + (size_t)c * 2048; const float* cw = args.in[11] + (size_t)c * 2048 * 64 + e; float a = 0.f;
            for (int k = lane; k < 2048; k += 64) a += pe[k] * cw[(size_t)k * 64];
            a = wave_sum(a); if (lane == 0) ((float*)(ws + WS_CBIAS))[gw] = a; }
        rope_table_phase((float*)(ws + WS_ROPE), vcu * (NWAVES * 64) + tid, G * NWAVES * 64);
        rows_norm_phase(x_in, nullptr, nullptr, 0.f, nullptr, nullptr, H, MTOK, gw, NGW, lane, false, 1.f, nullptr, XB, RS);
        rows_norm_phase(mem, nullptr, nullptr, 0.f, nullptr, mem_norm, (bf16*)(ws + WS_MN), MROWS, gw, NGW, lane);
        rows_norm_phase(mem, nullptr, nullptr, 0.f, nullptr, mem_norm + DM, (bf16*)(ws + WS_MN) + (size_t)MROWS * DM, MROWS, gw, NGW, lane);
        SEAM(PH_PRO);
    }
    if (IN(PH_MEMKV)) {
            PHASE_IDS
#pragma unroll 1
        for (int i = 0; i < 2; ++i) {
            pg8::Gemm g{(const bf16*)(ws + WS_MN) + (size_t)i * MROWS * DM, (const bf16*)(ws + WS_XWKV) + (size_t)i * DM * DM, MROWS, DM, DM};
            pg8::StaticOrder S; S.init(MROWS, DM, G, (bx + 128 * i) % G);
            pg8::EpiBf16P E{(bf16*)(ws + WS_KVM) + (size_t)i * MROWS * DM, DM};
            pg8::gemm_phase<pg8::EpiBf16P, pg8::StaticOrder, true, true>(lds, g, S, E, tid);
            __syncthreads();
        }
        SEAM(PH_MEMKV);
    }
    layer_phases<0>(args, lds, bar, wave, G, bx0, vcu0, lo, hi, stop);
    layer_phases<1>(args, lds, bar, wave, G, bx0, vcu0, lo, hi, stop);
#undef IN
#undef SEAM
}

#ifndef MK_MODE
#define MK_MODE 1
#endif
#ifndef MK_STOP
#define MK_STOP NPHASE
#endif
extern "C" void kernel_launch(void* const* d_in, const int* in_sizes, int n_in, void* d_out, int out_size, void* d_ws, size_t ws_size, hipStream_t stream) {
    static int grid = 0;
    if (grid == 0) {
        if (n_in != 24 || out_size != MTOK * DM || ws_size < WS_END) { fprintf(stderr, "kernel_launch: unexpected shapes: n_in %d out %d ws %zu\n", n_in, out_size, ws_size); grid = -1; return; }
        int dev = 0, cus = 0, per_cu = 0;
        if (hipGetDevice(&dev) != hipSuccess || hipDeviceGetAttribute(&cus, hipDeviceAttributeMultiprocessorCount, dev) != hipSuccess) { grid = -1; return; }
        if (hipFuncSetAttribute((const void*)fwd_kernel, hipFuncAttributeMaxDynamicSharedMemorySize, LDS_BYTES) != hipSuccess) { fprintf(stderr, "kernel_launch: hipFuncSetAttribute failed\n"); grid = -1; return; }
        if (hipOccupancyMaxActiveBlocksPerMultiprocessor(&per_cu, (const void*)fwd_kernel, NWAVES * 64, LDS_BYTES) != hipSuccess || per_cu < 1)
            fprintf(stderr, "kernel_launch: occupancy query reports %d workgroups per CU\n", per_cu);
        (void)hipGetLastError();
        grid = cus;
    }
    if (grid < 0) return;
    if (hipMemsetAsync((char*)d_ws + WS_CTL, 0, CTL_ZERO_BYTES, stream) != hipSuccess) return;
    Args a{};
    for (int i = 0; i < 24; ++i) a.in[i] = (const float*)d_in[i];
    a.out = (float*)d_out; a.ws = (unsigned char*)d_ws; a.stop = MK_STOP;
#if MK_MODE == 1
    a.ph_lo = 0; a.ph_hi = NPHASE; a.li = 0;
    hipLaunchKernelGGL(fwd_kernel, dim3(grid), dim3(NWAVES * 64), LDS_BYTES, stream, a);
#else
    for (int p = 0; p < NPHASE && p < MK_STOP; ++p) {
        a.ph_lo = p; a.ph_hi = p + 1; a.li = 0;
        hipLaunchKernelGGL(fwd_kernel, dim3(grid), dim3(NWAVES * 64), LDS_BYTES, stream, a);
#ifdef MK_REP
        { const int k = p < PH_L0 ? -1 : (p - PH_L0) % PPL, L = p < PH_L0 ? -1 : (p - PH_L0) / PPL; (void)k; (void)L;
          if (MK_REP) { a.li = 1; hipLaunchKernelGGL(fwd_kernel, dim3(grid), dim3(NWAVES * 64), LDS_BYTES, stream, a); a.li = 0; } }
#endif
    }
#endif
}
```

```cpp
#include <hip/hip_runtime.h>
#include <cstdio>
#include <cstdint>
namespace pg8 {
#define PG8_LAS __attribute__((address_space(3)))
typedef unsigned short bf16_t;
typedef short bf16x8 __attribute__((ext_vector_type(8)));
typedef float f32x4 __attribute__((ext_vector_type(4)));
typedef unsigned u32x4 __attribute__((ext_vector_type(4)));
constexpr int BM = 256, BK = 64, HALF = 128, HTB = HALF * BK * 2  , STAGE_BYTES = 8 * HTB, NXCD = 8, WGM = 8;

__host__ __device__ __forceinline__ int lds_byte(int r, int c) { const int st = (r >> 4) * 2 + (c >> 5), rr = r & 15, cc = c & 31, ob = rr * 64 + cc * 2; return st * 1024 + (ob ^ (((ob >> 9) & 1) << 5)); }
__host__ __device__ __forceinline__ void stage_rc(int b, int& R, int& C) { const int st = b / 1024, sb = b % 1024, swz = sb ^ (((sb >> 9) & 1) << 5); R = (st >> 1) * 16 + swz / 64; C = (st & 1) * 32 + (swz % 64) / 2; }
__host__ __device__ __forceinline__ int perm32(int rho) { const int n = rho >> 4, i = rho & 15; return 8 * (i >> 2) + 4 * n + (i & 3); }

struct Unit { int pm, pn; };
struct Gemm { const bf16_t* A; const bf16_t* Bt; int M, N, K; };
typedef int i32x4 __attribute__((ext_vector_type(4)));
typedef int i32x8 __attribute__((ext_vector_type(8)));
__device__ __forceinline__ i32x8 cat8(bf16x8 a, bf16x8 b) { const i32x4 x = __builtin_bit_cast(i32x4, a), y = __builtin_bit_cast(i32x4, b); return __builtin_shufflevector(x, y, 0, 1, 2, 3, 4, 5, 6, 7); }

struct StaticOrder {
    int nM, nN, nwg, G, c;
    __host__ __device__ void init(int M, int N, int G_, int c_) { nM = M / BM; nN = N / BM; nwg = nM * nN; G = G_; c = c_; }
    __host__ __device__ bool next(int i, Unit& u) const {
        const long L = (long)i * G + c; if (L >= nwg) return false;
        int wgid = (int)L; { const int q = nwg / NXCD, r = nwg % NXCD, xcd = wgid % NXCD, off = wgid / NXCD; wgid = (xcd < r ? xcd * (q + 1) : r * (q + 1) + (xcd - r) * q) + off; }
        const int nig = WGM * nN, gid = wgid / nig, fm = gid * WGM, gsz = (nM - fm) < WGM ? (nM - fm) : WGM;
        u.pm = fm + ((wgid % nig) % gsz); u.pn = (wgid % nig) / gsz; return true;
    }
    __device__ __forceinline__ void a_ready(const Unit&) const {}
    __device__ __forceinline__ void done(const Unit&) const {}
};


__device__ __forceinline__ unsigned cvt_pk_bf16(float lo, float hi) { unsigned r; asm volatile("v_cvt_pk_bf16_f32 %0, %1, %2" : "=v"(r) : "v"(lo), "v"(hi)); return r; }

struct EpiF32 {
    static constexpr bool PERM = false, AFTER_DRAIN = false;
    float* C; int ldc;
    __device__ __forceinline__ void operator()(const f32x4 (&acc)[2][2][4][2], const Unit& u, int wr, int wc, int fr, int fq) const {
        const int row0 = u.pm * BM + wr * 64 + fr, col0 = u.pn * BM + wc * 32 + 4 * fq;
#pragma unroll
        for (int ai = 0; ai < 2; ++ai)
#pragma unroll
            for (int m = 0; m < 4; ++m) { float* rowp = C + (size_t)(row0 + ai * HALF + m * 16) * ldc + col0;
#pragma unroll
                for (int bj = 0; bj < 2; ++bj)
#pragma unroll
                    for (int n = 0; n < 2; ++n) *(f32x4*)(rowp + bj * HALF + n * 16) = acc[ai][bj][m][n]; }
    }
};
struct EpiBf16P {
    static constexpr bool PERM = true, AFTER_DRAIN = false;
    bf16_t* O; int ldc;
    __device__ __forceinline__ void operator()(const f32x4 (&acc)[2][2][4][2], const Unit& u, int wr, int wc, int fr, int fq) const {
        const int row0 = u.pm * BM + wr * 64 + fr, col0 = u.pn * BM + wc * 32 + 8 * fq;
#pragma unroll
        for (int ai = 0; ai < 2; ++ai)
#pragma unroll
            for (int m = 0; m < 4; ++m) { bf16_t* rowp = O + (size_t)(row0 + ai * HALF + m * 16) * ldc + col0;
#pragma unroll
                for (int bj = 0; bj < 2; ++bj) { const f32x4 v0 = acc[ai][bj][m][0], v1 = acc[ai][bj][m][1];
                    u32x4 w; w.x = cvt_pk_bf16(v0[0], v0[1]); w.y = cvt_pk_bf16(v0[2], v0[3]); w.z = cvt_pk_bf16(v1[0], v1[1]); w.w = cvt_pk_bf16(v1[2], v1[3]);
                    *(u32x4*)(rowp + bj * HALF) = w; } }
    }
};
__device__ __forceinline__ float silu_mul(float g, float u) { return g * __builtin_amdgcn_rcpf(1.0f + __builtin_amdgcn_exp2f(g * -1.4426950408889634f)) * u; }
struct EpiSwiGLU {
    static constexpr bool PERM = true, AFTER_DRAIN = false;
    bf16_t* O; int ldc;
    __device__ __forceinline__ void operator()(const f32x4 (&acc)[2][2][4][2], const Unit& u, int wr, int wc, int fr, int fq) const {
        const int row0 = u.pm * BM + wr * 64 + fr, col0 = u.pn * HALF + wc * 32 + 8 * fq;
#pragma unroll
        for (int ai = 0; ai < 2; ++ai)
#pragma unroll
            for (int m = 0; m < 4; ++m) { bf16_t* rowp = O + (size_t)(row0 + ai * HALF + m * 16) * ldc + col0;
                const f32x4 g0 = acc[ai][0][m][0], g1 = acc[ai][0][m][1], u0 = acc[ai][1][m][0], u1 = acc[ai][1][m][1];
                u32x4 w; w.x = cvt_pk_bf16(silu_mul(g0[0], u0[0]), silu_mul(g0[1], u0[1])); w.y = cvt_pk_bf16(silu_mul(g0[2], u0[2]), silu_mul(g0[3], u0[3]));
                w.z = cvt_pk_bf16(silu_mul(g1[0], u1[0]), silu_mul(g1[1], u1[1])); w.w = cvt_pk_bf16(silu_mul(g1[2], u1[2]), silu_mul(g1[3], u1[3]));
                *(u32x4*)rowp = w; }
    }
};


__device__ __forceinline__ unsigned pk4_fp8(float a, float b, float c, float d, float S) {
    a = __builtin_amdgcn_fmed3f(a * S, -448.f, 448.f); b = __builtin_amdgcn_fmed3f(b * S, -448.f, 448.f); c = __builtin_amdgcn_fmed3f(c * S, -448.f, 448.f); d = __builtin_amdgcn_fmed3f(d * S, -448.f, 448.f);
    int p = __builtin_amdgcn_cvt_pk_fp8_f32(a, b, 0, false); p = __builtin_amdgcn_cvt_pk_fp8_f32(c, d, p, true); return (unsigned)p;
}
constexpr float F8S_H = 4.f, F8S_HID = 8.f, F8S_W = 64.f;
struct EpiSwiGLU8 {
    static constexpr bool PERM = true, AFTER_DRAIN = false;
    unsigned char* O; int ldc;
    __device__ __forceinline__ static uint2 hid8(const f32x4 g0, const f32x4 g1, const f32x4 u0, const f32x4 u1) {
        constexpr float GS = 1.f / (F8S_W * F8S_H), C1 = -1.4426950408889634f * GS, C2 = GS * GS * F8S_HID;
        const f32x4 t0 = g0 * C1, t1 = g1 * C1;
        f32x4 e0, e1;
#pragma unroll
        for (int i = 0; i < 4; ++i) { e0[i] = __builtin_amdgcn_rcpf(1.0f + __builtin_amdgcn_exp2f(t0[i])); e1[i] = __builtin_amdgcn_rcpf(1.0f + __builtin_amdgcn_exp2f(t1[i])); }
        const f32x4 h0 = (g0 * e0) * (u0 * C2), h1 = (g1 * e1) * (u1 * C2);
        uint2 w; w.x = pk4_fp8(h0[0], h0[1], h0[2], h0[3], 1.f); w.y = pk4_fp8(h1[0], h1[1], h1[2], h1[3], 1.f); return w;
    }
    __device__ __forceinline__ void operator()(const f32x4 (&acc)[2][2][4][2], const Unit& u, int wr, int wc, int fr, int fq) const {
        const int row0 = u.pm * BM + wr * 64 + fr, col0 = u.pn * HALF + wc * 32 + 8 * fq, odd = fq & 1;
#pragma unroll
        for (int ai = 0; ai < 2; ++ai)
#pragma unroll
            for (int m = 0; m < 4; m += 2) {
                uint2 a = hid8(acc[ai][0][m][0], acc[ai][0][m][1], acc[ai][1][m][0], acc[ai][1][m][1]);
                uint2 b = hid8(acc[ai][0][m + 1][0], acc[ai][0][m + 1][1], acc[ai][1][m + 1][0], acc[ai][1][m + 1][1]);
                { auto r = __builtin_amdgcn_permlane16_swap(a.x, b.x, false, false); a.x = r[0]; b.x = r[1]; }
                { auto r = __builtin_amdgcn_permlane16_swap(a.y, b.y, false, false); a.y = r[0]; b.y = r[1]; }
                unsigned char* rowp = O + (size_t)(row0 + ai * HALF + (m + odd) * 16) * ldc + col0 - 8 * odd;
                *(uint4*)rowp = make_uint4(a.x, a.y, b.x, b.y); }
    }
};
struct EpiBf16PS {
    static constexpr bool PERM = true, AFTER_DRAIN = false;
    bf16_t* O; int ldc; float sc;
    __device__ __forceinline__ void operator()(const f32x4 (&acc)[2][2][4][2], const Unit& u, int wr, int wc, int fr, int fq) const {
        const int row0 = u.pm * BM + wr * 64 + fr, col0 = u.pn * BM + wc * 32 + 8 * fq;
#pragma unroll
        for (int ai = 0; ai < 2; ++ai)
#pragma unroll
            for (int m = 0; m < 4; ++m) { bf16_t* rowp = O + (size_t)(row0 + ai * HALF + m * 16) * ldc + col0;
#pragma unroll
                for (int bj = 0; bj < 2; ++bj) { const f32x4 v0 = acc[ai][bj][m][0] * sc, v1 = acc[ai][bj][m][1] * sc;
                    u32x4 w; w.x = cvt_pk_bf16(v0[0], v0[1]); w.y = cvt_pk_bf16(v0[2], v0[3]); w.z = cvt_pk_bf16(v1[0], v1[1]); w.w = cvt_pk_bf16(v1[2], v1[3]);
                    *(u32x4*)(rowp + bj * HALF) = w; } }
    }
};
struct EpiBf16PR {
    static constexpr bool PERM = true, AFTER_DRAIN = false;
    bf16_t* O; int ldc; const float* R;
    __device__ __forceinline__ void operator()(const f32x4 (&acc)[2][2][4][2], const Unit& u, int wr, int wc, int fr, int fq) const {
        const int row0 = u.pm * BM + wr * 64 + fr, col0 = u.pn * BM + wc * 32 + 8 * fq;
        float rs[2][4];
#pragma unroll
        for (int ai = 0; ai < 2; ++ai)
#pragma unroll
            for (int m = 0; m < 4; ++m) rs[ai][m] = R[row0 + ai * HALF + m * 16];
#pragma unroll
        for (int ai = 0; ai < 2; ++ai)
#pragma unroll
            for (int m = 0; m < 4; ++m) { bf16_t* rowp = O + (size_t)(row0 + ai * HALF + m * 16) * ldc + col0;
#pragma unroll
                for (int bj = 0; bj < 2; ++bj) { const f32x4 v0 = acc[ai][bj][m][0] * rs[ai][m], v1 = acc[ai][bj][m][1] * rs[ai][m];
                    u32x4 w; w.x = cvt_pk_bf16(v0[0], v0[1]); w.y = cvt_pk_bf16(v0[2], v0[3]); w.z = cvt_pk_bf16(v1[0], v1[1]); w.w = cvt_pk_bf16(v1[2], v1[3]);
                    *(u32x4*)(rowp + bj * HALF) = w; } }
    }
};
struct EpiSwiGLUR {
    static constexpr bool PERM = true, AFTER_DRAIN = false;
    bf16_t* O; int ldc; const float* R;
    __device__ __forceinline__ void operator()(const f32x4 (&acc)[2][2][4][2], const Unit& u, int wr, int wc, int fr, int fq) const {
        const int row0 = u.pm * BM + wr * 64 + fr, col0 = u.pn * HALF + wc * 32 + 8 * fq;
        float rs[2][4];
#pragma unroll
        for (int ai = 0; ai < 2; ++ai)
#pragma unroll
            for (int m = 0; m < 4; ++m) rs[ai][m] = R[row0 + ai * HALF + m * 16];
#pragma unroll
        for (int ai = 0; ai < 2; ++ai)
#pragma unroll
            for (int m = 0; m < 4; ++m) { bf16_t* rowp = O + (size_t)(row0 + ai * HALF + m * 16) * ldc + col0;
                const f32x4 g0 = acc[ai][0][m][0] * rs[ai][m], g1 = acc[ai][0][m][1] * rs[ai][m], u0 = acc[ai][1][m][0] * rs[ai][m], u1 = acc[ai][1][m][1] * rs[ai][m];
                u32x4 w; w.x = cvt_pk_bf16(silu_mul(g0[0], u0[0]), silu_mul(g0[1], u0[1])); w.y = cvt_pk_bf16(silu_mul(g0[2], u0[2]), silu_mul(g0[3], u0[3]));
                w.z = cvt_pk_bf16(silu_mul(g1[0], u1[0]), silu_mul(g1[1], u1[1])); w.w = cvt_pk_bf16(silu_mul(g1[2], u1[2]), silu_mul(g1[3], u1[3]));
                *(u32x4*)rowp = w; }
    }
};
template <class Epi, class Sched, bool ALIGN_EPI = false, bool SP2 = false, bool F8 = false>
__device__ __forceinline__ void gemm_phase(PG8_LAS unsigned char* lds, const Gemm g, const Sched& S, const Epi& E, int tid_in) {
    int tid_l = tid_in; asm volatile("" : "+v"(tid_l));
    const int tid = tid_l, wid = __builtin_amdgcn_readfirstlane(tid >> 6), lane = tid & 63, wr = wid >> 2, wc = wid & 3, fr = lane & 15, fq = lane >> 4;
    const int K = F8 ? g.K / 2 : g.K, nt = K / BK;
    unsigned voffA[2], voffB[2];
#pragma unroll
    for (int i = 0; i < 2; ++i) { int R, C; stage_rc(tid * 16 + i * 8192, R, C); const int Rb = Epi::PERM ? ((R & ~31) + perm32(R & 31)) : R;
        voffA[i] = (unsigned)(R * K + C) * 2u; voffB[i] = (unsigned)(Rb * K + C) * 2u; }
    const size_t kstep = (size_t)(BK * 2);
    const size_t hstep = (size_t)HALF * K * 2;
    const size_t tstep = 2 * hstep;
    const unsigned ldsw = (unsigned)wid * 1024u;
    const int aoff = lds_byte(wr * 64 + fr, fq * 8), boff = lds_byte(wc * 32 + fr, fq * 8);
#define PG8_SA(b, h) (((b) * 2 + (h)) * HTB)
#define PG8_SB(b, h) ((4 + (b) * 2 + (h)) * HTB)
#define PG8_STAGE(bufoff, gbase, voff) do { const char* _gb = (const char*)(gbase); if constexpr (F8) asm volatile("" : "+s"(_gb));     \
        _Pragma("unroll") for (int _i = 0; _i < 2; ++_i) \
        __builtin_amdgcn_global_load_lds((const unsigned*)(_gb + (voff)[_i]), (PG8_LAS unsigned*)(lds + (bufoff) + ldsw + _i * 8192), 16, 0, 0); } while (0)
#define PG8_LDA(dst, b, h) do { _Pragma("unroll") for (int m = 0; m < 4; ++m) _Pragma("unroll") for (int k = 0; k < 2; ++k) dst[m][k] = *(const PG8_LAS bf16x8*)(lds + PG8_SA(b, h) + aoff + m * 2048 + k * 1024); } while (0)
#define PG8_LDB(dst, b, h) do { _Pragma("unroll") for (int n = 0; n < 2; ++n) _Pragma("unroll") for (int k = 0; k < 2; ++k) dst[n][k] = *(const PG8_LAS bf16x8*)(lds + PG8_SB(b, h) + boff + n * 2048 + k * 1024); } while (0)
#define PG8_MMA(ai, bj, At, Bt) do { __builtin_amdgcn_s_setprio(1); _Pragma("unroll") for (int m = 0; m < 4; ++m) _Pragma("unroll") for (int n = 0; n < 2; ++n) _Pragma("unroll") for (int k = 0; k < 2; ++k) \
        acc[ai][bj][m][n] = __builtin_amdgcn_mfma_f32_16x16x32_bf16(Bt[n][k], At[m][k], acc[ai][bj][m][n], 0, 0, 0); __builtin_amdgcn_s_setprio(0); } while (0)
#define PG8_MMA8(ai, bj, At, Bt) do { __builtin_amdgcn_s_setprio(1); _Pragma("unroll") for (int m = 0; m < 4; ++m) _Pragma("unroll") for (int n = 0; n < 2; ++n) \
        acc[ai][bj][m][n] = __builtin_amdgcn_mfma_scale_f32_16x16x128_f8f6f4(cat8(Bt[n][0], Bt[n][1]), cat8(At[m][0], At[m][1]), acc[ai][bj][m][n], 0, 0, 0, 0, 0, 0); __builtin_amdgcn_s_setprio(0); } while (0)
#define PG8_MM(ai, bj, At, Bt) do { if constexpr (F8) PG8_MMA8(ai, bj, At, Bt); else PG8_MMA(ai, bj, At, Bt); } while (0)
#define PG8_WAIT_V(n) asm volatile("s_waitcnt vmcnt(" #n ")" ::: "memory")
#define PG8_WAIT_L(n) asm volatile("s_waitcnt lgkmcnt(" #n ")" ::: "memory")
#define PG8_BAR __builtin_amdgcn_s_barrier()
#define PG8_SCHED __builtin_amdgcn_sched_barrier(0)
    Unit cur, nxt; int ui = 0;
    if (!S.next(0, cur)) return;
    f32x4 acc[2][2][4][2];
#pragma unroll
    for (int a = 0; a < 2; ++a)
#pragma unroll
        for (int b = 0; b < 2; ++b)
#pragma unroll
            for (int m = 0; m < 4; ++m)
#pragma unroll
                for (int n = 0; n < 2; ++n) acc[a][b][m][n] = (f32x4){0.f, 0.f, 0.f, 0.f};
    bf16x8 At[4][2], B0[2][2], B1[2][2];
    const char* cA = (const char*)g.A + (size_t)cur.pm * tstep; const char* cB = (const char*)g.Bt + (size_t)cur.pn * tstep;
    S.a_ready(cur);
    if constexpr (SP2) {
        PG8_STAGE(PG8_SB(0, 0), cB, voffB); PG8_STAGE(PG8_SB(0, 1), cB + hstep, voffB); PG8_STAGE(PG8_SA(0, 0), cA, voffA); PG8_STAGE(PG8_SA(0, 1), cA + hstep, voffA);
        if (wr == 1) PG8_BAR;
        PG8_WAIT_V(2); PG8_BAR;
        PG8_STAGE(PG8_SB(1, 0), cB + kstep, voffB); PG8_STAGE(PG8_SA(1, 0), cA + kstep, voffA); PG8_STAGE(PG8_SB(1, 1), cB + hstep + kstep, voffB);
        PG8_WAIT_V(6); PG8_BAR;
    } else {
        PG8_STAGE(PG8_SB(0, 0), cB, voffB); PG8_STAGE(PG8_SA(0, 0), cA, voffA); PG8_STAGE(PG8_SB(0, 1), cB + hstep, voffB); PG8_STAGE(PG8_SA(0, 1), cA + hstep, voffA);
        if (wr == 1) PG8_BAR;
        PG8_WAIT_V(4); PG8_BAR;
        PG8_STAGE(PG8_SB(1, 0), cB + kstep, voffB); PG8_STAGE(PG8_SA(1, 0), cA + kstep, voffA); PG8_STAGE(PG8_SB(1, 1), cB + hstep + kstep, voffB);
        PG8_WAIT_V(6); PG8_BAR;
    }
    for (;;) {
        const bool has_next = S.next(ui + 1, nxt);
        const char* nA = has_next ? (const char*)g.A + (size_t)nxt.pm * tstep : cA; const char* nB = has_next ? (const char*)g.Bt + (size_t)nxt.pn * tstep : cB;
#pragma unroll 1
        for (int t = 0; t < nt; t += 2) {
            const bool last = (t == nt - 2);
            const char* a1 = cA + (size_t)(t + 1) * kstep;
            const char* a2 = last ? nA : cA + (size_t)(t + 2) * kstep; const char* b2 = last ? nB : cB + (size_t)(t + 2) * kstep;
            const char* a3 = a2 + kstep; const char* b3 = b2 + kstep;
            if (last && has_next) S.a_ready(nxt);
            if constexpr (SP2) {
            PG8_LDB(B0, 0, 0); PG8_LDB(B1, 0, 1); PG8_SCHED; PG8_LDA(At, 0, 0); PG8_STAGE(PG8_SA(1, 1), a1 + hstep, voffA);
            PG8_WAIT_V(8); PG8_WAIT_L(0); PG8_BAR; PG8_MM(0, 0, At, B0); PG8_MM(0, 1, At, B1); PG8_BAR; PG8_SCHED;
            PG8_LDA(At, 0, 1); PG8_STAGE(PG8_SB(0, 0), b2, voffB); PG8_STAGE(PG8_SB(0, 1), b2 + hstep, voffB); PG8_STAGE(PG8_SA(0, 0), a2, voffA);
            PG8_WAIT_V(8); PG8_WAIT_L(0); PG8_BAR; PG8_MM(1, 0, At, B0); PG8_MM(1, 1, At, B1); PG8_BAR; PG8_SCHED;
            PG8_LDB(B0, 1, 0); PG8_LDB(B1, 1, 1); PG8_SCHED; PG8_LDA(At, 1, 0); PG8_STAGE(PG8_SA(0, 1), a2 + hstep, voffA);
            PG8_WAIT_V(8); PG8_WAIT_L(0); PG8_BAR; PG8_MM(0, 0, At, B0); PG8_MM(0, 1, At, B1); PG8_BAR; PG8_SCHED;
            PG8_LDA(At, 1, 1); PG8_STAGE(PG8_SB(1, 0), b3, voffB); PG8_STAGE(PG8_SB(1, 1), b3 + hstep, voffB); PG8_STAGE(PG8_SA(1, 0), a3, voffA);
            PG8_WAIT_V(8); PG8_WAIT_L(0); PG8_BAR; PG8_MM(1, 0, At, B0); PG8_MM(1, 1, At, B1); PG8_BAR; PG8_SCHED;
            } else {
            PG8_LDB(B0, 0, 0); PG8_SCHED; PG8_LDA(At, 0, 0); PG8_STAGE(PG8_SA(1, 1), a1 + hstep, voffA);
            PG8_WAIT_L(8); PG8_BAR; PG8_WAIT_L(0); PG8_MM(0, 0, At, B0); PG8_BAR; PG8_SCHED;
            PG8_LDB(B1, 0, 1); PG8_STAGE(PG8_SB(0, 0), b2, voffB);
            PG8_BAR; PG8_WAIT_L(0); PG8_MM(0, 1, At, B1); PG8_BAR;
            PG8_LDA(At, 0, 1); PG8_STAGE(PG8_SA(0, 0), a2, voffA);
            PG8_BAR; PG8_WAIT_L(0); PG8_MM(1, 0, At, B0); PG8_BAR; PG8_SCHED;
            PG8_STAGE(PG8_SB(0, 1), b2 + hstep, voffB);
            PG8_WAIT_V(6); PG8_BAR; PG8_MM(1, 1, At, B1); PG8_BAR;
            PG8_LDB(B0, 1, 0); PG8_SCHED; PG8_LDA(At, 1, 0); PG8_STAGE(PG8_SA(0, 1), a2 + hstep, voffA);
            PG8_WAIT_L(8); PG8_BAR; PG8_WAIT_L(0); PG8_MM(0, 0, At, B0); PG8_BAR; PG8_SCHED;
            PG8_LDB(B1, 1, 1); PG8_STAGE(PG8_SB(1, 0), b3, voffB);
            PG8_BAR; PG8_WAIT_L(0); PG8_MM(0, 1, At, B1); PG8_BAR;
            PG8_LDA(At, 1, 1); PG8_STAGE(PG8_SA(1, 0), a3, voffA);
            PG8_BAR; PG8_WAIT_L(0); PG8_MM(1, 0, At, B0); PG8_BAR; PG8_SCHED;
            PG8_STAGE(PG8_SB(1, 1), b3 + hstep, voffB);
            PG8_WAIT_V(6); PG8_BAR; PG8_MM(1, 1, At, B1); PG8_BAR;
            }
        }
        if constexpr (ALIGN_EPI) { if (wr == 0) PG8_BAR; }
        if constexpr (!Epi::AFTER_DRAIN) {
            if constexpr (F8) { int l2; asm volatile("v_mbcnt_lo_u32_b32 %0, -1, 0\n\tv_mbcnt_hi_u32_b32 %0, -1, %0" : "=v"(l2)); E(acc, cur, wr, wc, l2 & 15, l2 >> 4); }
            else E(acc, cur, wr, wc, fr, fq);
            S.done(cur); }
        if (!has_next) break;
#pragma unroll
        for (int a = 0; a < 2; ++a)
#pragma unroll
            for (int b = 0; b < 2; ++b)
#pragma unroll
                for (int m = 0; m < 4; ++m)
#pragma unroll
                    for (int n = 0; n < 2; ++n) acc[a][b][m][n] = (f32x4){0.f, 0.f, 0.f, 0.f};
        cur = nxt; cA = nA; cB = nB; ++ui;
        if constexpr (ALIGN_EPI) { if (wr == 1) PG8_BAR; }
    }
    PG8_WAIT_V(0);
    if constexpr (!ALIGN_EPI) { if (wr == 0) PG8_BAR; }
    PG8_BAR;
    if constexpr (Epi::AFTER_DRAIN) { E.fused(acc, cur, wr, wc, fr, fq, lds, wid, lane); S.done(cur); }
#undef PG8_SA
#undef PG8_SB
#undef PG8_STAGE
#undef PG8_LDA
#undef PG8_LDB
#undef PG8_MMA
#undef PG8_MMA8
#undef PG8_MM
#undef PG8_WAIT_V
#undef PG8_WAIT_L
#undef PG8_BAR
#undef PG8_SCHED
}
}

constexpr int DM = 1024, NB = 16, SEQ = 4096, MTOK = NB * SEQ, DFF = 2816, MEML = 256, MROWS = NB * MEML;
constexpr int EV_IN = 2240, EV_INP = 2304, OD_IN = 1952, OD_INP = 2048;
constexpr float RMS_EPS = 1e-6f;
constexpr int NWAVES = 8;

constexpr size_t MiB = 1u << 20;
constexpr size_t WS_CTL = 0, CTL_ZERO_BYTES = 1 * MiB;
constexpr size_t WS_WGU = 2 * MiB;
constexpr size_t WS_WD = 46 * MiB;
constexpr size_t WS_EVIN = 68 * MiB;
constexpr size_t WS_EVOUT = 73 * MiB;
constexpr size_t WS_ODIN = 75 * MiB;
constexpr size_t WS_ODOUT = 79 * MiB;
constexpr size_t WS_WUQ = 81 * MiB;
constexpr size_t WS_WUKV = 82 * MiB;
constexpr size_t WS_XWQ = 83 * MiB;
constexpr size_t WS_XWKV = 85 * MiB;
constexpr size_t WS_XWO = 89 * MiB;
constexpr size_t WS_MN = 92 * MiB;
constexpr size_t WS_KVM = 108 * MiB;
constexpr size_t WS_VMT = 124 * MiB;
constexpr size_t WS_H = 132 * MiB;
constexpr size_t WS_Y = 260 * MiB;
constexpr size_t WS_OV = 516 * MiB;
constexpr size_t WS_END = 1024 * MiB;
constexpr size_t WS_HID = WS_OV;
constexpr size_t WS_XQ = WS_OV;

constexpr int CW_BAR = 4096;
constexpr int RING_BYTES = 131072, LDSCTL_OFF = RING_BYTES, MISC_OFF = LDSCTL_OFF + 320, LDS_BYTES = 147456;

#define GAS __attribute__((address_space(1)))
#define LAS __attribute__((address_space(3)))
typedef unsigned short bf16;
typedef unsigned v4u __attribute__((ext_vector_type(4)));
typedef unsigned v2u __attribute__((ext_vector_type(2)));
typedef float f32x4 __attribute__((ext_vector_type(4)));
typedef short bf16x8 __attribute__((ext_vector_type(8)));
#define LDS_WAIT() asm volatile("s_waitcnt lgkmcnt(0)" ::: "memory")
#define VM_WAIT() asm volatile("s_waitcnt vmcnt(0)" ::: "memory")
__device__ __forceinline__ unsigned f2bf(float f) { unsigned u = __builtin_bit_cast(unsigned, f); return (u + 0x7fffu + ((u >> 16) & 1u)) >> 16; }
__device__ __forceinline__ unsigned pk2(float lo, float hi) { return f2bf(lo) | (f2bf(hi) << 16); }
__device__ __forceinline__ float bf2f(unsigned short b) { return __builtin_bit_cast(float, (unsigned)b << 16); }
template <int K> __device__ __forceinline__ unsigned lx_u(unsigned v) {
    if constexpr (K == 32) { auto rr = __builtin_amdgcn_permlane32_swap(v, v, false, false); return rr[0] ^ rr[1] ^ v; }
    else return (unsigned)__builtin_amdgcn_ds_swizzle((int)v, (K << 10) | 0x1f);
}
template <int K> __device__ __forceinline__ float lx_f(float v) { return __uint_as_float(lx_u<K>(__float_as_uint(v))); }
__device__ __forceinline__ float wave_sum(float v) {
    v += lx_f<1>(v); v += lx_f<2>(v); v += lx_f<4>(v); v += lx_f<8>(v); v += lx_f<16>(v); v += lx_f<32>(v);
    return v;
}
__device__ __forceinline__ float fmx(float a, float b) { return __builtin_elementwise_maximum(a, b); }
__device__ __forceinline__ float fmx3(float a, float b, float c) { return __builtin_elementwise_maximum(__builtin_elementwise_maximum(a, b), c); }
__device__ __forceinline__ float fmn(float a, float b) { return __builtin_elementwise_minimum(a, b); }

#define XB_TMO      128
#define XB_XCNT(j)  (256  + 64 * (j))
#define XB_XSUB(j)  (1280 + 64 * (j))
#define XB_XGEN(j)  (2304 + 64 * (j))
#define XB_TOP      3328
#define XB_TOPGEN   3392
#define XCD_BAR_WORDS 3456
#define XB_SPIN_CAP (1u << 18)

__device__ __forceinline__ unsigned xb_ld(unsigned* p)              { return __hip_atomic_load(p, __ATOMIC_RELAXED, __HIP_MEMORY_SCOPE_AGENT); }
__device__ __forceinline__ unsigned xb_add(unsigned* p, unsigned v) { return __hip_atomic_fetch_add(p, v, __ATOMIC_RELAXED, __HIP_MEMORY_SCOPE_AGENT); }
__device__ __forceinline__ unsigned xb_xcc_id() { return (unsigned)__builtin_amdgcn_s_getreg((3 << 11) | 20) & 0xFu; }
#define XB_SPIN(cond, bar) do { unsigned _sp = 0; while (cond) { __builtin_amdgcn_s_sleep(1); \
    if ((++_sp & 255u) == 0u) { if (xb_ld(&(bar)[XB_TMO])) break; if (_sp > XB_SPIN_CAP) { atomicAdd(&(bar)[XB_TMO], 1u); break; } } } } while (0)

struct XcdBarrier {
    unsigned* bar; unsigned x;
    unsigned w0;
    volatile LAS unsigned* st;
};

__device__ __forceinline__ XcdBarrier xcd_barrier_post(unsigned* bar, volatile LAS unsigned* st) {
    XcdBarrier b; b.bar = bar; b.x = xb_xcc_id(); b.st = st; b.w0 = (unsigned)__builtin_amdgcn_readfirstlane((threadIdx.x >> 6) == 0 ? 1 : 0);
    if (threadIdx.x == 0) (void)xb_add(&bar[XB_XCNT(b.x)], 1u);
    return b;
}
__device__ __forceinline__ void xcd_barrier_complete(unsigned* bar, unsigned x, unsigned& nloc, unsigned& nx) {
    const unsigned G = gridDim.x * gridDim.y * gridDim.z;
    unsigned sum, cnt, mine, sp = 0u;
    for (;;) {
        sum = 0u; cnt = 0u; mine = 0u;
#pragma unroll
        for (unsigned j = 0; j < 16; ++j) { const unsigned c = xb_ld(&bar[XB_XCNT(j)]); sum += c; cnt += (c > 0u) ? 1u : 0u; mine = (j == x) ? c : mine; }
        if (sum == G) break;
        __builtin_amdgcn_s_sleep(1);
        if ((++sp & 255u) == 0u) { if (xb_ld(&bar[XB_TMO])) break; if (sp > XB_SPIN_CAP) { atomicAdd(&bar[XB_TMO], 1u); break; } }
    }
    nloc = mine > 0u ? mine : 1u; nx = cnt > 0u ? cnt : 1u;
}

__device__ __forceinline__ void xcd_barrier(const XcdBarrier& b) {
    asm volatile("s_waitcnt vmcnt(0)" ::: "memory");
    __syncthreads();
    unsigned xb_lane; asm volatile("v_mbcnt_lo_u32_b32 %0, -1, 0\n\tv_mbcnt_hi_u32_b32 %0, -1, %0" : "=v"(xb_lane));
    if (b.w0 != 0u && xb_lane == 0u) {
        unsigned* bar = b.bar;
        __builtin_amdgcn_s_waitcnt(0);
        unsigned nloc = b.st[0], nx = b.st[1];
        if (nloc == 0u) { xcd_barrier_complete(bar, b.x, nloc, nx); b.st[0] = nloc; b.st[1] = nx; }
        const unsigned old = xb_add(&bar[XB_XSUB(b.x)], 1u);
        const unsigned gen = old / nloc;
        if (old + 1u == (gen + 1u) * nloc) {
            __builtin_amdgcn_fence(__ATOMIC_RELEASE, "agent");
            asm volatile("s_waitcnt vmcnt(0)" ::: "memory");
            const unsigned og = xb_add(&bar[XB_TOP], 1u);
            const unsigned tg = og / nx;
            if (og + 1u == (tg + 1u) * nx) xb_add(&bar[XB_TOPGEN], 1u);
            else XB_SPIN(xb_ld(&bar[XB_TOPGEN]) == tg, bar);
            __builtin_amdgcn_fence(__ATOMIC_ACQUIRE, "agent");
            xb_add(&bar[XB_XGEN(b.x)], 1u);
            asm volatile("s_waitcnt vmcnt(0)" ::: "memory");
        } else {
            XB_SPIN(xb_ld(&bar[XB_XGEN(b.x)]) == gen, bar);
            __builtin_amdgcn_fence(__ATOMIC_ACQUIRE, "agent");
            asm volatile("s_waitcnt vmcnt(0)" ::: "memory");
        }
    }
    __syncthreads();
}


typedef float f32x16 __attribute__((ext_vector_type(16)));
typedef short s16x4 __attribute__((ext_vector_type(4)));
constexpr float NEGBIG = -1e30f, LOG2E = 1.4426950408889634f;
constexpr int KP128 = 272, KBUF_BYTES = 64 * KP128, VBUF_BYTES = 64 * 320;
constexpr int AT_KBUF = 0, AT_VBUF = 2 * KBUF_BYTES, AT_BT = AT_VBUF + 2 * VBUF_BYTES, BT_STRIDE = 132, AT_WS = AT_BT + 20 * BT_STRIDE * 4, AT_WS_PER_WAVE = 4096;
static_assert(AT_WS + 8 * AT_WS_PER_WAVE <= RING_BYTES, "attention LDS map");
__device__ __forceinline__ int crow(int r, int hi) { return (r & 3) + 8 * (r >> 2) + 4 * hi; }
typedef float f32x2_t __attribute__((ext_vector_type(2))); typedef __bf16 bf16x2_t __attribute__((ext_vector_type(2)));
__device__ __forceinline__ unsigned cvtpk(float lo, float hi) { f32x2_t v = {lo, hi}; bf16x2_t b = __builtin_convertvector(v, bf16x2_t); return __builtin_bit_cast(unsigned, b); }
typedef float f32x8_t __attribute__((ext_vector_type(8)));
typedef float f32x2_t __attribute__((ext_vector_type(2)));
__device__ __forceinline__ float vsum32(const f32x16 (&s)[2]) {
    const f32x16 a = s[0] + s[1]; const f32x8_t b = a.lo + a.hi; const f32x4 c = b.lo + b.hi; const f32x2_t d = c.lo + c.hi; return d.x + d.y;
}
__device__ __forceinline__ float swapmax(float v) { auto rr = __builtin_amdgcn_permlane32_swap(__float_as_uint(v), __float_as_uint(v), false, false); return fmx(__uint_as_float(rr[0]), __uint_as_float(rr[1])); }
__device__ __forceinline__ float swapsum(float v) { auto rr = __builtin_amdgcn_permlane32_swap(__float_as_uint(v), __float_as_uint(v), false, false); return __uint_as_float(rr[0]) + __uint_as_float(rr[1]); }
__device__ __forceinline__ float swapget(float v) { return lx_f<32>(v); }

struct KVSrc {
    const bf16* ka; int kpa;
    const bf16* kb; int kpb;
    const bf16* v; int vp;
};
template <int DQK, int KA, int DV> struct Stage {
    static constexpr int CPR = DQK / 8, NKC = 64 * CPR, NKI = (NKC + 511) / 512, CPV = DV / 8, NVC = 64 * CPV, NVI = (NVC + 511) / 512, KP = DQK * 2 + 16, VP = (DV == 64 ? 192 : 320);
    v4u k[NKI]; v4u v[NVI];
    __device__ __forceinline__ void load(const KVSrc& s, int kt, int tid) {
#pragma unroll
        for (int i = 0; i < NKI; ++i) { const int c = tid + 512 * i; if (NKC % 512 == 0 || c < NKC) { const int row = c / CPR, cc = c % CPR;
            const bf16* p = (KA == DQK || cc < KA / 8) ? s.ka + (size_t)(64 * kt + row) * s.kpa + 8 * cc : s.kb + (size_t)(64 * kt + row) * s.kpb + 8 * (cc - KA / 8);
            k[i] = *(const GAS v4u*)p; } }
#pragma unroll
        for (int i = 0; i < NVI; ++i) { const int c = tid + 512 * i; if (NVC % 512 == 0 || c < NVC) { const int row = c / CPV, cc = c % CPV;
            v[i] = *(const GAS v4u*)(s.v + (size_t)(64 * kt + row) * s.vp + 8 * cc); } }
    }
    __device__ __forceinline__ void store(LAS unsigned char* lds, int buf, int tid) const {
#pragma unroll
        for (int i = 0; i < NKI; ++i) { const int c = tid + 512 * i; if (NKC % 512 == 0 || c < NKC) { const int row = c / CPR, cc = c % CPR;
            *(LAS v4u*)(lds + AT_KBUF + buf * KBUF_BYTES + row * KP + 16 * cc) = k[i]; } }
#pragma unroll
        for (int i = 0; i < NVI; ++i) { const int c = tid + 512 * i; if (NVC % 512 == 0 || c < NVC) { const int row = c / CPV, cc = c % CPV;
            *(LAS v4u*)(lds + AT_VBUF + buf * VBUF_BYTES + row * VP + 16 * cc) = v[i]; } }
    }
};
template <int DQK, int GR = 0> __device__ __forceinline__ void qk_tile(const LAS unsigned char* kbuf, const bf16x8 (&qf)[DQK / 16], f32x16 (&s)[2], int lane, const f32x16 c0 = (f32x16){}) {
    constexpr int KP = DQK * 2 + 16, ND = DQK / 16, G = GR ? GR : 2;
    const int r32 = lane & 31, hi = lane >> 5;
    s[0] = c0; s[1] = c0;
#pragma unroll
    for (int g = 0; g < ND / G; ++g) {
        bf16x8 kf[2][G];
#pragma unroll
        for (int d = 0; d < G; ++d)
#pragma unroll
            for (int st = 0; st < 2; ++st) kf[st][d] = *(const LAS bf16x8*)(kbuf + (32 * st + r32) * KP + 32 * (g * G + d) + 16 * hi);
        __builtin_amdgcn_sched_barrier(0);
#pragma unroll
        for (int d = 0; d < G; ++d)
#pragma unroll
            for (int st = 0; st < 2; ++st) s[st] = __builtin_amdgcn_mfma_f32_32x32x16_bf16(kf[st][d], qf[g * G + d], s[st], 0, 0, 0);
    }
}
__device__ __forceinline__ float softmax_tile(f32x16 (&s)[2], float& m, float& l) {
    float mx = NEGBIG;
#pragma unroll
    for (int r = 0; r < 16; ++r) mx = fmx3(mx, s[0][r], s[1][r]);
    mx = swapmax(mx);
    const float mn = fmx(m, mx), alpha = __builtin_amdgcn_exp2f(m - mn), ms = fmx(mn, -1e29f);
    m = mn; { const float nms = -ms; s[0] = s[0] + nms; s[1] = s[1] + nms; }
#pragma unroll
    for (int st = 0; st < 2; ++st)
#pragma unroll
        for (int r = 0; r < 16; ++r) s[st][r] = __builtin_amdgcn_exp2f(s[st][r]);
    const float rs = vsum32(s);
    l = l * alpha + rs;
    return alpha;
}
struct VFrag { bf16x8 f[2][4]; };
typedef short v4i16_t __attribute__((ext_vector_type(4)));
template <int VP> __device__ __forceinline__ void pv_load(const LAS unsigned char* vbuf, int dp, VFrag& v, int lane) {
    const int g = lane >> 4, q = (lane & 15) >> 2, p = lane & 3;
    const LAS unsigned char* base = vbuf + (4 * (g >> 1) + q) * VP + (16 * (g & 1) + 4 * p) * 2;
#pragma unroll
    for (int k = 0; k < 4; ++k)
#pragma unroll
        for (int d2 = 0; d2 < 2; ++d2) {
            const v4i16_t lo = __builtin_amdgcn_ds_read_tr16_b64_v4i16((LAS v4i16_t*)(base + (16 * k) * VP + 64 * (2 * dp + d2)));
            const v4i16_t hh = __builtin_amdgcn_ds_read_tr16_b64_v4i16((LAS v4i16_t*)(base + (16 * k + 8) * VP + 64 * (2 * dp + d2)));
            v.f[d2][k] = (bf16x8){lo[0], lo[1], lo[2], lo[3], hh[0], hh[1], hh[2], hh[3]}; }
}
__device__ __forceinline__ void p_pack(const f32x16 (&p)[2], bf16x8 (&pf)[4]) {
#pragma unroll
    for (int k = 0; k < 4; ++k) { const int st = k >> 1, s = k & 1; v4u w; w.x = cvtpk(p[st][8 * s + 0], p[st][8 * s + 1]); w.y = cvtpk(p[st][8 * s + 2], p[st][8 * s + 3]); w.z = cvtpk(p[st][8 * s + 4], p[st][8 * s + 5]); w.w = cvtpk(p[st][8 * s + 6], p[st][8 * s + 7]);
        pf[k] = __builtin_bit_cast(bf16x8, w); }
}
__device__ __forceinline__ void pv_mma(const VFrag& v, const bf16x8 (&pf)[4], f32x16& o0, f32x16& o1) {
#pragma unroll
    for (int k = 0; k < 4; ++k) { o0 = __builtin_amdgcn_mfma_f32_32x32x16_bf16(v.f[0][k], pf[k], o0, 0, 0, 0); o1 = __builtin_amdgcn_mfma_f32_32x32x16_bf16(v.f[1][k], pf[k], o1, 0, 0, 0); }
}
template <int DV> __device__ __forceinline__ void pv_tile(const LAS unsigned char* vbuf, const f32x16 (&p)[2], f32x16 (&o)[DV / 32], int lane) {
    bf16x8 pf[4]; p_pack(p, pf);
#pragma unroll
    for (int dp = 0; dp < DV / 64; ++dp) { VFrag v; pv_load<(DV == 64 ? 192 : 320)>(vbuf, dp, v, lane); __builtin_amdgcn_sched_barrier(0); pv_mma(v, pf, o[2 * dp], o[2 * dp + 1]); }
}
constexpr float DEFER_THR = 8.0f;
struct SmState { float mhat, l; bool started; };
template <int DQK, int DV, class F, bool EARLYV>
__device__ __forceinline__ void attn_tile(LAS unsigned char* lds, int buf, int kt, const bf16x8 (&qf)[DQK / 16], F& f, f32x16 (&o)[DV / 32], SmState& S, f32x16& negm, int lane) {
    f32x16 s[2];
    qk_tile<DQK>(lds + AT_KBUF + buf * KBUF_BYTES, qf, s, lane, negm);
    const LAS unsigned char* vbuf = lds + AT_VBUF + buf * VBUF_BYTES;
    VFrag vfr;
    if constexpr (DV == 64 && EARLYV) { pv_load<(DV == 64 ? 192 : 320)>(vbuf, 0, vfr, lane); __builtin_amdgcn_sched_barrier(0); }
    f.apply(s, kt);
    float mx = NEGBIG;
#pragma unroll
    for (int r = 0; r < 16; ++r) mx = fmx3(mx, s[0][r], s[1][r]);
    mx = swapmax(mx);
    const bool need = S.started ? (mx > DEFER_THR) : (mx > -1e29f);
    if (__any(need)) {
        const float delta = need ? mx : 0.f, fac = (need && S.started) ? __builtin_amdgcn_exp2f(-delta) : 1.f;
        S.mhat += delta; S.l *= fac; S.started = S.started || need;
#pragma unroll
        for (int st = 0; st < 2; ++st)
#pragma unroll
            for (int r = 0; r < 16; ++r) s[st][r] -= delta;
#pragma unroll
        for (int dt = 0; dt < DV / 32; ++dt) o[dt] = o[dt] * fac;
#pragma unroll
        for (int r = 0; r < 16; ++r) negm[r] = -S.mhat;
    }
#pragma unroll
    for (int st = 0; st < 2; ++st)
#pragma unroll
        for (int r = 0; r < 16; ++r) s[st][r] = __builtin_amdgcn_exp2f(s[st][r]);
    S.l += vsum32(s);
    bf16x8 pf[4]; p_pack(s, pf);
#pragma unroll
    for (int dp = 0; dp < DV / 64; ++dp) {
        if constexpr (!(DV == 64 && EARLYV)) { pv_load<(DV == 64 ? 192 : 320)>(vbuf, dp, vfr, lane); __builtin_amdgcn_sched_barrier(0); }
        pv_mma(vfr, pf, o[2 * dp], o[2 * dp + 1]);
    }
}
template <int DQK, int KA, int DV, class F, bool EARLYV = true, bool DEEP = false>
__device__ __forceinline__ void attn_loop(LAS unsigned char* lds, const KVSrc& kv, int kt0, int kt1, const bf16x8 (&qf)[DQK / 16], F& f, f32x16 (&o)[DV / 32], SmState& S, int tid, int lane) {
    if (kt0 >= kt1) return;
    Stage<DQK, KA, DV> sg0;
    __syncthreads();
    sg0.load(kv, kt0, tid); sg0.store(lds, 0, tid);
    f32x16 negm;
#pragma unroll
    for (int r = 0; r < 16; ++r) negm[r] = -S.mhat;
    if constexpr (DEEP) {
        Stage<DQK, KA, DV> sg1;
        if (kt0 + 1 < kt1) sg1.load(kv, kt0 + 1, tid);
        __syncthreads();
        for (int kt = kt0; kt < kt1; kt += 2) {
            if (kt + 2 < kt1) { sg0.load(kv, kt + 2, tid); f.pre(kt + 2); }
            if (!f.skip(kt)) attn_tile<DQK, DV, F, EARLYV>(lds, 0, kt, qf, f, o, S, negm, lane);
            if (kt + 1 < kt1) sg1.store(lds, 1, tid);
            __syncthreads();
            if (kt + 1 < kt1) {
                if (kt + 3 < kt1) { sg1.load(kv, kt + 3, tid); f.pre(kt + 3); }
                if (!f.skip(kt + 1)) attn_tile<DQK, DV, F, EARLYV>(lds, 1, kt + 1, qf, f, o, S, negm, lane);
                if (kt + 2 < kt1) sg0.store(lds, 0, tid);
                __syncthreads();
            }
        }
    } else {
        __syncthreads();
        for (int kt = kt0; kt < kt1; ++kt) {
            const int buf = (kt - kt0) & 1;
            if (kt + 1 < kt1) { sg0.load(kv, kt + 1, tid); f.pre(kt + 1); }
            if (!f.skip(kt)) attn_tile<DQK, DV, F, EARLYV>(lds, buf, kt, qf, f, o, S, negm, lane);
            if (kt + 1 < kt1) sg0.store(lds, buf ^ 1, tid);
            __syncthreads();
        }
    }
}
__device__ __forceinline__ void build_bias_tables(LAS unsigned char* lds, const float* tab, int tid) {
    LAS float* BT = (LAS float*)(lds + AT_BT);
    for (int i = tid; i < 20 * 129; i += NWAVES * 64) { const int h = i / 129, d = i % 129;
        int b = d; if (d >= 16) { b = 16 + (int)(__log2f((float)d * 0.0625f) * (16.0f / 3.0f)); b = b > 31 ? 31 : b; }
        BT[h * BT_STRIDE + d] = (tab[b * 20 + h] - tab[31 * 20 + h]) * LOG2E; }
}
__device__ __forceinline__ void swap_pair(v2u& a, v2u& b) {
    { auto r = __builtin_amdgcn_permlane32_swap(a.x, b.x, false, false); a.x = r[0]; b.x = r[1]; }
    { auto r = __builtin_amdgcn_permlane32_swap(a.y, b.y, false, false); a.y = r[0]; b.y = r[1]; }
}
template <int DV> __device__ __forceinline__ void store_ot(bf16* orow, const f32x16 (&o)[DV / 32], float scale, int lane) {
    const int hi = lane >> 5;
    bf16* dst = orow + 8 * hi;
#pragma unroll
    for (int dt = 0; dt < DV / 32; ++dt)
#pragma unroll
        for (int r4 = 0; r4 < 4; r4 += 2) {
            v2u a, b;
            a.x = cvtpk(o[dt][4 * r4 + 0] * scale, o[dt][4 * r4 + 1] * scale); a.y = cvtpk(o[dt][4 * r4 + 2] * scale, o[dt][4 * r4 + 3] * scale);
            b.x = cvtpk(o[dt][4 * r4 + 4] * scale, o[dt][4 * r4 + 5] * scale); b.y = cvtpk(o[dt][4 * r4 + 6] * scale, o[dt][4 * r4 + 7] * scale);
            swap_pair(a, b);
            *(GAS v4u*)(dst + 32 * dt + 8 * r4) = (v4u){a.x, a.y, b.x, b.y}; }
}
template <int DQK> __device__ __forceinline__ void load_q(const bf16* qrow, bf16x8 (&qf)[DQK / 16], int lane) {
    const int hi = lane >> 5;
#pragma unroll
    for (int d0 = 0; d0 < DQK / 16; ++d0) qf[d0] = *(const GAS bf16x8*)(qrow + 16 * d0 + 8 * hi);
}
__device__ __forceinline__ bf16x8 scale_frag(bf16x8 a, float sc) {
    v4u w;
    w.x = cvtpk(bf2f((unsigned short)a[0]) * sc, bf2f((unsigned short)a[1]) * sc); w.y = cvtpk(bf2f((unsigned short)a[2]) * sc, bf2f((unsigned short)a[3]) * sc);
    w.z = cvtpk(bf2f((unsigned short)a[4]) * sc, bf2f((unsigned short)a[5]) * sc); w.w = cvtpk(bf2f((unsigned short)a[6]) * sc, bf2f((unsigned short)a[7]) * sc);
    return __builtin_bit_cast(bf16x8, w);
}
template <int DQK> __device__ __forceinline__ void load_q_scaled(const bf16* qrow, bf16x8 (&qf)[DQK / 16], float sc, int lane) {
    load_q<DQK>(qrow, qf, lane);
#pragma unroll
    for (int d0 = 0; d0 < DQK / 16; ++d0) qf[d0] = scale_frag(qf[d0], sc);
}

struct FPlain { __device__ __forceinline__ void pre(int) {} __device__ __forceinline__ bool skip(int) const { return false; }
    __device__ __forceinline__ void apply(f32x16 (&)[2], int) {} };
__device__ __forceinline__ void xattn_unit(LAS unsigned char* lds, const bf16* XQ, const bf16* KVM, bf16* O, int b, int h, int qt, int tid_in, int lane_in, int wave) {
    int lane = lane_in; asm volatile("" : "+v"(lane)); const int tid = wave * 64 + lane; (void)tid_in;
    const int t = qt * 256 + wave * 32 + (lane & 31);
    bf16x8 qf[8]; load_q_scaled<128>(XQ + (size_t)(b * SEQ + t) * 512 + h * 128, qf, 0.08838834764831845f * LOG2E, lane);
    KVSrc kv{KVM + (size_t)(b * MEML) * DM + h * 128, DM, nullptr, 0, KVM + (size_t)(b * MEML) * DM + 512 + h * 128, DM};
    f32x16 o[4] = {}; SmState S{0.f, 0.f, false};
    FPlain f;
    attn_loop<128, 128, 128, FPlain>(lds, kv, 0, MEML / 64, qf, f, o, S, tid, lane);
    const float lt = swapsum(S.l);
    store_ot<128>(O + (size_t)(b * SEQ + t) * 512 + h * 128, o, lt > 0.f ? 1.f / lt : 0.f, lane);
}


constexpr int C_QA = 0, C_KVA = 512, C_GA = 1280, C_QB = 1304, C_KB = 1816, C_VB = 1880, C_IQ = 1944, C_IK = 2200, C_IW = 2232;
constexpr size_t WS_CWT = 91 * MiB;
constexpr size_t WS_CBIAS = 91 * MiB + 512 * 1024;
constexpr size_t WS_P0 = WS_OV, WS_KCMP = WS_OV + 288 * MiB, WS_VCMP = WS_OV + 289 * MiB, WS_SEL = WS_OV + 330 * MiB;
static_assert(WS_SEL + 32 * MiB <= WS_END, "even overlay");

__device__ __forceinline__ void nsa_compress_item(const bf16* P0, const bf16* CWT, const float* CBIAS, bf16* KCMP, bf16* VCMP, int item, int lane) {
    const int nt = item & 7, g = (item >> 3) & 1, b = (item >> 4) & 15, c = item >> 8;
    const int r32 = lane & 31, hi = lane >> 5, n = nt * 32 + r32, nc = n > 254 ? 254 : n;
    const bf16* ap = P0 + (size_t)(b * SEQ + 16 * nc) * EV_INP + C_KVA + c * 128 + g * 64 + 8 * hi;
    const bf16* bp = CWT + (size_t)(c * 64 + r32) * 2048 + 8 * hi;
    f32x16 acc[2] = {};
#pragma unroll 4
    for (int kk = 0; kk < 128; ++kk) {
        const bf16x8 a = *(const GAS bf16x8*)(ap + (size_t)(kk >> 2) * EV_INP + (kk & 3) * 16);
        const bf16x8 b0 = *(const GAS bf16x8*)(bp + kk * 16), b1 = *(const GAS bf16x8*)(bp + 32 * 2048 + kk * 16);
        acc[0] = __builtin_amdgcn_mfma_f32_32x32x16_bf16(a, b0, acc[0], 0, 0, 0);
        acc[1] = __builtin_amdgcn_mfma_f32_32x32x16_bf16(a, b1, acc[1], 0, 0, 0);
    }
#pragma unroll
    for (int eh = 0; eh < 2; ++eh) { const int e = 32 * eh + r32; const float bias = CBIAS[c * 64 + e];
        bf16* dst = c == 0 ? KCMP : VCMP;
#pragma unroll
        for (int r = 0; r < 16; ++r) { const int nn = nt * 32 + crow(r, hi); dst[((size_t)(b * 2 + g) * 256 + nn) * 64 + e] = (bf16)(nn > 254 ? 0u : f2bf(acc[eh][r] + bias)); }
    }
}

__device__ __forceinline__ void nsa_compress_pair(LAS unsigned char* lds, const bf16* P0, const bf16* CWT, const float* CBIAS, bf16* KCMP, bf16* VCMP, int it0, int wave, int lane) {
    const int item = it0 + (wave >> 2), ks = wave & 3; const bool live = item < 512;
    const int nt = item & 7, g = (item >> 3) & 1, b = (item >> 4) & 15, c = (item >> 8) & 1;
    const int r32 = lane & 31, hi = lane >> 5, n = nt * 32 + r32, nc = n > 254 ? 254 : n;
    const bf16* ap = P0 + (size_t)(b * SEQ + 16 * nc) * EV_INP + C_KVA + c * 128 + g * 64 + 8 * hi;
    const bf16* bp = CWT + (size_t)(c * 64 + r32) * 2048 + 8 * hi;
    f32x16 acc[2] = {};
    if (live) {
#pragma unroll 8
        for (int kk = 32 * ks; kk < 32 * ks + 32; ++kk) {
            const bf16x8 a = *(const GAS bf16x8*)(ap + (size_t)(kk >> 2) * EV_INP + (kk & 3) * 16);
            const bf16x8 b0 = *(const GAS bf16x8*)(bp + kk * 16), b1 = *(const GAS bf16x8*)(bp + 32 * 2048 + kk * 16);
            acc[0] = __builtin_amdgcn_mfma_f32_32x32x16_bf16(a, b0, acc[0], 0, 0, 0);
            acc[1] = __builtin_amdgcn_mfma_f32_32x32x16_bf16(a, b1, acc[1], 0, 0, 0);
        }
    }
    LAS float* red = (LAS float*)lds + (wave >> 2) * 3 * 2048 + lane;
    if (ks) {
#pragma unroll
        for (int eh = 0; eh < 2; ++eh)
#pragma unroll
            for (int r = 0; r < 16; ++r) red[(ks - 1) * 2048 + (eh * 16 + r) * 64] = acc[eh][r];
    }
    __syncthreads();
    if (!ks && live) {
#pragma unroll
        for (int j = 0; j < 3; ++j)
#pragma unroll
            for (int eh = 0; eh < 2; ++eh)
#pragma unroll
                for (int r = 0; r < 16; ++r) acc[eh][r] += red[j * 2048 + (eh * 16 + r) * 64];
#pragma unroll
        for (int eh = 0; eh < 2; ++eh) { const int e = 32 * eh + r32; const float bias = CBIAS[c * 64 + e];
            bf16* dst = c == 0 ? KCMP : VCMP;
#pragma unroll
            for (int r = 0; r < 16; ++r) { const int nn = nt * 32 + crow(r, hi); dst[((size_t)(b * 2 + g) * 256 + nn) * 64 + e] = (bf16)(nn > 254 ? 0u : f2bf(acc[eh][r] + bias)); }
        }
    }
    __syncthreads();
}

constexpr int IX_MASK = 0, IX_RED = 8192, IX_CNT = IX_RED + 1024, IX_NC = IX_CNT + 1024, IX_CAND = IX_NC + 64, IX_THR = IX_CAND + 8192, IX_LIST = IX_THR + 128;
__device__ __forceinline__ unsigned f2ord(float f) { const unsigned b = __float_as_uint(f); return b ^ ((unsigned)((int)b >> 31) | 0x80000000u); }
__device__ __forceinline__ float ord2f(unsigned u) { return __uint_as_float(u ^ ((u >> 31) ? 0x80000000u : 0xffffffffu)); }
__device__ __forceinline__ void dsa_index_unit(LAS unsigned char* lds, const bf16* P0, unsigned short* SEL, int b, int qt, int tid_in, int lane_in, int wave) {
    int lane = lane_in; asm volatile("" : "+v"(lane)); const int tid = wave * 64 + lane; (void)tid_in;
    const int q = lane & 15, g4 = lane >> 4, t0 = 16 * qt, t = t0 + q, nkt = qt + 1;
    const int ni = nkt > wave ? (nkt - wave + 7) >> 3 : 0, nc4 = (ni + 3) >> 2;
    const bf16* base = P0 + (size_t)(b * SEQ) * EV_INP;
    bf16x8 bq[8]; float w[8];
#pragma unroll
    for (int h = 0; h < 8; ++h) { bq[h] = *(const GAS bf16x8*)(base + (size_t)t * EV_INP + C_IQ + h * 32 + 8 * g4); w[h] = bf2f(base[(size_t)t * EV_INP + C_IW + h]); }
    typedef float f32x4v __attribute__((ext_vector_type(4)));
    const bf16* kbase = base + (size_t)(16 * wave + q) * EV_INP + C_IK + 8 * g4;
    float sc[32][4];
    const float NINF = -__builtin_inff();
#pragma unroll
    for (int g = 0; g < 8; ++g) {
        if (32 * g + wave < nkt) {
            bf16x8 ab[4];
#pragma unroll
            for (int j = 0; j < 4; ++j) if (8 * (4 * g + j) + wave < nkt) { const bf16* kp = kbase; asm volatile("" : "+v"(kp));
                ab[j] = *(const GAS bf16x8*)(kp + (size_t)(4 * g + j) * (128 * EV_INP)); }
            asm volatile("s_waitcnt vmcnt(0)" ::: "memory");
#pragma unroll
            for (int j = 0; j < 4; ++j) {
                const int i = 4 * g + j, kt = 8 * i + wave;
                if (kt < nkt) {
                    const bf16x8 a = ab[j];
                    float a4[4] = {0.f, 0.f, 0.f, 0.f};
#pragma unroll
                    for (int h = 0; h < 8; ++h) { const f32x4v c = __builtin_amdgcn_mfma_f32_16x16x32_bf16(a, bq[h], (f32x4v){0.f, 0.f, 0.f, 0.f}, 0, 0, 0);
#pragma unroll
                        for (int r = 0; r < 4; ++r) a4[r] += w[h] * fmx(c[r], 0.f); }
#pragma unroll
                    for (int r = 0; r < 4; ++r) sc[i][r] = (kt < qt || 4 * g4 + r <= q) ? a4[r] : NINF;
                } else {
#pragma unroll
                    for (int r = 0; r < 4; ++r) sc[i][r] = NINF;
                }
            }
        } else {
#pragma unroll
            for (int j = 0; j < 4; ++j)
#pragma unroll
                for (int r = 0; r < 4; ++r) sc[4 * g + j][r] = NINF;
        }
    }
    LAS float* RED = (LAS float*)(lds + IX_RED); LAS unsigned* CNT = (LAS unsigned*)(lds + IX_CNT); LAS unsigned* MK = (LAS unsigned*)(lds + IX_MASK);
    LAS unsigned* NC = (LAS unsigned*)(lds + IX_NC); LAS unsigned long long* CAND = (LAS unsigned long long*)(lds + IX_CAND); LAS unsigned long long* THR = (LAS unsigned long long*)(lds + IX_THR);
    float lmax = NINF, lmin = __builtin_inff();
#pragma unroll
    for (int c = 0; c < 8; ++c) if (c < nc4) {
#pragma unroll
        for (int j = 0; j < 4; ++j)
#pragma unroll
            for (int r = 0; r < 4; ++r) { const float v = sc[4 * c + j][r]; lmax = fmx(lmax, v); lmin = fmn(lmin, v == NINF ? __builtin_inff() : v); }
    }
    lmax = fmx(lmax, lx_f<16>(lmax)); lmax = fmx(lmax, lx_f<32>(lmax));
    lmin = fmn(lmin, lx_f<16>(lmin)); lmin = fmn(lmin, lx_f<32>(lmin));
    __syncthreads();
    if (g4 == 0) { RED[wave * 16 + q] = lmax; RED[128 + wave * 16 + q] = lmin; }
    for (int i = tid; i < 2048; i += NWAVES * 64) MK[i] = 0u;
    if (tid < 16) NC[tid] = 0u;
    __syncthreads();
    float hiv = NINF, lov = __builtin_inff();
#pragma unroll
    for (int wv = 0; wv < 8; ++wv) { hiv = fmx(hiv, RED[wv * 16 + q]); lov = fmn(lov, RED[128 + wv * 16 + q]); }
    lov = lov - fabsf(lov) * 1e-3f - 1e-6f;
    unsigned clo = (unsigned)(t + 1), chi = 0u;
    bool done = (t + 1 <= 256), fine = false; float thr = NINF; unsigned thk = 0u;
    for (int it = 0; it < 64; ++it) {
        const float mid = 0.5f * (lov + hiv);
        unsigned cnt = 0;
#pragma unroll
        for (int c = 0; c < 8; ++c) if (c < nc4) {
#pragma unroll
            for (int j = 0; j < 4; ++j)
#pragma unroll
                for (int r = 0; r < 4; ++r) cnt += (sc[4 * c + j][r] > mid) ? 1u : 0u;
        }
        cnt += lx_u<16>(cnt); cnt += lx_u<32>(cnt);
        LAS unsigned* cb = CNT + (it & 1) * 128;
        if (g4 == 0) cb[wave * 16 + q] = cnt;
        __syncthreads();
        unsigned tot = 0;
#pragma unroll
        for (int wv = 0; wv < 8; ++wv) tot += cb[wv * 16 + q];
        if (!done && !fine) {
            if (tot == 256u) { thr = mid; done = true; }
            else if (!(mid > lov && mid < hiv)) { thr = lov; done = true; }
            else { if (tot > 256u) { lov = mid; clo = tot; } else { hiv = mid; chi = tot; }
                   if (clo - chi <= 64u) fine = true; }
        }
        if (__all(done || fine)) break;
    }
    const unsigned kinv0 = (unsigned)(4095 - (16 * wave + 4 * g4));
    if (fine) {
#pragma unroll
        for (int c = 0; c < 8; ++c) if (c < nc4) {
#pragma unroll
            for (int j = 0; j < 4; ++j)
#pragma unroll
                for (int r = 0; r < 4; ++r) { const float v = sc[4 * c + j][r];
                    if (v > lov && v <= hiv) { const unsigned pos = __hip_atomic_fetch_add(NC + q, 1u, __ATOMIC_RELAXED, __HIP_MEMORY_SCOPE_WORKGROUP);
                        if (pos < 64u) CAND[q * 64 + pos] = ((unsigned long long)f2ord(v) << 32) | (kinv0 - (unsigned)(128 * (4 * c + j) + r)); } }
        }
    }
    __syncthreads();
#pragma unroll 1
    for (int k = 0; k < 2; ++k) {
        const int qq = 2 * wave + k;
        const int fq = __builtin_amdgcn_readlane((int)fine, qq), need = __builtin_amdgcn_readlane((int)(256u - chi), qq);
        if (fq) {
            const unsigned n = NC[qq]; const unsigned long long comp = (unsigned)lane < n ? CAND[qq * 64 + lane] : 0ull;
            const unsigned c_lo = (unsigned)comp, c_hi = (unsigned)(comp >> 32);
            int rank = 0;
#pragma unroll
            for (int jj = 0; jj < 64; ++jj) { const unsigned long long c2 = ((unsigned long long)(unsigned)__builtin_amdgcn_readlane((int)c_hi, jj) << 32) | (unsigned)__builtin_amdgcn_readlane((int)c_lo, jj); rank += (c2 > comp) ? 1 : 0; }
            if (rank == need - 1) THR[qq] = comp;
        }
    }
    __syncthreads();
    if (fine) { const unsigned long long t64 = THR[q]; thr = ord2f((unsigned)(t64 >> 32)); thk = (unsigned)t64; }
    LAS unsigned* mkw = MK + q * 128 + (wave >> 1); const int mksh = 16 * (wave & 1) + 4 * g4;
#pragma unroll
    for (int c = 0; c < 8; ++c) if (c < nc4) {
#pragma unroll
        for (int j = 0; j < 4; ++j) { const int i = 4 * c + j;
            unsigned nib = 0;
#pragma unroll
            for (int r = 0; r < 4; ++r) { const float v = sc[i][r]; nib |= (v > thr || (fine && v == thr && kinv0 - (unsigned)(128 * i + r) >= thk)) ? (1u << r) : 0u; }
            if (nib) __hip_atomic_fetch_or(mkw + 4 * i, nib << mksh, __ATOMIC_RELAXED, __HIP_MEMORY_SCOPE_WORKGROUP); }
    }
    __syncthreads();
    LAS unsigned short* LST = (LAS unsigned short*)(lds + IX_LIST);
#pragma unroll 1
    for (int k = 0; k < 2; ++k) {
        const int qq = 2 * wave + k;
        unsigned long long wd = *(const LAS unsigned long long*)(lds + IX_MASK + (qq * 64 + lane) * 8);
        const int c = __popcll(wd); int incl = c;
#pragma unroll
        for (int d = 1; d < 64; d <<= 1) { const int n = __builtin_amdgcn_ds_bpermute((lane - d) << 2, incl); if (lane >= d) incl += n; }
        int pos = incl - c; const int total = __builtin_amdgcn_readlane(incl, 63);
        while (wd) { const int bbit = __builtin_ctzll(wd); if (pos < 256) LST[qq * 256 + pos] = (unsigned short)(64 * lane + bbit); ++pos; wd &= wd - 1; }
        for (int p = total + lane; p < 256; p += 64) LST[qq * 256 + p] = (unsigned short)0xffffu;
    }
    __syncthreads();
    { const v4u v = *(const LAS v4u*)(lds + IX_LIST + tid * 16);
      *(GAS v4u*)((unsigned char*)(SEL + (size_t)(b * SEQ + t0) * 256) + tid * 16) = v; }
}

struct FSel {
    unsigned long long selmask; int t, cur, hi; const LAS float* BT;
    __device__ __forceinline__ void pre(int) {}
    __device__ __forceinline__ bool skip(int kt) const { return !__any((int)((selmask >> kt) & 1ull)); }
    __device__ __forceinline__ void apply(f32x16 (&s)[2], int kt) {
        const bool on = (selmask >> kt) & 1ull;
        if (kt + 3 <= cur) {
            if (!__all((int)on)) {
#pragma unroll
                for (int st = 0; st < 2; ++st)
#pragma unroll
                    for (int r = 0; r < 16; ++r) s[st][r] = on ? s[st][r] : NEGBIG; }
        } else {
#pragma unroll
            for (int st = 0; st < 2; ++st)
#pragma unroll
                for (int r = 0; r < 16; ++r) { const int dist = t - (64 * kt + 32 * st + crow(r, hi)); const unsigned di = (unsigned)dist < 128u ? (unsigned)dist : 128u;
                    s[st][r] = (on && dist >= 0) ? s[st][r] + BT[di] : NEGBIG; }
        }
    }
};
struct FWin {
    int t, cur, hi; const LAS float* BT;
    __device__ __forceinline__ void pre(int) {}
    __device__ __forceinline__ bool skip(int) const { return false; }
    __device__ __forceinline__ void apply(f32x16 (&s)[2], int kt) {
        const int dk = cur - kt;
        if (!(dk >= 3 && dk <= 7)) {
#pragma unroll
            for (int st = 0; st < 2; ++st)
#pragma unroll
                for (int r = 0; r < 16; ++r) { const int dist = t - (64 * kt + 32 * st + crow(r, hi)); const unsigned di = (unsigned)dist < 128u ? (unsigned)dist : 128u;
                    s[st][r] = (dist >= 0 && dist < 512) ? s[st][r] + BT[di] : NEGBIG; }
        }
    }
};
__device__ __forceinline__ float sigmoidf_(float x) { return __builtin_amdgcn_rcpf(1.0f + __builtin_amdgcn_exp2f(-x * LOG2E)); }

__device__ __forceinline__ void nsa_unit(LAS unsigned char* lds, const bf16* P0, const bf16* KCMP, const bf16* VCMP, bf16* OC, int b, int g, int qt, int tid_in, int lane_in, int wave) {
    int lane = lane_in; asm volatile("" : "+v"(lane)); const int tid = wave * 64 + lane; (void)tid_in;
    const int r32 = lane & 31, hi = lane >> 5, qi = r32 >> 2, hh = r32 & 3, head = g * 4 + hh;
    const int t0 = qt * 64, t = t0 + wave * 8 + qi, cur = qt;
    const bf16* prow = P0 + (size_t)(b * SEQ + t) * EV_INP;
    bf16x8 qf[4]; load_q_scaled<64>(prow + C_QA + head * 64, qf, 0.125f * LOG2E, lane);
    const LAS float* BT = (const LAS float*)(lds + AT_BT) + head * BT_STRIDE;
    const float g0 = sigmoidf_(bf2f(prow[C_GA + g * 12 + hh * 3 + 0])), g1 = sigmoidf_(bf2f(prow[C_GA + g * 12 + hh * 3 + 1])), g2 = sigmoidf_(bf2f(prow[C_GA + g * 12 + hh * 3 + 2]));
    LAS float* impL = (LAS float*)(lds + AT_WS + wave * AT_WS_PER_WAVE);
    LAS unsigned long long* selL = (LAS unsigned long long*)(lds + AT_WS + wave * AT_WS_PER_WAVE + 2048);
    f32x16 oacc[2];
    {
        f32x16 o[2] = {}; float m = NEGBIG, l = 0.f, carry = 0.f;
        float imp[32];
#pragma unroll
        for (int i = 0; i < 32; ++i) imp[i] = 0.f;
        const int ncv = (t0 + 63 >= 31) ? ((t0 + 63 - 31) >> 4) + 1 : 0;
        const int nkt = ncv >= 256 ? 4 : (ncv + 63) >> 6;
        KVSrc kv{KCMP + (size_t)((b * 2 + g) * 256) * 64, 64, nullptr, 0, VCMP + (size_t)((b * 2 + g) * 256) * 64, 64};
        Stage<64, 64, 64> sg;
        __syncthreads();
        if (nkt > 0) { sg.load(kv, 0, tid); sg.store(lds, 0, tid); }
        __syncthreads();
#pragma unroll
        for (int kt = 0; kt < 4; ++kt) {
            if (kt < nkt) {
                const int buf = kt & 1;
                if (kt + 1 < nkt) sg.load(kv, kt + 1, tid);
                f32x16 s[2];
                qk_tile<64, 2>(lds + AT_KBUF + buf * KBUF_BYTES, qf, s, lane);
#pragma unroll
                for (int st = 0; st < 2; ++st)
#pragma unroll
                    for (int r = 0; r < 16; ++r) { const int dist = t - (16 * (64 * kt + 32 * st + crow(r, hi)) + 31); const unsigned di = (unsigned)dist < 128u ? (unsigned)dist : 128u;
                        s[st][r] = dist >= 0 ? s[st][r] + BT[di] : NEGBIG; }
                const float alpha = softmax_tile(s, m, l);
                o[0] = o[0] * alpha; o[1] = o[1] * alpha; carry *= alpha;
#pragma unroll
                for (int i = 0; i < kt * 8; ++i) imp[i] *= alpha;
                pv_tile<64>(lds + AT_VBUF + buf * VBUF_BYTES, s, o, lane);
                float G[2][4], ol[2][4];
#pragma unroll
                for (int st = 0; st < 2; ++st)
#pragma unroll
                    for (int q4 = 0; q4 < 4; ++q4) { G[st][q4] = (s[st][4 * q4] + s[st][4 * q4 + 1]) + (s[st][4 * q4 + 2] + s[st][4 * q4 + 3]); ol[st][q4] = swapget(s[st][4 * q4 + 3]); }
#pragma unroll
                for (int st = 0; st < 2; ++st)
#pragma unroll
                    for (int q4 = 0; q4 < 4; ++q4) { const float prev = q4 > 0 ? ol[st][q4 - 1] : (st == 1 ? ol[0][3] : carry);
                        imp[kt * 8 + st * 4 + q4] = G[st][q4] + (hi ? ol[st][q4] : prev); }
                carry = ol[1][3];
                if (kt + 1 < nkt) sg.store(lds, buf ^ 1, tid);
                __syncthreads();
            }
        }
        const float lt = swapsum(l), inv = lt > 0.f ? 1.f / lt : 0.f;
        oacc[0] = o[0] * (inv * g0); oacc[1] = o[1] * (inv * g0);
#pragma unroll
        for (int i = 0; i < 32; ++i) { float v = imp[i] * inv; v += lx_f<1>(v); v += lx_f<2>(v);
            if (hh == 0) impL[qi * 64 + 16 * (i >> 3) + 8 * ((i >> 2) & 1) + 2 * (i & 3) + hi] = v; }
    }
    LDS_WAIT(); asm volatile("" ::: "memory");
#pragma unroll 1
    for (int q2 = 0; q2 < 8; ++q2) {
        const int j = lane; const bool valid = j <= cur, forced = (j == 0) || (j == cur) || (j == cur - 1);
        const float val = impL[q2 * 64 + j] + (forced ? 1000.f : 0.f);
        const unsigned long long comp = ((unsigned long long)(valid ? __float_as_uint(val) + 1u : 0u) << 6) | (unsigned long long)(63 - j);
        const unsigned clo = (unsigned)comp, chi = (unsigned)(comp >> 32);
        int rank = 0;
#pragma unroll
        for (int jj = 0; jj < 64; ++jj) { const unsigned long long c2 = ((unsigned long long)(unsigned)__builtin_amdgcn_readlane((int)chi, jj) << 32) | (unsigned)__builtin_amdgcn_readlane((int)clo, jj); rank += (c2 > comp) ? 1 : 0; }
        const unsigned long long mk = __ballot(valid && rank < 16);
        if (lane == 0) selL[q2] = mk;
    }
    LDS_WAIT(); asm volatile("" ::: "memory");
    const unsigned long long selmask = selL[qi];
    {
        f32x16 o[2] = {}; SmState S{0.f, 0.f, false};
        KVSrc kv{P0 + (size_t)(b * SEQ) * EV_INP + C_KVA + 2 * 128 + g * 64, EV_INP, nullptr, 0, P0 + (size_t)(b * SEQ) * EV_INP + C_KVA + 3 * 128 + g * 64, EV_INP};
        FSel f{selmask, t, cur, hi, BT};
        int tid2 = tid; asm volatile("" : "+v"(tid2));
        attn_loop<64, 64, 64, FSel, false>(lds, kv, 0, cur + 1, qf, f, o, S, tid2, lane);
        const float lt = swapsum(S.l), inv = lt > 0.f ? 1.f / lt : 0.f;
        oacc[0] = oacc[0] + o[0] * (inv * g1); oacc[1] = oacc[1] + o[1] * (inv * g1);
    }
    {
        f32x16 o[2] = {}; SmState S{0.f, 0.f, false};
        KVSrc kv{P0 + (size_t)(b * SEQ) * EV_INP + C_KVA + 4 * 128 + g * 64, EV_INP, nullptr, 0, P0 + (size_t)(b * SEQ) * EV_INP + C_KVA + 5 * 128 + g * 64, EV_INP};
        FWin f{t, cur, hi, BT};
        int tid3 = tid; asm volatile("" : "+v"(tid3));
        attn_loop<64, 64, 64, FWin, false>(lds, kv, cur >= 8 ? cur - 8 : 0, cur + 1, qf, f, o, S, tid3, lane);
        const float lt = swapsum(S.l), inv = lt > 0.f ? 1.f / lt : 0.f;
        oacc[0] = oacc[0] + o[0] * (inv * g2); oacc[1] = oacc[1] + o[1] * (inv * g2);
    }
    store_ot<64>(OC + (size_t)(b * SEQ + t) * DM + head * 64, oacc, 1.f, lane);
}
constexpr int DG_VP = 136, DG_VT = 64 * DG_VP;
static_assert(8 * DG_VT <= AT_BT, "DSA gather LDS map");
__device__ __forceinline__ void dsa_unit(LAS unsigned char* lds, const bf16* P0, const unsigned short* SEL, bf16* OC, int b, int qt, int tid_in, int lane_in, int wave) {
    int lane = lane_in; asm volatile("" : "+v"(lane)); (void)tid_in;
    const int r32 = lane & 31, hi = lane >> 5, hh = r32 & 7;
    const LAS float* BT = (const LAS float*)(lds + AT_BT) + (8 + hh) * BT_STRIDE;
    LAS unsigned char* vt = lds + wave * DG_VT;
    LAS unsigned short* lq = (LAS unsigned short*)(lds + AT_WS + wave * AT_WS_PER_WAVE);
    const bf16* kb = P0 + (size_t)(b * SEQ) * EV_INP + C_KB + 8 * hi;
    const bf16* vb = P0 + (size_t)(b * SEQ) * EV_INP + C_VB + 8 * (lane & 7);
#define DG_LOADK(LQ, J) do { _Pragma("unroll") for (int st = 0; st < 2; ++st) { unsigned ik = (LQ)[64 * (J) + 32 * st + r32]; ik = ik > 4095u ? 0u : ik; \
        _Pragma("unroll") for (int d0 = 0; d0 < 4; ++d0) kf[st][d0] = *(const GAS bf16x8*)(kb + (size_t)ik * EV_INP + 16 * d0); } } while (0)
#define DG_LOADV(LQ, J) do { _Pragma("unroll") for (int i = 0; i < 8; ++i) { unsigned iv = (LQ)[64 * (J) + 8 * i + (lane >> 3)]; iv = iv > 4095u ? 0u : iv; vr[i] = *(const GAS v4u*)(vb + (size_t)iv * EV_INP); } } while (0)
    bf16x8 kf[2][4]; v4u vr[8];
    { const int t = qt * 32 + wave * 4; *(LAS v2u*)(lq + 4 * lane) = *(const GAS v2u*)(SEL + (size_t)(b * SEQ + t) * 256 + 4 * lane); }
    DG_LOADK(lq, 0); DG_LOADV(lq, 0);
#pragma unroll 1
    for (int qi = 0; qi < 4; ++qi) {
        const int t = qt * 32 + wave * 4 + qi;
        LAS unsigned short* lqc = lq + 256 * (qi & 1); LAS unsigned short* lqn = lq + 256 * ((qi + 1) & 1);
        if (qi + 1 < 4) *(LAS v2u*)(lqn + 4 * lane) = *(const GAS v2u*)(SEL + (size_t)(b * SEQ + t + 1) * 256 + 4 * lane);
        bf16x8 qf[4]; load_q_scaled<64>(P0 + (size_t)(b * SEQ + t) * EV_INP + C_QB + hh * 64, qf, 0.125f * LOG2E, lane);
        f32x16 o[2] = {}; SmState S{0.f, 0.f, false};
#pragma unroll
        for (int j = 0; j < 4; ++j) {
#pragma unroll
            for (int i = 0; i < 8; ++i) { LAS unsigned char* d = vt + (8 * i + (lane >> 3)) * DG_VP + (lane & 7) * 16; *(LAS v2u*)d = (v2u){vr[i].x, vr[i].y}; *(LAS v2u*)(d + 8) = (v2u){vr[i].z, vr[i].w}; }
            if (j < 3) DG_LOADV(lqc, j + 1); else if (qi + 1 < 4) DG_LOADV(lqn, 0);
            f32x16 s[2];
#pragma unroll
            for (int r = 0; r < 16; ++r) { s[0][r] = -S.mhat; s[1][r] = -S.mhat; }
#pragma unroll
            for (int d0 = 0; d0 < 4; ++d0)
#pragma unroll
                for (int st = 0; st < 2; ++st) s[st] = __builtin_amdgcn_mfma_f32_32x32x16_bf16(kf[st][d0], qf[d0], s[st], 0, 0, 0);
            if (j < 3) DG_LOADK(lqc, j + 1); else if (qi + 1 < 4) DG_LOADK(lqn, 0);
            if (j >= 2 || t < 255) {
#pragma unroll
                for (int st = 0; st < 2; ++st)
#pragma unroll
                    for (int r = 0; r < 16; ++r) { const int ix = lqc[64 * j + 32 * st + crow(r, hi)]; const int dist = t - ix; const unsigned di = (unsigned)dist < 128u ? (unsigned)dist : 128u;
                        s[st][r] = dist >= 0 ? s[st][r] + BT[di] : NEGBIG; }
            }
            float mx = NEGBIG;
#pragma unroll
            for (int r = 0; r < 16; ++r) mx = fmx3(mx, s[0][r], s[1][r]);
            mx = swapmax(mx);
            const bool need = S.started ? (mx > DEFER_THR) : (mx > -1e29f);
            if (__any(need)) {
                const float delta = need ? mx : 0.f, fac = (need && S.started) ? __builtin_amdgcn_exp2f(-delta) : 1.f;
                S.mhat += delta; S.l *= fac; S.started = S.started || need;
#pragma unroll
                for (int st = 0; st < 2; ++st)
#pragma unroll
                    for (int r = 0; r < 16; ++r) s[st][r] -= delta;
                o[0] = o[0] * fac; o[1] = o[1] * fac;
            }
#pragma unroll
            for (int st = 0; st < 2; ++st)
#pragma unroll
                for (int r = 0; r < 16; ++r) s[st][r] = __builtin_amdgcn_exp2f(s[st][r]);
            S.l += vsum32(s);
            bf16x8 pf[4]; p_pack(s, pf);
            VFrag vfr; pv_load<DG_VP>(vt, 0, vfr, lane);
            pv_mma(vfr, pf, o[0], o[1]);
        }
        const float lt = swapsum(S.l);
        if (r32 < 8) store_ot<64>(OC + (size_t)(b * SEQ + t) * DM + 512 + hh * 64, o, lt > 0.f ? 1.f / lt : 0.f, lane);
    }
#undef DG_LOADK
#undef DG_LOADV
}


constexpr int D_CQ = 0, D_CKV = 256, D_KR = 384, D_QD = 416, D_KD = 928, D_VD = 1440;
constexpr size_t WS_ROPE = 91 * MiB + 640 * 1024;
constexpr size_t WS_P1 = WS_OV, WS_CQN = WS_OV + 256 * MiB, WS_CKVN = WS_OV + 288 * MiB, WS_KR = WS_OV + 320 * MiB;
constexpr size_t WS_QMLA = WS_Y, WS_KVMLA = WS_Y + 96 * MiB;
static_assert(WS_KR + 4 * MiB <= WS_END && WS_KVMLA + 128 * MiB <= WS_OV, "odd overlay");
constexpr float LAM_INIT = 0.35550906759097f;

__device__ __forceinline__ void rope_table_phase(float* ROPE, int gt, int NGT) {
    for (int idx = gt; idx < SEQ * 16; idx += NGT) { const int t = idx >> 4, i = idx & 15;
        const float inv = exp2f(-(float)i * (13.287712379549449f / 16.0f));
        const double rev = (double)((float)t * inv) * 0.15915494309189535;
        const float fr = (float)(rev - __builtin_floor(rev));
        ROPE[2 * idx] = __builtin_amdgcn_cosf(fr); ROPE[2 * idx + 1] = __builtin_amdgcn_sinf(fr); }
}
__device__ __forceinline__ void odd_prep_rows(const bf16* P1, const float* qn, const float* kvn, const float* ROPE, bf16* CQN, bf16* CKVN, bf16* KR, int gw, int NGW, int lane) {
    float gq[4], gk[2];
#pragma unroll
    for (int j = 0; j < 4; ++j) gq[j] = qn[4 * lane + j];
    gk[0] = kvn[2 * lane]; gk[1] = kvn[2 * lane + 1];
    for (int m = gw; m < MTOK; m += NGW) {
        const bf16* row = P1 + (size_t)m * OD_INP;
        const v2u cq = *(const GAS v2u*)(row + D_CQ + 4 * lane); const unsigned ck = *(const GAS unsigned*)(row + D_CKV + 2 * lane);
        float x[4] = {bf2f((unsigned short)(cq.x & 0xffff)), bf2f((unsigned short)(cq.x >> 16)), bf2f((unsigned short)(cq.y & 0xffff)), bf2f((unsigned short)(cq.y >> 16))};
        float y[2] = {bf2f((unsigned short)(ck & 0xffff)), bf2f((unsigned short)(ck >> 16))};
        const float r1 = __builtin_amdgcn_rsqf(wave_sum((x[0] * x[0] + x[1] * x[1]) + (x[2] * x[2] + x[3] * x[3])) * (1.f / 256.f) + RMS_EPS);
        const float r2 = __builtin_amdgcn_rsqf(wave_sum(y[0] * y[0] + y[1] * y[1]) * (1.f / 128.f) + RMS_EPS);
        v2u o; o.x = pk2(x[0] * r1 * gq[0], x[1] * r1 * gq[1]); o.y = pk2(x[2] * r1 * gq[2], x[3] * r1 * gq[3]);
        *(GAS v2u*)(CQN + (size_t)m * 256 + 4 * lane) = o;
        *(GAS unsigned*)(CKVN + (size_t)m * 256 + 2 * lane) = pk2(y[0] * r2 * gk[0], y[1] * r2 * gk[1]);
        *(GAS unsigned*)(CKVN + (size_t)m * 256 + 128 + 2 * lane) = 0u;
        if (lane < 16) { const int t = m & (SEQ - 1); const float c = ROPE[(t * 16 + lane) * 2], s = ROPE[(t * 16 + lane) * 2 + 1];
            const float x1 = bf2f(row[D_KR + lane]), x2 = bf2f(row[D_KR + 16 + lane]);
            KR[(size_t)m * 32 + lane] = (bf16)f2bf(x1 * c - x2 * s); KR[(size_t)m * 32 + 16 + lane] = (bf16)f2bf(x1 * s + x2 * c); }
    }
}
template <bool BIAS> struct FCausal {
    int t, tmin, tmax, hi; const LAS float* BT;
    __device__ __forceinline__ void pre(int) {}
    __device__ __forceinline__ bool skip(int kt) const { return 64 * kt > tmax; }
    __device__ __forceinline__ void apply(f32x16 (&s)[2], int kt) {
        if (!(64 * kt + 63 <= tmin && (!BIAS || tmin - (64 * kt + 63) >= 113))) {
#pragma unroll
            for (int st = 0; st < 2; ++st)
#pragma unroll
                for (int r = 0; r < 16; ++r) { const int dist = t - (64 * kt + 32 * st + crow(r, hi)); const unsigned di = (unsigned)dist < 128u ? (unsigned)dist : 128u;
                    s[st][r] = dist >= 0 ? s[st][r] + (BIAS ? BT[di] : 0.f) : NEGBIG; }
        }
    }
};
__device__ __forceinline__ void mla_unit(LAS unsigned char* lds, const bf16* QM, const bf16* KVM_, const bf16* KR, const float* ROPE, bf16* OC, int b, int h, int qt, int tid_in, int lane_in, int wave) {
    int lane = lane_in; asm volatile("" : "+v"(lane)); const int tid = wave * 64 + lane; (void)tid_in;
    const int r32 = lane & 31, hi = lane >> 5, t = qt * 256 + wave * 32 + r32;
    bf16x8 qf[6]; load_q<96>(QM + (size_t)(b * SEQ + t) * 768 + h * 96, qf, lane);
    {
        const float* rp = ROPE + (size_t)(t * 16 + 8 * hi) * 2;
        bf16x8 a = qf[4], c = qf[5];
#pragma unroll
        for (int j = 0; j < 8; ++j) { const float cs = rp[2 * j], sn = rp[2 * j + 1], x1 = bf2f((unsigned short)a[j]), x2 = bf2f((unsigned short)c[j]);
            a[j] = (short)f2bf(x1 * cs - x2 * sn); c[j] = (short)f2bf(x1 * sn + x2 * cs); }
        qf[4] = a; qf[5] = c;
    }
#pragma unroll
    for (int d0 = 0; d0 < 6; ++d0) qf[d0] = scale_frag(qf[d0], 0.10206207261596577f * LOG2E);
    KVSrc kv{KVM_ + (size_t)(b * SEQ) * 1024 + h * 128, 1024, KR + (size_t)(b * SEQ) * 32, 32, KVM_ + (size_t)(b * SEQ) * 1024 + h * 128 + 64, 1024};
    f32x16 o[2] = {}; SmState S{0.f, 0.f, false};
    FCausal<false> f{t, qt * 256 + wave * 32, qt * 256 + wave * 32 + 31, hi, nullptr};
    attn_loop<96, 64, 64, FCausal<false>, false, true>(lds, kv, 0, 4 * qt + 4, qf, f, o, S, tid, lane);
    const float lt = swapsum(S.l);
    store_ot<64>(OC + (size_t)(b * SEQ + t) * DM + h * 64, o, lt > 0.f ? 1.f / lt : 0.f, lane);
}
__device__ __forceinline__ void diff_unit(LAS unsigned char* lds, const bf16* P1, const float* lam, const float* subln, bf16* OC, int b, int h, int qt, int tid_in, int lane_in, int wave) {
    int lane = lane_in; asm volatile("" : "+v"(lane)); const int tid = wave * 64 + lane; (void)tid_in;
    const int r32 = lane & 31, hi = lane >> 5, t = qt * 256 + wave * 32 + r32;
    const LAS float* BT = (const LAS float*)(lds + AT_BT) + (16 + h) * BT_STRIDE;
    float d01 = 0.f, d23 = 0.f;
    { d01 = lam[lane] * lam[64 + lane]; d23 = lam[128 + lane] * lam[192 + lane]; d01 = wave_sum(d01); d23 = wave_sum(d23); }
    const float lam_full = __expf(d01) - __expf(d23) + LAM_INIT;
    unsigned o0p[32];
    f32x16 o[4];
#pragma unroll 1
    for (int e = 0; e < 2; ++e) {
        bf16x8 qf[4]; load_q_scaled<64>(P1 + (size_t)(b * SEQ + t) * OD_INP + D_QD + (h * 2 + e) * 64, qf, 0.125f * LOG2E, lane);
        KVSrc kv{P1 + (size_t)(b * SEQ) * OD_INP + D_KD + (h * 2 + e) * 64, OD_INP, nullptr, 0, P1 + (size_t)(b * SEQ) * OD_INP + D_VD + h * 128, OD_INP};
#pragma unroll
        for (int dt = 0; dt < 4; ++dt) o[dt] = (f32x16){};
        SmState S{0.f, 0.f, false};
        FCausal<true> f{t, qt * 256 + wave * 32, qt * 256 + wave * 32 + 31, hi, BT};
        attn_loop<64, 64, 128, FCausal<true>>(lds, kv, 0, 4 * qt + 4, qf, f, o, S, tid, lane);
        const float lt = swapsum(S.l), inv = lt > 0.f ? 1.f / lt : 0.f;
        if (e == 0) {
#pragma unroll
            for (int dt = 0; dt < 4; ++dt)
#pragma unroll
                for (int k = 0; k < 8; ++k) o0p[dt * 8 + k] = cvtpk(o[dt][2 * k] * inv, o[dt][2 * k + 1] * inv);
        } else {
            float ss = 0.f;
#pragma unroll
            for (int dt = 0; dt < 4; ++dt)
#pragma unroll
                for (int k = 0; k < 8; ++k) { const unsigned w = o0p[dt * 8 + k];
                    const float a0 = __uint_as_float(w << 16) - lam_full * (o[dt][2 * k] * inv), a1 = __uint_as_float(w & 0xffff0000u) - lam_full * (o[dt][2 * k + 1] * inv);
                    o[dt][2 * k] = a0; o[dt][2 * k + 1] = a1; ss += a0 * a0 + a1 * a1; }
            ss = swapsum(ss);
            const float rn = __builtin_amdgcn_rsqf(ss * (1.f / 128.f) + RMS_EPS) * (1.0f - LAM_INIT);
            bf16* orow = OC + (size_t)(b * SEQ + t) * DM + 512 + h * 128;
#pragma unroll
            for (int dt = 0; dt < 4; ++dt)
#pragma unroll
                for (int r4 = 0; r4 < 4; r4 += 2) { const int d = 32 * dt + 8 * r4 + 4 * hi; const f32x4 gn = *(const GAS f32x4*)(subln + d), gm = *(const GAS f32x4*)(subln + d + 8);
                    v2u wa, wb; wa.x = cvtpk(o[dt][4 * r4 + 0] * rn * gn.x, o[dt][4 * r4 + 1] * rn * gn.y); wa.y = cvtpk(o[dt][4 * r4 + 2] * rn * gn.z, o[dt][4 * r4 + 3] * rn * gn.w);
                    wb.x = cvtpk(o[dt][4 * r4 + 4] * rn * gm.x, o[dt][4 * r4 + 5] * rn * gm.y); wb.y = cvtpk(o[dt][4 * r4 + 6] * rn * gm.z, o[dt][4 * r4 + 7] * rn * gm.w);
                    swap_pair(wa, wb);
                    *(GAS v4u*)(orow + 32 * dt + 8 * r4 + 8 * hi) = (v4u){wa.x, wa.y, wb.x, wb.y}; }
        }
    }
}


__device__ __forceinline__ void tr_item(const float* W, int N, bf16* WT, int ldk, int drow0, LAS float* scr, int k0, int n0, int lane, const float* grow = nullptr) {
#pragma unroll 8
    for (int i = 0; i < 32; ++i) { const int kk = 2 * i + (lane >> 5); float wv = W[(size_t)(k0 + kk) * N + n0 + (lane & 31)]; if (grow) wv *= grow[k0 + kk]; scr[kk * 33 + (lane & 31)] = wv; }
    LDS_WAIT(); asm volatile("" ::: "memory");
    const int c = lane & 7;
#pragma unroll
    for (int j = 0; j < 4; ++j) { const int n = (lane >> 3) + 8 * j; const LAS float* s = scr + (8 * c) * 33 + n;
        v4u o; o.x = pk2(s[0 * 33], s[1 * 33]); o.y = pk2(s[2 * 33], s[3 * 33]); o.z = pk2(s[4 * 33], s[5 * 33]); o.w = pk2(s[6 * 33], s[7 * 33]);
        *(GAS v4u*)(WT + (size_t)(drow0 + n) * ldk + k0 + 8 * c) = o; }
    LDS_WAIT(); asm volatile("" ::: "memory");
}
__device__ __forceinline__ void tr_item8(const float* W, int N, unsigned char* WT, int ldk, int drow0, LAS float* scr, int k0, int n0, int lane) {
#pragma unroll 8
    for (int i = 0; i < 32; ++i) { const int kk = 2 * i + (lane >> 5); scr[kk * 33 + (lane & 31)] = W[(size_t)(k0 + kk) * N + n0 + (lane & 31)]; }
    LDS_WAIT(); asm volatile("" ::: "memory");
    const int c = lane & 7;
#pragma unroll
    for (int j = 0; j < 4; ++j) { const int n = (lane >> 3) + 8 * j; const LAS float* s = scr + (8 * c) * 33 + n;
        v2u o; o.x = pg8::pk4_fp8(s[0 * 33], s[1 * 33], s[2 * 33], s[3 * 33], pg8::F8S_W); o.y = pg8::pk4_fp8(s[4 * 33], s[5 * 33], s[6 * 33], s[7 * 33], pg8::F8S_W);
        *(GAS v2u*)(WT + (size_t)(drow0 + n) * ldk + k0 + 8 * c) = o; }
    LDS_WAIT(); asm volatile("" ::: "memory");
}
constexpr size_t WS_XB = WS_OV + 370 * MiB;
constexpr size_t WS_RS = 1 * MiB;
constexpr int F8_FROM = 1;
__device__ __forceinline__ void rows_norm_phase(const float* xsrc, float* xdst, const bf16* Y, float w, const float* gpost, const float* gpre, bf16* H, int nrows, int gw, int NGW, int lane, bool f8 = false, float ysc = 1.f, const bf16* xsb = nullptr, bf16* xdb = nullptr, float* Rout = nullptr) {
    f32x4 gp[4], gq[4];
#pragma unroll
    for (int j = 0; j < 4; ++j) {
        gp[j] = Y ? ((const GAS f32x4*)gpost)[lane + 64 * j] * w : (f32x4){0.f, 0.f, 0.f, 0.f};
        gq[j] = gpre ? ((const GAS f32x4*)gpre)[lane + 64 * j] : (f32x4){0.f, 0.f, 0.f, 0.f};
    }
    for (int m = gw; m < nrows; m += NGW) {
        f32x4 x[4];
        if (xsb) {
            const GAS v2u* xr = (const GAS v2u*)(xsb + (size_t)m * DM) + lane;
#pragma unroll
            for (int j = 0; j < 4; ++j) { const v2u xv = xr[64 * j]; x[j] = (f32x4){__uint_as_float(xv.x << 16), __uint_as_float(xv.x & 0xffff0000u), __uint_as_float(xv.y << 16), __uint_as_float(xv.y & 0xffff0000u)}; }
        } else {
            const GAS f32x4* xr = (const GAS f32x4*)(xsrc + (size_t)m * DM) + lane;
#pragma unroll
            for (int j = 0; j < 4; ++j) x[j] = xr[64 * j];
        }
        if (Y) {
            const GAS v2u* yr = (const GAS v2u*)(Y + (size_t)m * DM) + lane;
            f32x4 y[4]; float s = 0.f;
#pragma unroll
            for (int j = 0; j < 4; ++j) { const v2u yv = yr[64 * j]; y[j] = (f32x4){__uint_as_float(yv.x << 16), __uint_as_float(yv.x & 0xffff0000u), __uint_as_float(yv.y << 16), __uint_as_float(yv.y & 0xffff0000u)} * ysc;
                s += (y[j].x * y[j].x + y[j].y * y[j].y) + (y[j].z * y[j].z + y[j].w * y[j].w); }
            const float rstd = __builtin_amdgcn_rsqf(wave_sum(s) * (1.f / DM) + RMS_EPS);
#pragma unroll
            for (int j = 0; j < 4; ++j) x[j] = x[j] + y[j] * rstd * gp[j];
        }
        if (xdst) {
            GAS f32x4* xo = (GAS f32x4*)(xdst + (size_t)m * DM) + lane;
#pragma unroll
            for (int j = 0; j < 4; ++j) xo[64 * j] = x[j];
        }
        if (xdb) {
            GAS v2u* xo = (GAS v2u*)(xdb + (size_t)m * DM) + lane;
#pragma unroll
            for (int j = 0; j < 4; ++j) { v2u o; o.x = pk2(x[j].x, x[j].y); o.y = pk2(x[j].z, x[j].w); xo[64 * j] = o; }
        }
        if (gpre || Rout) {
            float s2 = 0.f;
#pragma unroll
            for (int j = 0; j < 4; ++j) s2 += (x[j].x * x[j].x + x[j].y * x[j].y) + (x[j].z * x[j].z + x[j].w * x[j].w);
            const float r2 = __builtin_amdgcn_rsqf(wave_sum(s2) * (1.f / DM) + RMS_EPS);
            if (Rout && lane == 0) Rout[m] = r2;
            if (gpre) {
            if (f8) {
                GAS unsigned* ho = (GAS unsigned*)((unsigned char*)H + (size_t)m * DM) + lane;
#pragma unroll
                for (int j = 0; j < 4; ++j) { const f32x4 h = x[j] * r2 * gq[j]; ho[64 * j] = pg8::pk4_fp8(h.x, h.y, h.z, h.w, pg8::F8S_H); }
            } else {
            GAS v2u* ho = (GAS v2u*)(H + (size_t)m * DM) + lane;
#pragma unroll
            for (int j = 0; j < 4; ++j) { const f32x4 h = x[j] * r2 * gq[j]; v2u o; o.x = pk2(h.x, h.y); o.y = pk2(h.z, h.w); ho[64 * j] = o; }
            }
            }
        }
    }
}
__device__ __forceinline__ void transpose_cols_phase(const bf16* src, int ld, int col0, int ncols, int nb, int S, bf16* dst, LAS unsigned short* scr, int gw, int NGW, int lane, int gsz = 1 << 30, int gstride = 0) {
    const int nct = ncols / 64, nst = S / 64, nitems = nb * nct * nst;
    for (int it = gw; it < nitems; it += NGW) {
        const int st = it % nst, ct = (it / nst) % nct, b = it / (nst * nct);
        const bf16* sp = src + (size_t)(b * S + st * 64) * ld + col0 + ((ct * 64) / gsz) * gstride + (ct * 64) % gsz;
#pragma unroll
        for (int i = 0; i < 8; ++i) { const int r = i * 8 + (lane >> 3), c8 = (lane & 7) * 8;
            const v4u v = *(const GAS v4u*)(sp + (size_t)r * ld + c8);
            LAS unsigned* d = (LAS unsigned*)(scr + r * 66 + c8); d[0] = v.x; d[1] = v.y; d[2] = v.z; d[3] = v.w; }
        LDS_WAIT(); asm volatile("" ::: "memory");
        bf16* dp = dst + ((size_t)(b * ncols + ct * 64)) * S + st * 64;
#pragma unroll
        for (int i = 0; i < 8; ++i) { const int c = i * 8 + (lane >> 3), r8 = (lane & 7) * 8;
            unsigned short e[8];
#pragma unroll
            for (int k = 0; k < 8; ++k) e[k] = scr[(r8 + k) * 66 + c];
            v4u o; o.x = e[0] | ((unsigned)e[1] << 16); o.y = e[2] | ((unsigned)e[3] << 16); o.z = e[4] | ((unsigned)e[5] << 16); o.w = e[6] | ((unsigned)e[7] << 16);
            *(GAS v4u*)(dp + (size_t)c * S + r8) = o; }
        LDS_WAIT(); asm volatile("" ::: "memory");
    }
}

struct Args { const float* in[24]; float* out; unsigned char* ws; int ph_lo, ph_hi, stop, li; };
constexpr int PH_PRO = 0, PH_MEMKV = 1, PH_MEMVT = 2, PH_L0 = 3, PPL = 17, NPHASE = PH_L0 + 2 * PPL;

#define PHASE_IDS unsigned char* ws = args.ws; asm volatile("" : "+s"(ws)); int bx = bx0, vcu = vcu0; asm volatile("" : "+s"(bx), "+s"(vcu)); const int gw = vcu * NWAVES + wave, NGW = G * NWAVES; (void)gw; (void)NGW; (void)bx; int lane_l; asm volatile("v_mbcnt_lo_u32_b32 %0, -1, 0\n\tv_mbcnt_hi_u32_b32 %0, -1, %0" : "=v"(lane_l)); const int lane = lane_l, tid = wave * 64 + lane; bf16* const H = (bf16*)(ws + WS_H); bf16* const Y = (bf16*)(ws + WS_Y); bf16* const XB = (bf16*)(ws + WS_XB); float* const RS = (float*)(ws + WS_RS); (void)H; (void)Y; (void)XB; (void)RS; (void)tid;
#define IN(k) (lo <= (k) && (k) < hi && (k) < stop)
#define SEAM(k) do { if ((k) + 1 < hi && (k) + 1 < stop) { XcdBarrier b2 = bar; asm volatile("" : "+s"(b2.bar), "+s"(b2.x)); xcd_barrier(b2); } } while (0)
template <int L> __device__ __forceinline__ void layer_phases(const Args& args, LAS unsigned char* lds, const XcdBarrier& bar, int wave, int G, int bx0, int vcu0, int lo, int hi, int stop) {
    const float* x_in = args.in[0]; const float* norm_pre = args.in[3]; const float* norm_post = args.in[4]; float* xout = args.out;

        const int base = PH_L0 + L * PPL;
        const float* gpre = norm_pre + (size_t)L * 4 * DM; const float* gpost = norm_post + (size_t)L * 4 * DM;
        if (IN(base + 0)) {
            PHASE_IDS
            pg8::StaticOrder S; S.init(MTOK, 5632, G, bx);
            if constexpr (L * 2 + 0 >= F8_FROM) {
                pg8::Gemm g{H, (const bf16*)(ws + WS_WGU) + (size_t)(L * 2 + 0) * 5632 * DM, MTOK, 5632, DM};
                pg8::EpiSwiGLU8 E{ws + WS_HID, DFF};
                pg8::gemm_phase<pg8::EpiSwiGLU8, pg8::StaticOrder, true, true, true>(lds, g, S, E, tid);
            } else {
                pg8::Gemm g{XB, (const bf16*)(ws + WS_WGU) + (size_t)(L * 2 + 0) * 5632 * DM, MTOK, 5632, DM};
                pg8::EpiSwiGLUR E{(bf16*)(ws + WS_HID), DFF, RS};
                pg8::gemm_phase<pg8::EpiSwiGLUR, pg8::StaticOrder, true, true>(lds, g, S, E, tid);
            }
            SEAM(base + 0);
        }
        if (IN(base + 1)) {
            PHASE_IDS
            pg8::StaticOrder S; S.init(MTOK, DM, G, bx);
            pg8::EpiBf16P E{Y, DM};
            if constexpr (L * 2 + 0 >= F8_FROM) {
                pg8::Gemm g{(const bf16*)(ws + WS_HID), (const bf16*)(ws + WS_WD) + (size_t)(L * 2 + 0) * DM * DFF, MTOK, DM, DFF};
                pg8::gemm_phase<pg8::EpiBf16P, pg8::StaticOrder, true, true, true>(lds, g, S, E, tid);
            } else {
                pg8::Gemm g{(const bf16*)(ws + WS_HID), (const bf16*)(ws + WS_WD) + (size_t)(L * 2 + 0) * DM * DFF, MTOK, DM, DFF};
                pg8::gemm_phase<pg8::EpiBf16P, pg8::StaticOrder, true, true>(lds, g, S, E, tid);
            }
            SEAM(base + 1);
        }
        if (IN(base + 2)) {
            PHASE_IDS
            rows_norm_phase(nullptr, nullptr, Y, 0.5f, gpost, L == 0 ? nullptr : gpre + DM, H, MTOK, gw, NGW, lane, L == 1, L * 2 + 0 >= F8_FROM ? 1.f / (pg8::F8S_W * pg8::F8S_HID) : 1.f, XB, XB, L == 0 ? RS : nullptr);
            SEAM(base + 2);
        }
        if (L == 0 && IN(base + 3)) {
            PHASE_IDS
            pg8::Gemm g{XB, (const bf16*)(ws + WS_EVIN), MTOK, EV_INP, DM};
            pg8::StaticOrder S; S.init(MTOK, EV_INP, G, bx);
            pg8::EpiBf16PR E{(bf16*)(ws + WS_P0), EV_INP, RS};
            pg8::gemm_phase<pg8::EpiBf16PR, pg8::StaticOrder, true, true>(lds, g, S, E, tid);
            SEAM(base + 3);
        }
        if (L == 0 && IN(base + 4)) {
            PHASE_IDS
            if (args.li == 0) { PHASE_IDS
            const bf16* P0 = (const bf16*)(ws + WS_P0);
            for (int it0 = vcu * 2; it0 < 512; it0 += G * 2) nsa_compress_pair(lds, P0, (const bf16*)(ws + WS_CWT), (const float*)(ws + WS_CBIAS), (bf16*)(ws + WS_KCMP), (bf16*)(ws + WS_VCMP), it0, wave, lane);
            }
            __syncthreads();
            { PHASE_IDS
            const bf16* P0 = (const bf16*)(ws + WS_P0);
            for (int u = vcu, i = 0; u < NB * 256; u += G, ++i) {
                int b, qt;
                if (G == 256) { b = vcu >> 4; const int sub = vcu & 15; qt = (i & 1) ? 16 * i + 15 - sub : 16 * i + sub; } else { b = u & 15; qt = u >> 4; }
                dsa_index_unit(lds, P0, (unsigned short*)(ws + WS_SEL), b, qt, tid, lane, wave);
            } }
            SEAM(base + 4);
        }
        if (L == 0 && IN(base + 5)) {
            PHASE_IDS
            build_bias_tables(lds, args.in[2], tid);
            __syncthreads();
            { PHASE_IDS
            const bf16* P0 = (const bf16*)(ws + WS_P0);
            for (int u = vcu, i = 0; u < NB * 2 * 64; u += G, ++i) {
                int bg, qt;
                if (G == 256) { bg = vcu >> 3; const int sub = vcu & 7; qt = (i & 1) ? 8 * i + 7 - sub : 8 * i + sub; } else { bg = u & 31; qt = u >> 5; }
                nsa_unit(lds, P0, (const bf16*)(ws + WS_KCMP), (const bf16*)(ws + WS_VCMP), H, bg >> 1, bg & 1, qt, tid, lane, wave);
            } }
            { PHASE_IDS
            const bf16* P0 = (const bf16*)(ws + WS_P0);
            for (int u = vcu, i = 0; u < NB * 128; u += G, ++i) {
                int b, qt;
                if (G == 256) { b = vcu >> 4; const int sub = vcu & 15; qt = (i & 1) ? 16 * i + 15 - sub : 16 * i + sub; } else { b = u & 15; qt = u >> 4; }
                dsa_unit(lds, P0, (const unsigned short*)(ws + WS_SEL), H, b, qt, tid, lane, wave);
            } }
            SEAM(base + 5);
        }
        if (L == 1 && IN(base + 3)) {
            PHASE_IDS
            pg8::Gemm g{H, (const bf16*)(ws + WS_ODIN), MTOK, OD_INP, DM};
            pg8::StaticOrder S; S.init(MTOK, OD_INP, G, bx);
            pg8::EpiBf16PS E{(bf16*)(ws + WS_P1), OD_INP, 1.f / (pg8::F8S_W * pg8::F8S_H)};
            pg8::gemm_phase<pg8::EpiBf16PS, pg8::StaticOrder, true, true, true>(lds, g, S, E, tid);
            SEAM(base + 3);
        }
        if (L == 1 && IN(base + 4)) {
            PHASE_IDS
            const bf16* P1 = (const bf16*)(ws + WS_P1);
            odd_prep_rows(P1, args.in[14], args.in[15], (const float*)(ws + WS_ROPE), (bf16*)(ws + WS_CQN), (bf16*)(ws + WS_CKVN), (bf16*)(ws + WS_KR), gw, NGW, lane);
            SEAM(base + 4);
        }
        if (L == 1 && IN(base + 5)) {
            PHASE_IDS
            { pg8::Gemm g{(const bf16*)(ws + WS_CQN), (const bf16*)(ws + WS_WUQ), MTOK, 768, 256};
              pg8::StaticOrder S; S.init(MTOK, 768, G, bx);
              pg8::EpiBf16P E{(bf16*)(ws + WS_QMLA), 768};
              pg8::gemm_phase<pg8::EpiBf16P, pg8::StaticOrder, true, true>(lds, g, S, E, tid); }
            __syncthreads();
            { pg8::Gemm g{(const bf16*)(ws + WS_CKVN), (const bf16*)(ws + WS_WUKV), MTOK, 1024, 256};
              pg8::StaticOrder S; S.init(MTOK, 1024, G, bx);
              pg8::EpiBf16P E{(bf16*)(ws + WS_KVMLA), 1024};
              pg8::gemm_phase<pg8::EpiBf16P, pg8::StaticOrder, true, true>(lds, g, S, E, tid); }
            SEAM(base + 5);
        }
        if (L == 1 && IN(base + 7)) {
            { PHASE_IDS
            build_bias_tables(lds, args.in[2], tid);
            __syncthreads();
            for (int u = vcu, i = 0; u < NB * 8 * 16; u += G, ++i) {
                int bh, qt;
                if (G == 256) { bh = vcu >> 1; const int sub = vcu & 1; qt = (i & 1) ? 2 * i + 1 - sub : 2 * i + sub; } else { bh = u & 127; qt = u >> 7; }
                mla_unit(lds, (const bf16*)(ws + WS_QMLA), (const bf16*)(ws + WS_KVMLA), (const bf16*)(ws + WS_KR), (const float*)(ws + WS_ROPE), H, bh >> 3, bh & 7, qt, tid, lane, wave);
            } }
            { PHASE_IDS
            for (int u = vcu, i = 0; u < NB * 4 * 16; u += G, ++i) {
                int bh, qt;
                if (G == 256) { bh = vcu >> 2; const int sub = vcu & 3; qt = (i & 1) ? 4 * i + 3 - sub : 4 * i + sub; } else { bh = u & 63; qt = u >> 6; }
                diff_unit(lds, (const bf16*)(ws + WS_P1), args.in[18], args.in[19], H, bh >> 2, bh & 3, qt, tid, lane, wave);
            } }
            SEAM(base + 7);
        }
        if (IN(base + 8)) {
            PHASE_IDS
            pg8::Gemm g{H, (const bf16*)(ws + (L == 0 ? WS_EVOUT : WS_ODOUT)), MTOK, DM, DM};
            pg8::StaticOrder S; S.init(MTOK, DM, G, bx);
            pg8::EpiBf16P E{Y, DM};
            pg8::gemm_phase<pg8::EpiBf16P, pg8::StaticOrder, true, true>(lds, g, S, E, tid);
            SEAM(base + 8);
        }
        if (IN(base + 9)) {
            PHASE_IDS
            rows_norm_phase(nullptr, nullptr, Y, 1.0f, gpost + DM, nullptr, H, MTOK, gw, NGW, lane, false, 1.f, XB, XB, RS);
            SEAM(base + 9);
        }
        if (IN(base + 10)) {
            PHASE_IDS
            pg8::Gemm g{XB, (const bf16*)(ws + WS_XWQ) + (size_t)L * 512 * DM, MTOK, 512, DM};
            pg8::StaticOrder S; S.init(MTOK, 512, G, bx);
            pg8::EpiBf16PR E{(bf16*)(ws + WS_XQ), 512, RS};
            pg8::gemm_phase<pg8::EpiBf16PR, pg8::StaticOrder, true, true>(lds, g, S, E, tid);
            SEAM(base + 10);
        }
        if (IN(base + 11)) {
            PHASE_IDS
            for (int u = vcu; u < NB * 4 * 16; u += G) {
                const int qt = u & 15, h = (u >> 4) & 3, b = u >> 6;
                xattn_unit(lds, (const bf16*)(ws + WS_XQ), (const bf16*)(ws + WS_KVM) + (size_t)L * MROWS * DM, H, b, h, qt, tid, lane, wave);
            }
            SEAM(base + 11);
        }
        if (IN(base + 12)) {
            PHASE_IDS
            pg8::Gemm g{H, (const bf16*)(ws + WS_XWO) + (size_t)L * DM * 512, MTOK, DM, 512};
            pg8::StaticOrder S; S.init(MTOK, DM, G, bx);
            pg8::EpiBf16P E{Y, DM};
            pg8::gemm_phase<pg8::EpiBf16P, pg8::StaticOrder, true, true>(lds, g, S, E, tid);
            SEAM(base + 12);
        }
        if (IN(base + 13)) {
            PHASE_IDS
            rows_norm_phase(nullptr, nullptr, Y, 1.0f, gpost + 2 * DM, gpre + 3 * DM, H, MTOK, gw, NGW, lane, L * 2 + 1 >= F8_FROM, 1.f, XB, XB);
            SEAM(base + 13);
        }
        if (IN(base + 14)) {
            PHASE_IDS
            pg8::StaticOrder S; S.init(MTOK, 5632, G, bx);
            if constexpr (L * 2 + 1 >= F8_FROM) {
                pg8::Gemm g{H, (const bf16*)(ws + WS_WGU) + (size_t)(L * 2 + 1) * 5632 * DM, MTOK, 5632, DM};
                pg8::EpiSwiGLU8 E{ws + WS_HID, DFF};
                pg8::gemm_phase<pg8::EpiSwiGLU8, pg8::StaticOrder, true, true, true>(lds, g, S, E, tid);
            } else {
                pg8::Gemm g{H, (const bf16*)(ws + WS_WGU) + (size_t)(L * 2 + 1) * 5632 * DM, MTOK, 5632, DM};
                pg8::EpiSwiGLU E{(bf16*)(ws + WS_HID), DFF};
                pg8::gemm_phase<pg8::EpiSwiGLU, pg8::StaticOrder, true, true>(lds, g, S, E, tid);
            }
            SEAM(base + 14);
        }
        if (IN(base + 15)) {
            PHASE_IDS
            pg8::StaticOrder S; S.init(MTOK, DM, G, bx);
            pg8::EpiBf16P E{Y, DM};
            if constexpr (L * 2 + 1 >= F8_FROM) {
                pg8::Gemm g{(const bf16*)(ws + WS_HID), (const bf16*)(ws + WS_WD) + (size_t)(L * 2 + 1) * DM * DFF, MTOK, DM, DFF};
                pg8::gemm_phase<pg8::EpiBf16P, pg8::StaticOrder, true, true, true>(lds, g, S, E, tid);
            } else {
                pg8::Gemm g{(const bf16*)(ws + WS_HID), (const bf16*)(ws + WS_WD) + (size_t)(L * 2 + 1) * DM * DFF, MTOK, DM, DFF};
                pg8::gemm_phase<pg8::EpiBf16P, pg8::StaticOrder, true, true>(lds, g, S, E, tid);
            }
            SEAM(base + 15);
        }
        if (IN(base + 16)) {
            PHASE_IDS
            rows_norm_phase(nullptr, L == 0 ? nullptr : xout, Y, 0.5f, gpost + 3 * DM, L == 0 ? norm_pre + 4 * DM : nullptr, H, MTOK, gw, NGW, lane, L * 2 + 2 >= F8_FROM, L * 2 + 1 >= F8_FROM ? 1.f / (pg8::F8S_W * pg8::F8S_HID) : 1.f, XB, L == 0 ? XB : nullptr);
            SEAM(base + 16);
        }
}


__global__ void __launch_bounds__(NWAVES * 64, 2) fwd_kernel(Args args) {
    extern __shared__ __attribute__((aligned(16))) unsigned char lds_raw[];
    LAS unsigned char* lds = (LAS unsigned char*)lds_raw;
    volatile LAS unsigned* MISC = (volatile LAS unsigned*)(lds + MISC_OFF);
    const int tid0 = threadIdx.x, wave = __builtin_amdgcn_readfirstlane(tid0 >> 6);
    const int G = gridDim.x, bx0 = blockIdx.x;
    const int vcu0 = (G % 8 == 0) ? (bx0 % 8) * (G / 8) + bx0 / 8 : bx0;
    unsigned* ctl = (unsigned*)(args.ws + WS_CTL);
    for (int u = tid0; u < (LDS_BYTES - LDSCTL_OFF) / 4; u += NWAVES * 64) ((LAS unsigned*)(lds + LDSCTL_OFF))[u] = 0u;
    __syncthreads();
    XcdBarrier bar = xcd_barrier_post(ctl + CW_BAR + args.li * XCD_BAR_WORDS, MISC + 8);
    const int lo = args.ph_lo, hi = args.ph_hi, stop = args.stop;

    const float* x_in = args.in[0]; const float* mem = args.in[1];
    const float* norm_pre = args.in[3]; const float* norm_post = args.in[4]; const float* mem_norm = args.in[5];
    float* xout = args.out;

    if (IN(PH_PRO)) {
            PHASE_IDS
        LAS float* scr = (LAS float*)(lds + wave * 16384);
        constexpr int I_GU = (DM / 64) * (DFF / 32), I_D = (DFF / 64) * (DM / 32);
        constexpr int I_EVIN = (DM / 64) * (EV_IN / 32), I_SQ = (DM / 64) * (DM / 32), I_ODIN = (DM / 64) * (OD_IN / 32);
        constexpr int I_UQ = (256 / 64) * (768 / 32), I_UKV = (128 / 64) * (1024 / 32), I_XQ = (DM / 64) * (512 / 32), I_XO = (512 / 64) * (DM / 32);
        constexpr int I_CW = (2048 / 64) * (64 / 32);
        constexpr int NITEMS = 8 * I_GU + 4 * I_D + I_EVIN + I_SQ + I_ODIN + I_SQ + I_UQ + I_UKV + 2 * I_XQ + 2 * I_SQ + 2 * I_XO + 2 * I_CW;
        for (int it = gw; it < NITEMS; it += NGW) {
            int r = it;
            if (r < 8 * I_GU) { const int mat = r / I_GU, rr = r % I_GU, which = mat & 1, ij = mat >> 1, nblk = DFF / 32, k0 = (rr / nblk) * 64, n0 = (rr % nblk) * 32;
                if (ij >= F8_FROM) tr_item8((which ? args.in[7] : args.in[6]) + (size_t)ij * DM * DFF, DFF, ws + WS_WGU + (size_t)ij * 5632 * DM * 2, DM, (n0 / 128) * 256 + which * 128 + (n0 % 128), scr, k0, n0, lane);
                else tr_item((which ? args.in[7] : args.in[6]) + (size_t)ij * DM * DFF, DFF, (bf16*)(ws + WS_WGU) + (size_t)ij * 5632 * DM, DM, (n0 / 128) * 256 + which * 128 + (n0 % 128), scr, k0, n0, lane, norm_pre);
                continue; } r -= 8 * I_GU;
            if (r < 4 * I_D) { const int mat = r / I_D, rr = r % I_D, nblk = DM / 32, k0 = (rr / nblk) * 64, n0 = (rr % nblk) * 32;
                if (mat >= F8_FROM) tr_item8(args.in[8] + (size_t)mat * DFF * DM, DM, ws + WS_WD + (size_t)mat * DM * DFF * 2, DFF, n0, scr, k0, n0, lane);
                else tr_item(args.in[8] + (size_t)mat * DFF * DM, DM, (bf16*)(ws + WS_WD) + (size_t)mat * DM * DFF, DFF, n0, scr, k0, n0, lane);
                continue; } r -= 4 * I_D;
            if (r < I_EVIN) { const int nblk = EV_IN / 32, k0 = (r / nblk) * 64, n0 = (r % nblk) * 32; tr_item(args.in[9], EV_IN, (bf16*)(ws + WS_EVIN), DM, n0, scr, k0, n0, lane, norm_pre + DM); continue; } r -= I_EVIN;
            if (r < I_SQ) { const int nblk = DM / 32, k0 = (r / nblk) * 64, n0 = (r % nblk) * 32; tr_item(args.in[12], DM, (bf16*)(ws + WS_EVOUT), DM, n0, scr, k0, n0, lane); continue; } r -= I_SQ;
            if (r < I_ODIN) { const int nblk = OD_IN / 32, k0 = (r / nblk) * 64, n0 = (r % nblk) * 32; tr_item8(args.in[13], OD_IN, ws + WS_ODIN, DM, n0, scr, k0, n0, lane); continue; } r -= I_ODIN;
            if (r < I_SQ) { const int nblk = DM / 32, k0 = (r / nblk) * 64, n0 = (r % nblk) * 32; tr_item(args.in[20], DM, (bf16*)(ws + WS_ODOUT), DM, n0, scr, k0, n0, lane); continue; } r -= I_SQ;
            if (r < I_UQ) { const int nblk = 768 / 32, k0 = (r / nblk) * 64, n0 = (r % nblk) * 32; tr_item(args.in[16], 768, (bf16*)(ws + WS_WUQ), 256, n0, scr, k0, n0, lane); continue; } r -= I_UQ;
            if (r < I_UKV) { const int nblk = 1024 / 32, k0 = (r / nblk) * 64, n0 = (r % nblk) * 32; tr_item(args.in[17], 1024, (bf16*)(ws + WS_WUKV), 256, n0, scr, k0, n0, lane); continue; } r -= I_UKV;
            if (r < 2 * I_XQ) { const int mat = r / I_XQ, rr = r % I_XQ, nblk = 512 / 32, k0 = (rr / nblk) * 64, n0 = (rr % nblk) * 32;
                tr_item(args.in[21] + (size_t)mat * DM * 512, 512, (bf16*)(ws + WS_XWQ) + (size_t)mat * 512 * DM, DM, n0, scr, k0, n0, lane, norm_pre + (size_t)(mat * 4 + 2) * DM); continue; } r -= 2 * I_XQ;
            if (r < 2 * I_SQ) { const int mat = r / I_SQ, rr = r % I_SQ, nblk = DM / 32, k0 = (rr / nblk) * 64, n0 = (rr % nblk) * 32;
                tr_item(args.in[22] + (size_t)mat * DM * DM, DM, (bf16*)(ws + WS_XWKV) + (size_t)mat * DM * DM, DM, n0, scr, k0, n0, lane); continue; } r -= 2 * I_SQ;
            if (r < 2 * I_XO) { const int mat = r / I_XO, rr = r % I_XO, nblk = DM / 32, k0 = (rr / nblk) * 64, n0 = (rr % nblk) * 32;
                tr_item(args.in[23] + (size_t)mat * 512 * DM, DM, (bf16*)(ws + WS_XWO) + (size_t)mat * DM * 512, 512, n0, scr, k0, n0, lane); continue; } r -= 2 * I_XO;
            { const int mat = r / I_CW, rr = r % I_CW, nblk = 64 / 32, k0 = (rr / nblk) * 64, n0 = (rr % nblk) * 32;
                tr_item(args.in[11] + (size_t)mat * 2048 * 64, 64, (bf16*)(ws + WS_CWT) + (size_t)mat * 64 * 2048, 2048, n0, scr, k0, n0, lane); }
        }
        { const int gt = vcu * (NWAVES * 64) + tid, NGT = G * NWAVES * 64; const v4u z = (v4u){0u, 0u, 0u, 0u};
          for (int i = gt; i < (EV_INP - EV_IN) * DM / 8; i += NGT) ((GAS v4u*)((bf16*)(ws + WS_EVIN) + (size_t)EV_IN * DM))[i] = z;
          for (int i = gt; i < (OD_INP - OD_IN) * DM / 16; i += NGT) ((GAS v4u*)(ws + WS_ODIN + (size_t)OD_IN * DM))[i] = z;
          for (int i = gt; i < 1024 * 16; i += NGT) ((GAS v4u*)((bf16*)(ws + WS_WUKV) + (size_t)(i >> 4) * 256 + 128))[i & 15] = z; }
        if (gw < 128) { const int c = gw >> 6, e = gw & 63; const float* pe = args.in[10] + (size_t)c * 2048; const float* cw = args.in[11] + (size_t)c * 2048 * 64 + e; float a = 0.f;
            for (int k = lane; k < 2048; k += 64) a += pe[k] * cw[(size_t)k * 64];
            a = wave_sum(a); if (lane == 0) ((float*)(ws + WS_CBIAS))[gw] = a; }
        rope_table_phase((float*)(ws + WS_ROPE), vcu * (NWAVES * 64) + tid, G * NWAVES * 64);
        rows_norm_phase(x_in, nullptr, nullptr, 0.f, nullptr, nullptr, H, MTOK, gw, NGW, lane, false, 1.f, nullptr, XB, RS);
        rows_norm_phase(mem, nullptr, nullptr, 0.f, nullptr, mem_norm, (bf16*)(ws + WS_MN), MROWS, gw, NGW, lane);
        rows_norm_phase(mem, nullptr, nullptr, 0.f, nullptr, mem_norm + DM, (bf16*)(ws + WS_MN) + (size_t)MROWS * DM, MROWS, gw, NGW, lane);
        SEAM(PH_PRO);
    }
    if (IN(PH_MEMKV)) {
            PHASE_IDS
#pragma unroll 1
        for (int i = 0; i < 2; ++i) {
            pg8::Gemm g{(const bf16*)(ws + WS_MN) + (size_t)i * MROWS * DM, (const bf16*)(ws + WS_XWKV) + (size_t)i * DM * DM, MROWS, DM, DM};
            pg8::StaticOrder S; S.init(MROWS, DM, G, (bx + 128 * i) % G);
            pg8::EpiBf16P E{(bf16*)(ws + WS_KVM) + (size_t)i * MROWS * DM, DM};
            pg8::gemm_phase<pg8::EpiBf16P, pg8::StaticOrder, true, true>(lds, g, S, E, tid);
            __syncthreads();
        }
        SEAM(PH_MEMKV);
    }
    layer_phases<0>(args, lds, bar, wave, G, bx0, vcu0, lo, hi, stop);
    layer_phases<1>(args, lds, bar, wave, G, bx0, vcu0, lo, hi, stop);
#undef IN
#undef SEAM
}

#ifndef MK_MODE
#define MK_MODE 1
#endif
#ifndef MK_STOP
#define MK_STOP NPHASE
#endif
extern "C" void kernel_launch(void* const* d_in, const int* in_sizes, int n_in, void* d_out, int out_size, void* d_ws, size_t ws_size, hipStream_t stream) {
    static int grid = 0;
    if (grid == 0) {
        if (n_in != 24 || out_size != MTOK * DM || ws_size < WS_END) { fprintf(stderr, "kernel_launch: unexpected shapes: n_in %d out %d ws %zu\n", n_in, out_size, ws_size); grid = -1; return; }
        int dev = 0, cus = 0, per_cu = 0;
        if (hipGetDevice(&dev) != hipSuccess || hipDeviceGetAttribute(&cus, hipDeviceAttributeMultiprocessorCount, dev) != hipSuccess) { grid = -1; return; }
        if (hipFuncSetAttribute((const void*)fwd_kernel, hipFuncAttributeMaxDynamicSharedMemorySize, LDS_BYTES) != hipSuccess) { fprintf(stderr, "kernel_launch: hipFuncSetAttribute failed\n"); grid = -1; return; }
        if (hipOccupancyMaxActiveBlocksPerMultiprocessor(&per_cu, (const void*)fwd_kernel, NWAVES * 64, LDS_BYTES) != hipSuccess || per_cu < 1)
            fprintf(stderr, "kernel_launch: occupancy query reports %d workgroups per CU\n", per_cu);
        (void)hipGetLastError();
        grid = cus;
    }
    if (grid < 0) return;
    if (hipMemsetAsync((char*)d_ws + WS_CTL, 0, CTL_ZERO_BYTES, stream) != hipSuccess) return;
    Args a{};
    for (int i = 0; i < 24; ++i) a.in[i] = (const float*)d_in[i];
    a.out = (float*)d_out; a.ws = (unsigned char*)d_ws; a.stop = MK_STOP;
#if MK_MODE == 1
    a.ph_lo = 0; a.ph_hi = NPHASE; a.li = 0;
    hipLaunchKernelGGL(fwd_kernel, dim3(grid), dim3(NWAVES * 64), LDS_BYTES, stream, a);
#else
    for (int p = 0; p < NPHASE && p < MK_STOP; ++p) {
        a.ph_lo = p; a.ph_hi = p + 1; a.li = 0;
        hipLaunchKernelGGL(fwd_kernel, dim3(grid), dim3(NWAVES * 64), LDS_BYTES, stream, a);
#ifdef MK_REP
        { const int k = p < PH_L0 ? -1 : (p - PH_L0) % PPL, L = p < PH_L0 ? -1 : (p - PH_L0) / PPL; (void)k; (void)L;
          if (MK_REP) { a.li = 1; hipLaunchKernelGGL(fwd_kernel, dim3(grid), dim3(NWAVES * 64), LDS_BYTES, stream, a); a.li = 0; } }
#endif
    }
#endif
}
```

```cpp
#include <hip/hip_runtime.h>
#include <cstdio>
#include <cstdint>
namespace pg8 {
#define PG8_LAS __attribute__((address_space(3)))
typedef unsigned short bf16_t;
typedef short bf16x8 __attribute__((ext_vector_type(8)));
typedef float f32x4 __attribute__((ext_vector_type(4)));
typedef unsigned u32x4 __attribute__((ext_vector_type(4)));
constexpr int BM = 256, BK = 64, HALF = 128, HTB = HALF * BK * 2  , STAGE_BYTES = 8 * HTB, NXCD = 8, WGM = 8;

__host__ __device__ __forceinline__ int lds_byte(int r, int c) { const int st = (r >> 4) * 2 + (c >> 5), rr = r & 15, cc = c & 31, ob = rr * 64 + cc * 2; return st * 1024 + (ob ^ (((ob >> 9) & 1) << 5)); }
__host__ __device__ __forceinline__ void stage_rc(int b, int& R, int& C) { const int st = b / 1024, sb = b % 1024, swz = sb ^ (((sb >> 9) & 1) << 5); R = (st >> 1) * 16 + swz / 64; C = (st & 1) * 32 + (swz % 64) / 2; }
__host__ __device__ __forceinline__ int perm32(int rho) { const int n = rho >> 4, i = rho & 15; return 8 * (i >> 2) + 4 * n + (i & 3); }

struct Unit { int pm, pn; };
struct Gemm { const bf16_t* A; const bf16_t* Bt; int M, N, K; };
typedef int i32x4 __attribute__((ext_vector_type(4)));
typedef int i32x8 __attribute__((ext_vector_type(8)));
__device__ __forceinline__ i32x8 cat8(bf16x8 a, bf16x8 b) { const i32x4 x = __builtin_bit_cast(i32x4, a), y = __builtin_bit_cast(i32x4, b); return __builtin_shufflevector(x, y, 0, 1, 2, 3, 4, 5, 6, 7); }

struct StaticOrder {
    int nM, nN, nwg, G, c;
    __host__ __device__ void init(int M, int N, int G_, int c_) { nM = M / BM; nN = N / BM; nwg = nM * nN; G = G_; c = c_; }
    __host__ __device__ bool next(int i, Unit& u) const {
        const long L = (long)i * G + c; if (L >= nwg) return false;
        int wgid = (int)L; { const int q = nwg / NXCD, r = nwg % NXCD, xcd = wgid % NXCD, off = wgid / NXCD; wgid = (xcd < r ? xcd * (q + 1) : r * (q + 1) + (xcd - r) * q) + off; }
        const int nig = WGM * nN, gid = wgid / nig, fm = gid * WGM, gsz = (nM - fm) < WGM ? (nM - fm) : WGM;
        u.pm = fm + ((wgid % nig) % gsz); u.pn = (wgid % nig) / gsz; return true;
    }
    __device__ __forceinline__ void a_ready(const Unit&) const {}
    __device__ __forceinline__ void done(const Unit&) const {}
};


__device__ __forceinline__ unsigned cvt_pk_bf16(float lo, float hi) { unsigned r; asm volatile("v_cvt_pk_bf16_f32 %0, %1, %2" : "=v"(r) : "v"(lo), "v"(hi)); return r; }

struct EpiF32 {
    static constexpr bool PERM = false, AFTER_DRAIN = false;
    float* C; int ldc;
    __device__ __forceinline__ void operator()(const f32x4 (&acc)[2][2][4][2], const Unit& u, int wr, int wc, int fr, int fq) const {
        const int row0 = u.pm * BM + wr * 64 + fr, col0 = u.pn * BM + wc * 32 + 4 * fq;
#pragma unroll
        for (int ai = 0; ai < 2; ++ai)
#pragma unroll
            for (int m = 0; m < 4; ++m) { float* rowp = C + (size_t)(row0 + ai * HALF + m * 16) * ldc + col0;
#pragma unroll
                for (int bj = 0; bj < 2; ++bj)
#pragma unroll
                    for (int n = 0; n < 2; ++n) *(f32x4*)(rowp + bj * HALF + n * 16) = acc[ai][bj][m][n]; }
    }
};
struct EpiBf16P {
    static constexpr bool PERM = true, AFTER_DRAIN = false;
    bf16_t* O; int ldc;
    __device__ __forceinline__ void operator()(const f32x4 (&acc)[2][2][4][2], const Unit& u, int wr, int wc, int fr, int fq) const {
        const int row0 = u.pm * BM + wr * 64 + fr, col0 = u.pn * BM + wc * 32 + 8 * fq;
#pragma unroll
        for (int ai = 0; ai < 2; ++ai)
#pragma unroll
            for (int m = 0; m < 4; ++m) { bf16_t* rowp = O + (size_t)(row0 + ai * HALF + m * 16) * ldc + col0;
#pragma unroll
                for (int bj = 0; bj < 2; ++bj) { const f32x4 v0 = acc[ai][bj][m][0], v1 = acc[ai][bj][m][1];
                    u32x4 w; w.x = cvt_pk_bf16(v0[0], v0[1]); w.y = cvt_pk_bf16(v0[2], v0[3]); w.z = cvt_pk_bf16(v1[0], v1[1]); w.w = cvt_pk_bf16(v1[2], v1[3]);
                    *(u32x4*)(rowp + bj * HALF) = w; } }
    }
};
__device__ __forceinline__ float silu_mul(float g, float u) { return g * __builtin_amdgcn_rcpf(1.0f + __builtin_amdgcn_exp2f(g * -1.4426950408889634f)) * u; }
struct EpiSwiGLU {
    static constexpr bool PERM = true, AFTER_DRAIN = false;
    bf16_t* O; int ldc;
    __device__ __forceinline__ void operator()(const f32x4 (&acc)[2][2][4][2], const Unit& u, int wr, int wc, int fr, int fq) const {
        const int row0 = u.pm * BM + wr * 64 + fr, col0 = u.pn * HALF + wc * 32 + 8 * fq;
#pragma unroll
        for (int ai = 0; ai < 2; ++ai)
#pragma unroll
            for (int m = 0; m < 4; ++m) { bf16_t* rowp = O + (size_t)(row0 + ai * HALF + m * 16) * ldc + col0;
                const f32x4 g0 = acc[ai][0][m][0], g1 = acc[ai][0][m][1], u0 = acc[ai][1][m][0], u1 = acc[ai][1][m][1];
                u32x4 w; w.x = cvt_pk_bf16(silu_mul(g0[0], u0[0]), silu_mul(g0[1], u0[1])); w.y = cvt_pk_bf16(silu_mul(g0[2], u0[2]), silu_mul(g0[3], u0[3]));
                w.z = cvt_pk_bf16(silu_mul(g1[0], u1[0]), silu_mul(g1[1], u1[1])); w.w = cvt_pk_bf16(silu_mul(g1[2], u1[2]), silu_mul(g1[3], u1[3]));
                *(u32x4*)rowp = w; }
    }
};


__device__ __forceinline__ unsigned pk4_fp8(float a, float b, float c, float d, float S) {
    a = __builtin_amdgcn_fmed3f(a * S, -448.f, 448.f); b = __builtin_amdgcn_fmed3f(b * S, -448.f, 448.f); c = __builtin_amdgcn_fmed3f(c * S, -448.f, 448.f); d = __builtin_amdgcn_fmed3f(d * S, -448.f, 448.f);
    int p = __builtin_amdgcn_cvt_pk_fp8_f32(a, b, 0, false); p = __builtin_amdgcn_cvt_pk_fp8_f32(c, d, p, true); return (unsigned)p;
}
constexpr float F8S_H = 4.f, F8S_HID = 8.f, F8S_W = 64.f;
struct EpiSwiGLU8 {
    static constexpr bool PERM = true, AFTER_DRAIN = false;
    unsigned char* O; int ldc;
    __device__ __forceinline__ static uint2 hid8(const f32x4 g0, const f32x4 g1, const f32x4 u0, const f32x4 u1) {
        constexpr float GS = 1.f / (F8S_W * F8S_H), C1 = -1.4426950408889634f * GS, C2 = GS * GS * F8S_HID;
        const f32x4 t0 = g0 * C1, t1 = g1 * C1;
        f32x4 e0, e1;
#pragma unroll
        for (int i = 0; i < 4; ++i) { e0[i] = __builtin_amdgcn_rcpf(1.0f + __builtin_amdgcn_exp2f(t0[i])); e1[i] = __builtin_amdgcn_rcpf(1.0f + __builtin_amdgcn_exp2f(t1[i])); }
        const f32x4 h0 = (g0 * e0) * (u0 * C2), h1 = (g1 * e1) * (u1 * C2);
        uint2 w; w.x = pk4_fp8(h0[0], h0[1], h0[2], h0[3], 1.f); w.y = pk4_fp8(h1[0], h1[1], h1[2], h1[3], 1.f); return w;
    }
    __device__ __forceinline__ void operator()(const f32x4 (&acc)[2][2][4][2], const Unit& u, int wr, int wc, int fr, int fq) const {
        const int row0 = u.pm * BM + wr * 64 + fr, col0 = u.pn * HALF + wc * 32 + 8 * fq, odd = fq & 1;
#pragma unroll
        for (int ai = 0; ai < 2; ++ai)
#pragma unroll
            for (int m = 0; m < 4; m += 2) {
                uint2 a = hid8(acc[ai][0][m][0], acc[ai][0][m][1], acc[ai][1][m][0], acc[ai][1][m][1]);
                uint2 b = hid8(acc[ai][0][m + 1][0], acc[ai][0][m + 1][1], acc[ai][1][m + 1][0], acc[ai][1][m + 1][1]);
                { auto r = __builtin_amdgcn_permlane16_swap(a.x, b.x, false, false); a.x = r[0]; b.x = r[1]; }
                { auto r = __builtin_amdgcn_permlane16_swap(a.y, b.y, false, false); a.y = r[0]; b.y = r[1]; }
                unsigned char* rowp = O + (size_t)(row0 + ai * HALF + (m + odd) * 16) * ldc + col0 - 8 * odd;
                *(uint4*)rowp = make_uint4(a.x, a.y, b.x, b.y); }
    }
};
struct EpiBf16PS {
    static constexpr bool PERM = true, AFTER_DRAIN = false;
    bf16_t* O; int ldc; float sc;
    __device__ __forceinline__ void operator()(const f32x4 (&acc)[2][2][4][2], const Unit& u, int wr, int wc, int fr, int fq) const {
        const int row0 = u.pm * BM + wr * 64 + fr, col0 = u.pn * BM + wc * 32 + 8 * fq;
#pragma unroll
        for (int ai = 0; ai < 2; ++ai)
#pragma unroll
            for (int m = 0; m < 4; ++m) { bf16_t* rowp = O + (size_t)(row0 + ai * HALF + m * 16) * ldc + col0;
#pragma unroll
                for (int bj = 0; bj < 2; ++bj) { const f32x4 v0 = acc[ai][bj][m][0] * sc, v1 = acc[ai][bj][m][1] * sc;
                    u32x4 w; w.x = cvt_pk_bf16(v0[0], v0[1]); w.y = cvt_pk_bf16(v0[2], v0[3]); w.z = cvt_pk_bf16(v1[0], v1[1]); w.w = cvt_pk_bf16(v1[2], v1[3]);
                    *(u32x4*)(rowp + bj * HALF) = w; } }
    }
};
struct EpiBf16PR {
    static constexpr bool PERM = true, AFTER_DRAIN = false;
    bf16_t* O; int ldc; const float* R;
    __device__ __forceinline__ void operator()(const f32x4 (&acc)[2][2][4][2], const Unit& u, int wr, int wc, int fr, int fq) const {
        const int row0 = u.pm * BM + wr * 64 + fr, col0 = u.pn * BM + wc * 32 + 8 * fq;
        float rs[2][4];
#pragma unroll
        for (int ai = 0; ai < 2; ++ai)
#pragma unroll
            for (int m = 0; m < 4; ++m) rs[ai][m] = R[row0 + ai * HALF + m * 16];
#pragma unroll
        for (int ai = 0; ai < 2; ++ai)
#pragma unroll
            for (int m = 0; m < 4; ++m) { bf16_t* rowp = O + (size_t)(row0 + ai * HALF + m * 16) * ldc + col0;
#pragma unroll
                for (int bj = 0; bj < 2; ++bj) { const f32x4 v0 = acc[ai][bj][m][0] * rs[ai][m], v1 = acc[ai][bj][m][1] * rs[ai][m];
                    u32x4 w; w.x = cvt_pk_bf16(v0[0], v0[1]); w.y = cvt_pk_bf16(v0[2], v0[3]); w.z = cvt_pk_bf16(v1[0], v1[1]); w.w = cvt_pk_bf16(v1[2], v1[3]);
                    *(u32x4*)(rowp + bj * HALF) = w; } }
    }
};
struct EpiSwiGLUR {
    static constexpr bool PERM = true, AFTER_DRAIN = false;
    bf16_t* O; int ldc; const float* R;
    __device__ __forceinline__ void operator()(const f32x4 (&acc)[2][2][4][2], const Unit& u, int wr, int wc, int fr, int fq) const {
        const int row0 = u.pm * BM + wr * 64 + fr, col0 = u.pn * HALF + wc * 32 + 8 * fq;
        float rs[2][4];
#pragma unroll
        for (int ai = 0; ai < 2; ++ai)
#pragma unroll
            for (int m = 0; m < 4; ++m) rs[ai][m] = R[row0 + ai * HALF + m * 16];
#pragma unroll
        for (int ai = 0; ai < 2; ++ai)
#pragma unroll
            for (int m = 0; m < 4; ++m) { bf16_t* rowp = O + (size_t)(row0 + ai * HALF + m * 16) * ldc + col0;
                const f32x4 g0 = acc[ai][0][m][0] * rs[ai][m], g1 = acc[ai][0][m][1] * rs[ai][m], u0 = acc[ai][1][m][0] * rs[ai][m], u1 = acc[ai][1][m][1] * rs[ai][m];
                u32x4 w; w.x = cvt_pk_bf16(silu_mul(g0[0], u0[0]), silu_mul(g0[1], u0[1])); w.y = cvt_pk_bf16(silu_mul(g0[2], u0[2]), silu_mul(g0[3], u0[3]));
                w.z = cvt_pk_bf16(silu_mul(g1[0], u1[0]), silu_mul(g1[1], u1[1])); w.w = cvt_pk_bf16(silu_mul(g1[2], u1[2]), silu_mul(g1[3], u1[3]));
                *(u32x4*)rowp = w; }
    }
};
template <class Epi, class Sched, bool ALIGN_EPI = false, bool SP2 = false, bool F8 = false>
__device__ __forceinline__ void gemm_phase(PG8_LAS unsigned char* lds, const Gemm g, const Sched& S, const Epi& E, int tid_in) {
    int tid_l = tid_in; asm volatile("" : "+v"(tid_l));
    const int tid = tid_l, wid = __builtin_amdgcn_readfirstlane(tid >> 6), lane = tid & 63, wr = wid >> 2, wc = wid & 3, fr = lane & 15, fq = lane >> 4;
    const int K = F8 ? g.K / 2 : g.K, nt = K / BK;
    unsigned voffA[2], voffB[2];
#pragma unroll
    for (int i = 0; i < 2; ++i) { int R, C; stage_rc(tid * 16 + i * 8192, R, C); const int Rb = Epi::PERM ? ((R & ~31) + perm32(R & 31)) : R;
        voffA[i] = (unsigned)(R * K + C) * 2u; voffB[i] = (unsigned)(Rb * K + C) * 2u; }
    const size_t kstep = (size_t)(BK * 2);
    const size_t hstep = (size_t)HALF * K * 2;
    const size_t tstep = 2 * hstep;
    const unsigned ldsw = (unsigned)wid * 1024u;
    const int aoff = lds_byte(wr * 64 + fr, fq * 8), boff = lds_byte(wc * 32 + fr, fq * 8);
#define PG8_SA(b, h) (((b) * 2 + (h)) * HTB)
#define PG8_SB(b, h) ((4 + (b) * 2 + (h)) * HTB)
#define PG8_STAGE(bufoff, gbase, voff) do { const char* _gb = (const char*)(gbase); if constexpr (F8) asm volatile("" : "+s"(_gb));     \
        _Pragma("unroll") for (int _i = 0; _i < 2; ++_i) \
        __builtin_amdgcn_global_load_lds((const unsigned*)(_gb + (voff)[_i]), (PG8_LAS unsigned*)(lds + (bufoff) + ldsw + _i * 8192), 16, 0, 0); } while (0)
#define PG8_LDA(dst, b, h) do { _Pragma("unroll") for (int m = 0; m < 4; ++m) _Pragma("unroll") for (int k = 0; k < 2; ++k) dst[m][k] = *(const PG8_LAS bf16x8*)(lds + PG8_SA(b, h) + aoff + m * 2048 + k * 1024); } while (0)
#define PG8_LDB(dst, b, h) do { _Pragma("unroll") for (int n = 0; n < 2; ++n) _Pragma("unroll") for (int k = 0; k < 2; ++k) dst[n][k] = *(const PG8_LAS bf16x8*)(lds + PG8_SB(b, h) + boff + n * 2048 + k * 1024); } while (0)
#define PG8_MMA(ai, bj, At, Bt) do { __builtin_amdgcn_s_setprio(1); _Pragma("unroll") for (int m = 0; m < 4; ++m) _Pragma("unroll") for (int n = 0; n < 2; ++n) _Pragma("unroll") for (int k = 0; k < 2; ++k) \
        acc[ai][bj][m][n] = __builtin_amdgcn_mfma_f32_16x16x32_bf16(Bt[n][k], At[m][k], acc[ai][bj][m][n], 0, 0, 0); __builtin_amdgcn_s_setprio(0); } while (0)
#define PG8_MMA8(ai, bj, At, Bt) do { __builtin_amdgcn_s_setprio(1); _Pragma("unroll") for (int m = 0; m < 4; ++m) _Pragma("unroll") for (int n = 0; n < 2; ++n) \
        acc[ai][bj][m][n] = __builtin_amdgcn_mfma_scale_f32_16x16x128_f8f6f4(cat8(Bt[n][0], Bt[n][1]), cat8(At[m][0], At[m][1]), acc[ai][bj][m][n], 0, 0, 0, 0, 0, 0); __builtin_amdgcn_s_setprio(0); } while (0)
#define PG8_MM(ai, bj, At, Bt) do { if constexpr (F8) PG8_MMA8(ai, bj, At, Bt); else PG8_MMA(ai, bj, At, Bt); } while (0)
#define PG8_WAIT_V(n) asm volatile("s_waitcnt vmcnt(" #n ")" ::: "memory")
#define PG8_WAIT_L(n) asm volatile("s_waitcnt lgkmcnt(" #n ")" ::: "memory")
#define PG8_BAR __builtin_amdgcn_s_barrier()
#define PG8_SCHED __builtin_amdgcn_sched_barrier(0)
    Unit cur, nxt; int ui = 0;
    if (!S.next(0, cur)) return;
    f32x4 acc[2][2][4][2];
#pragma unroll
    for (int a = 0; a < 2; ++a)
#pragma unroll
        for (int b = 0; b < 2; ++b)
#pragma unroll
            for (int m = 0; m < 4; ++m)
#pragma unroll
                for (int n = 0; n < 2; ++n) acc[a][b][m][n] = (f32x4){0.f, 0.f, 0.f, 0.f};
    bf16x8 At[4][2], B0[2][2], B1[2][2];
    const char* cA = (const char*)g.A + (size_t)cur.pm * tstep; const char* cB = (const char*)g.Bt + (size_t)cur.pn * tstep;
    S.a_ready(cur);
    if constexpr (SP2) {
        PG8_STAGE(PG8_SB(0, 0), cB, voffB); PG8_STAGE(PG8_SB(0, 1), cB + hstep, voffB); PG8_STAGE(PG8_SA(0, 0), cA, voffA); PG8_STAGE(PG8_SA(0, 1), cA + hstep, voffA);
        if (wr == 1) PG8_BAR;
        PG8_WAIT_V(2); PG8_BAR;
        PG8_STAGE(PG8_SB(1, 0), cB + kstep, voffB); PG8_STAGE(PG8_SA(1, 0), cA + kstep, voffA); PG8_STAGE(PG8_SB(1, 1), cB + hstep + kstep, voffB);
        PG8_WAIT_V(6); PG8_BAR;
    } else {
        PG8_STAGE(PG8_SB(0, 0), cB, voffB); PG8_STAGE(PG8_SA(0, 0), cA, voffA); PG8_STAGE(PG8_SB(0, 1), cB + hstep, voffB); PG8_STAGE(PG8_SA(0, 1), cA + hstep, voffA);
        if (wr == 1) PG8_BAR;
        PG8_WAIT_V(4); PG8_BAR;
        PG8_STAGE(PG8_SB(1, 0), cB + kstep, voffB); PG8_STAGE(PG8_SA(1, 0), cA + kstep, voffA); PG8_STAGE(PG8_SB(1, 1), cB + hstep + kstep, voffB);
        PG8_WAIT_V(6); PG8_BAR;
    }
    for (;;) {
        const bool has_next = S.next(ui + 1, nxt);
        const char* nA = has_next ? (const char*)g.A + (size_t)nxt.pm * tstep : cA; const char* nB = has_next ? (const char*)g.Bt + (size_t)nxt.pn * tstep : cB;
#pragma unroll 1
        for (int t = 0; t < nt; t += 2) {
            const bool last = (t == nt - 2);
            const char* a1 = cA + (size_t)(t + 1) * kstep;
            const char* a2 = last ? nA : cA + (size_t)(t + 2) * kstep; const char* b2 = last ? nB : cB + (size_t)(t + 2) * kstep;
            const char* a3 = a2 + kstep; const char* b3 = b2 + kstep;
            if (last && has_next) S.a_ready(nxt);
            if constexpr (SP2) {
            PG8_LDB(B0, 0, 0); PG8_LDB(B1, 0, 1); PG8_SCHED; PG8_LDA(At, 0, 0); PG8_STAGE(PG8_SA(1, 1), a1 + hstep, voffA);
            PG8_WAIT_V(8); PG8_WAIT_L(0); PG8_BAR; PG8_MM(0, 0, At, B0); PG8_MM(0, 1, At, B1); PG8_BAR; PG8_SCHED;
            PG8_LDA(At, 0, 1); PG8_STAGE(PG8_SB(0, 0), b2, voffB); PG8_STAGE(PG8_SB(0, 1), b2 + hstep, voffB); PG8_STAGE(PG8_SA(0, 0), a2, voffA);
            PG8_WAIT_V(8); PG8_WAIT_L(0); PG8_BAR; PG8_MM(1, 0, At, B0); PG8_MM(1, 1, At, B1); PG8_BAR; PG8_SCHED;
            PG8_LDB(B0, 1, 0); PG8_LDB(B1, 1, 1); PG8_SCHED; PG8_LDA(At, 1, 0); PG8_STAGE(PG8_SA(0, 1), a2 + hstep, voffA);
            PG8_WAIT_V(8); PG8_WAIT_L(0); PG8_BAR; PG8_MM(0, 0, At, B0); PG8_MM(0, 1, At, B1); PG8_BAR; PG8_SCHED;
            PG8_LDA(At, 1, 1); PG8_STAGE(PG8_SB(1, 0), b3, voffB); PG8_STAGE(PG8_SB(1, 1), b3 + hstep, voffB); PG8_STAGE(PG8_SA(1, 0), a3, voffA);
            PG8_WAIT_V(8); PG8_WAIT_L(0); PG8_BAR; PG8_MM(1, 0, At, B0); PG8_MM(1, 1, At, B1); PG8_BAR; PG8_SCHED;
            } else {
            PG8_LDB(B0, 0, 0); PG8_SCHED; PG8_LDA(At, 0, 0); PG8_STAGE(PG8_SA(1, 1), a1 + hstep, voffA);
            PG8_WAIT_L(8); PG8_BAR; PG8_WAIT_L(0); PG8_MM(0, 0, At, B0); PG8_BAR; PG8_SCHED;
            PG8_LDB(B1, 0, 1); PG8_STAGE(PG8_SB(0, 0), b2, voffB);
            PG8_BAR; PG8_WAIT_L(0); PG8_MM(0, 1, At, B1); PG8_BAR;
            PG8_LDA(At, 0, 1); PG8_STAGE(PG8_SA(0, 0), a2, voffA);
            PG8_BAR; PG8_WAIT_L(0); PG8_MM(1, 0, At, B0); PG8_BAR; PG8_SCHED;
            PG8_STAGE(PG8_SB(0, 1), b2 + hstep, voffB);
            PG8_WAIT_V(6); PG8_BAR; PG8_MM(1, 1, At, B1); PG8_BAR;
            PG8_LDB(B0, 1, 0); PG8_SCHED; PG8_LDA(At, 1, 0); PG8_STAGE(PG8_SA(0, 1), a2 + hstep, voffA);
            PG8_WAIT_L(8); PG8_BAR; PG8_WAIT_L(0); PG8_MM(0, 0, At, B0); PG8_BAR; PG8_SCHED;
            PG8_LDB(B1, 1, 1); PG8_STAGE(PG8_SB(1, 0), b3, voffB);
            PG8_BAR; PG8_WAIT_L(0); PG8_MM(0, 1, At, B1); PG8_BAR;
            PG8_LDA(At, 1, 1); PG8_STAGE(PG8_SA(1, 0), a3, voffA);
            PG8_BAR; PG8_WAIT_L(0); PG8_MM(1, 0, At, B0); PG8_BAR; PG8_SCHED;
            PG8_STAGE(PG8_SB(1, 1), b3 + hstep, voffB);
            PG8_WAIT_V(6); PG8_BAR; PG8_MM(1, 1, At, B1); PG8_BAR;
            }
        }
        if constexpr (ALIGN_EPI) { if (wr == 0) PG8_BAR; }
        if constexpr (!Epi::AFTER_DRAIN) {
            if constexpr (F8) { int l2; asm volatile("v_mbcnt_lo_u32_b32 %0, -1, 0\n\tv_mbcnt_hi_u32_b32 %0, -1, %0" : "=v"(l2)); E(acc, cur, wr, wc, l2 & 15, l2 >> 4); }
            else E(acc, cur, wr, wc, fr, fq);
            S.done(cur); }
        if (!has_next) break;
#pragma unroll
        for (int a = 0; a < 2; ++a)
#pragma unroll
            for (int b = 0; b < 2; ++b)
#pragma unroll
                for (int m = 0; m < 4; ++m)
#pragma unroll
                    for (int n = 0; n < 2; ++n) acc[a][b][m][n] = (f32x4){0.f, 0.f, 0.f, 0.f};
        cur = nxt; cA = nA; cB = nB; ++ui;
        if constexpr (ALIGN_EPI) { if (wr == 1) PG8_BAR; }
    }
    PG8_WAIT_V(0);
    if constexpr (!ALIGN_EPI) { if (wr == 0) PG8_BAR; }
    PG8_BAR;
    if constexpr (Epi::AFTER_DRAIN) { E.fused(acc, cur, wr, wc, fr, fq, lds, wid, lane); S.done(cur); }
#undef PG8_SA
#undef PG8_SB
#undef PG8_STAGE
#undef PG8_LDA
#undef PG8_LDB
#undef PG8_MMA
#undef PG8_MMA8
#undef PG8_MM
#undef PG8_WAIT_V
#undef PG8_WAIT_L
#undef PG8_BAR
#undef PG8_SCHED
}
}

constexpr int DM = 1024, NB = 16, SEQ = 4096, MTOK = NB * SEQ, DFF = 2816, MEML = 256, MROWS = NB * MEML;
constexpr int EV_IN = 2240, EV_INP = 2304, OD_IN = 1952, OD_INP = 2048;
constexpr float RMS_EPS = 1e-6f;
constexpr int NWAVES = 8;

constexpr size_t MiB = 1u << 20;
constexpr size_t WS_CTL = 0, CTL_ZERO_BYTES = 1 * MiB;
constexpr size_t WS_WGU = 2 * MiB;
constexpr size_t WS_WD = 46 * MiB;
constexpr size_t WS_EVIN = 68 * MiB;
constexpr size_t WS_EVOUT = 73 * MiB;
constexpr size_t WS_ODIN = 75 * MiB;
constexpr size_t WS_ODOUT = 79 * MiB;
constexpr size_t WS_WUQ = 81 * MiB;
constexpr size_t WS_WUKV = 82 * MiB;
constexpr size_t WS_XWQ = 83 * MiB;
constexpr size_t WS_XWKV = 85 * MiB;
constexpr size_t WS_XWO = 89 * MiB;
constexpr size_t WS_MN = 92 * MiB;
constexpr size_t WS_KVM = 108 * MiB;
constexpr size_t WS_VMT = 124 * MiB;
constexpr size_t WS_H = 132 * MiB;
constexpr size_t WS_Y = 260 * MiB;
constexpr size_t WS_OV = 516 * MiB;
constexpr size_t WS_END = 1024 * MiB;
constexpr size_t WS_HID = WS_OV;
constexpr size_t WS_XQ = WS_OV;

constexpr int CW_BAR = 4096;
constexpr int RING_BYTES = 131072, LDSCTL_OFF = RING_BYTES, MISC_OFF = LDSCTL_OFF + 320, LDS_BYTES = 147456;

#define GAS __attribute__((address_space(1)))
#define LAS __attribute__((address_space(3)))
typedef unsigned short bf16;
typedef unsigned v4u __attribute__((ext_vector_type(4)));
typedef unsigned v2u __attribute__((ext_vector_type(2)));
typedef float f32x4 __attribute__((ext_vector_type(4)));
typedef short bf16x8 __attribute__((ext_vector_type(8)));
#define LDS_WAIT() asm volatile("s_waitcnt lgkmcnt(0)" ::: "memory")
#define VM_WAIT() asm volatile("s_waitcnt vmcnt(0)" ::: "memory")
__device__ __forceinline__ unsigned f2bf(float f) { unsigned u = __builtin_bit_cast(unsigned, f); return (u + 0x7fffu + ((u >> 16) & 1u)) >> 16; }
__device__ __forceinline__ unsigned pk2(float lo, float hi) { return f2bf(lo) | (f2bf(hi) << 16); }
__device__ __forceinline__ float bf2f(unsigned short b) { return __builtin_bit_cast(float, (unsigned)b << 16); }
template <int K> __device__ __forceinline__ unsigned lx_u(unsigned v) {
    if constexpr (K == 32) { auto rr = __builtin_amdgcn_permlane32_swap(v, v, false, false); return rr[0] ^ rr[1] ^ v; }
    else return (unsigned)__builtin_amdgcn_ds_swizzle((int)v, (K << 10) | 0x1f);
}
template <int K> __device__ __forceinline__ float lx_f(float v) { return __uint_as_float(lx_u<K>(__float_as_uint(v))); }
__device__ __forceinline__ float wave_sum(float v) {
    v += lx_f<1>(v); v += lx_f<2>(v); v += lx_f<4>(v); v += lx_f<8>(v); v += lx_f<16>(v); v += lx_f<32>(v);
    return v;
}
__device__ __forceinline__ float fmx(float a, float b) { return __builtin_elementwise_maximum(a, b); }
__device__ __forceinline__ float fmx3(float a, float b, float c) { return __builtin_elementwise_maximum(__builtin_elementwise_maximum(a, b), c); }
__device__ __forceinline__ float fmn(float a, float b) { return __builtin_elementwise_minimum(a, b); }

#define XB_TMO      128
#define XB_XCNT(j)  (256  + 64 * (j))
#define XB_XSUB(j)  (1280 + 64 * (j))
#define XB_XGEN(j)  (2304 + 64 * (j))
#define XB_TOP      3328
#define XB_TOPGEN   3392
#define XCD_BAR_WORDS 3456
#define XB_SPIN_CAP (1u << 18)

__device__ __forceinline__ unsigned xb_ld(unsigned* p)              { return __hip_atomic_load(p, __ATOMIC_RELAXED, __HIP_MEMORY_SCOPE_AGENT); }
__device__ __forceinline__ unsigned xb_add(unsigned* p, unsigned v) { return __hip_atomic_fetch_add(p, v, __ATOMIC_RELAXED, __HIP_MEMORY_SCOPE_AGENT); }
__device__ __forceinline__ unsigned xb_xcc_id() { return (unsigned)__builtin_amdgcn_s_getreg((3 << 11) | 20) & 0xFu; }
#define XB_SPIN(cond, bar) do { unsigned _sp = 0; while (cond) { __builtin_amdgcn_s_sleep(1); \
    if ((++_sp & 255u) == 0u) { if (xb_ld(&(bar)[XB_TMO])) break; if (_sp > XB_SPIN_CAP) { atomicAdd(&(bar)[XB_TMO], 1u); break; } } } } while (0)

struct XcdBarrier {
    unsigned* bar; unsigned x;
    unsigned w0;
    volatile LAS unsigned* st;
};

__device__ __forceinline__ XcdBarrier xcd_barrier_post(unsigned* bar, volatile LAS unsigned* st) {
    XcdBarrier b; b.bar = bar; b.x = xb_xcc_id(); b.st = st; b.w0 = (unsigned)__builtin_amdgcn_readfirstlane((threadIdx.x >> 6) == 0 ? 1 : 0);
    if (threadIdx.x == 0) (void)xb_add(&bar[XB_XCNT(b.x)], 1u);
    return b;
}
__device__ __forceinline__ void xcd_barrier_complete(unsigned* bar, unsigned x, unsigned& nloc, unsigned& nx) {
    const unsigned G = gridDim.x * gridDim.y * gridDim.z;
    unsigned sum, cnt, mine, sp = 0u;
    for (;;) {
        sum = 0u; cnt = 0u; mine = 0u;
#pragma unroll
        for (unsigned j = 0; j < 16; ++j) { const unsigned c = xb_ld(&bar[XB_XCNT(j)]); sum += c; cnt += (c > 0u) ? 1u : 0u; mine = (j == x) ? c : mine; }
        if (sum == G) break;
        __builtin_amdgcn_s_sleep(1);
        if ((++sp & 255u) == 0u) { if (xb_ld(&bar[XB_TMO])) break; if (sp > XB_SPIN_CAP) { atomicAdd(&bar[XB_TMO], 1u); break; } }
    }
    nloc = mine > 0u ? mine : 1u; nx = cnt > 0u ? cnt : 1u;
}

__device__ __forceinline__ void xcd_barrier(const XcdBarrier& b) {
    asm volatile("s_waitcnt vmcnt(0)" ::: "memory");
    __syncthreads();
    unsigned xb_lane; asm volatile("v_mbcnt_lo_u32_b32 %0, -1, 0\n\tv_mbcnt_hi_u32_b32 %0, -1, %0" : "=v"(xb_lane));
    if (b.w0 != 0u && xb_lane == 0u) {
        unsigned* bar = b.bar;
        __builtin_amdgcn_s_waitcnt(0);
        unsigned nloc = b.st[0], nx = b.st[1];
        if (nloc == 0u) { xcd_barrier_complete(bar, b.x, nloc, nx); b.st[0] = nloc; b.st[1] = nx; }
        const unsigned old = xb_add(&bar[XB_XSUB(b.x)], 1u);
        const unsigned gen = old / nloc;
        if (old + 1u == (gen + 1u) * nloc) {
            __builtin_amdgcn_fence(__ATOMIC_RELEASE, "agent");
            asm volatile("s_waitcnt vmcnt(0)" ::: "memory");
            const unsigned og = xb_add(&bar[XB_TOP], 1u);
            const unsigned tg = og / nx;
            if (og + 1u == (tg + 1u) * nx) xb_add(&bar[XB_TOPGEN], 1u);
            else XB_SPIN(xb_ld(&bar[XB_TOPGEN]) == tg, bar);
            __builtin_amdgcn_fence(__ATOMIC_ACQUIRE, "agent");
            xb_add(&bar[XB_XGEN(b.x)], 1u);
            asm volatile("s_waitcnt vmcnt(0)" ::: "memory");
        } else {
            XB_SPIN(xb_ld(&bar[XB_XGEN(b.x)]) == gen, bar);
            __builtin_amdgcn_fence(__ATOMIC_ACQUIRE, "agent");
            asm volatile("s_waitcnt vmcnt(0)" ::: "memory");
        }
    }
    __syncthreads();
}


typedef float f32x16 __attribute__((ext_vector_type(16)));
typedef short s16x4 __attribute__((ext_vector_type(4)));
constexpr float NEGBIG = -1e30f, LOG2E = 1.4426950408889634f;
constexpr int KP128 = 272, KBUF_BYTES = 64 * KP128, VBUF_BYTES = 64 * 320;
constexpr int AT_KBUF = 0, AT_VBUF = 2 * KBUF_BYTES, AT_BT = AT_VBUF + 2 * VBUF_BYTES, BT_STRIDE = 132, AT_WS = AT_BT + 20 * BT_STRIDE * 4, AT_WS_PER_WAVE = 4096;
static_assert(AT_WS + 8 * AT_WS_PER_WAVE <= RING_BYTES, "attention LDS map");
__device__ __forceinline__ int crow(int r, int hi) { return (r & 3) + 8 * (r >> 2) + 4 * hi; }
typedef float f32x2_t __attribute__((ext_vector_type(2))); typedef __bf16 bf16x2_t __attribute__((ext_vector_type(2)));
__device__ __forceinline__ unsigned cvtpk(float lo, float hi) { f32x2_t v = {lo, hi}; bf16x2_t b = __builtin_convertvector(v, bf16x2_t); return __builtin_bit_cast(unsigned, b); }
typedef float f32x8_t __attribute__((ext_vector_type(8)));
typedef float f32x2_t __attribute__((ext_vector_type(2)));
__device__ __forceinline__ float vsum32(const f32x16 (&s)[2]) {
    const f32x16 a = s[0] + s[1]; const f32x8_t b = a.lo + a.hi; const f32x4 c = b.lo + b.hi; const f32x2_t d = c.lo + c.hi; return d.x + d.y;
}
__device__ __forceinline__ float swapmax(float v) { auto rr = __builtin_amdgcn_permlane32_swap(__float_as_uint(v), __float_as_uint(v), false, false); return fmx(__uint_as_float(rr[0]), __uint_as_float(rr[1])); }
__device__ __forceinline__ float swapsum(float v) { auto rr = __builtin_amdgcn_permlane32_swap(__float_as_uint(v), __float_as_uint(v), false, false); return __uint_as_float(rr[0]) + __uint_as_float(rr[1]); }
__device__ __forceinline__ float swapget(float v) { return lx_f<32>(v); }

struct KVSrc {
    const bf16* ka; int kpa;
    const bf16* kb; int kpb;
    const bf16* v; int vp;
};
template <int DQK, int KA, int DV> struct Stage {
    static constexpr int CPR = DQK / 8, NKC = 64 * CPR, NKI = (NKC + 511) / 512, CPV = DV / 8, NVC = 64 * CPV, NVI = (NVC + 511) / 512, KP = DQK * 2 + 16, VP = (DV == 64 ? 192 : 320);
    v4u k[NKI]; v4u v[NVI];
    __device__ __forceinline__ void load(const KVSrc& s, int kt, int tid) {
#pragma unroll
        for (int i = 0; i < NKI; ++i) { const int c = tid + 512 * i; if (NKC % 512 == 0 || c < NKC) { const int row = c / CPR, cc = c % CPR;
            const bf16* p = (KA == DQK || cc < KA / 8) ? s.ka + (size_t)(64 * kt + row) * s.kpa + 8 * cc : s.kb + (size_t)(64 * kt + row) * s.kpb + 8 * (cc - KA / 8);
            k[i] = *(const GAS v4u*)p; } }
#pragma unroll
        for (int i = 0; i < NVI; ++i) { const int c = tid + 512 * i; if (NVC % 512 == 0 || c < NVC) { const int row = c / CPV, cc = c % CPV;
            v[i] = *(const GAS v4u*)(s.v + (size_t)(64 * kt + row) * s.vp + 8 * cc); } }
    }
    __device__ __forceinline__ void store(LAS unsigned char* lds, int buf, int tid) const {
#pragma unroll
        for (int i = 0; i < NKI; ++i) { const int c = tid + 512 * i; if (NKC % 512 == 0 || c < NKC) { const int row = c / CPR, cc = c % CPR;
            *(LAS v4u*)(lds + AT_KBUF + buf * KBUF_BYTES + row * KP + 16 * cc) = k[i]; } }
#pragma unroll
        for (int i = 0; i < NVI; ++i) { const int c = tid + 512 * i; if (NVC % 512 == 0 || c < NVC) { const int row = c / CPV, cc = c % CPV;
            *(LAS v4u*)(lds + AT_VBUF + buf * VBUF_BYTES + row * VP + 16 * cc) = v[i]; } }
    }
};
template <int DQK, int GR = 0> __device__ __forceinline__ void qk_tile(const LAS unsigned char* kbuf, const bf16x8 (&qf)[DQK / 16], f32x16 (&s)[2], int lane, const f32x16 c0 = (f32x16){}) {
    constexpr int KP = DQK * 2 + 16, ND = DQK / 16, G = GR ? GR : 2;
    const int r32 = lane & 31, hi = lane >> 5;
    s[0] = c0; s[1] = c0;
#pragma unroll
    for (int g = 0; g < ND / G; ++g) {
        bf16x8 kf[2][G];
#pragma unroll
        for (int d = 0; d < G; ++d)
#pragma unroll
            for (int st = 0; st < 2; ++st) kf[st][d] = *(const LAS bf16x8*)(kbuf + (32 * st + r32) * KP + 32 * (g * G + d) + 16 * hi);
        __builtin_amdgcn_sched_barrier(0);
#pragma unroll
        for (int d = 0; d < G; ++d)
#pragma unroll
            for (int st = 0; st < 2; ++st) s[st] = __builtin_amdgcn_mfma_f32_32x32x16_bf16(kf[st][d], qf[g * G + d], s[st], 0, 0, 0);
    }
}
__device__ __forceinline__ float softmax_tile(f32x16 (&s)[2], float& m, float& l) {
    float mx = NEGBIG;
#pragma unroll
    for (int r = 0; r < 16; ++r) mx = fmx3(mx, s[0][r], s[1][r]);
    mx = swapmax(mx);
    const float mn = fmx(m, mx), alpha = __builtin_amdgcn_exp2f(m - mn), ms = fmx(mn, -1e29f);
    m = mn; { const float nms = -ms; s[0] = s[0] + nms; s[1] = s[1] + nms; }
#pragma unroll
    for (int st = 0; st < 2; ++st)
#pragma unroll
        for (int r = 0; r < 16; ++r) s[st][r] = __builtin_amdgcn_exp2f(s[st][r]);
    const float rs = vsum32(s);
    l = l * alpha + rs;
    return alpha;
}
struct VFrag { bf16x8 f[2][4]; };
typedef short v4i16_t __attribute__((ext_vector_type(4)));
template <int VP> __device__ __forceinline__ void pv_load(const LAS unsigned char* vbuf, int dp, VFrag& v, int lane) {
    const int g = lane >> 4, q = (lane & 15) >> 2, p = lane & 3;
    const LAS unsigned char* base = vbuf + (4 * (g >> 1) + q) * VP + (16 * (g & 1) + 4 * p) * 2;
#pragma unroll
    for (int k = 0; k < 4; ++k)
#pragma unroll
        for (int d2 = 0; d2 < 2; ++d2) {
            const v4i16_t lo = __builtin_amdgcn_ds_read_tr16_b64_v4i16((LAS v4i16_t*)(base + (16 * k) * VP + 64 * (2 * dp + d2)));
            const v4i16_t hh = __builtin_amdgcn_ds_read_tr16_b64_v4i16((LAS v4i16_t*)(base + (16 * k + 8) * VP + 64 * (2 * dp + d2)));
            v.f[d2][k] = (bf16x8){lo[0], lo[1], lo[2], lo[3], hh[0], hh[1], hh[2], hh[3]}; }
}
__device__ __forceinline__ void p_pack(const f32x16 (&p)[2], bf16x8 (&pf)[4]) {
#pragma unroll
    for (int k = 0; k < 4; ++k) { const int st = k >> 1, s = k & 1; v4u w; w.x = cvtpk(p[st][8 * s + 0], p[st][8 * s + 1]); w.y = cvtpk(p[st][8 * s + 2], p[st][8 * s + 3]); w.z = cvtpk(p[st][8 * s + 4], p[st][8 * s + 5]); w.w = cvtpk(p[st][8 * s + 6], p[st][8 * s + 7]);
        pf[k] = __builtin_bit_cast(bf16x8, w); }
}
__device__ __forceinline__ void pv_mma(const VFrag& v, const bf16x8 (&pf)[4], f32x16& o0, f32x16& o1) {
#pragma unroll
    for (int k = 0; k < 4; ++k) { o0 = __builtin_amdgcn_mfma_f32_32x32x16_bf16(v.f[0][k], pf[k], o0, 0, 0, 0); o1 = __builtin_amdgcn_mfma_f32_32x32x16_bf16(v.f[1][k], pf[k], o1, 0, 0, 0); }
}
template <int DV> __device__ __forceinline__ void pv_tile(const LAS unsigned char* vbuf, const f32x16 (&p)[2], f32x16 (&o)[DV / 32], int lane) {
    bf16x8 pf[4]; p_pack(p, pf);
#pragma unroll
    for (int dp = 0; dp < DV / 64; ++dp) { VFrag v; pv_load<(DV == 64 ? 192 : 320)>(vbuf, dp, v, lane); __builtin_amdgcn_sched_barrier(0); pv_mma(v, pf, o[2 * dp], o[2 * dp + 1]); }
}
constexpr float DEFER_THR = 8.0f;
struct SmState { float mhat, l; bool started; };
template <int DQK, int DV, class F, bool EARLYV>
__device__ __forceinline__ void attn_tile(LAS unsigned char* lds, int buf, int kt, const bf16x8 (&qf)[DQK / 16], F& f, f32x16 (&o)[DV / 32], SmState& S, f32x16& negm, int lane) {
    f32x16 s[2];
    qk_tile<DQK>(lds + AT_KBUF + buf * KBUF_BYTES, qf, s, lane, negm);
    const LAS unsigned char* vbuf = lds + AT_VBUF + buf * VBUF_BYTES;
    VFrag vfr;
    if constexpr (DV == 64 && EARLYV) { pv_load<(DV == 64 ? 192 : 320)>(vbuf, 0, vfr, lane); __builtin_amdgcn_sched_barrier(0); }
    f.apply(s, kt);
    float mx = NEGBIG;
#pragma unroll
    for (int r = 0; r < 16; ++r) mx = fmx3(mx, s[0][r], s[1][r]);
    mx = swapmax(mx);
    const bool need = S.started ? (mx > DEFER_THR) : (mx > -1e29f);
    if (__any(need)) {
        const float delta = need ? mx : 0.f, fac = (need && S.started) ? __builtin_amdgcn_exp2f(-delta) : 1.f;
        S.mhat += delta; S.l *= fac; S.started = S.started || need;
#pragma unroll
        for (int st = 0; st < 2; ++st)
#pragma unroll
            for (int r = 0; r < 16; ++r) s[st][r] -= delta;
#pragma unroll
        for (int dt = 0; dt < DV / 32; ++dt) o[dt] = o[dt] * fac;
#pragma unroll
        for (int r = 0; r < 16; ++r) negm[r] = -S.mhat;
    }
#pragma unroll
    for (int st = 0; st < 2; ++st)
#pragma unroll
        for (int r = 0; r < 16; ++r) s[st][r] = __builtin_amdgcn_exp2f(s[st][r]);
    S.l += vsum32(s);
    bf16x8 pf[4]; p_pack(s, pf);
#pragma unroll
    for (int dp = 0; dp < DV / 64; ++dp) {
        if constexpr (!(DV == 64 && EARLYV)) { pv_load<(DV == 64 ? 192 : 320)>(vbuf, dp, vfr, lane); __builtin_amdgcn_sched_barrier(0); }
        pv_mma(vfr, pf, o[2 * dp], o[2 * dp + 1]);
    }
}
template <int DQK, int KA, int DV, class F, bool EARLYV = true, bool DEEP = false>
__device__ __forceinline__ void attn_loop(LAS unsigned char* lds, const KVSrc& kv, int kt0, int kt1, const bf16x8 (&qf)[DQK / 16], F& f, f32x16 (&o)[DV / 32], SmState& S, int tid, int lane) {
    if (kt0 >= kt1) return;
    Stage<DQK, KA, DV> sg0;
    __syncthreads();
    sg0.load(kv, kt0, tid); sg0.store(lds, 0, tid);
    f32x16 negm;
#pragma unroll
    for (int r = 0; r < 16; ++r) negm[r] = -S.mhat;
    if constexpr (DEEP) {
        Stage<DQK, KA, DV> sg1;
        if (kt0 + 1 < kt1) sg1.load(kv, kt0 + 1, tid);
        __syncthreads();
        for (int kt = kt0; kt < kt1; kt += 2) {
            if (kt + 2 < kt1) { sg0.load(kv, kt + 2, tid); f.pre(kt + 2); }
            if (!f.skip(kt)) attn_tile<DQK, DV, F, EARLYV>(lds, 0, kt, qf, f, o, S, negm, lane);
            if (kt + 1 < kt1) sg1.store(lds, 1, tid);
            __syncthreads();
            if (kt + 1 < kt1) {
                if (kt + 3 < kt1) { sg1.load(kv, kt + 3, tid); f.pre(kt + 3); }
                if (!f.skip(kt + 1)) attn_tile<DQK, DV, F, EARLYV>(lds, 1, kt + 1, qf, f, o, S, negm, lane);
                if (kt + 2 < kt1) sg0.store(lds, 0, tid);
                __syncthreads();
            }
        }
    } else {
        __syncthreads();
        for (int kt = kt0; kt < kt1; ++kt) {
            const int buf = (kt - kt0) & 1;
            if (kt + 1 < kt1) { sg0.load(kv, kt + 1, tid); f.pre(kt + 1); }
            if (!f.skip(kt)) attn_tile<DQK, DV, F, EARLYV>(lds, buf, kt, qf, f, o, S, negm, lane);
            if (kt + 1 < kt1) sg0.store(lds, buf ^ 1, tid);
            __syncthreads();
        }
    }
}
__device__ __forceinline__ void build_bias_tables(LAS unsigned char* lds, const float* tab, int tid) {
    LAS float* BT = (LAS float*)(lds + AT_BT);
    for (int i = tid; i < 20 * 129; i += NWAVES * 64) { const int h = i / 129, d = i % 129;
        int b = d; if (d >= 16) { b = 16 + (int)(__log2f((float)d * 0.0625f) * (16.0f / 3.0f)); b = b > 31 ? 31 : b; }
        BT[h * BT_STRIDE + d] = (tab[b * 20 + h] - tab[31 * 20 + h]) * LOG2E; }
}
__device__ __forceinline__ void swap_pair(v2u& a, v2u& b) {
    { auto r = __builtin_amdgcn_permlane32_swap(a.x, b.x, false, false); a.x = r[0]; b.x = r[1]; }
    { auto r = __builtin_amdgcn_permlane32_swap(a.y, b.y, false, false); a.y = r[0]; b.y = r[1]; }
}
template <int DV> __device__ __forceinline__ void store_ot(bf16* orow, const f32x16 (&o)[DV / 32], float scale, int lane) {
    const int hi = lane >> 5;
    bf16* dst = orow + 8 * hi;
#pragma unroll
    for (int dt = 0; dt < DV / 32; ++dt)
#pragma unroll
        for (int r4 = 0; r4 < 4; r4 += 2) {
            v2u a, b;
            a.x = cvtpk(o[dt][4 * r4 + 0] * scale, o[dt][4 * r4 + 1] * scale); a.y = cvtpk(o[dt][4 * r4 + 2] * scale, o[dt][4 * r4 + 3] * scale);
            b.x = cvtpk(o[dt][4 * r4 + 4] * scale, o[dt][4 * r4 + 5] * scale); b.y = cvtpk(o[dt][4 * r4 + 6] * scale, o[dt][4 * r4 + 7] * scale);
            swap_pair(a, b);
            *(GAS v4u*)(dst + 32 * dt + 8 * r4) = (v4u){a.x, a.y, b.x, b.y}; }
}
template <int DQK> __device__ __forceinline__ void load_q(const bf16* qrow, bf16x8 (&qf)[DQK / 16], int lane) {
    const int hi = lane >> 5;
#pragma unroll
    for (int d0 = 0; d0 < DQK / 16; ++d0) qf[d0] = *(const GAS bf16x8*)(qrow + 16 * d0 + 8 * hi);
}
__device__ __forceinline__ bf16x8 scale_frag(bf16x8 a, float sc) {
    v4u w;
    w.x = cvtpk(bf2f((unsigned short)a[0]) * sc, bf2f((unsigned short)a[1]) * sc); w.y = cvtpk(bf2f((unsigned short)a[2]) * sc, bf2f((unsigned short)a[3]) * sc);
    w.z = cvtpk(bf2f((unsigned short)a[4]) * sc, bf2f((unsigned short)a[5]) * sc); w.w = cvtpk(bf2f((unsigned short)a[6]) * sc, bf2f((unsigned short)a[7]) * sc);
    return __builtin_bit_cast(bf16x8, w);
}
template <int DQK> __device__ __forceinline__ void load_q_scaled(const bf16* qrow, bf16x8 (&qf)[DQK / 16], float sc, int lane) {
    load_q<DQK>(qrow, qf, lane);
#pragma unroll
    for (int d0 = 0; d0 < DQK / 16; ++d0) qf[d0] = scale_frag(qf[d0], sc);
}

struct FPlain { __device__ __forceinline__ void pre(int) {} __device__ __forceinline__ bool skip(int) const { return false; }
    __device__ __forceinline__ void apply(f32x16 (&)[2], int) {} };
__device__ __forceinline__ void xattn_unit(LAS unsigned char* lds, const bf16* XQ, const bf16* KVM, bf16* O, int b, int h, int qt, int tid_in, int lane_in, int wave) {
    int lane = lane_in; asm volatile("" : "+v"(lane)); const int tid = wave * 64 + lane; (void)tid_in;
    const int t = qt * 256 + wave * 32 + (lane & 31);
    bf16x8 qf[8]; load_q_scaled<128>(XQ + (size_t)(b * SEQ + t) * 512 + h * 128, qf, 0.08838834764831845f * LOG2E, lane);
    KVSrc kv{KVM + (size_t)(b * MEML) * DM + h * 128, DM, nullptr, 0, KVM + (size_t)(b * MEML) * DM + 512 + h * 128, DM};
    f32x16 o[4] = {}; SmState S{0.f, 0.f, false};
    FPlain f;
    attn_loop<128, 128, 128, FPlain>(lds, kv, 0, MEML / 64, qf, f, o, S, tid, lane);
    const float lt = swapsum(S.l);
    store_ot<128>(O + (size_t)(b * SEQ + t) * 512 + h * 128, o, lt > 0.f ? 1.f / lt : 0.f, lane);
}


constexpr int C_QA = 0, C_KVA = 512, C_GA = 1280, C_QB = 1304, C_KB = 1816, C_VB = 1880, C_IQ = 1944, C_IK = 2200, C_IW = 2232;
constexpr size_t WS_CWT = 91 * MiB;
constexpr size_t WS_CBIAS = 91 * MiB + 512 * 1024;
constexpr size_t WS_P0 = WS_OV, WS_KCMP = WS_OV + 288 * MiB, WS_VCMP = WS_OV + 289 * MiB, WS_SEL = WS_OV + 330 * MiB;
static_assert(WS_SEL + 32 * MiB <= WS_END, "even overlay");

__device__ __forceinline__ void nsa_compress_item(const bf16* P0, const bf16* CWT, const float* CBIAS, bf16* KCMP, bf16* VCMP, int item, int lane) {
    const int nt = item & 7, g = (item >> 3) & 1, b = (item >> 4) & 15, c = item >> 8;
    const int r32 = lane & 31, hi = lane >> 5, n = nt * 32 + r32, nc = n > 254 ? 254 : n;
    const bf16* ap = P0 + (size_t)(b * SEQ + 16 * nc) * EV_INP + C_KVA + c * 128 + g * 64 + 8 * hi;
    const bf16* bp = CWT + (size_t)(c * 64 + r32) * 2048 + 8 * hi;
    f32x16 acc[2] = {};
#pragma unroll 4
    for (int kk = 0; kk < 128; ++kk) {
        const bf16x8 a = *(const GAS bf16x8*)(ap + (size_t)(kk >> 2) * EV_INP + (kk & 3) * 16);
        const bf16x8 b0 = *(const GAS bf16x8*)(bp + kk * 16), b1 = *(const GAS bf16x8*)(bp + 32 * 2048 + kk * 16);
        acc[0] = __builtin_amdgcn_mfma_f32_32x32x16_bf16(a, b0, acc[0], 0, 0, 0);
        acc[1] = __builtin_amdgcn_mfma_f32_32x32x16_bf16(a, b1, acc[1], 0, 0, 0);
    }
#pragma unroll
    for (int eh = 0; eh < 2; ++eh) { const int e = 32 * eh + r32; const float bias = CBIAS[c * 64 + e];
        bf16* dst = c == 0 ? KCMP : VCMP;
#pragma unroll
        for (int r = 0; r < 16; ++r) { const int nn = nt * 32 + crow(r, hi); dst[((size_t)(b * 2 + g) * 256 + nn) * 64 + e] = (bf16)(nn > 254 ? 0u : f2bf(acc[eh][r] + bias)); }
    }
}

__device__ __forceinline__ void nsa_compress_pair(LAS unsigned char* lds, const bf16* P0, const bf16* CWT, const float* CBIAS, bf16* KCMP, bf16* VCMP, int it0, int wave, int lane) {
    const int item = it0 + (wave >> 2), ks = wave & 3; const bool live = item < 512;
    const int nt = item & 7, g = (item >> 3) & 1, b = (item >> 4) & 15, c = (item >> 8) & 1;
    const int r32 = lane & 31, hi = lane >> 5, n = nt * 32 + r32, nc = n > 254 ? 254 : n;
    const bf16* ap = P0 + (size_t)(b * SEQ + 16 * nc) * EV_INP + C_KVA + c * 128 + g * 64 + 8 * hi;
    const bf16* bp = CWT + (size_t)(c * 64 + r32) * 2048 + 8 * hi;
    f32x16 acc[2] = {};
    if (live) {
#pragma unroll 8
        for (int kk = 32 * ks; kk < 32 * ks + 32; ++kk) {
            const bf16x8 a = *(const GAS bf16x8*)(ap + (size_t)(kk >> 2) * EV_INP + (kk & 3) * 16);
            const bf16x8 b0 = *(const GAS bf16x8*)(bp + kk * 16), b1 = *(const GAS bf16x8*)(bp + 32 * 2048 + kk * 16);
            acc[0] = __builtin_amdgcn_mfma_f32_32x32x16_bf16(a, b0, acc[0], 0, 0, 0);
            acc[1] = __builtin_amdgcn_mfma_f32_32x32x16_bf16(a, b1, acc[1], 0, 0, 0);
        }
    }
    LAS float* red = (LAS float*)lds + (wave >> 2) * 3 * 2048 + lane;
    if (ks) {
#pragma unroll
        for (int eh = 0; eh < 2; ++eh)
#pragma unroll
            for (int r = 0; r < 16; ++r) red[(ks - 1) * 2048 + (eh * 16 + r) * 64] = acc[eh][r];
    }
    __syncthreads();
    if (!ks && live) {
#pragma unroll
        for (int j = 0; j < 3; ++j)
#pragma unroll
            for (int eh = 0; eh < 2; ++eh)
#pragma unroll
                for (int r = 0; r < 16; ++r) acc[eh][r] += red[j * 2048 + (eh * 16 + r) * 64];
#pragma unroll
        for (int eh = 0; eh < 2; ++eh) { const int e = 32 * eh + r32; const float bias = CBIAS[c * 64 + e];
            bf16* dst = c == 0 ? KCMP : VCMP;
#pragma unroll
            for (int r = 0; r < 16; ++r) { const int nn = nt * 32 + crow(r, hi); dst[((size_t)(b * 2 + g) * 256 + nn) * 64 + e] = (bf16)(nn > 254 ? 0u : f2bf(acc[eh][r] + bias)); }
        }
    }
    __syncthreads();
}

constexpr int IX_MASK = 0, IX_RED = 8192, IX_CNT = IX_RED + 1024, IX_NC = IX_CNT + 1024, IX_CAND = IX_NC + 64, IX_THR = IX_CAND + 8192, IX_LIST = IX_THR + 128;
__device__ __forceinline__ unsigned f2ord(float f) { const unsigned b = __float_as_uint(f); return b ^ ((unsigned)((int)b >> 31) | 0x80000000u); }
__device__ __forceinline__ float ord2f(unsigned u) { return __uint_as_float(u ^ ((u >> 31) ? 0x80000000u : 0xffffffffu)); }
__device__ __forceinline__ void dsa_index_unit(LAS unsigned char* lds, const bf16* P0, unsigned short* SEL, int b, int qt, int tid_in, int lane_in, int wave) {
    int lane = lane_in; asm volatile("" : "+v"(lane)); const int tid = wave * 64 + lane; (void)tid_in;
    const int q = lane & 15, g4 = lane >> 4, t0 = 16 * qt, t = t0 + q, nkt = qt + 1;
    const int ni = nkt > wave ? (nkt - wave + 7) >> 3 : 0, nc4 = (ni + 3) >> 2;
    const bf16* base = P0 + (size_t)(b * SEQ) * EV_INP;
    bf16x8 bq[8]; float w[8];
#pragma unroll
    for (int h = 0; h < 8; ++h) { bq[h] = *(const GAS bf16x8*)(base + (size_t)t * EV_INP + C_IQ + h * 32 + 8 * g4); w[h] = bf2f(base[(size_t)t * EV_INP + C_IW + h]); }
    typedef float f32x4v __attribute__((ext_vector_type(4)));
    const bf16* kbase = base + (size_t)(16 * wave + q) * EV_INP + C_IK + 8 * g4;
    float sc[32][4];
    const float NINF = -__builtin_inff();
#pragma unroll
    for (int g = 0; g < 8; ++g) {
        if (32 * g + wave < nkt) {
            bf16x8 ab[4];
#pragma unroll
            for (int j = 0; j < 4; ++j) if (8 * (4 * g + j) + wave < nkt) { const bf16* kp = kbase; asm volatile("" : "+v"(kp));
                ab[j] = *(const GAS bf16x8*)(kp + (size_t)(4 * g + j) * (128 * EV_INP)); }
            asm volatile("s_waitcnt vmcnt(0)" ::: "memory");
#pragma unroll
            for (int j = 0; j < 4; ++j) {
                const int i = 4 * g + j, kt = 8 * i + wave;
                if (kt < nkt) {
                    const bf16x8 a = ab[j];
                    float a4[4] = {0.f, 0.f, 0.f, 0.f};
#pragma unroll
                    for (int h = 0; h < 8; ++h) { const f32x4v c = __builtin_amdgcn_mfma_f32_16x16x32_bf16(a, bq[h], (f32x4v){0.f, 0.f, 0.f, 0.f}, 0, 0, 0);
#pragma unroll
                        for (int r = 0; r < 4; ++r) a4[r] += w[h] * fmx(c[r], 0.f); }
#pragma unroll
                    for (int r = 0; r < 4; ++r) sc[i][r] = (kt < qt || 4 * g4 + r <= q) ? a4[r] : NINF;
                } else {
#pragma unroll
                    for (int r = 0; r < 4; ++r) sc[i][r] = NINF;
                }
            }
        } else {
#pragma unroll
            for (int j = 0; j < 4; ++j)
#pragma unroll
                for (int r = 0; r < 4; ++r) sc[4 * g + j][r] = NINF;
        }
    }
    LAS float* RED = (LAS float*)(lds + IX_RED); LAS unsigned* CNT = (LAS unsigned*)(lds + IX_CNT); LAS unsigned* MK = (LAS unsigned*)(lds + IX_MASK);
    LAS unsigned* NC = (LAS unsigned*)(lds + IX_NC); LAS unsigned long long* CAND = (LAS unsigned long long*)(lds + IX_CAND); LAS unsigned long long* THR = (LAS unsigned long long*)(lds + IX_THR);
    float lmax = NINF, lmin = __builtin_inff();
#pragma unroll
    for (int c = 0; c < 8; ++c) if (c < nc4) {
#pragma unroll
        for (int j = 0; j < 4; ++j)
#pragma unroll
            for (int r = 0; r < 4; ++r) { const float v = sc[4 * c + j][r]; lmax = fmx(lmax, v); lmin = fmn(lmin, v == NINF ? __builtin_inff() : v); }
    }
    lmax = fmx(lmax, lx_f<16>(lmax)); lmax = fmx(lmax, lx_f<32>(lmax));
    lmin = fmn(lmin, lx_f<16>(lmin)); lmin = fmn(lmin, lx_f<32>(lmin));
    __syncthreads();
    if (g4 == 0) { RED[wave * 16 + q] = lmax; RED[128 + wave * 16 + q] = lmin; }
    for (int i = tid; i < 2048; i += NWAVES * 64) MK[i] = 0u;
    if (tid < 16) NC[tid] = 0u;
    __syncthreads();
    float hiv = NINF, lov = __builtin_inff();
#pragma unroll
    for (int wv = 0; wv < 8; ++wv) { hiv = fmx(hiv, RED[wv * 16 + q]); lov = fmn(lov, RED[128 + wv * 16 + q]); }
    lov = lov - fabsf(lov) * 1e-3f - 1e-6f;
    unsigned clo = (unsigned)(t + 1), chi = 0u;
    bool done = (t + 1 <= 256), fine = false; float thr = NINF; unsigned thk = 0u;
    for (int it = 0; it < 64; ++it) {
        const float mid = 0.5f * (lov + hiv);
        unsigned cnt = 0;
#pragma unroll
        for (int c = 0; c < 8; ++c) if (c < nc4) {
#pragma unroll
            for (int j = 0; j < 4; ++j)
#pragma unroll
                for (int r = 0; r < 4; ++r) cnt += (sc[4 * c + j][r] > mid) ? 1u : 0u;
        }
        cnt += lx_u<16>(cnt); cnt += lx_u<32>(cnt);
        LAS unsigned* cb = CNT + (it & 1) * 128;
        if (g4 == 0) cb[wave * 16 + q] = cnt;
        __syncthreads();
        unsigned tot = 0;
#pragma unroll
        for (int wv = 0; wv < 8; ++wv) tot += cb[wv * 16 + q];
        if (!done && !fine) {
            if (tot == 256u) { thr = mid; done = true; }
            else if (!(mid > lov && mid < hiv)) { thr = lov; done = true; }
            else { if (tot > 256u) { lov = mid; clo = tot; } else { hiv = mid; chi = tot; }
                   if (clo - chi <= 64u) fine = true; }
        }
        if (__all(done || fine)) break;
    }
    const unsigned kinv0 = (unsigned)(4095 - (16 * wave + 4 * g4));
    if (fine) {
#pragma unroll
        for (int c = 0; c < 8; ++c) if (c < nc4) {
#pragma unroll
            for (int j = 0; j < 4; ++j)
#pragma unroll
                for (int r = 0; r < 4; ++r) { const float v = sc[4 * c + j][r];
                    if (v > lov && v <= hiv) { const unsigned pos = __hip_atomic_fetch_add(NC + q, 1u, __ATOMIC_RELAXED, __HIP_MEMORY_SCOPE_WORKGROUP);
                        if (pos < 64u) CAND[q * 64 + pos] = ((unsigned long long)f2ord(v) << 32) | (kinv0 - (unsigned)(128 * (4 * c + j) + r)); } }
        }
    }
    __syncthreads();
#pragma unroll 1
    for (int k = 0; k < 2; ++k) {
        const int qq = 2 * wave + k;
        const int fq = __builtin_amdgcn_readlane((int)fine, qq), need = __builtin_amdgcn_readlane((int)(256u - chi), qq);
        if (fq) {
            const unsigned n = NC[qq]; const unsigned long long comp = (unsigned)lane < n ? CAND[qq * 64 + lane] : 0ull;
            const unsigned c_lo = (unsigned)comp, c_hi = (unsigned)(comp >> 32);
            int rank = 0;
#pragma unroll
            for (int jj = 0; jj < 64; ++jj) { const unsigned long long c2 = ((unsigned long long)(unsigned)__builtin_amdgcn_readlane((int)c_hi, jj) << 32) | (unsigned)__builtin_amdgcn_readlane((int)c_lo, jj); rank += (c2 > comp) ? 1 : 0; }
            if (rank == need - 1) THR[qq] = comp;
        }
    }
    __syncthreads();
    if (fine) { const unsigned long long t64 = THR[q]; thr = ord2f((unsigned)(t64 >> 32)); thk = (unsigned)t64; }
    LAS unsigned* mkw = MK + q * 128 + (wave >> 1); const int mksh = 16 * (wave & 1) + 4 * g4;
#pragma unroll
    for (int c = 0; c < 8; ++c) if (c < nc4) {
#pragma unroll
        for (int j = 0; j < 4; ++j) { const int i = 4 * c + j;
            unsigned nib = 0;
#pragma unroll
            for (int r = 0; r < 4; ++r) { const float v = sc[i][r]; nib |= (v > thr || (fine && v == thr && kinv0 - (unsigned)(128 * i + r) >= thk)) ? (1u << r) : 0u; }
            if (nib) __hip_atomic_fetch_or(mkw + 4 * i, nib << mksh, __ATOMIC_RELAXED, __HIP_MEMORY_SCOPE_WORKGROUP); }
    }
    __syncthreads();
    LAS unsigned short* LST = (LAS unsigned short*)(lds + IX_LIST);
#pragma unroll 1
    for (int k = 0; k < 2; ++k) {
        const int qq = 2 * wave + k;
        unsigned long long wd = *(const LAS unsigned long long*)(lds + IX_MASK + (qq * 64 + lane) * 8);
        const int c = __popcll(wd); int incl = c;
#pragma unroll
        for (int d = 1; d < 64; d <<= 1) { const int n = __builtin_amdgcn_ds_bpermute((lane - d) << 2, incl); if (lane >= d) incl += n; }
        int pos = incl - c; const int total = __builtin_amdgcn_readlane(incl, 63);
        while (wd) { const int bbit = __builtin_ctzll(wd); if (pos < 256) LST[qq * 256 + pos] = (unsigned short)(64 * lane + bbit); ++pos; wd &= wd - 1; }
        for (int p = total + lane; p < 256; p += 64) LST[qq * 256 + p] = (unsigned short)0xffffu;
    }
    __syncthreads();
    { const v4u v = *(const LAS v4u*)(lds + IX_LIST + tid * 16);
      *(GAS v4u*)((unsigned char*)(SEL + (size_t)(b * SEQ + t0) * 256) + tid * 16) = v; }
}

struct FSel {
    unsigned long long selmask; int t, cur, hi; const LAS float* BT;
    __device__ __forceinline__ void pre(int) {}
    __device__ __forceinline__ bool skip(int kt) const { return !__any((int)((selmask >> kt) & 1ull)); }
    __device__ __forceinline__ void apply(f32x16 (&s)[2], int kt) {
        const bool on = (selmask >> kt) & 1ull;
        if (kt + 3 <= cur) {
            if (!__all((int)on)) {
#pragma unroll
                for (int st = 0; st < 2; ++st)
#pragma unroll
                    for (int r = 0; r < 16; ++r) s[st][r] = on ? s[st][r] : NEGBIG; }
        } else {
#pragma unroll
            for (int st = 0; st < 2; ++st)
#pragma unroll
                for (int r = 0; r < 16; ++r) { const int dist = t - (64 * kt + 32 * st + crow(r, hi)); const unsigned di = (unsigned)dist < 128u ? (unsigned)dist : 128u;
                    s[st][r] = (on && dist >= 0) ? s[st][r] + BT[di] : NEGBIG; }
        }
    }
};
struct FWin {
    int t, cur, hi; const LAS float* BT;
    __device__ __forceinline__ void pre(int) {}
    __device__ __forceinline__ bool skip(int) const { return false; }
    __device__ __forceinline__ void apply(f32x16 (&s)[2], int kt) {
        const int dk = cur - kt;
        if (!(dk >= 3 && dk <= 7)) {
#pragma unroll
            for (int st = 0; st < 2; ++st)
#pragma unroll
                for (int r = 0; r < 16; ++r) { const int dist = t - (64 * kt + 32 * st + crow(r, hi)); const unsigned di = (unsigned)dist < 128u ? (unsigned)dist : 128u;
                    s[st][r] = (dist >= 0 && dist < 512) ? s[st][r] + BT[di] : NEGBIG; }
        }
    }
};
__device__ __forceinline__ float sigmoidf_(float x) { return __builtin_amdgcn_rcpf(1.0f + __builtin_amdgcn_exp2f(-x * LOG2E)); }

__device__ __forceinline__ void nsa_unit(LAS unsigned char* lds, const bf16* P0, const bf16* KCMP, const bf16* VCMP, bf16* OC, int b, int g, int qt, int tid_in, int lane_in, int wave) {
    int lane = lane_in; asm volatile("" : "+v"(lane)); const int tid = wave * 64 + lane; (void)tid_in;
    const int r32 = lane & 31, hi = lane >> 5, qi = r32 >> 2, hh = r32 & 3, head = g * 4 + hh;
    const int t0 = qt * 64, t = t0 + wave * 8 + qi, cur = qt;
    const bf16* prow = P0 + (size_t)(b * SEQ + t) * EV_INP;
    bf16x8 qf[4]; load_q_scaled<64>(prow + C_QA + head * 64, qf, 0.125f * LOG2E, lane);
    const LAS float* BT = (const LAS float*)(lds + AT_BT) + head * BT_STRIDE;
    const float g0 = sigmoidf_(bf2f(prow[C_GA + g * 12 + hh * 3 + 0])), g1 = sigmoidf_(bf2f(prow[C_GA + g * 12 + hh * 3 + 1])), g2 = sigmoidf_(bf2f(prow[C_GA + g * 12 + hh * 3 + 2]));
    LAS float* impL = (LAS float*)(lds + AT_WS + wave * AT_WS_PER_WAVE);
    LAS unsigned long long* selL = (LAS unsigned long long*)(lds + AT_WS + wave * AT_WS_PER_WAVE + 2048);
    f32x16 oacc[2];
    {
        f32x16 o[2] = {}; float m = NEGBIG, l = 0.f, carry = 0.f;
        float imp[32];
#pragma unroll
        for (int i = 0; i < 32; ++i) imp[i] = 0.f;
        const int ncv = (t0 + 63 >= 31) ? ((t0 + 63 - 31) >> 4) + 1 : 0;
        const int nkt = ncv >= 256 ? 4 : (ncv + 63) >> 6;
        KVSrc kv{KCMP + (size_t)((b * 2 + g) * 256) * 64, 64, nullptr, 0, VCMP + (size_t)((b * 2 + g) * 256) * 64, 64};
        Stage<64, 64, 64> sg;
        __syncthreads();
        if (nkt > 0) { sg.load(kv, 0, tid); sg.store(lds, 0, tid); }
        __syncthreads();
#pragma unroll
        for (int kt = 0; kt < 4; ++kt) {
            if (kt < nkt) {
                const int buf = kt & 1;
                if (kt + 1 < nkt) sg.load(kv, kt + 1, tid);
                f32x16 s[2];
                qk_tile<64, 2>(lds + AT_KBUF + buf * KBUF_BYTES, qf, s, lane);
#pragma unroll
                for (int st = 0; st < 2; ++st)
#pragma unroll
                    for (int r = 0; r < 16; ++r) { const int dist = t - (16 * (64 * kt + 32 * st + crow(r, hi)) + 31); const unsigned di = (unsigned)dist < 128u ? (unsigned)dist : 128u;
                        s[st][r] = dist >= 0 ? s[st][r] + BT[di] : NEGBIG; }
                const float alpha = softmax_tile(s, m, l);
                o[0] = o[0] * alpha; o[1] = o[1] * alpha; carry *= alpha;
#pragma unroll
                for (int i = 0; i < kt * 8; ++i) imp[i] *= alpha;
                pv_tile<64>(lds + AT_VBUF + buf * VBUF_BYTES, s, o, lane);
                float G[2][4], ol[2][4];
#pragma unroll
                for (int st = 0; st < 2; ++st)
#pragma unroll
                    for (int q4 = 0; q4 < 4; ++q4) { G[st][q4] = (s[st][4 * q4] + s[st][4 * q4 + 1]) + (s[st][4 * q4 + 2] + s[st][4 * q4 + 3]); ol[st][q4] = swapget(s[st][4 * q4 + 3]); }
#pragma unroll
                for (int st = 0; st < 2; ++st)
#pragma unroll
                    for (int q4 = 0; q4 < 4; ++q4) { const float prev = q4 > 0 ? ol[st][q4 - 1] : (st == 1 ? ol[0][3] : carry);
                        imp[kt * 8 + st * 4 + q4] = G[st][q4] + (hi ? ol[st][q4] : prev); }
                carry = ol[1][3];
                if (kt + 1 < nkt) sg.store(lds, buf ^ 1, tid);
                __syncthreads();
            }
        }
        const float lt = swapsum(l), inv = lt > 0.f ? 1.f / lt : 0.f;
        oacc[0] = o[0] * (inv * g0); oacc[1] = o[1] * (inv * g0);
#pragma unroll
        for (int i = 0; i < 32; ++i) { float v = imp[i] * inv; v += lx_f<1>(v); v += lx_f<2>(v);
            if (hh == 0) impL[qi * 64 + 16 * (i >> 3) + 8 * ((i >> 2) & 1) + 2 * (i & 3) + hi] = v; }
    }
    LDS_WAIT(); asm volatile("" ::: "memory");
#pragma unroll 1
    for (int q2 = 0; q2 < 8; ++q2) {
        const int j = lane; const bool valid = j <= cur, forced = (j == 0) || (j == cur) || (j == cur - 1);
        const float val = impL[q2 * 64 + j] + (forced ? 1000.f : 0.f);
        const unsigned long long comp = ((unsigned long long)(valid ? __float_as_uint(val) + 1u : 0u) << 6) | (unsigned long long)(63 - j);
        const unsigned clo = (unsigned)comp, chi = (unsigned)(comp >> 32);
        int rank = 0;
#pragma unroll
        for (int jj = 0; jj < 64; ++jj) { const unsigned long long c2 = ((unsigned long long)(unsigned)__builtin_amdgcn_readlane((int)chi, jj) << 32) | (unsigned)__builtin_amdgcn_readlane((int)clo, jj); rank += (c2 > comp) ? 1 : 0; }
        const unsigned long long mk = __ballot(valid && rank < 16);
        if (lane == 0) selL[q2] = mk;
    }
    LDS_WAIT(); asm volatile("" ::: "memory");
    const unsigned long long selmask = selL[qi];
    {
        f32x16 o[2] = {}; SmState S{0.f, 0.f, false};
        KVSrc kv{P0 + (size_t)(b * SEQ) * EV_INP + C_KVA + 2 * 128 + g * 64, EV_INP, nullptr, 0, P0 + (size_t)(b * SEQ) * EV_INP + C_KVA + 3 * 128 + g * 64, EV_INP};
        FSel f{selmask, t, cur, hi, BT};
        int tid2 = tid; asm volatile("" : "+v"(tid2));
        attn_loop<64, 64, 64, FSel, false>(lds, kv, 0, cur + 1, qf, f, o, S, tid2, lane);
        const float lt = swapsum(S.l), inv = lt > 0.f ? 1.f / lt : 0.f;
        oacc[0] = oacc[0] + o[0] * (inv * g1); oacc[1] = oacc[1] + o[1] * (inv * g1);
    }
    {
        f32x16 o[2] = {}; SmState S{0.f, 0.f, false};
        KVSrc kv{P0 + (size_t)(b * SEQ) * EV_INP + C_KVA + 4 * 128 + g * 64, EV_INP, nullptr, 0, P0 + (size_t)(b * SEQ) * EV_INP + C_KVA + 5 * 128 + g * 64, EV_INP};
        FWin f{t, cur, hi, BT};
        int tid3 = tid; asm volatile("" : "+v"(tid3));
        attn_loop<64, 64, 64, FWin, false>(lds, kv, cur >= 8 ? cur - 8 : 0, cur + 1, qf, f, o, S, tid3, lane);
        const float lt = swapsum(S.l), inv = lt > 0.f ? 1.f / lt : 0.f;
        oacc[0] = oacc[0] + o[0] * (inv * g2); oacc[1] = oacc[1] + o[1] * (inv * g2);
    }
    store_ot<64>(OC + (size_t)(b * SEQ + t) * DM + head * 64, oacc, 1.f, lane);
}
constexpr int DG_VP = 136, DG_VT = 64 * DG_VP;
static_assert(8 * DG_VT <= AT_BT, "DSA gather LDS map");
__device__ __forceinline__ void dsa_unit(LAS unsigned char* lds, const bf16* P0, const unsigned short* SEL, bf16* OC, int b, int qt, int tid_in, int lane_in, int wave) {
    int lane = lane_in; asm volatile("" : "+v"(lane)); (void)tid_in;
    const int r32 = lane & 31, hi = lane >> 5, hh = r32 & 7;
    const LAS float* BT = (const LAS float*)(lds + AT_BT) + (8 + hh) * BT_STRIDE;
    LAS unsigned char* vt = lds + wave * DG_VT;
    LAS unsigned short* lq = (LAS unsigned short*)(lds + AT_WS + wave * AT_WS_PER_WAVE);
    const bf16* kb = P0 + (size_t)(b * SEQ) * EV_INP + C_KB + 8 * hi;
    const bf16* vb = P0 + (size_t)(b * SEQ) * EV_INP + C_VB + 8 * (lane & 7);
#define DG_LOADK(LQ, J) do { _Pragma("unroll") for (int st = 0; st < 2; ++st) { unsigned ik = (LQ)[64 * (J) + 32 * st + r32]; ik = ik > 4095u ? 0u : ik; \
        _Pragma("unroll") for (int d0 = 0; d0 < 4; ++d0) kf[st][d0] = *(const GAS bf16x8*)(kb + (size_t)ik * EV_INP + 16 * d0); } } while (0)
#define DG_LOADV(LQ, J) do { _Pragma("unroll") for (int i = 0; i < 8; ++i) { unsigned iv = (LQ)[64 * (J) + 8 * i + (lane >> 3)]; iv = iv > 4095u ? 0u : iv; vr[i] = *(const GAS v4u*)(vb + (size_t)iv * EV_INP); } } while (0)
    bf16x8 kf[2][4]; v4u vr[8];
    { const int t = qt * 32 + wave * 4; *(LAS v2u*)(lq + 4 * lane) = *(const GAS v2u*)(SEL + (size_t)(b * SEQ + t) * 256 + 4 * lane); }
    DG_LOADK(lq, 0); DG_LOADV(lq, 0);
#pragma unroll 1
    for (int qi = 0; qi < 4; ++qi) {
        const int t = qt * 32 + wave * 4 + qi;
        LAS unsigned short* lqc = lq + 256 * (qi & 1); LAS unsigned short* lqn = lq + 256 * ((qi + 1) & 1);
        if (qi + 1 < 4) *(LAS v2u*)(lqn + 4 * lane) = *(const GAS v2u*)(SEL + (size_t)(b * SEQ + t + 1) * 256 + 4 * lane);
        bf16x8 qf[4]; load_q_scaled<64>(P0 + (size_t)(b * SEQ + t) * EV_INP + C_QB + hh * 64, qf, 0.125f * LOG2E, lane);
        f32x16 o[2] = {}; SmState S{0.f, 0.f, false};
#pragma unroll
        for (int j = 0; j < 4; ++j) {
#pragma unroll
            for (int i = 0; i < 8; ++i) { LAS unsigned char* d = vt + (8 * i + (lane >> 3)) * DG_VP + (lane & 7) * 16; *(LAS v2u*)d = (v2u){vr[i].x, vr[i].y}; *(LAS v2u*)(d + 8) = (v2u){vr[i].z, vr[i].w}; }
            if (j < 3) DG_LOADV(lqc, j + 1); else if (qi + 1 < 4) DG_LOADV(lqn, 0);
            f32x16 s[2];
#pragma unroll
            for (int r = 0; r < 16; ++r) { s[0][r] = -S.mhat; s[1][r] = -S.mhat; }
#pragma unroll
            for (int d0 = 0; d0 < 4; ++d0)
#pragma unroll
                for (int st = 0; st < 2; ++st) s[st] = __builtin_amdgcn_mfma_f32_32x32x16_bf16(kf[st][d0], qf[d0], s[st], 0, 0, 0);
            if (j < 3) DG_LOADK(lqc, j + 1); else if (qi + 1 < 4) DG_LOADK(lqn, 0);
            const int lastix = lqc[64 * j + 63];
            if ((j >= 2 || t < 255) && !(lastix != 0xffff && t - lastix >= 113)) {
#pragma unroll
                for (int st = 0; st < 2; ++st)
#pragma unroll
                    for (int r = 0; r < 16; ++r) { const int ix = lqc[64 * j + 32 * st + crow(r, hi)]; const int dist = t - ix; const unsigned di = (unsigned)dist < 128u ? (unsigned)dist : 128u;
                        s[st][r] = dist >= 0 ? s[st][r] + BT[di] : NEGBIG; }
            }
            float mx = NEGBIG;
#pragma unroll
            for (int r = 0; r < 16; ++r) mx = fmx3(mx, s[0][r], s[1][r]);
            mx = swapmax(mx);
            const bool need = S.started ? (mx > DEFER_THR) : (mx > -1e29f);
            if (__any(need)) {
                const float delta = need ? mx : 0.f, fac = (need && S.started) ? __builtin_amdgcn_exp2f(-delta) : 1.f;
                S.mhat += delta; S.l *= fac; S.started = S.started || need;
#pragma unroll
                for (int st = 0; st < 2; ++st)
#pragma unroll
                    for (int r = 0; r < 16; ++r) s[st][r] -= delta;
                o[0] = o[0] * fac; o[1] = o[1] * fac;
            }
#pragma unroll
            for (int st = 0; st < 2; ++st)
#pragma unroll
                for (int r = 0; r < 16; ++r) s[st][r] = __builtin_amdgcn_exp2f(s[st][r]);
            S.l += vsum32(s);
            bf16x8 pf[4]; p_pack(s, pf);
            VFrag vfr; pv_load<DG_VP>(vt, 0, vfr, lane);
            pv_mma(vfr, pf, o[0], o[1]);
        }
        const float lt = swapsum(S.l);
        if (r32 < 8) store_ot<64>(OC + (size_t)(b * SEQ + t) * DM + 512 + hh * 64, o, lt > 0.f ? 1.f / lt : 0.f, lane);
    }
#undef DG_LOADK
#undef DG_LOADV
}


constexpr int D_CQ = 0, D_CKV = 256, D_KR = 384, D_QD = 416, D_KD = 928, D_VD = 1440;
constexpr size_t WS_ROPE = 91 * MiB + 640 * 1024;
constexpr size_t WS_P1 = WS_OV, WS_CQN = WS_OV + 256 * MiB, WS_CKVN = WS_OV + 288 * MiB, WS_KR = WS_OV + 320 * MiB;
constexpr size_t WS_QMLA = WS_Y, WS_KVMLA = WS_Y + 96 * MiB;
static_assert(WS_KR + 4 * MiB <= WS_END && WS_KVMLA + 128 * MiB <= WS_OV, "odd overlay");
constexpr float LAM_INIT = 0.35550906759097f;

__device__ __forceinline__ void rope_table_phase(float* ROPE, int gt, int NGT) {
    for (int idx = gt; idx < SEQ * 16; idx += NGT) { const int t = idx >> 4, i = idx & 15;
        const float inv = exp2f(-(float)i * (13.287712379549449f / 16.0f));
        const double rev = (double)((float)t * inv) * 0.15915494309189535;
        const float fr = (float)(rev - __builtin_floor(rev));
        ROPE[2 * idx] = __builtin_amdgcn_cosf(fr); ROPE[2 * idx + 1] = __builtin_amdgcn_sinf(fr); }
}
__device__ __forceinline__ void odd_prep_rows(const bf16* P1, const float* qn, const float* kvn, const float* ROPE, bf16* CQN, bf16* CKVN, bf16* KR, int gw, int NGW, int lane) {
    float gq[4], gk[2];
#pragma unroll
    for (int j = 0; j < 4; ++j) gq[j] = qn[4 * lane + j];
    gk[0] = kvn[2 * lane]; gk[1] = kvn[2 * lane + 1];
    for (int m = gw; m < MTOK; m += NGW) {
        const bf16* row = P1 + (size_t)m * OD_INP;
        const v2u cq = *(const GAS v2u*)(row + D_CQ + 4 * lane); const unsigned ck = *(const GAS unsigned*)(row + D_CKV + 2 * lane);
        float x[4] = {bf2f((unsigned short)(cq.x & 0xffff)), bf2f((unsigned short)(cq.x >> 16)), bf2f((unsigned short)(cq.y & 0xffff)), bf2f((unsigned short)(cq.y >> 16))};
        float y[2] = {bf2f((unsigned short)(ck & 0xffff)), bf2f((unsigned short)(ck >> 16))};
        const float r1 = __builtin_amdgcn_rsqf(wave_sum((x[0] * x[0] + x[1] * x[1]) + (x[2] * x[2] + x[3] * x[3])) * (1.f / 256.f) + RMS_EPS);
        const float r2 = __builtin_amdgcn_rsqf(wave_sum(y[0] * y[0] + y[1] * y[1]) * (1.f / 128.f) + RMS_EPS);
        v2u o; o.x = pk2(x[0] * r1 * gq[0], x[1] * r1 * gq[1]); o.y = pk2(x[2] * r1 * gq[2], x[3] * r1 * gq[3]);
        *(GAS v2u*)(CQN + (size_t)m * 256 + 4 * lane) = o;
        *(GAS unsigned*)(CKVN + (size_t)m * 256 + 2 * lane) = pk2(y[0] * r2 * gk[0], y[1] * r2 * gk[1]);
        *(GAS unsigned*)(CKVN + (size_t)m * 256 + 128 + 2 * lane) = 0u;
        if (lane < 16) { const int t = m & (SEQ - 1); const float c = ROPE[(t * 16 + lane) * 2], s = ROPE[(t * 16 + lane) * 2 + 1];
            const float x1 = bf2f(row[D_KR + lane]), x2 = bf2f(row[D_KR + 16 + lane]);
            KR[(size_t)m * 32 + lane] = (bf16)f2bf(x1 * c - x2 * s); KR[(size_t)m * 32 + 16 + lane] = (bf16)f2bf(x1 * s + x2 * c); }
    }
}
template <bool BIAS> struct FCausal {
    int t, tmin, tmax, hi; const LAS float* BT;
    __device__ __forceinline__ void pre(int) {}
    __device__ __forceinline__ bool skip(int kt) const { return 64 * kt > tmax; }
    __device__ __forceinline__ void apply(f32x16 (&s)[2], int kt) {
        if (!(64 * kt + 63 <= tmin && (!BIAS || tmin - (64 * kt + 63) >= 113))) {
#pragma unroll
            for (int st = 0; st < 2; ++st)
#pragma unroll
                for (int r = 0; r < 16; ++r) { const int dist = t - (64 * kt + 32 * st + crow(r, hi)); const unsigned di = (unsigned)dist < 128u ? (unsigned)dist : 128u;
                    s[st][r] = dist >= 0 ? s[st][r] + (BIAS ? BT[di] : 0.f) : NEGBIG; }
        }
    }
};
__device__ __forceinline__ void mla_unit(LAS unsigned char* lds, const bf16* QM, const bf16* KVM_, const bf16* KR, const float* ROPE, bf16* OC, int b, int h, int qt, int tid_in, int lane_in, int wave) {
    int lane = lane_in; asm volatile("" : "+v"(lane)); const int tid = wave * 64 + lane; (void)tid_in;
    const int r32 = lane & 31, hi = lane >> 5, t = qt * 256 + wave * 32 + r32;
    bf16x8 qf[6]; load_q<96>(QM + (size_t)(b * SEQ + t) * 768 + h * 96, qf, lane);
    {
        const float* rp = ROPE + (size_t)(t * 16 + 8 * hi) * 2;
        bf16x8 a = qf[4], c = qf[5];
#pragma unroll
        for (int j = 0; j < 8; ++j) { const float cs = rp[2 * j], sn = rp[2 * j + 1], x1 = bf2f((unsigned short)a[j]), x2 = bf2f((unsigned short)c[j]);
            a[j] = (short)f2bf(x1 * cs - x2 * sn); c[j] = (short)f2bf(x1 * sn + x2 * cs); }
        qf[4] = a; qf[5] = c;
    }
#pragma unroll
    for (int d0 = 0; d0 < 6; ++d0) qf[d0] = scale_frag(qf[d0], 0.10206207261596577f * LOG2E);
    KVSrc kv{KVM_ + (size_t)(b * SEQ) * 1024 + h * 128, 1024, KR + (size_t)(b * SEQ) * 32, 32, KVM_ + (size_t)(b * SEQ) * 1024 + h * 128 + 64, 1024};
    f32x16 o[2] = {}; SmState S{0.f, 0.f, false};
    FCausal<false> f{t, qt * 256 + wave * 32, qt * 256 + wave * 32 + 31, hi, nullptr};
    attn_loop<96, 64, 64, FCausal<false>, false, true>(lds, kv, 0, 4 * qt + 4, qf, f, o, S, tid, lane);
    const float lt = swapsum(S.l);
    store_ot<64>(OC + (size_t)(b * SEQ + t) * DM + h * 64, o, lt > 0.f ? 1.f / lt : 0.f, lane);
}
__device__ __forceinline__ void diff_unit(LAS unsigned char* lds, const bf16* P1, const float* lam, const float* subln, bf16* OC, int b, int h, int qt, int tid_in, int lane_in, int wave) {
    int lane = lane_in; asm volatile("" : "+v"(lane)); const int tid = wave * 64 + lane; (void)tid_in;
    const int r32 = lane & 31, hi = lane >> 5, t = qt * 256 + wave * 32 + r32;
    const LAS float* BT = (const LAS float*)(lds + AT_BT) + (16 + h) * BT_STRIDE;
    float d01 = 0.f, d23 = 0.f;
    { d01 = lam[lane] * lam[64 + lane]; d23 = lam[128 + lane] * lam[192 + lane]; d01 = wave_sum(d01); d23 = wave_sum(d23); }
    const float lam_full = __expf(d01) - __expf(d23) + LAM_INIT;
    unsigned o0p[32];
    f32x16 o[4];
#pragma unroll 1
    for (int e = 0; e < 2; ++e) {
        bf16x8 qf[4]; load_q_scaled<64>(P1 + (size_t)(b * SEQ + t) * OD_INP + D_QD + (h * 2 + e) * 64, qf, 0.125f * LOG2E, lane);
        KVSrc kv{P1 + (size_t)(b * SEQ) * OD_INP + D_KD + (h * 2 + e) * 64, OD_INP, nullptr, 0, P1 + (size_t)(b * SEQ) * OD_INP + D_VD + h * 128, OD_INP};
#pragma unroll
        for (int dt = 0; dt < 4; ++dt) o[dt] = (f32x16){};
        SmState S{0.f, 0.f, false};
        FCausal<true> f{t, qt * 256 + wave * 32, qt * 256 + wave * 32 + 31, hi, BT};
        attn_loop<64, 64, 128, FCausal<true>>(lds, kv, 0, 4 * qt + 4, qf, f, o, S, tid, lane);
        const float lt = swapsum(S.l), inv = lt > 0.f ? 1.f / lt : 0.f;
        if (e == 0) {
#pragma unroll
            for (int dt = 0; dt < 4; ++dt)
#pragma unroll
                for (int k = 0; k < 8; ++k) o0p[dt * 8 + k] = cvtpk(o[dt][2 * k] * inv, o[dt][2 * k + 1] * inv);
        } else {
            float ss = 0.f;
#pragma unroll
            for (int dt = 0; dt < 4; ++dt)
#pragma unroll
                for (int k = 0; k < 8; ++k) { const unsigned w = o0p[dt * 8 + k];
                    const float a0 = __uint_as_float(w << 16) - lam_full * (o[dt][2 * k] * inv), a1 = __uint_as_float(w & 0xffff0000u) - lam_full * (o[dt][2 * k + 1] * inv);
                    o[dt][2 * k] = a0; o[dt][2 * k + 1] = a1; ss += a0 * a0 + a1 * a1; }
            ss = swapsum(ss);
            const float rn = __builtin_amdgcn_rsqf(ss * (1.f / 128.f) + RMS_EPS) * (1.0f - LAM_INIT);
            bf16* orow = OC + (size_t)(b * SEQ + t) * DM + 512 + h * 128;
#pragma unroll
            for (int dt = 0; dt < 4; ++dt)
#pragma unroll
                for (int r4 = 0; r4 < 4; r4 += 2) { const int d = 32 * dt + 8 * r4 + 4 * hi; const f32x4 gn = *(const GAS f32x4*)(subln + d), gm = *(const GAS f32x4*)(subln + d + 8);
                    v2u wa, wb; wa.x = cvtpk(o[dt][4 * r4 + 0] * rn * gn.x, o[dt][4 * r4 + 1] * rn * gn.y); wa.y = cvtpk(o[dt][4 * r4 + 2] * rn * gn.z, o[dt][4 * r4 + 3] * rn * gn.w);
                    wb.x = cvtpk(o[dt][4 * r4 + 4] * rn * gm.x, o[dt][4 * r4 + 5] * rn * gm.y); wb.y = cvtpk(o[dt][4 * r4 + 6] * rn * gm.z, o[dt][4 * r4 + 7] * rn * gm.w);
                    swap_pair(wa, wb);
                    *(GAS v4u*)(orow + 32 * dt + 8 * r4 + 8 * hi) = (v4u){wa.x, wa.y, wb.x, wb.y}; }
        }
    }
}


__device__ __forceinline__ void tr_item(const float* W, int N, bf16* WT, int ldk, int drow0, LAS float* scr, int k0, int n0, int lane, const float* grow = nullptr) {
#pragma unroll 8
    for (int i = 0; i < 32; ++i) { const int kk = 2 * i + (lane >> 5); float wv = W[(size_t)(k0 + kk) * N + n0 + (lane & 31)]; if (grow) wv *= grow[k0 + kk]; scr[kk * 33 + (lane & 31)] = wv; }
    LDS_WAIT(); asm volatile("" ::: "memory");
    const int c = lane & 7;
#pragma unroll
    for (int j = 0; j < 4; ++j) { const int n = (lane >> 3) + 8 * j; const LAS float* s = scr + (8 * c) * 33 + n;
        v4u o; o.x = pk2(s[0 * 33], s[1 * 33]); o.y = pk2(s[2 * 33], s[3 * 33]); o.z = pk2(s[4 * 33], s[5 * 33]); o.w = pk2(s[6 * 33], s[7 * 33]);
        *(GAS v4u*)(WT + (size_t)(drow0 + n) * ldk + k0 + 8 * c) = o; }
    LDS_WAIT(); asm volatile("" ::: "memory");
}
__device__ __forceinline__ void tr_item8(const float* W, int N, unsigned char* WT, int ldk, int drow0, LAS float* scr, int k0, int n0, int lane) {
#pragma unroll 8
    for (int i = 0; i < 32; ++i) { const int kk = 2 * i + (lane >> 5); scr[kk * 33 + (lane & 31)] = W[(size_t)(k0 + kk) * N + n0 + (lane & 31)]; }
    LDS_WAIT(); asm volatile("" ::: "memory");
    const int c = lane & 7;
#pragma unroll
    for (int j = 0; j < 4; ++j) { const int n = (lane >> 3) + 8 * j; const LAS float* s = scr + (8 * c) * 33 + n;
        v2u o; o.x = pg8::pk4_fp8(s[0 * 33], s[1 * 33], s[2 * 33], s[3 * 33], pg8::F8S_W); o.y = pg8::pk4_fp8(s[4 * 33], s[5 * 33], s[6 * 33], s[7 * 33], pg8::F8S_W);
        *(GAS v2u*)(WT + (size_t)(drow0 + n) * ldk + k0 + 8 * c) = o; }
    LDS_WAIT(); asm volatile("" ::: "memory");
}
constexpr size_t WS_XB = WS_OV + 370 * MiB;
constexpr size_t WS_RS = 1 * MiB;
constexpr int F8_FROM = 1;
__device__ __forceinline__ void rows_norm_phase(const float* xsrc, float* xdst, const bf16* Y, float w, const float* gpost, const float* gpre, bf16* H, int nrows, int gw, int NGW, int lane, bool f8 = false, float ysc = 1.f, const bf16* xsb = nullptr, bf16* xdb = nullptr, float* Rout = nullptr) {
    f32x4 gp[4], gq[4];
#pragma unroll
    for (int j = 0; j < 4; ++j) {
        gp[j] = Y ? ((const GAS f32x4*)gpost)[lane + 64 * j] * w : (f32x4){0.f, 0.f, 0.f, 0.f};
        gq[j] = gpre ? ((const GAS f32x4*)gpre)[lane + 64 * j] : (f32x4){0.f, 0.f, 0.f, 0.f};
    }
    for (int m = gw; m < nrows; m += NGW) {
        f32x4 x[4];
        if (xsb) {
            const GAS v2u* xr = (const GAS v2u*)(xsb + (size_t)m * DM) + lane;
#pragma unroll
            for (int j = 0; j < 4; ++j) { const v2u xv = xr[64 * j]; x[j] = (f32x4){__uint_as_float(xv.x << 16), __uint_as_float(xv.x & 0xffff0000u), __uint_as_float(xv.y << 16), __uint_as_float(xv.y & 0xffff0000u)}; }
        } else {
            const GAS f32x4* xr = (const GAS f32x4*)(xsrc + (size_t)m * DM) + lane;
#pragma unroll
            for (int j = 0; j < 4; ++j) x[j] = xr[64 * j];
        }
        if (Y) {
            const GAS v2u* yr = (const GAS v2u*)(Y + (size_t)m * DM) + lane;
            f32x4 y[4]; float s = 0.f;
#pragma unroll
            for (int j = 0; j < 4; ++j) { const v2u yv = yr[64 * j]; y[j] = (f32x4){__uint_as_float(yv.x << 16), __uint_as_float(yv.x & 0xffff0000u), __uint_as_float(yv.y << 16), __uint_as_float(yv.y & 0xffff0000u)} * ysc;
                s += (y[j].x * y[j].x + y[j].y * y[j].y) + (y[j].z * y[j].z + y[j].w * y[j].w); }
            const float rstd = __builtin_amdgcn_rsqf(wave_sum(s) * (1.f / DM) + RMS_EPS);
#pragma unroll
            for (int j = 0; j < 4; ++j) x[j] = x[j] + y[j] * rstd * gp[j];
        }
        if (xdst) {
            GAS f32x4* xo = (GAS f32x4*)(xdst + (size_t)m * DM) + lane;
#pragma unroll
            for (int j = 0; j < 4; ++j) xo[64 * j] = x[j];
        }
        if (xdb) {
            GAS v2u* xo = (GAS v2u*)(xdb + (size_t)m * DM) + lane;
#pragma unroll
            for (int j = 0; j < 4; ++j) { v2u o; o.x = pk2(x[j].x, x[j].y); o.y = pk2(x[j].z, x[j].w); xo[64 * j] = o; }
        }
        if (gpre || Rout) {
            float s2 = 0.f;
#pragma unroll
            for (int j = 0; j < 4; ++j) s2 += (x[j].x * x[j].x + x[j].y * x[j].y) + (x[j].z * x[j].z + x[j].w * x[j].w);
            const float r2 = __builtin_amdgcn_rsqf(wave_sum(s2) * (1.f / DM) + RMS_EPS);
            if (Rout && lane == 0) Rout[m] = r2;
            if (gpre) {
            if (f8) {
                GAS unsigned* ho = (GAS unsigned*)((unsigned char*)H + (size_t)m * DM) + lane;
#pragma unroll
                for (int j = 0; j < 4; ++j) { const f32x4 h = x[j] * r2 * gq[j]; ho[64 * j] = pg8::pk4_fp8(h.x, h.y, h.z, h.w, pg8::F8S_H); }
            } else {
            GAS v2u* ho = (GAS v2u*)(H + (size_t)m * DM) + lane;
#pragma unroll
            for (int j = 0; j < 4; ++j) { const f32x4 h = x[j] * r2 * gq[j]; v2u o; o.x = pk2(h.x, h.y); o.y = pk2(h.z, h.w); ho[64 * j] = o; }
            }
            }
        }
    }
}
__device__ __forceinline__ void transpose_cols_phase(const bf16* src, int ld, int col0, int ncols, int nb, int S, bf16* dst, LAS unsigned short* scr, int gw, int NGW, int lane, int gsz = 1 << 30, int gstride = 0) {
    const int nct = ncols / 64, nst = S / 64, nitems = nb * nct * nst;
    for (int it = gw; it < nitems; it += NGW) {
        const int st = it % nst, ct = (it / nst) % nct, b = it / (nst * nct);
        const bf16* sp = src + (size_t)(b * S + st * 64) * ld + col0 + ((ct * 64) / gsz) * gstride + (ct * 64) % gsz;
#pragma unroll
        for (int i = 0; i < 8; ++i) { const int r = i * 8 + (lane >> 3), c8 = (lane & 7) * 8;
            const v4u v = *(const GAS v4u*)(sp + (size_t)r * ld + c8);
            LAS unsigned* d = (LAS unsigned*)(scr + r * 66 + c8); d[0] = v.x; d[1] = v.y; d[2] = v.z; d[3] = v.w; }
        LDS_WAIT(); asm volatile("" ::: "memory");
        bf16* dp = dst + ((size_t)(b * ncols + ct * 64)) * S + st * 64;
#pragma unroll
        for (int i = 0; i < 8; ++i) { const int c = i * 8 + (lane >> 3), r8 = (lane & 7) * 8;
            unsigned short e[8];
#pragma unroll
            for (int k = 0; k < 8; ++k) e[k] = scr[(r8 + k) * 66 + c];
            v4u o; o.x = e[0] | ((unsigned)e[1] << 16); o.y = e[2] | ((unsigned)e[3] << 16); o.z = e[4] | ((unsigned)e[5] << 16); o.w = e[6] | ((unsigned)e[7] << 16);
            *(GAS v4u*)(dp + (size_t)c * S + r8) = o; }
        LDS_WAIT(); asm volatile("" ::: "memory");
    }
}

struct Args { const float* in[24]; float* out; unsigned char* ws; int ph_lo, ph_hi, stop, li; };
constexpr int PH_PRO = 0, PH_MEMKV = 1, PH_MEMVT = 2, PH_L0 = 3, PPL = 17, NPHASE = PH_L0 + 2 * PPL;

#define PHASE_IDS unsigned char* ws = args.ws; asm volatile("" : "+s"(ws)); int bx = bx0, vcu = vcu0; asm volatile("" : "+s"(bx), "+s"(vcu)); const int gw = vcu * NWAVES + wave, NGW = G * NWAVES; (void)gw; (void)NGW; (void)bx; int lane_l; asm volatile("v_mbcnt_lo_u32_b32 %0, -1, 0\n\tv_mbcnt_hi_u32_b32 %0, -1, %0" : "=v"(lane_l)); const int lane = lane_l, tid = wave * 64 + lane; bf16* const H = (bf16*)(ws + WS_H); bf16* const Y = (bf16*)(ws + WS_Y); bf16* const XB = (bf16*)(ws + WS_XB); float* const RS = (float*)(ws + WS_RS); (void)H; (void)Y; (void)XB; (void)RS; (void)tid;
#define IN(k) (lo <= (k) && (k) < hi && (k) < stop)
#define SEAM(k) do { if ((k) + 1 < hi && (k) + 1 < stop) { XcdBarrier b2 = bar; asm volatile("" : "+s"(b2.bar), "+s"(b2.x)); xcd_barrier(b2); } } while (0)
template <int L> __device__ __forceinline__ void layer_phases(const Args& args, LAS unsigned char* lds, const XcdBarrier& bar, int wave, int G, int bx0, int vcu0, int lo, int hi, int stop) {
    const float* x_in = args.in[0]; const float* norm_pre = args.in[3]; const float* norm_post = args.in[4]; float* xout = args.out;

        const int base = PH_L0 + L * PPL;
        const float* gpre = norm_pre + (size_t)L * 4 * DM; const float* gpost = norm_post + (size_t)L * 4 * DM;
        if (IN(base + 0)) {
            PHASE_IDS
            pg8::StaticOrder S; S.init(MTOK, 5632, G, bx);
            if constexpr (L * 2 + 0 >= F8_FROM) {
                pg8::Gemm g{H, (const bf16*)(ws + WS_WGU) + (size_t)(L * 2 + 0) * 5632 * DM, MTOK, 5632, DM};
                pg8::EpiSwiGLU8 E{ws + WS_HID, DFF};
                pg8::gemm_phase<pg8::EpiSwiGLU8, pg8::StaticOrder, true, true, true>(lds, g, S, E, tid);
            } else {
                pg8::Gemm g{XB, (const bf16*)(ws + WS_WGU) + (size_t)(L * 2 + 0) * 5632 * DM, MTOK, 5632, DM};
                pg8::EpiSwiGLUR E{(bf16*)(ws + WS_HID), DFF, RS};
                pg8::gemm_phase<pg8::EpiSwiGLUR, pg8::StaticOrder, true, true>(lds, g, S, E, tid);
            }
            SEAM(base + 0);
        }
        if (IN(base + 1)) {
            PHASE_IDS
            pg8::StaticOrder S; S.init(MTOK, DM, G, bx);
            pg8::EpiBf16P E{Y, DM};
            if constexpr (L * 2 + 0 >= F8_FROM) {
                pg8::Gemm g{(const bf16*)(ws + WS_HID), (const bf16*)(ws + WS_WD) + (size_t)(L * 2 + 0) * DM * DFF, MTOK, DM, DFF};
                pg8::gemm_phase<pg8::EpiBf16P, pg8::StaticOrder, true, true, true>(lds, g, S, E, tid);
            } else {
                pg8::Gemm g{(const bf16*)(ws + WS_HID), (const bf16*)(ws + WS_WD) + (size_t)(L * 2 + 0) * DM * DFF, MTOK, DM, DFF};
                pg8::gemm_phase<pg8::EpiBf16P, pg8::StaticOrder, true, true>(lds, g, S, E, tid);
            }
            SEAM(base + 1);
        }
        if (IN(base + 2)) {
            PHASE_IDS
            rows_norm_phase(nullptr, nullptr, Y, 0.5f, gpost, L == 0 ? nullptr : gpre + DM, H, MTOK, gw, NGW, lane, L == 1, L * 2 + 0 >= F8_FROM ? 1.f / (pg8::F8S_W * pg8::F8S_HID) : 1.f, XB, XB, L == 0 ? RS : nullptr);
            SEAM(base + 2);
        }
        if (L == 0 && IN(base + 3)) {
            PHASE_IDS
            pg8::Gemm g{XB, (const bf16*)(ws + WS_EVIN), MTOK, EV_INP, DM};
            pg8::StaticOrder S; S.init(MTOK, EV_INP, G, bx);
            pg8::EpiBf16PR E{(bf16*)(ws + WS_P0), EV_INP, RS};
            pg8::gemm_phase<pg8::EpiBf16PR, pg8::StaticOrder, true, true>(lds, g, S, E, tid);
            SEAM(base + 3);
        }
        if (L == 0 && IN(base + 4)) {
            PHASE_IDS
            if (args.li == 0) { PHASE_IDS
            const bf16* P0 = (const bf16*)(ws + WS_P0);
            for (int it0 = vcu * 2; it0 < 512; it0 += G * 2) nsa_compress_pair(lds, P0, (const bf16*)(ws + WS_CWT), (const float*)(ws + WS_CBIAS), (bf16*)(ws + WS_KCMP), (bf16*)(ws + WS_VCMP), it0, wave, lane);
            }
            __syncthreads();
            { PHASE_IDS
            const bf16* P0 = (const bf16*)(ws + WS_P0);
            for (int u = vcu, i = 0; u < NB * 256; u += G, ++i) {
                int b, qt;
                if (G == 256) { b = vcu >> 4; const int sub = vcu & 15; qt = (i & 1) ? 16 * i + 15 - sub : 16 * i + sub; } else { b = u & 15; qt = u >> 4; }
                dsa_index_unit(lds, P0, (unsigned short*)(ws + WS_SEL), b, qt, tid, lane, wave);
            } }
            SEAM(base + 4);
        }
        if (L == 0 && IN(base + 5)) {
            PHASE_IDS
            build_bias_tables(lds, args.in[2], tid);
            __syncthreads();
            { PHASE_IDS
            const bf16* P0 = (const bf16*)(ws + WS_P0);
            for (int u = vcu, i = 0; u < NB * 2 * 64; u += G, ++i) {
                int bg, qt;
                if (G == 256) { bg = vcu >> 3; const int sub = vcu & 7; qt = (i & 1) ? 8 * i + 7 - sub : 8 * i + sub; } else { bg = u & 31; qt = u >> 5; }
                nsa_unit(lds, P0, (const bf16*)(ws + WS_KCMP), (const bf16*)(ws + WS_VCMP), H, bg >> 1, bg & 1, qt, tid, lane, wave);
            } }
            { PHASE_IDS
            const bf16* P0 = (const bf16*)(ws + WS_P0);
            for (int u = vcu, i = 0; u < NB * 128; u += G, ++i) {
                int b, qt;
                if (G == 256) { b = vcu >> 4; const int sub = vcu & 15; qt = (i & 1) ? 16 * i + 15 - sub : 16 * i + sub; } else { b = u & 15; qt = u >> 4; }
                dsa_unit(lds, P0, (const unsigned short*)(ws + WS_SEL), H, b, qt, tid, lane, wave);
            } }
            SEAM(base + 5);
        }
        if (L == 1 && IN(base + 3)) {
            PHASE_IDS
            pg8::Gemm g{H, (const bf16*)(ws + WS_ODIN), MTOK, OD_INP, DM};
            pg8::StaticOrder S; S.init(MTOK, OD_INP, G, bx);
            pg8::EpiBf16PS E{(bf16*)(ws + WS_P1), OD_INP, 1.f / (pg8::F8S_W * pg8::F8S_H)};
            pg8::gemm_phase<pg8::EpiBf16PS, pg8::StaticOrder, true, true, true>(lds, g, S, E, tid);
            SEAM(base + 3);
        }
        if (L == 1 && IN(base + 4)) {
            PHASE_IDS
            const bf16* P1 = (const bf16*)(ws + WS_P1);
            odd_prep_rows(P1, args.in[14], args.in[15], (const float*)(ws + WS_ROPE), (bf16*)(ws + WS_CQN), (bf16*)(ws + WS_CKVN), (bf16*)(ws + WS_KR), gw, NGW, lane);
            SEAM(base + 4);
        }
        if (L == 1 && IN(base + 5)) {
            PHASE_IDS
            { pg8::Gemm g{(const bf16*)(ws + WS_CQN), (const bf16*)(ws + WS_WUQ), MTOK, 768, 256};
              pg8::StaticOrder S; S.init(MTOK, 768, G, bx);
              pg8::EpiBf16P E{(bf16*)(ws + WS_QMLA), 768};
              pg8::gemm_phase<pg8::EpiBf16P, pg8::StaticOrder, true, true>(lds, g, S, E, tid); }
            __syncthreads();
            { pg8::Gemm g{(const bf16*)(ws + WS_CKVN), (const bf16*)(ws + WS_WUKV), MTOK, 1024, 256};
              pg8::StaticOrder S; S.init(MTOK, 1024, G, bx);
              pg8::EpiBf16P E{(bf16*)(ws + WS_KVMLA), 1024};
              pg8::gemm_phase<pg8::EpiBf16P, pg8::StaticOrder, true, true>(lds, g, S, E, tid); }
            SEAM(base + 5);
        }
        if (L == 1 && IN(base + 7)) {
            { PHASE_IDS
            build_bias_tables(lds, args.in[2], tid);
            __syncthreads();
            for (int u = vcu, i = 0; u < NB * 8 * 16; u += G, ++i) {
                int bh, qt;
                if (G == 256) { bh = vcu >> 1; const int sub = vcu & 1; qt = (i & 1) ? 2 * i + 1 - sub : 2 * i + sub; } else { bh = u & 127; qt = u >> 7; }
                mla_unit(lds, (const bf16*)(ws + WS_QMLA), (const bf16*)(ws + WS_KVMLA), (const bf16*)(ws + WS_KR), (const float*)(ws + WS_ROPE), H, bh >> 3, bh & 7, qt, tid, lane, wave);
            } }
            { PHASE_IDS
            for (int u = vcu, i = 0; u < NB * 4 * 16; u += G, ++i) {
                int bh, qt;
                if (G == 256) { bh = vcu >> 2; const int sub = vcu & 3; qt = (i & 1) ? 4 * i + 3 - sub : 4 * i + sub; } else { bh = u & 63; qt = u >> 6; }
                diff_unit(lds, (const bf16*)(ws + WS_P1), args.in[18], args.in[19], H, bh >> 2, bh & 3, qt, tid, lane, wave);
            } }
            SEAM(base + 7);
        }
        if (IN(base + 8)) {
            PHASE_IDS
            pg8::Gemm g{H, (const bf16*)(ws + (L == 0 ? WS_EVOUT : WS_ODOUT)), MTOK, DM, DM};
            pg8::StaticOrder S; S.init(MTOK, DM, G, bx);
            pg8::EpiBf16P E{Y, DM};
            pg8::gemm_phase<pg8::EpiBf16P, pg8::StaticOrder, true, true>(lds, g, S, E, tid);
            SEAM(base + 8);
        }
        if (IN(base + 9)) {
            PHASE_IDS
            rows_norm_phase(nullptr, nullptr, Y, 1.0f, gpost + DM, nullptr, H, MTOK, gw, NGW, lane, false, 1.f, XB, XB, RS);
            SEAM(base + 9);
        }
        if (IN(base + 10)) {
            PHASE_IDS
            pg8::Gemm g{XB, (const bf16*)(ws + WS_XWQ) + (size_t)L * 512 * DM, MTOK, 512, DM};
            pg8::StaticOrder S; S.init(MTOK, 512, G, bx);
            pg8::EpiBf16PR E{(bf16*)(ws + WS_XQ), 512, RS};
            pg8::gemm_phase<pg8::EpiBf16PR, pg8::StaticOrder, true, true>(lds, g, S, E, tid);
            SEAM(base + 10);
        }
        if (IN(base + 11)) {
            PHASE_IDS
            for (int u = vcu; u < NB * 4 * 16; u += G) {
                const int qt = u & 15, h = (u >> 4) & 3, b = u >> 6;
                xattn_unit(lds, (const bf16*)(ws + WS_XQ), (const bf16*)(ws + WS_KVM) + (size_t)L * MROWS * DM, H, b, h, qt, tid, lane, wave);
            }
            SEAM(base + 11);
        }
        if (IN(base + 12)) {
            PHASE_IDS
            pg8::Gemm g{H, (const bf16*)(ws + WS_XWO) + (size_t)L * DM * 512, MTOK, DM, 512};
            pg8::StaticOrder S; S.init(MTOK, DM, G, bx);
            pg8::EpiBf16P E{Y, DM};
            pg8::gemm_phase<pg8::EpiBf16P, pg8::StaticOrder, true, true>(lds, g, S, E, tid);
            SEAM(base + 12);
        }
        if (IN(base + 13)) {
            PHASE_IDS
            rows_norm_phase(nullptr, nullptr, Y, 1.0f, gpost + 2 * DM, gpre + 3 * DM, H, MTOK, gw, NGW, lane, L * 2 + 1 >= F8_FROM, 1.f, XB, XB);
            SEAM(base + 13);
        }
        if (IN(base + 14)) {
            PHASE_IDS
            pg8::StaticOrder S; S.init(MTOK, 5632, G, bx);
            if constexpr (L * 2 + 1 >= F8_FROM) {
                pg8::Gemm g{H, (const bf16*)(ws + WS_WGU) + (size_t)(L * 2 + 1) * 5632 * DM, MTOK, 5632, DM};
                pg8::EpiSwiGLU8 E{ws + WS_HID, DFF};
                pg8::gemm_phase<pg8::EpiSwiGLU8, pg8::StaticOrder, true, true, true>(lds, g, S, E, tid);
            } else {
                pg8::Gemm g{H, (const bf16*)(ws + WS_WGU) + (size_t)(L * 2 + 1) * 5632 * DM, MTOK, 5632, DM};
                pg8::EpiSwiGLU E{(bf16*)(ws + WS_HID), DFF};
                pg8::gemm_phase<pg8::EpiSwiGLU, pg8::StaticOrder, true, true>(lds, g, S, E, tid);
            }
            SEAM(base + 14);
        }
        if (IN(base + 15)) {
            PHASE_IDS
            pg8::StaticOrder S; S.init(MTOK, DM, G, bx);
            pg8::EpiBf16P E{Y, DM};
            if constexpr (L * 2 + 1 >= F8_FROM) {
                pg8::Gemm g{(const bf16*)(ws + WS_HID), (const bf16*)(ws + WS_WD) + (size_t)(L * 2 + 1) * DM * DFF, MTOK, DM, DFF};
                pg8::gemm_phase<pg8::EpiBf16P, pg8::StaticOrder, true, true, true>(lds, g, S, E, tid);
            } else {
                pg8::Gemm g{(const bf16*)(ws + WS_HID), (const bf16*)(ws + WS_WD) + (size_t)(L * 2 + 1) * DM * DFF, MTOK, DM, DFF};
                pg8::gemm_phase<pg8::EpiBf16P, pg8::StaticOrder, true, true>(lds, g, S, E, tid);
            }
            SEAM(base + 15);
        }
        if (IN(base + 16)) {
            PHASE_IDS
            rows_norm_phase(nullptr, L == 0 ? nullptr : xout, Y, 0.5f, gpost + 3 * DM, L == 0 ? norm_pre + 4 * DM : nullptr, H, MTOK, gw, NGW, lane, L * 2 + 2 >= F8_FROM, L * 2 + 1 >= F8_FROM ? 1.f / (pg8::F8S_W * pg8::F8S_HID) : 1.f, XB, L == 0 ? XB : nullptr);
            SEAM(base + 16);
        }
}


__global__ void __launch_bounds__(NWAVES * 64, 2) fwd_kernel(Args args) {
    extern __shared__ __attribute__((aligned(16))) unsigned char lds_raw[];
    LAS unsigned char* lds = (LAS unsigned char*)lds_raw;
    volatile LAS unsigned* MISC = (volatile LAS unsigned*)(lds + MISC_OFF);
    const int tid0 = threadIdx.x, wave = __builtin_amdgcn_readfirstlane(tid0 >> 6);
    const int G = gridDim.x, bx0 = blockIdx.x;
    const int vcu0 = (G % 8 == 0) ? (bx0 % 8) * (G / 8) + bx0 / 8 : bx0;
    unsigned* ctl = (unsigned*)(args.ws + WS_CTL);
    for (int u = tid0; u < (LDS_BYTES - LDSCTL_OFF) / 4; u += NWAVES * 64) ((LAS unsigned*)(lds + LDSCTL_OFF))[u] = 0u;
    __syncthreads();
    XcdBarrier bar = xcd_barrier_post(ctl + CW_BAR + args.li * XCD_BAR_WORDS, MISC + 8);
    const int lo = args.ph_lo, hi = args.ph_hi, stop = args.stop;

    const float* x_in = args.in[0]; const float* mem = args.in[1];
    const float* norm_pre = args.in[3]; const float* norm_post = args.in[4]; const float* mem_norm = args.in[5];
    float* xout = args.out;

    if (IN(PH_PRO)) {
            PHASE_IDS
        LAS float* scr = (LAS float*)(lds + wave * 16384);
        constexpr int I_GU = (DM / 64) * (DFF / 32), I_D = (DFF / 64) * (DM / 32);
        constexpr int I_EVIN = (DM / 64) * (EV_IN / 32), I_SQ = (DM / 64) * (DM / 32), I_ODIN = (DM / 64) * (OD_IN / 32);
        constexpr int I_UQ = (256 / 64) * (768 / 32), I_UKV = (128 / 64) * (1024 / 32), I_XQ = (DM / 64) * (512 / 32), I_XO = (512 / 64) * (DM / 32);
        constexpr int I_CW = (2048 / 64) * (64 / 32);
        constexpr int NITEMS = 8 * I_GU + 4 * I_D + I_EVIN + I_SQ + I_ODIN + I_SQ + I_UQ + I_UKV + 2 * I_XQ + 2 * I_SQ + 2 * I_XO + 2 * I_CW;
        for (int it = gw; it < NITEMS; it += NGW) {
            int r = it;
            if (r < 8 * I_GU) { const int mat = r / I_GU, rr = r % I_GU, which = mat & 1, ij = mat >> 1, nblk = DFF / 32, k0 = (rr / nblk) * 64, n0 = (rr % nblk) * 32;
                if (ij >= F8_FROM) tr_item8((which ? args.in[7] : args.in[6]) + (size_t)ij * DM * DFF, DFF, ws + WS_WGU + (size_t)ij * 5632 * DM * 2, DM, (n0 / 128) * 256 + which * 128 + (n0 % 128), scr, k0, n0, lane);
                else tr_item((which ? args.in[7] : args.in[6]) + (size_t)ij * DM * DFF, DFF, (bf16*)(ws + WS_WGU) + (size_t)ij * 5632 * DM, DM, (n0 / 128) * 256 + which * 128 + (n0 % 128), scr, k0, n0, lane, norm_pre);
                continue; } r -= 8 * I_GU;
            if (r < 4 * I_D) { const int mat = r / I_D, rr = r % I_D, nblk = DM / 32, k0 = (rr / nblk) * 64, n0 = (rr % nblk) * 32;
                if (mat >= F8_FROM) tr_item8(args.in[8] + (size_t)mat * DFF * DM, DM, ws + WS_WD + (size_t)mat * DM * DFF * 2, DFF, n0, scr, k0, n0, lane);
                else tr_item(args.in[8] + (size_t)mat * DFF * DM, DM, (bf16*)(ws + WS_WD) + (size_t)mat * DM * DFF, DFF, n0, scr, k0, n0, lane);
                continue; } r -= 4 * I_D;
            if (r < I_EVIN) { const int nblk = EV_IN / 32, k0 = (r / nblk) * 64, n0 = (r % nblk) * 32; tr_item(args.in[9], EV_IN, (bf16*)(ws + WS_EVIN), DM, n0, scr, k0, n0, lane, norm_pre + DM); continue; } r -= I_EVIN;
            if (r < I_SQ) { const int nblk = DM / 32, k0 = (r / nblk) * 64, n0 = (r % nblk) * 32; tr_item(args.in[12], DM, (bf16*)(ws + WS_EVOUT), DM, n0, scr, k0, n0, lane); continue; } r -= I_SQ;
            if (r < I_ODIN) { const int nblk = OD_IN / 32, k0 = (r / nblk) * 64, n0 = (r % nblk) * 32; tr_item8(args.in[13], OD_IN, ws + WS_ODIN, DM, n0, scr, k0, n0, lane); continue; } r -= I_ODIN;
            if (r < I_SQ) { const int nblk = DM / 32, k0 = (r / nblk) * 64, n0 = (r % nblk) * 32; tr_item(args.in[20], DM, (bf16*)(ws + WS_ODOUT), DM, n0, scr, k0, n0, lane); continue; } r -= I_SQ;
            if (r < I_UQ) { const int nblk = 768 / 32, k0 = (r / nblk) * 64, n0 = (r % nblk) * 32; tr_item(args.in[16], 768, (bf16*)(ws + WS_WUQ), 256, n0, scr, k0, n0, lane); continue; } r -= I_UQ;
            if (r < I_UKV) { const int nblk = 1024 / 32, k0 = (r / nblk) * 64, n0 = (r % nblk) * 32; tr_item(args.in[17], 1024, (bf16*)(ws + WS_WUKV), 256, n0, scr, k0, n0, lane); continue; } r -= I_UKV;
            if (r < 2 * I_XQ) { const int mat = r / I_XQ, rr = r % I_XQ, nblk = 512 / 32, k0 = (rr / nblk) * 64, n0 = (rr % nblk) * 32;
                tr_item(args.in[21] + (size_t)mat * DM * 512, 512, (bf16*)(ws + WS_XWQ) + (size_t)mat * 512 * DM, DM, n0, scr, k0, n0, lane, norm_pre + (size_t)(mat * 4 + 2) * DM); continue; } r -= 2 * I_XQ;
            if (r < 2 * I_SQ) { const int mat = r / I_SQ, rr = r % I_SQ, nblk = DM / 32, k0 = (rr / nblk) * 64, n0 = (rr % nblk) * 32;
                tr_item(args.in[22] + (size_t)mat * DM * DM, DM, (bf16*)(ws + WS_XWKV) + (size_t)mat * DM * DM, DM, n0, scr, k0, n0, lane); continue; } r -= 2 * I_SQ;
            if (r < 2 * I_XO) { const int mat = r / I_XO, rr = r % I_XO, nblk = DM / 32, k0 = (rr / nblk) * 64, n0 = (rr % nblk) * 32;
                tr_item(args.in[23] + (size_t)mat * 512 * DM, DM, (bf16*)(ws + WS_XWO) + (size_t)mat * DM * 512, 512, n0, scr, k0, n0, lane); continue; } r -= 2 * I_XO;
            { const int mat = r / I_CW, rr = r % I_CW, nblk = 64 / 32, k0 = (rr / nblk) * 64, n0 = (rr % nblk) * 32;
                tr_item(args.in[11] + (size_t)mat * 2048 * 64, 64, (bf16*)(ws + WS_CWT) + (size_t)mat * 64 * 2048, 2048, n0, scr, k0, n0, lane); }
        }
        { const int gt = vcu * (NWAVES * 64) + tid, NGT = G * NWAVES * 64; const v4u z = (v4u){0u, 0u, 0u, 0u};
          for (int i = gt; i < (EV_INP - EV_IN) * DM / 8; i += NGT) ((GAS v4u*)((bf16*)(ws + WS_EVIN) + (size_t)EV_IN * DM))[i] = z;
          for (int i = gt; i < (OD_INP - OD_IN) * DM / 16; i += NGT) ((GAS v4u*)(ws + WS_ODIN + (size_t)OD_IN * DM))[i] = z;
          for (int i = gt; i < 1024 * 16; i += NGT) ((GAS v4u*)((bf16*)(ws + WS_WUKV) + (size_t)(i >> 4) * 256 + 128))[i & 15] = z; }
        if (gw < 128) { const int c = gw >> 6, e = gw & 63; const float* pe = args.in[10] + (size_t)c * 2048; const float* cw = args.in[11] + (size_t)c * 2048 * 64 + e; float a = 0.f;
            for (int k = lane; k < 2048; k += 64) a += pe[k] * cw[(size_t)k * 64];
            a = wave_sum(a); if (lane == 0) ((float*)(ws + WS_CBIAS))[gw] = a; }
        rope_table_phase((float*)(ws + WS_ROPE), vcu * (NWAVES * 64) + tid, G * NWAVES * 64);
        rows_norm_phase(x_in, nullptr, nullptr, 0.f, nullptr, nullptr, H, MTOK, gw, NGW, lane, false, 1.f, nullptr, XB, RS);
        rows_norm_phase(mem, nullptr, nullptr, 0.f, nullptr, mem_norm, (bf16*)(ws + WS_MN), MROWS, gw, NGW, lane);
        rows_norm_phase(mem, nullptr, nullptr, 0.f, nullptr, mem_norm + DM, (bf16*)(ws + WS_MN) + (size_t)MROWS * DM, MROWS, gw, NGW, lane);
        SEAM(PH_PRO);
    }
    if (IN(PH_MEMKV)) {
            PHASE_IDS
#pragma unroll 1
        for (int i = 0; i < 2; ++i) {
            pg8::Gemm g{(const bf16*)(ws + WS_MN) + (size_t)i * MROWS * DM, (const bf16*)(ws + WS_XWKV) + (size_t)i * DM * DM, MROWS, DM, DM};
            pg8::StaticOrder S; S.init(MROWS, DM, G, (bx + 128 * i) % G);
            pg8::EpiBf16P E{(bf16*)(ws + WS_KVM) + (size_t)i * MROWS * DM, DM};
            pg8::gemm_phase<pg8::EpiBf16P, pg8::StaticOrder, true, true>(lds, g, S, E, tid);
            __syncthreads();
        }
        SEAM(PH_MEMKV);
    }
    layer_phases<0>(args, lds, bar, wave, G, bx0, vcu0, lo, hi, stop);
    layer_phases<1>(args, lds, bar, wave, G, bx0, vcu0, lo, hi, stop);
#undef IN
#undef SEAM
}

#ifndef MK_MODE
#define MK_MODE 1
#endif
#ifndef MK_STOP
#define MK_STOP NPHASE
#endif
extern "C" void kernel_launch(void* const* d_in, const int* in_sizes, int n_in, void* d_out, int out_size, void* d_ws, size_t ws_size, hipStream_t stream) {
    static int grid = 0;
    if (grid == 0) {
        if (n_in != 24 || out_size != MTOK * DM || ws_size < WS_END) { fprintf(stderr, "kernel_launch: unexpected shapes: n_in %d out %d ws %zu\n", n_in, out_size, ws_size); grid = -1; return; }
        int dev = 0, cus = 0, per_cu = 0;
        if (hipGetDevice(&dev) != hipSuccess || hipDeviceGetAttribute(&cus, hipDeviceAttributeMultiprocessorCount, dev) != hipSuccess) { grid = -1; return; }
        if (hipFuncSetAttribute((const void*)fwd_kernel, hipFuncAttributeMaxDynamicSharedMemorySize, LDS_BYTES) != hipSuccess) { fprintf(stderr, "kernel_launch: hipFuncSetAttribute failed\n"); grid = -1; return; }
        if (hipOccupancyMaxActiveBlocksPerMultiprocessor(&per_cu, (const void*)fwd_kernel, NWAVES * 64, LDS_BYTES) != hipSuccess || per_cu < 1)
            fprintf(stderr, "kernel_launch: occupancy query reports %d workgroups per CU\n", per_cu);
        (void)hipGetLastError();
        grid = cus;
    }
    if (grid < 0) return;
    if (hipMemsetAsync((char*)d_ws + WS_CTL, 0, CTL_ZERO_BYTES, stream) != hipSuccess) return;
    Args a{};
    for (int i = 0; i < 24; ++i) a.in[i] = (const float*)d_in[i];
    a.out = (float*)d_out; a.ws = (unsigned char*)d_ws; a.stop = MK_STOP;
#if MK_MODE == 1
    a.ph_lo = 0; a.ph_hi = NPHASE; a.li = 0;
    hipLaunchKernelGGL(fwd_kernel, dim3(grid), dim3(NWAVES * 64), LDS_BYTES, stream, a);
#else
    for (int p = 0; p < NPHASE && p < MK_STOP; ++p) {
        a.ph_lo = p; a.ph_hi = p + 1; a.li = 0;
        hipLaunchKernelGGL(fwd_kernel, dim3(grid), dim3(NWAVES * 64), LDS_BYTES, stream, a);
#ifdef MK_REP
        { const int k = p < PH_L0 ? -1 : (p - PH_L0) % PPL, L = p < PH_L0 ? -1 : (p - PH_L0) / PPL; (void)k; (void)L;
          if (MK_REP) { a.li = 1; hipLaunchKernelGGL(fwd_kernel, dim3(grid), dim3(NWAVES * 64), LDS_BYTES, stream, a); a.li = 0; } }
#endif
    }
#endif
}
```

```cpp
#include <hip/hip_runtime.h>
#include <cstdio>
#include <cstdint>
namespace pg8 {
#define PG8_LAS __attribute__((address_space(3)))
typedef unsigned short bf16_t;
typedef short bf16x8 __attribute__((ext_vector_type(8)));
typedef float f32x4 __attribute__((ext_vector_type(4)));
typedef unsigned u32x4 __attribute__((ext_vector_type(4)));
constexpr int BM = 256, BK = 64, HALF = 128, HTB = HALF * BK * 2  , STAGE_BYTES = 8 * HTB, NXCD = 8, WGM = 8;

__host__ __device__ __forceinline__ int lds_byte(int r, int c) { const int st = (r >> 4) * 2 + (c >> 5), rr = r & 15, cc = c & 31, ob = rr * 64 + cc * 2; return st * 1024 + (ob ^ (((ob >> 9) & 1) << 5)); }
__host__ __device__ __forceinline__ void stage_rc(int b, int& R, int& C) { const int st = b / 1024, sb = b % 1024, swz = sb ^ (((sb >> 9) & 1) << 5); R = (st >> 1) * 16 + swz / 64; C = (st & 1) * 32 + (swz % 64) / 2; }
__host__ __device__ __forceinline__ int perm32(int rho) { const int n = rho >> 4, i = rho & 15; return 8 * (i >> 2) + 4 * n + (i & 3); }

struct Unit { int pm, pn; };
struct Gemm { const bf16_t* A; const bf16_t* Bt; int M, N, K; };
typedef int i32x4 __attribute__((ext_vector_type(4)));
typedef int i32x8 __attribute__((ext_vector_type(8)));
__device__ __forceinline__ i32x8 cat8(bf16x8 a, bf16x8 b) { const i32x4 x = __builtin_bit_cast(i32x4, a), y = __builtin_bit_cast(i32x4, b); return __builtin_shufflevector(x, y, 0, 1, 2, 3, 4, 5, 6, 7); }

struct StaticOrder {
    int nM, nN, nwg, G, c;
    __host__ __device__ void init(int M, int N, int G_, int c_) { nM = M / BM; nN = N / BM; nwg = nM * nN; G = G_; c = c_; }
    __host__ __device__ bool next(int i, Unit& u) const {
        const long L = (long)i * G + c; if (L >= nwg) return false;
        int wgid = (int)L; { const int q = nwg / NXCD, r = nwg % NXCD, xcd = wgid % NXCD, off = wgid / NXCD; wgid = (xcd < r ? xcd * (q + 1) : r * (q + 1) + (xcd - r) * q) + off; }
        const int nig = WGM * nN, gid = wgid / nig, fm = gid * WGM, gsz = (nM - fm) < WGM ? (nM - fm) : WGM;
        u.pm = fm + ((wgid % nig) % gsz); u.pn = (wgid % nig) / gsz; return true;
    }
    __device__ __forceinline__ void a_ready(const Unit&) const {}
    __device__ __forceinline__ void done(const Unit&) const {}
};


__device__ __forceinline__ unsigned cvt_pk_bf16(float lo, float hi) { unsigned r; asm volatile("v_cvt_pk_bf16_f32 %0, %1, %2" : "=v"(r) : "v"(lo), "v"(hi)); return r; }

struct EpiF32 {
    static constexpr bool PERM = false, AFTER_DRAIN = false;
    float* C; int ldc;
    __device__ __forceinline__ void operator()(const f32x4 (&acc)[2][2][4][2], const Unit& u, int wr, int wc, int fr, int fq) const {
        const int row0 = u.pm * BM + wr * 64 + fr, col0 = u.pn * BM + wc * 32 + 4 * fq;
#pragma unroll
        for (int ai = 0; ai < 2; ++ai)
#pragma unroll
            for (int m = 0; m < 4; ++m) { float* rowp = C + (size_t)(row0 + ai * HALF + m * 16) * ldc + col0;
#pragma unroll
                for (int bj = 0; bj < 2; ++bj)
#pragma unroll
                    for (int n = 0; n < 2; ++n) *(f32x4*)(rowp + bj * HALF + n * 16) = acc[ai][bj][m][n]; }
    }
};
struct EpiBf16P {
    static constexpr bool PERM = true, AFTER_DRAIN = false;
    bf16_t* O; int ldc;
    __device__ __forceinline__ void operator()(const f32x4 (&acc)[2][2][4][2], const Unit& u, int wr, int wc, int fr, int fq) const {
        const int row0 = u.pm * BM + wr * 64 + fr, col0 = u.pn * BM + wc * 32 + 8 * fq;
#pragma unroll
        for (int ai = 0; ai < 2; ++ai)
#pragma unroll
            for (int m = 0; m < 4; ++m) { bf16_t* rowp = O + (size_t)(row0 + ai * HALF + m * 16) * ldc + col0;
#pragma unroll
                for (int bj = 0; bj < 2; ++bj) { const f32x4 v0 = acc[ai][bj][m][0], v1 = acc[ai][bj][m][1];
                    u32x4 w; w.x = cvt_pk_bf16(v0[0], v0[1]); w.y = cvt_pk_bf16(v0[2], v0[3]); w.z = cvt_pk_bf16(v1[0], v1[1]); w.w = cvt_pk_bf16(v1[2], v1[3]);
                    *(u32x4*)(rowp + bj * HALF) = w; } }
    }
};
__device__ __forceinline__ float silu_mul(float g, float u) { return g * __builtin_amdgcn_rcpf(1.0f + __builtin_amdgcn_exp2f(g * -1.4426950408889634f)) * u; }
struct EpiSwiGLU {
    static constexpr bool PERM = true, AFTER_DRAIN = false;
    bf16_t* O; int ldc;
    __device__ __forceinline__ void operator()(const f32x4 (&acc)[2][2][4][2], const Unit& u, int wr, int wc, int fr, int fq) const {
        const int row0 = u.pm * BM + wr * 64 + fr, col0 = u.pn * HALF + wc * 32 + 8 * fq;
#pragma unroll
        for (int ai = 0; ai < 2; ++ai)
#pragma unroll
            for (int m = 0; m < 4; ++m) { bf16_t* rowp = O + (size_t)(row0 + ai * HALF + m * 16) * ldc + col0;
                const f32x4 g0 = acc[ai][0][m][0], g1 = acc[ai][0][m][1], u0 = acc[ai][1][m][0], u1 = acc[ai][1][m][1];
                u32x4 w; w.x = cvt_pk_bf16(silu_mul(g0[0], u0[0]), silu_mul(g0[1], u0[1])); w.y = cvt_pk_bf16(silu_mul(g0[2], u0[2]), silu_mul(g0[3], u0[3]));
                w.z = cvt_pk_bf16(silu_mul(g1[0], u1[0]), silu_mul(g1[1], u1[1])); w.w = cvt_pk_bf16(silu_mul(g1[2], u1[2]), silu_mul(g1[3], u1[3]));
                *(u32x4*)rowp = w; }
    }
};


__device__ __forceinline__ unsigned pk4_fp8(float a, float b, float c, float d, float S) {
    a = __builtin_amdgcn_fmed3f(a * S, -448.f, 448.f); b = __builtin_amdgcn_fmed3f(b * S, -448.f, 448.f); c = __builtin_amdgcn_fmed3f(c * S, -448.f, 448.f); d = __builtin_amdgcn_fmed3f(d * S, -448.f, 448.f);
    int p = __builtin_amdgcn_cvt_pk_fp8_f32(a, b, 0, false); p = __builtin_amdgcn_cvt_pk_fp8_f32(c, d, p, true); return (unsigned)p;
}
constexpr float F8S_H = 4.f, F8S_HID = 8.f, F8S_W = 64.f;
struct EpiSwiGLU8 {
    static constexpr bool PERM = true, AFTER_DRAIN = false;
    unsigned char* O; int ldc;
    __device__ __forceinline__ static uint2 hid8(const f32x4 g0, const f32x4 g1, const f32x4 u0, const f32x4 u1) {
        constexpr float GS = 1.f / (F8S_W * F8S_H), C1 = -1.4426950408889634f * GS, C2 = GS * GS * F8S_HID;
        const f32x4 t0 = g0 * C1, t1 = g1 * C1;
        f32x4 e0, e1;
#pragma unroll
        for (int i = 0; i < 4; ++i) { e0[i] = __builtin_amdgcn_rcpf(1.0f + __builtin_amdgcn_exp2f(t0[i])); e1[i] = __builtin_amdgcn_rcpf(1.0f + __builtin_amdgcn_exp2f(t1[i])); }
        const f32x4 h0 = (g0 * e0) * (u0 * C2), h1 = (g1 * e1) * (u1 * C2);
        uint2 w; w.x = pk4_fp8(h0[0], h0[1], h0[2], h0[3], 1.f); w.y = pk4_fp8(h1[0], h1[1], h1[2], h1[3], 1.f); return w;
    }
    __device__ __forceinline__ void operator()(const f32x4 (&acc)[2][2][4][2], const Unit& u, int wr, int wc, int fr, int fq) const {
        const int row0 = u.pm * BM + wr * 64 + fr, col0 = u.pn * HALF + wc * 32 + 8 * fq, odd = fq & 1;
#pragma unroll
        for (int ai = 0; ai < 2; ++ai)
#pragma unroll
            for (int m = 0; m < 4; m += 2) {
                uint2 a = hid8(acc[ai][0][m][0], acc[ai][0][m][1], acc[ai][1][m][0], acc[ai][1][m][1]);
                uint2 b = hid8(acc[ai][0][m + 1][0], acc[ai][0][m + 1][1], acc[ai][1][m + 1][0], acc[ai][1][m + 1][1]);
                { auto r = __builtin_amdgcn_permlane16_swap(a.x, b.x, false, false); a.x = r[0]; b.x = r[1]; }
                { auto r = __builtin_amdgcn_permlane16_swap(a.y, b.y, false, false); a.y = r[0]; b.y = r[1]; }
                unsigned char* rowp = O + (size_t)(row0 + ai * HALF + (m + odd) * 16) * ldc + col0 - 8 * odd;
                *(uint4*)rowp = make_uint4(a.x, a.y, b.x, b.y); }
    }
};
struct EpiBf16PS {
    static constexpr bool PERM = true, AFTER_DRAIN = false;
    bf16_t* O; int ldc; float sc;
    __device__ __forceinline__ void operator()(const f32x4 (&acc)[2][2][4][2], const Unit& u, int wr, int wc, int fr, int fq) const {
        const int row0 = u.pm * BM + wr * 64 + fr, col0 = u.pn * BM + wc * 32 + 8 * fq;
#pragma unroll
        for (int ai = 0; ai < 2; ++ai)
#pragma unroll
            for (int m = 0; m < 4; ++m) { bf16_t* rowp = O + (size_t)(row0 + ai * HALF + m * 16) * ldc + col0;
#pragma unroll
                for (int bj = 0; bj < 2; ++bj) { const f32x4 v0 = acc[ai][bj][m][0] * sc, v1 = acc[ai][bj][m][1] * sc;
                    u32x4 w; w.x = cvt_pk_bf16(v0[0], v0[1]); w.y = cvt_pk_bf16(v0[2], v0[3]); w.z = cvt_pk_bf16(v1[0], v1[1]); w.w = cvt_pk_bf16(v1[2], v1[3]);
                    *(u32x4*)(rowp + bj * HALF) = w; } }
    }
};
struct EpiBf16PR {
    static constexpr bool PERM = true, AFTER_DRAIN = false;
    bf16_t* O; int ldc; const float* R;
    __device__ __forceinline__ void operator()(const f32x4 (&acc)[2][2][4][2], const Unit& u, int wr, int wc, int fr, int fq) const {
        const int row0 = u.pm * BM + wr * 64 + fr, col0 = u.pn * BM + wc * 32 + 8 * fq;
        float rs[2][4];
#pragma unroll
        for (int ai = 0; ai < 2; ++ai)
#pragma unroll
            for (int m = 0; m < 4; ++m) rs[ai][m] = R[row0 + ai * HALF + m * 16];
#pragma unroll
        for (int ai = 0; ai < 2; ++ai)
#pragma unroll
            for (int m = 0; m < 4; ++m) { bf16_t* rowp = O + (size_t)(row0 + ai * HALF + m * 16) * ldc + col0;
#pragma unroll
                for (int bj = 0; bj < 2; ++bj) { const f32x4 v0 = acc[ai][bj][m][0] * rs[ai][m], v1 = acc[ai][bj][m][1] * rs[ai][m];
                    u32x4 w; w.x = cvt_pk_bf16(v0[0], v0[1]); w.y = cvt_pk_bf16(v0[2], v0[3]); w.z = cvt_pk_bf16(v1[0], v1[1]); w.w = cvt_pk_bf16(v1[2], v1[3]);
                    *(u32x4*)(rowp + bj * HALF) = w; } }
    }
};
struct EpiSwiGLUR {
    static constexpr bool PERM = true, AFTER_DRAIN = false;
    bf16_t* O; int ldc; const float* R;
    __device__ __forceinline__ void operator()(const f32x4 (&acc)[2][2][4][2], const Unit& u, int wr, int wc, int fr, int fq) const {
        const int row0 = u.pm * BM + wr * 64 + fr, col0 = u.pn * HALF + wc * 32 + 8 * fq;
        float rs[2][4];
#pragma unroll
        for (int ai = 0; ai < 2; ++ai)
#pragma unroll
            for (int m = 0; m < 4; ++m) rs[ai][m] = R[row0 + ai * HALF + m * 16];
#pragma unroll
        for (int ai = 0; ai < 2; ++ai)
#pragma unroll
            for (int m = 0; m < 4; ++m) { bf16_t* rowp = O + (size_t)(row0 + ai * HALF + m * 16) * ldc + col0;
                const f32x4 g0 = acc[ai][0][m][0] * rs[ai][m], g1 = acc[ai][0][m][1] * rs[ai][m], u0 = acc[ai][1][m][0] * rs[ai][m], u1 = acc[ai][1][m][1] * rs[ai][m];
                u32x4 w; w.x = cvt_pk_bf16(silu_mul(g0[0], u0[0]), silu_mul(g0[1], u0[1])); w.y = cvt_pk_bf16(silu_mul(g0[2], u0[2]), silu_mul(g0[3], u0[3]));
                w.z = cvt_pk_bf16(silu_mul(g1[0], u1[0]), silu_mul(g1[1], u1[1])); w.w = cvt_pk_bf16(silu_mul(g1[2], u1[2]), silu_mul(g1[3], u1[3]));
                *(u32x4*)rowp = w; }
    }
};
template <class Epi, class Sched, bool ALIGN_EPI = false, bool SP2 = false, bool F8 = false>
__device__ __forceinline__ void gemm_phase(PG8_LAS unsigned char* lds, const Gemm g, const Sched& S, const Epi& E, int tid_in) {
    int tid_l = tid_in; asm volatile("" : "+v"(tid_l));
    const int tid = tid_l, wid = __builtin_amdgcn_readfirstlane(tid >> 6), lane = tid & 63, wr = wid >> 2, wc = wid & 3, fr = lane & 15, fq = lane >> 4;
    const int K = F8 ? g.K / 2 : g.K, nt = K / BK;
    unsigned voffA[2], voffB[2];
#pragma unroll
    for (int i = 0; i < 2; ++i) { int R, C; stage_rc(tid * 16 + i * 8192, R, C); const int Rb = Epi::PERM ? ((R & ~31) + perm32(R & 31)) : R;
        voffA[i] = (unsigned)(R * K + C) * 2u; voffB[i] = (unsigned)(Rb * K + C) * 2u; }
    const size_t kstep = (size_t)(BK * 2);
    const size_t hstep = (size_t)HALF * K * 2;
    const size_t tstep = 2 * hstep;
    const unsigned ldsw = (unsigned)wid * 1024u;
    const int aoff = lds_byte(wr * 64 + fr, fq * 8), boff = lds_byte(wc * 32 + fr, fq * 8);
#define PG8_SA(b, h) (((b) * 2 + (h)) * HTB)
#define PG8_SB(b, h) ((4 + (b) * 2 + (h)) * HTB)
#define PG8_STAGE(bufoff, gbase, voff) do { const char* _gb = (const char*)(gbase); if constexpr (F8) asm volatile("" : "+s"(_gb));     \
        _Pragma("unroll") for (int _i = 0; _i < 2; ++_i) \
        __builtin_amdgcn_global_load_lds((const unsigned*)(_gb + (voff)[_i]), (PG8_LAS unsigned*)(lds + (bufoff) + ldsw + _i * 8192), 16, 0, 0); } while (0)
#define PG8_LDA(dst, b, h) do { _Pragma("unroll") for (int m = 0; m < 4; ++m) _Pragma("unroll") for (int k = 0; k < 2; ++k) dst[m][k] = *(const PG8_LAS bf16x8*)(lds + PG8_SA(b, h) + aoff + m * 2048 + k * 1024); } while (0)
#define PG8_LDB(dst, b, h) do { _Pragma("unroll") for (int n = 0; n < 2; ++n) _Pragma("unroll") for (int k = 0; k < 2; ++k) dst[n][k] = *(const PG8_LAS bf16x8*)(lds + PG8_SB(b, h) + boff + n * 2048 + k * 1024); } while (0)
#define PG8_MMA(ai, bj, At, Bt) do { __builtin_amdgcn_s_setprio(1); _Pragma("unroll") for (int m = 0; m < 4; ++m) _Pragma("unroll") for (int n = 0; n < 2; ++n) _Pragma("unroll") for (int k = 0; k < 2; ++k) \
        acc[ai][bj][m][n] = __builtin_amdgcn_mfma_f32_16x16x32_bf16(Bt[n][k], At[m][k], acc[ai][bj][m][n], 0, 0, 0); __builtin_amdgcn_s_setprio(0); } while (0)
#define PG8_MMA8(ai, bj, At, Bt) do { __builtin_amdgcn_s_setprio(1); _Pragma("unroll") for (int m = 0; m < 4; ++m) _Pragma("unroll") for (int n = 0; n < 2; ++n) \
        acc[ai][bj][m][n] = __builtin_amdgcn_mfma_scale_f32_16x16x128_f8f6f4(cat8(Bt[n][0], Bt[n][1]), cat8(At[m][0], At[m][1]), acc[ai][bj][m][n], 0, 0, 0, 0, 0, 0); __builtin_amdgcn_s_setprio(0); } while (0)
#define PG8_MM(ai, bj, At, Bt) do { if constexpr (F8) PG8_MMA8(ai, bj, At, Bt); else PG8_MMA(ai, bj, At, Bt); } while (0)
#define PG8_WAIT_V(n) asm volatile("s_waitcnt vmcnt(" #n ")" ::: "memory")
#define PG8_WAIT_L(n) asm volatile("s_waitcnt lgkmcnt(" #n ")" ::: "memory")
#define PG8_BAR __builtin_amdgcn_s_barrier()
#define PG8_SCHED __builtin_amdgcn_sched_barrier(0)
    Unit cur, nxt; int ui = 0;
    if (!S.next(0, cur)) return;
    f32x4 acc[2][2][4][2];
#pragma unroll
    for (int a = 0; a < 2; ++a)
#pragma unroll
        for (int b = 0; b < 2; ++b)
#pragma unroll
            for (int m = 0; m < 4; ++m)
#pragma unroll
                for (int n = 0; n < 2; ++n) acc[a][b][m][n] = (f32x4){0.f, 0.f, 0.f, 0.f};
    bf16x8 At[4][2], B0[2][2], B1[2][2];
    const char* cA = (const char*)g.A + (size_t)cur.pm * tstep; const char* cB = (const char*)g.Bt + (size_t)cur.pn * tstep;
    S.a_ready(cur);
    if constexpr (SP2) {
        PG8_STAGE(PG8_SB(0, 0), cB, voffB); PG8_STAGE(PG8_SB(0, 1), cB + hstep, voffB); PG8_STAGE(PG8_SA(0, 0), cA, voffA); PG8_STAGE(PG8_SA(0, 1), cA + hstep, voffA);
        if (wr == 1) PG8_BAR;
        PG8_WAIT_V(2); PG8_BAR;
        PG8_STAGE(PG8_SB(1, 0), cB + kstep, voffB); PG8_STAGE(PG8_SA(1, 0), cA + kstep, voffA); PG8_STAGE(PG8_SB(1, 1), cB + hstep + kstep, voffB);
        PG8_WAIT_V(6); PG8_BAR;
    } else {
        PG8_STAGE(PG8_SB(0, 0), cB, voffB); PG8_STAGE(PG8_SA(0, 0), cA, voffA); PG8_STAGE(PG8_SB(0, 1), cB + hstep, voffB); PG8_STAGE(PG8_SA(0, 1), cA + hstep, voffA);
        if (wr == 1) PG8_BAR;
        PG8_WAIT_V(4); PG8_BAR;
        PG8_STAGE(PG8_SB(1, 0), cB + kstep, voffB); PG8_STAGE(PG8_SA(1, 0), cA + kstep, voffA); PG8_STAGE(PG8_SB(1, 1), cB + hstep + kstep, voffB);
        PG8_WAIT_V(6); PG8_BAR;
    }
    for (;;) {
        const bool has_next = S.next(ui + 1, nxt);
        const char* nA = has_next ? (const char*)g.A + (size_t)nxt.pm * tstep : cA; const char* nB = has_next ? (const char*)g.Bt + (size_t)nxt.pn * tstep : cB;
#pragma unroll 1
        for (int t = 0; t < nt; t += 2) {
            const bool last = (t == nt - 2);
            const char* a1 = cA + (size_t)(t + 1) * kstep;
            const char* a2 = last ? nA : cA + (size_t)(t + 2) * kstep; const char* b2 = last ? nB : cB + (size_t)(t + 2) * kstep;
            const char* a3 = a2 + kstep; const char* b3 = b2 + kstep;
            if (last && has_next) S.a_ready(nxt);
            if constexpr (SP2) {
            PG8_LDB(B0, 0, 0); PG8_LDB(B1, 0, 1); PG8_SCHED; PG8_LDA(At, 0, 0); PG8_STAGE(PG8_SA(1, 1), a1 + hstep, voffA);
            PG8_WAIT_V(8); PG8_WAIT_L(0); PG8_BAR; PG8_MM(0, 0, At, B0); PG8_MM(0, 1, At, B1); PG8_BAR; PG8_SCHED;
            PG8_LDA(At, 0, 1); PG8_STAGE(PG8_SB(0, 0), b2, voffB); PG8_STAGE(PG8_SB(0, 1), b2 + hstep, voffB); PG8_STAGE(PG8_SA(0, 0), a2, voffA);
            PG8_WAIT_V(8); PG8_WAIT_L(0); PG8_BAR; PG8_MM(1, 0, At, B0); PG8_MM(1, 1, At, B1); PG8_BAR; PG8_SCHED;
            PG8_LDB(B0, 1, 0); PG8_LDB(B1, 1, 1); PG8_SCHED; PG8_LDA(At, 1, 0); PG8_STAGE(PG8_SA(0, 1), a2 + hstep, voffA);
            PG8_WAIT_V(8); PG8_WAIT_L(0); PG8_BAR; PG8_MM(0, 0, At, B0); PG8_MM(0, 1, At, B1); PG8_BAR; PG8_SCHED;
            PG8_LDA(At, 1, 1); PG8_STAGE(PG8_SB(1, 0), b3, voffB); PG8_STAGE(PG8_SB(1, 1), b3 + hstep, voffB); PG8_STAGE(PG8_SA(1, 0), a3, voffA);
            PG8_WAIT_V(8); PG8_WAIT_L(0); PG8_BAR; PG8_MM(1, 0, At, B0); PG8_MM(1, 1, At, B1); PG8_BAR; PG8_SCHED;
            } else {
            PG8_LDB(B0, 0, 0); PG8_SCHED; PG8_LDA(At, 0, 0); PG8_STAGE(PG8_SA(1, 1), a1 + hstep, voffA);
            PG8_WAIT_L(8); PG8_BAR; PG8_WAIT_L(0); PG8_MM(0, 0, At, B0); PG8_BAR; PG8_SCHED;
            PG8_LDB(B1, 0, 1); PG8_STAGE(PG8_SB(0, 0), b2, voffB);
            PG8_BAR; PG8_WAIT_L(0); PG8_MM(0, 1, At, B1); PG8_BAR;
            PG8_LDA(At, 0, 1); PG8_STAGE(PG8_SA(0, 0), a2, voffA);
            PG8_BAR; PG8_WAIT_L(0); PG8_MM(1, 0, At, B0); PG8_BAR; PG8_SCHED;
            PG8_STAGE(PG8_SB(0, 1), b2 + hstep, voffB);
            PG8_WAIT_V(6); PG8_BAR; PG8_MM(1, 1, At, B1); PG8_BAR;
            PG8_LDB(B0, 1, 0); PG8_SCHED; PG8_LDA(At, 1, 0); PG8_STAGE(PG8_SA(0, 1), a2 + hstep, voffA);
            PG8_WAIT_L(8); PG8_BAR; PG8_WAIT_L(0); PG8_MM(0, 0, At, B0); PG8_BAR; PG8_SCHED;
            PG8_LDB(B1, 1, 1); PG8_STAGE(PG8_SB(1, 0), b3, voffB);
            PG8_BAR; PG8_WAIT_L(0); PG8_MM(0, 1, At, B1); PG8_BAR;
            PG8_LDA(At, 1, 1); PG8_STAGE(PG8_SA(1, 0), a3, voffA);
            PG8_BAR; PG8_WAIT_L(0); PG8_MM(1, 0, At, B0); PG8_BAR; PG8_SCHED;
            PG8_STAGE(PG8_SB(1, 1), b3 + hstep, voffB);
            PG8_WAIT_V(6); PG8_BAR; PG8_MM(1, 1, At, B1); PG8_BAR;
            }
        }
        if constexpr (ALIGN_EPI) { if (wr == 0) PG8_BAR; }
        if constexpr (!Epi::AFTER_DRAIN) {
            if constexpr (F8) { int l2; asm volatile("v_mbcnt_lo_u32_b32 %0, -1, 0\n\tv_mbcnt_hi_u32_b32 %0, -1, %0" : "=v"(l2)); E(acc, cur, wr, wc, l2 & 15, l2 >> 4); }
            else E(acc, cur, wr, wc, fr, fq);
            S.done(cur); }
        if (!has_next) break;
#pragma unroll
        for (int a = 0; a < 2; ++a)
#pragma unroll
            for (int b = 0; b < 2; ++b)
#pragma unroll
                for (int m = 0; m < 4; ++m)
#pragma unroll
                    for (int n = 0; n < 2; ++n) acc[a][b][m][n] = (f32x4){0.f, 0.f, 0.f, 0.f};
        cur = nxt; cA = nA; cB = nB; ++ui;
        if constexpr (ALIGN_EPI) { if (wr == 1) PG8_BAR; }
    }
    PG8_WAIT_V(0);
    if constexpr (!ALIGN_EPI) { if (wr == 0) PG8_BAR; }
    PG8_BAR;
    if constexpr (Epi::AFTER_DRAIN) { E.fused(acc, cur, wr, wc, fr, fq, lds, wid, lane); S.done(cur); }
#undef PG8_SA
#undef PG8_SB
#undef PG8_STAGE
#undef PG8_LDA
#undef PG8_LDB
#undef PG8_MMA
#undef PG8_MMA8
#undef PG8_MM
#undef PG8_WAIT_V
#undef PG8_WAIT_L
#undef PG8_BAR
#undef PG8_SCHED
}
}

constexpr int DM = 1024, NB = 16, SEQ = 4096, MTOK = NB * SEQ, DFF = 2816, MEML = 256, MROWS = NB * MEML;
constexpr int EV_IN = 2240, EV_INP = 2304, OD_IN = 1952, OD_INP = 2048;
constexpr float RMS_EPS = 1e-6f;
constexpr int NWAVES = 8;

constexpr size_t MiB = 1u << 20;
constexpr size_t WS_CTL = 0, CTL_ZERO_BYTES = 1 * MiB;
constexpr size_t WS_WGU = 2 * MiB;
constexpr size_t WS_WD = 46 * MiB;
constexpr size_t WS_EVIN = 68 * MiB;
constexpr size_t WS_EVOUT = 73 * MiB;
constexpr size_t WS_ODIN = 75 * MiB;
constexpr size_t WS_ODOUT = 79 * MiB;
constexpr size_t WS_WUQ = 81 * MiB;
constexpr size_t WS_WUKV = 82 * MiB;
constexpr size_t WS_XWQ = 83 * MiB;
constexpr size_t WS_XWKV = 85 * MiB;
constexpr size_t WS_XWO = 89 * MiB;
constexpr size_t WS_MN = 92 * MiB;
constexpr size_t WS_KVM = 108 * MiB;
constexpr size_t WS_VMT = 124 * MiB;
constexpr size_t WS_H = 132 * MiB;
constexpr size_t WS_Y = 260 * MiB;
constexpr size_t WS_OV = 516 * MiB;
constexpr size_t WS_END = 1024 * MiB;
constexpr size_t WS_HID = WS_OV;
constexpr size_t WS_XQ = WS_OV;

constexpr int CW_BAR = 4096;
constexpr int RING_BYTES = 131072, LDSCTL_OFF = 144384, MISC_OFF = LDSCTL_OFF + 320, LDS_BYTES = LDSCTL_OFF + 16384;

#define GAS __attribute__((address_space(1)))
#define LAS __attribute__((address_space(3)))
typedef unsigned short bf16;
typedef unsigned v4u __attribute__((ext_vector_type(4)));
typedef unsigned v2u __attribute__((ext_vector_type(2)));
typedef float f32x4 __attribute__((ext_vector_type(4)));
typedef short bf16x8 __attribute__((ext_vector_type(8)));
#define LDS_WAIT() asm volatile("s_waitcnt lgkmcnt(0)" ::: "memory")
#define VM_WAIT() asm volatile("s_waitcnt vmcnt(0)" ::: "memory")
__device__ __forceinline__ unsigned f2bf(float f) { unsigned u = __builtin_bit_cast(unsigned, f); return (u + 0x7fffu + ((u >> 16) & 1u)) >> 16; }
__device__ __forceinline__ unsigned pk2(float lo, float hi) { return f2bf(lo) | (f2bf(hi) << 16); }
__device__ __forceinline__ float bf2f(unsigned short b) { return __builtin_bit_cast(float, (unsigned)b << 16); }
template <int K> __device__ __forceinline__ unsigned lx_u(unsigned v) {
    if constexpr (K == 32) { auto rr = __builtin_amdgcn_permlane32_swap(v, v, false, false); return rr[0] ^ rr[1] ^ v; }
    else return (unsigned)__builtin_amdgcn_ds_swizzle((int)v, (K << 10) | 0x1f);
}
template <int K> __device__ __forceinline__ float lx_f(float v) { return __uint_as_float(lx_u<K>(__float_as_uint(v))); }
__device__ __forceinline__ float wave_sum(float v) {
    v += lx_f<1>(v); v += lx_f<2>(v); v += lx_f<4>(v); v += lx_f<8>(v); v += lx_f<16>(v); v += lx_f<32>(v);
    return v;
}
__device__ __forceinline__ float fmx(float a, float b) { return __builtin_elementwise_maximum(a, b); }
__device__ __forceinline__ float fmx3(float a, float b, float c) { return __builtin_elementwise_maximum(__builtin_elementwise_maximum(a, b), c); }
__device__ __forceinline__ float fmn(float a, float b) { return __builtin_elementwise_minimum(a, b); }

#define XB_TMO      128
#define XB_XCNT(j)  (256  + 64 * (j))
#define XB_XSUB(j)  (1280 + 64 * (j))
#define XB_XGEN(j)  (2304 + 64 * (j))
#define XB_TOP      3328
#define XB_TOPGEN   3392
#define XCD_BAR_WORDS 3456
#define XB_SPIN_CAP (1u << 18)

__device__ __forceinline__ unsigned xb_ld(unsigned* p)              { return __hip_atomic_load(p, __ATOMIC_RELAXED, __HIP_MEMORY_SCOPE_AGENT); }
__device__ __forceinline__ unsigned xb_add(unsigned* p, unsigned v) { return __hip_atomic_fetch_add(p, v, __ATOMIC_RELAXED, __HIP_MEMORY_SCOPE_AGENT); }
__device__ __forceinline__ unsigned xb_xcc_id() { return (unsigned)__builtin_amdgcn_s_getreg((3 << 11) | 20) & 0xFu; }
#define XB_SPIN(cond, bar) do { unsigned _sp = 0; while (cond) { __builtin_amdgcn_s_sleep(1); \
    if ((++_sp & 255u) == 0u) { if (xb_ld(&(bar)[XB_TMO])) break; if (_sp > XB_SPIN_CAP) { atomicAdd(&(bar)[XB_TMO], 1u); break; } } } } while (0)

struct XcdBarrier {
    unsigned* bar; unsigned x;
    unsigned w0;
    volatile LAS unsigned* st;
};

__device__ __forceinline__ XcdBarrier xcd_barrier_post(unsigned* bar, volatile LAS unsigned* st) {
    XcdBarrier b; b.bar = bar; b.x = xb_xcc_id(); b.st = st; b.w0 = (unsigned)__builtin_amdgcn_readfirstlane((threadIdx.x >> 6) == 0 ? 1 : 0);
    if (threadIdx.x == 0) (void)xb_add(&bar[XB_XCNT(b.x)], 1u);
    return b;
}
__device__ __forceinline__ void xcd_barrier_complete(unsigned* bar, unsigned x, unsigned& nloc, unsigned& nx) {
    const unsigned G = gridDim.x * gridDim.y * gridDim.z;
    unsigned sum, cnt, mine, sp = 0u;
    for (;;) {
        sum = 0u; cnt = 0u; mine = 0u;
#pragma unroll
        for (unsigned j = 0; j < 16; ++j) { const unsigned c = xb_ld(&bar[XB_XCNT(j)]); sum += c; cnt += (c > 0u) ? 1u : 0u; mine = (j == x) ? c : mine; }
        if (sum == G) break;
        __builtin_amdgcn_s_sleep(1);
        if ((++sp & 255u) == 0u) { if (xb_ld(&bar[XB_TMO])) break; if (sp > XB_SPIN_CAP) { atomicAdd(&bar[XB_TMO], 1u); break; } }
    }
    nloc = mine > 0u ? mine : 1u; nx = cnt > 0u ? cnt : 1u;
}

__device__ __forceinline__ void xcd_barrier(const XcdBarrier& b) {
    asm volatile("s_waitcnt vmcnt(0)" ::: "memory");
    __syncthreads();
    unsigned xb_lane; asm volatile("v_mbcnt_lo_u32_b32 %0, -1, 0\n\tv_mbcnt_hi_u32_b32 %0, -1, %0" : "=v"(xb_lane));
    if (b.w0 != 0u && xb_lane == 0u) {
        unsigned* bar = b.bar;
        __builtin_amdgcn_s_waitcnt(0);
        unsigned nloc = b.st[0], nx = b.st[1];
        if (nloc == 0u) { xcd_barrier_complete(bar, b.x, nloc, nx); b.st[0] = nloc; b.st[1] = nx; }
        const unsigned old = xb_add(&bar[XB_XSUB(b.x)], 1u);
        const unsigned gen = old / nloc;
        if (old + 1u == (gen + 1u) * nloc) {
            __builtin_amdgcn_fence(__ATOMIC_RELEASE, "agent");
            asm volatile("s_waitcnt vmcnt(0)" ::: "memory");
            const unsigned og = xb_add(&bar[XB_TOP], 1u);
            const unsigned tg = og / nx;
            if (og + 1u == (tg + 1u) * nx) xb_add(&bar[XB_TOPGEN], 1u);
            else XB_SPIN(xb_ld(&bar[XB_TOPGEN]) == tg, bar);
            __builtin_amdgcn_fence(__ATOMIC_ACQUIRE, "agent");
            xb_add(&bar[XB_XGEN(b.x)], 1u);
            asm volatile("s_waitcnt vmcnt(0)" ::: "memory");
        } else {
            XB_SPIN(xb_ld(&bar[XB_XGEN(b.x)]) == gen, bar);
            __builtin_amdgcn_fence(__ATOMIC_ACQUIRE, "agent");
            asm volatile("s_waitcnt vmcnt(0)" ::: "memory");
        }
    }
    __syncthreads();
}


typedef float f32x16 __attribute__((ext_vector_type(16)));
typedef short s16x4 __attribute__((ext_vector_type(4)));
constexpr float NEGBIG = -1e30f, LOG2E = 1.4426950408889634f;
constexpr int KP128 = 272, KBUF_BYTES = 64 * KP128, VBUF_BYTES = 64 * 320;
constexpr int AT_KBUF = 0, AT_VBUF = 2 * KBUF_BYTES, AT_BT = AT_VBUF + 2 * VBUF_BYTES, BT_STRIDE = 132, AT_WS = AT_BT + 20 * BT_STRIDE * 4, AT_WS_PER_WAVE = 4096;
static_assert(AT_WS + 8 * AT_WS_PER_WAVE <= RING_BYTES, "attention LDS map");
__device__ __forceinline__ int crow(int r, int hi) { return (r & 3) + 8 * (r >> 2) + 4 * hi; }
typedef float f32x2_t __attribute__((ext_vector_type(2))); typedef __bf16 bf16x2_t __attribute__((ext_vector_type(2)));
__device__ __forceinline__ unsigned cvtpk(float lo, float hi) { f32x2_t v = {lo, hi}; bf16x2_t b = __builtin_convertvector(v, bf16x2_t); return __builtin_bit_cast(unsigned, b); }
typedef float f32x8_t __attribute__((ext_vector_type(8)));
typedef float f32x2_t __attribute__((ext_vector_type(2)));
__device__ __forceinline__ float vsum32(const f32x16 (&s)[2]) {
    const f32x16 a = s[0] + s[1]; const f32x8_t b = a.lo + a.hi; const f32x4 c = b.lo + b.hi; const f32x2_t d = c.lo + c.hi; return d.x + d.y;
}
__device__ __forceinline__ float swapmax(float v) { auto rr = __builtin_amdgcn_permlane32_swap(__float_as_uint(v), __float_as_uint(v), false, false); return fmx(__uint_as_float(rr[0]), __uint_as_float(rr[1])); }
__device__ __forceinline__ float swapsum(float v) { auto rr = __builtin_amdgcn_permlane32_swap(__float_as_uint(v), __float_as_uint(v), false, false); return __uint_as_float(rr[0]) + __uint_as_float(rr[1]); }
__device__ __forceinline__ float swapget(float v) { return lx_f<32>(v); }

struct KVSrc {
    const bf16* ka; int kpa;
    const bf16* kb; int kpb;
    const bf16* v; int vp;
};
template <int DQK, int KA, int DV> struct Stage {
    static constexpr int CPR = DQK / 8, NKC = 64 * CPR, NKI = (NKC + 511) / 512, CPV = DV / 8, NVC = 64 * CPV, NVI = (NVC + 511) / 512, KP = DQK * 2 + 16, VP = (DV == 64 ? 192 : 320);
    v4u k[NKI]; v4u v[NVI];
    __device__ __forceinline__ void load(const KVSrc& s, int kt, int tid) {
#pragma unroll
        for (int i = 0; i < NKI; ++i) { const int c = tid + 512 * i; if (NKC % 512 == 0 || c < NKC) { const int row = c / CPR, cc = c % CPR;
            const bf16* p = (KA == DQK || cc < KA / 8) ? s.ka + (size_t)(64 * kt + row) * s.kpa + 8 * cc : s.kb + (size_t)(64 * kt + row) * s.kpb + 8 * (cc - KA / 8);
            k[i] = *(const GAS v4u*)p; } }
#pragma unroll
        for (int i = 0; i < NVI; ++i) { const int c = tid + 512 * i; if (NVC % 512 == 0 || c < NVC) { const int row = c / CPV, cc = c % CPV;
            v[i] = *(const GAS v4u*)(s.v + (size_t)(64 * kt + row) * s.vp + 8 * cc); } }
    }
    __device__ __forceinline__ void store(LAS unsigned char* lds, int buf, int tid) const {
#pragma unroll
        for (int i = 0; i < NKI; ++i) { const int c = tid + 512 * i; if (NKC % 512 == 0 || c < NKC) { const int row = c / CPR, cc = c % CPR;
            *(LAS v4u*)(lds + AT_KBUF + buf * KBUF_BYTES + row * KP + 16 * cc) = k[i]; } }
#pragma unroll
        for (int i = 0; i < NVI; ++i) { const int c = tid + 512 * i; if (NVC % 512 == 0 || c < NVC) { const int row = c / CPV, cc = c % CPV;
            *(LAS v4u*)(lds + AT_VBUF + buf * VBUF_BYTES + row * VP + 16 * cc) = v[i]; } }
    }
};
template <int DQK, int GR = 0> __device__ __forceinline__ void qk_tile(const LAS unsigned char* kbuf, const bf16x8 (&qf)[DQK / 16], f32x16 (&s)[2], int lane, const f32x16 c0 = (f32x16){}) {
    constexpr int KP = DQK * 2 + 16, ND = DQK / 16, G = GR ? GR : 2;
    const int r32 = lane & 31, hi = lane >> 5;
    s[0] = c0; s[1] = c0;
#pragma unroll
    for (int g = 0; g < ND / G; ++g) {
        bf16x8 kf[2][G];
#pragma unroll
        for (int d = 0; d < G; ++d)
#pragma unroll
            for (int st = 0; st < 2; ++st) kf[st][d] = *(const LAS bf16x8*)(kbuf + (32 * st + r32) * KP + 32 * (g * G + d) + 16 * hi);
        __builtin_amdgcn_sched_barrier(0);
#pragma unroll
        for (int d = 0; d < G; ++d)
#pragma unroll
            for (int st = 0; st < 2; ++st) s[st] = __builtin_amdgcn_mfma_f32_32x32x16_bf16(kf[st][d], qf[g * G + d], s[st], 0, 0, 0);
    }
}
__device__ __forceinline__ float softmax_tile(f32x16 (&s)[2], float& m, float& l) {
    float mx = NEGBIG;
#pragma unroll
    for (int r = 0; r < 16; ++r) mx = fmx3(mx, s[0][r], s[1][r]);
    mx = swapmax(mx);
    const float mn = fmx(m, mx), alpha = __builtin_amdgcn_exp2f(m - mn), ms = fmx(mn, -1e29f);
    m = mn; { const float nms = -ms; s[0] = s[0] + nms; s[1] = s[1] + nms; }
#pragma unroll
    for (int st = 0; st < 2; ++st)
#pragma unroll
        for (int r = 0; r < 16; ++r) s[st][r] = __builtin_amdgcn_exp2f(s[st][r]);
    const float rs = vsum32(s);
    l = l * alpha + rs;
    return alpha;
}
struct VFrag { bf16x8 f[2][4]; };
typedef short v4i16_t __attribute__((ext_vector_type(4)));
template <int VP> __device__ __forceinline__ void pv_load(const LAS unsigned char* vbuf, int dp, VFrag& v, int lane) {
    const int g = lane >> 4, q = (lane & 15) >> 2, p = lane & 3;
    const LAS unsigned char* base = vbuf + (4 * (g >> 1) + q) * VP + (16 * (g & 1) + 4 * p) * 2;
#pragma unroll
    for (int k = 0; k < 4; ++k)
#pragma unroll
        for (int d2 = 0; d2 < 2; ++d2) {
            const v4i16_t lo = __builtin_amdgcn_ds_read_tr16_b64_v4i16((LAS v4i16_t*)(base + (16 * k) * VP + 64 * (2 * dp + d2)));
            const v4i16_t hh = __builtin_amdgcn_ds_read_tr16_b64_v4i16((LAS v4i16_t*)(base + (16 * k + 8) * VP + 64 * (2 * dp + d2)));
            v.f[d2][k] = (bf16x8){lo[0], lo[1], lo[2], lo[3], hh[0], hh[1], hh[2], hh[3]}; }
}
__device__ __forceinline__ void p_pack(const f32x16 (&p)[2], bf16x8 (&pf)[4]) {
#pragma unroll
    for (int k = 0; k < 4; ++k) { const int st = k >> 1, s = k & 1; v4u w; w.x = cvtpk(p[st][8 * s + 0], p[st][8 * s + 1]); w.y = cvtpk(p[st][8 * s + 2], p[st][8 * s + 3]); w.z = cvtpk(p[st][8 * s + 4], p[st][8 * s + 5]); w.w = cvtpk(p[st][8 * s + 6], p[st][8 * s + 7]);
        pf[k] = __builtin_bit_cast(bf16x8, w); }
}
__device__ __forceinline__ void pv_mma(const VFrag& v, const bf16x8 (&pf)[4], f32x16& o0, f32x16& o1) {
#pragma unroll
    for (int k = 0; k < 4; ++k) { o0 = __builtin_amdgcn_mfma_f32_32x32x16_bf16(v.f[0][k], pf[k], o0, 0, 0, 0); o1 = __builtin_amdgcn_mfma_f32_32x32x16_bf16(v.f[1][k], pf[k], o1, 0, 0, 0); }
}
template <int DV> __device__ __forceinline__ void pv_tile(const LAS unsigned char* vbuf, const f32x16 (&p)[2], f32x16 (&o)[DV / 32], int lane) {
    bf16x8 pf[4]; p_pack(p, pf);
#pragma unroll
    for (int dp = 0; dp < DV / 64; ++dp) { VFrag v; pv_load<(DV == 64 ? 192 : 320)>(vbuf, dp, v, lane); __builtin_amdgcn_sched_barrier(0); pv_mma(v, pf, o[2 * dp], o[2 * dp + 1]); }
}
constexpr float DEFER_THR = 8.0f;
struct SmState { float mhat, l; bool started; };
template <int DQK, int DV, class F, bool EARLYV>
__device__ __forceinline__ void attn_tile(LAS unsigned char* lds, int buf, int kt, const bf16x8 (&qf)[DQK / 16], F& f, f32x16 (&o)[DV / 32], SmState& S, f32x16& negm, int lane) {
    f32x16 s[2];
    qk_tile<DQK>(lds + AT_KBUF + buf * KBUF_BYTES, qf, s, lane, negm);
    const LAS unsigned char* vbuf = lds + AT_VBUF + buf * VBUF_BYTES;
    VFrag vfr;
    if constexpr (DV == 64 && EARLYV) { pv_load<(DV == 64 ? 192 : 320)>(vbuf, 0, vfr, lane); __builtin_amdgcn_sched_barrier(0); }
    f.apply(s, kt);
    float mx = NEGBIG;
#pragma unroll
    for (int r = 0; r < 16; ++r) mx = fmx3(mx, s[0][r], s[1][r]);
    mx = swapmax(mx);
    const bool need = S.started ? (mx > DEFER_THR) : (mx > -1e29f);
    if (__any(need)) {
        const float delta = need ? mx : 0.f, fac = (need && S.started) ? __builtin_amdgcn_exp2f(-delta) : 1.f;
        S.mhat += delta; S.l *= fac; S.started = S.started || need;
#pragma unroll
        for (int st = 0; st < 2; ++st)
#pragma unroll
            for (int r = 0; r < 16; ++r) s[st][r] -= delta;
#pragma unroll
        for (int dt = 0; dt < DV / 32; ++dt) o[dt] = o[dt] * fac;
#pragma unroll
        for (int r = 0; r < 16; ++r) negm[r] = -S.mhat;
    }
#pragma unroll
    for (int st = 0; st < 2; ++st)
#pragma unroll
        for (int r = 0; r < 16; ++r) s[st][r] = __builtin_amdgcn_exp2f(s[st][r]);
    S.l += vsum32(s);
    bf16x8 pf[4]; p_pack(s, pf);
#pragma unroll
    for (int dp = 0; dp < DV / 64; ++dp) {
        if constexpr (!(DV == 64 && EARLYV)) { pv_load<(DV == 64 ? 192 : 320)>(vbuf, dp, vfr, lane); __builtin_amdgcn_sched_barrier(0); }
        pv_mma(vfr, pf, o[2 * dp], o[2 * dp + 1]);
    }
}
template <int DQK, int KA, int DV, class F, bool EARLYV = true, bool DEEP = false>
__device__ __forceinline__ void attn_loop(LAS unsigned char* lds, const KVSrc& kv, int kt0, int kt1, const bf16x8 (&qf)[DQK / 16], F& f, f32x16 (&o)[DV / 32], SmState& S, int tid, int lane) {
    if (kt0 >= kt1) return;
    Stage<DQK, KA, DV> sg0;
    __syncthreads();
    sg0.load(kv, kt0, tid); sg0.store(lds, 0, tid);
    f32x16 negm;
#pragma unroll
    for (int r = 0; r < 16; ++r) negm[r] = -S.mhat;
    if constexpr (DEEP) {
        Stage<DQK, KA, DV> sg1;
        if (kt0 + 1 < kt1) sg1.load(kv, kt0 + 1, tid);
        __syncthreads();
        for (int kt = kt0; kt < kt1; kt += 2) {
            if (kt + 2 < kt1) { sg0.load(kv, kt + 2, tid); f.pre(kt + 2); }
            if (!f.skip(kt)) attn_tile<DQK, DV, F, EARLYV>(lds, 0, kt, qf, f, o, S, negm, lane);
            if (kt + 1 < kt1) sg1.store(lds, 1, tid);
            __syncthreads();
            if (kt + 1 < kt1) {
                if (kt + 3 < kt1) { sg1.load(kv, kt + 3, tid); f.pre(kt + 3); }
                if (!f.skip(kt + 1)) attn_tile<DQK, DV, F, EARLYV>(lds, 1, kt + 1, qf, f, o, S, negm, lane);
                if (kt + 2 < kt1) sg0.store(lds, 0, tid);
                __syncthreads();
            }
        }
    } else {
        __syncthreads();
        for (int kt = kt0; kt < kt1; ++kt) {
            const int buf = (kt - kt0) & 1;
            if (kt + 1 < kt1) { sg0.load(kv, kt + 1, tid); f.pre(kt + 1); }
            if (!f.skip(kt)) attn_tile<DQK, DV, F, EARLYV>(lds, buf, kt, qf, f, o, S, negm, lane);
            if (kt + 1 < kt1) sg0.store(lds, buf ^ 1, tid);
            __syncthreads();
        }
    }
}
__device__ __forceinline__ void build_bias_tables(LAS unsigned char* lds, const float* tab, int tid) {
    LAS float* BT = (LAS float*)(lds + AT_BT);
    for (int i = tid; i < 20 * 129; i += NWAVES * 64) { const int h = i / 129, d = i % 129;
        int b = d; if (d >= 16) { b = 16 + (int)(__log2f((float)d * 0.0625f) * (16.0f / 3.0f)); b = b > 31 ? 31 : b; }
        BT[h * BT_STRIDE + d] = (tab[b * 20 + h] - tab[31 * 20 + h]) * LOG2E; }
}
__device__ __forceinline__ void swap_pair(v2u& a, v2u& b) {
    { auto r = __builtin_amdgcn_permlane32_swap(a.x, b.x, false, false); a.x = r[0]; b.x = r[1]; }
    { auto r = __builtin_amdgcn_permlane32_swap(a.y, b.y, false, false); a.y = r[0]; b.y = r[1]; }
}
template <int DV> __device__ __forceinline__ void store_ot(bf16* orow, const f32x16 (&o)[DV / 32], float scale, int lane) {
    const int hi = lane >> 5;
    bf16* dst = orow + 8 * hi;
#pragma unroll
    for (int dt = 0; dt < DV / 32; ++dt)
#pragma unroll
        for (int r4 = 0; r4 < 4; r4 += 2) {
            v2u a, b;
            a.x = cvtpk(o[dt][4 * r4 + 0] * scale, o[dt][4 * r4 + 1] * scale); a.y = cvtpk(o[dt][4 * r4 + 2] * scale, o[dt][4 * r4 + 3] * scale);
            b.x = cvtpk(o[dt][4 * r4 + 4] * scale, o[dt][4 * r4 + 5] * scale); b.y = cvtpk(o[dt][4 * r4 + 6] * scale, o[dt][4 * r4 + 7] * scale);
            swap_pair(a, b);
            *(GAS v4u*)(dst + 32 * dt + 8 * r4) = (v4u){a.x, a.y, b.x, b.y}; }
}
template <int DQK> __device__ __forceinline__ void load_q(const bf16* qrow, bf16x8 (&qf)[DQK / 16], int lane) {
    const int hi = lane >> 5;
#pragma unroll
    for (int d0 = 0; d0 < DQK / 16; ++d0) qf[d0] = *(const GAS bf16x8*)(qrow + 16 * d0 + 8 * hi);
}
__device__ __forceinline__ bf16x8 scale_frag(bf16x8 a, float sc) {
    v4u w;
    w.x = cvtpk(bf2f((unsigned short)a[0]) * sc, bf2f((unsigned short)a[1]) * sc); w.y = cvtpk(bf2f((unsigned short)a[2]) * sc, bf2f((unsigned short)a[3]) * sc);
    w.z = cvtpk(bf2f((unsigned short)a[4]) * sc, bf2f((unsigned short)a[5]) * sc); w.w = cvtpk(bf2f((unsigned short)a[6]) * sc, bf2f((unsigned short)a[7]) * sc);
    return __builtin_bit_cast(bf16x8, w);
}
template <int DQK> __device__ __forceinline__ void load_q_scaled(const bf16* qrow, bf16x8 (&qf)[DQK / 16], float sc, int lane) {
    load_q<DQK>(qrow, qf, lane);
#pragma unroll
    for (int d0 = 0; d0 < DQK / 16; ++d0) qf[d0] = scale_frag(qf[d0], sc);
}

struct FPlain { __device__ __forceinline__ void pre(int) {} __device__ __forceinline__ bool skip(int) const { return false; }
    __device__ __forceinline__ void apply(f32x16 (&)[2], int) {} };
__device__ __forceinline__ void xattn_unit(LAS unsigned char* lds, const bf16* XQ, const bf16* KVM, bf16* O, int b, int h, int qt, int tid_in, int lane_in, int wave) {
    int lane = lane_in; asm volatile("" : "+v"(lane)); const int tid = wave * 64 + lane; (void)tid_in;
    const int t = qt * 256 + wave * 32 + (lane & 31);
    bf16x8 qf[8]; load_q_scaled<128>(XQ + (size_t)(b * SEQ + t) * 512 + h * 128, qf, 0.08838834764831845f * LOG2E, lane);
    KVSrc kv{KVM + (size_t)(b * MEML) * DM + h * 128, DM, nullptr, 0, KVM + (size_t)(b * MEML) * DM + 512 + h * 128, DM};
    f32x16 o[4] = {}; SmState S{0.f, 0.f, false};
    FPlain f;
    attn_loop<128, 128, 128, FPlain>(lds, kv, 0, MEML / 64, qf, f, o, S, tid, lane);
    const float lt = swapsum(S.l);
    store_ot<128>(O + (size_t)(b * SEQ + t) * 512 + h * 128, o, lt > 0.f ? 1.f / lt : 0.f, lane);
}


constexpr int C_QA = 0, C_KVA = 512, C_GA = 1280, C_QB = 1304, C_KB = 1816, C_VB = 1880, C_IQ = 1944, C_IK = 2200, C_IW = 2232;
constexpr size_t WS_CWT = 91 * MiB;
constexpr size_t WS_CBIAS = 91 * MiB + 512 * 1024;
constexpr size_t WS_P0 = WS_OV, WS_KCMP = WS_OV + 288 * MiB, WS_VCMP = WS_OV + 289 * MiB, WS_SEL = WS_OV + 330 * MiB;
static_assert(WS_SEL + 32 * MiB <= WS_END, "even overlay");

__device__ __forceinline__ void nsa_compress_item(const bf16* P0, const bf16* CWT, const float* CBIAS, bf16* KCMP, bf16* VCMP, int item, int lane) {
    const int nt = item & 7, g = (item >> 3) & 1, b = (item >> 4) & 15, c = item >> 8;
    const int r32 = lane & 31, hi = lane >> 5, n = nt * 32 + r32, nc = n > 254 ? 254 : n;
    const bf16* ap = P0 + (size_t)(b * SEQ + 16 * nc) * EV_INP + C_KVA + c * 128 + g * 64 + 8 * hi;
    const bf16* bp = CWT + (size_t)(c * 64 + r32) * 2048 + 8 * hi;
    f32x16 acc[2] = {};
#pragma unroll 4
    for (int kk = 0; kk < 128; ++kk) {
        const bf16x8 a = *(const GAS bf16x8*)(ap + (size_t)(kk >> 2) * EV_INP + (kk & 3) * 16);
        const bf16x8 b0 = *(const GAS bf16x8*)(bp + kk * 16), b1 = *(const GAS bf16x8*)(bp + 32 * 2048 + kk * 16);
        acc[0] = __builtin_amdgcn_mfma_f32_32x32x16_bf16(a, b0, acc[0], 0, 0, 0);
        acc[1] = __builtin_amdgcn_mfma_f32_32x32x16_bf16(a, b1, acc[1], 0, 0, 0);
    }
#pragma unroll
    for (int eh = 0; eh < 2; ++eh) { const int e = 32 * eh + r32; const float bias = CBIAS[c * 64 + e];
        bf16* dst = c == 0 ? KCMP : VCMP;
#pragma unroll
        for (int r = 0; r < 16; ++r) { const int nn = nt * 32 + crow(r, hi); dst[((size_t)(b * 2 + g) * 256 + nn) * 64 + e] = (bf16)(nn > 254 ? 0u : f2bf(acc[eh][r] + bias)); }
    }
}

__device__ __forceinline__ void nsa_compress_pair(LAS unsigned char* lds, const bf16* P0, const bf16* CWT, const float* CBIAS, bf16* KCMP, bf16* VCMP, int it0, int wave, int lane) {
    const int item = it0 + (wave >> 2), ks = wave & 3; const bool live = item < 512;
    const int nt = item & 7, g = (item >> 3) & 1, b = (item >> 4) & 15, c = (item >> 8) & 1;
    const int r32 = lane & 31, hi = lane >> 5, n = nt * 32 + r32, nc = n > 254 ? 254 : n;
    const bf16* ap = P0 + (size_t)(b * SEQ + 16 * nc) * EV_INP + C_KVA + c * 128 + g * 64 + 8 * hi;
    const bf16* bp = CWT + (size_t)(c * 64 + r32) * 2048 + 8 * hi;
    f32x16 acc[2] = {};
    if (live) {
#pragma unroll 8
        for (int kk = 32 * ks; kk < 32 * ks + 32; ++kk) {
            const bf16x8 a = *(const GAS bf16x8*)(ap + (size_t)(kk >> 2) * EV_INP + (kk & 3) * 16);
            const bf16x8 b0 = *(const GAS bf16x8*)(bp + kk * 16), b1 = *(const GAS bf16x8*)(bp + 32 * 2048 + kk * 16);
            acc[0] = __builtin_amdgcn_mfma_f32_32x32x16_bf16(a, b0, acc[0], 0, 0, 0);
            acc[1] = __builtin_amdgcn_mfma_f32_32x32x16_bf16(a, b1, acc[1], 0, 0, 0);
        }
    }
    LAS float* red = (LAS float*)lds + (wave >> 2) * 3 * 2048 + lane;
    if (ks) {
#pragma unroll
        for (int eh = 0; eh < 2; ++eh)
#pragma unroll
            for (int r = 0; r < 16; ++r) red[(ks - 1) * 2048 + (eh * 16 + r) * 64] = acc[eh][r];
    }
    __syncthreads();
    if (!ks && live) {
#pragma unroll
        for (int j = 0; j < 3; ++j)
#pragma unroll
            for (int eh = 0; eh < 2; ++eh)
#pragma unroll
                for (int r = 0; r < 16; ++r) acc[eh][r] += red[j * 2048 + (eh * 16 + r) * 64];
#pragma unroll
        for (int eh = 0; eh < 2; ++eh) { const int e = 32 * eh + r32; const float bias = CBIAS[c * 64 + e];
            bf16* dst = c == 0 ? KCMP : VCMP;
#pragma unroll
            for (int r = 0; r < 16; ++r) { const int nn = nt * 32 + crow(r, hi); dst[((size_t)(b * 2 + g) * 256 + nn) * 64 + e] = (bf16)(nn > 254 ? 0u : f2bf(acc[eh][r] + bias)); }
        }
    }
    __syncthreads();
}

constexpr int IX_MASK = 0, IX_RED = 8192, IX_CNT = IX_RED + 1024, IX_NC = IX_CNT + 1024, IX_CAND = IX_NC + 64, IX_THR = IX_CAND + 8192, IX_LIST = IX_THR + 128;
__device__ __forceinline__ unsigned f2ord(float f) { const unsigned b = __float_as_uint(f); return b ^ ((unsigned)((int)b >> 31) | 0x80000000u); }
__device__ __forceinline__ float ord2f(unsigned u) { return __uint_as_float(u ^ ((u >> 31) ? 0x80000000u : 0xffffffffu)); }
__device__ __forceinline__ void dsa_index_unit(LAS unsigned char* lds, const bf16* P0, unsigned short* SEL, int b, int qt, int tid_in, int lane_in, int wave) {
    int lane = lane_in; asm volatile("" : "+v"(lane)); const int tid = wave * 64 + lane; (void)tid_in;
    const int q = lane & 15, g4 = lane >> 4, t0 = 16 * qt, t = t0 + q, nkt = qt + 1;
    const int ni = nkt > wave ? (nkt - wave + 7) >> 3 : 0, nc4 = (ni + 3) >> 2;
    const bf16* base = P0 + (size_t)(b * SEQ) * EV_INP;
    bf16x8 bq[8]; float w[8];
#pragma unroll
    for (int h = 0; h < 8; ++h) { bq[h] = *(const GAS bf16x8*)(base + (size_t)t * EV_INP + C_IQ + h * 32 + 8 * g4); w[h] = bf2f(base[(size_t)t * EV_INP + C_IW + h]); }
    typedef float f32x4v __attribute__((ext_vector_type(4)));
    const bf16* kbase = base + (size_t)(16 * wave + q) * EV_INP + C_IK + 8 * g4;
    float sc[32][4];
    const float NINF = -__builtin_inff();
#pragma unroll
    for (int g = 0; g < 8; ++g) {
        if (32 * g + wave < nkt) {
            bf16x8 ab[4];
#pragma unroll
            for (int j = 0; j < 4; ++j) if (8 * (4 * g + j) + wave < nkt) { const bf16* kp = kbase; asm volatile("" : "+v"(kp));
                ab[j] = *(const GAS bf16x8*)(kp + (size_t)(4 * g + j) * (128 * EV_INP)); }
            asm volatile("s_waitcnt vmcnt(0)" ::: "memory");
#pragma unroll
            for (int j = 0; j < 4; ++j) {
                const int i = 4 * g + j, kt = 8 * i + wave;
                if (kt < nkt) {
                    const bf16x8 a = ab[j];
                    float a4[4] = {0.f, 0.f, 0.f, 0.f};
#pragma unroll
                    for (int h = 0; h < 8; ++h) { const f32x4v c = __builtin_amdgcn_mfma_f32_16x16x32_bf16(a, bq[h], (f32x4v){0.f, 0.f, 0.f, 0.f}, 0, 0, 0);
#pragma unroll
                        for (int r = 0; r < 4; ++r) a4[r] += w[h] * fmx(c[r], 0.f); }
#pragma unroll
                    for (int r = 0; r < 4; ++r) sc[i][r] = (kt < qt || 4 * g4 + r <= q) ? a4[r] : NINF;
                } else {
#pragma unroll
                    for (int r = 0; r < 4; ++r) sc[i][r] = NINF;
                }
            }
        } else {
#pragma unroll
            for (int j = 0; j < 4; ++j)
#pragma unroll
                for (int r = 0; r < 4; ++r) sc[4 * g + j][r] = NINF;
        }
    }
    LAS float* RED = (LAS float*)(lds + IX_RED); LAS unsigned* CNT = (LAS unsigned*)(lds + IX_CNT); LAS unsigned* MK = (LAS unsigned*)(lds + IX_MASK);
    LAS unsigned* NC = (LAS unsigned*)(lds + IX_NC); LAS unsigned long long* CAND = (LAS unsigned long long*)(lds + IX_CAND); LAS unsigned long long* THR = (LAS unsigned long long*)(lds + IX_THR);
    float lmax = NINF, lmin = __builtin_inff();
#pragma unroll
    for (int c = 0; c < 8; ++c) if (c < nc4) {
#pragma unroll
        for (int j = 0; j < 4; ++j)
#pragma unroll
            for (int r = 0; r < 4; ++r) { const float v = sc[4 * c + j][r]; lmax = fmx(lmax, v); lmin = fmn(lmin, v == NINF ? __builtin_inff() : v); }
    }
    lmax = fmx(lmax, lx_f<16>(lmax)); lmax = fmx(lmax, lx_f<32>(lmax));
    lmin = fmn(lmin, lx_f<16>(lmin)); lmin = fmn(lmin, lx_f<32>(lmin));
    __syncthreads();
    if (g4 == 0) { RED[wave * 16 + q] = lmax; RED[128 + wave * 16 + q] = lmin; }
    for (int i = tid; i < 2048; i += NWAVES * 64) MK[i] = 0u;
    if (tid < 16) NC[tid] = 0u;
    __syncthreads();
    float hiv = NINF, lov = __builtin_inff();
#pragma unroll
    for (int wv = 0; wv < 8; ++wv) { hiv = fmx(hiv, RED[wv * 16 + q]); lov = fmn(lov, RED[128 + wv * 16 + q]); }
    lov = lov - fabsf(lov) * 1e-3f - 1e-6f;
    unsigned clo = (unsigned)(t + 1), chi = 0u;
    bool done = (t + 1 <= 256), fine = false; float thr = NINF; unsigned thk = 0u;
    for (int it = 0; it < 64; ++it) {
        const float mid = 0.5f * (lov + hiv);
        unsigned cnt = 0;
#pragma unroll
        for (int c = 0; c < 8; ++c) if (c < nc4) {
#pragma unroll
            for (int j = 0; j < 4; ++j)
#pragma unroll
                for (int r = 0; r < 4; ++r) cnt += (sc[4 * c + j][r] > mid) ? 1u : 0u;
        }
        cnt += lx_u<16>(cnt); cnt += lx_u<32>(cnt);
        LAS unsigned* cb = CNT + (it & 1) * 128;
        if (g4 == 0) cb[wave * 16 + q] = cnt;
        __syncthreads();
        unsigned tot = 0;
#pragma unroll
        for (int wv = 0; wv < 8; ++wv) tot += cb[wv * 16 + q];
        if (!done && !fine) {
            if (tot == 256u) { thr = mid; done = true; }
            else if (!(mid > lov && mid < hiv)) { thr = lov; done = true; }
            else { if (tot > 256u) { lov = mid; clo = tot; } else { hiv = mid; chi = tot; }
                   if (clo - chi <= 64u) fine = true; }
        }
        if (__all(done || fine)) break;
    }
    const unsigned kinv0 = (unsigned)(4095 - (16 * wave + 4 * g4));
    if (fine) {
#pragma unroll
        for (int c = 0; c < 8; ++c) if (c < nc4) {
#pragma unroll
            for (int j = 0; j < 4; ++j)
#pragma unroll
                for (int r = 0; r < 4; ++r) { const float v = sc[4 * c + j][r];
                    if (v > lov && v <= hiv) { const unsigned pos = __hip_atomic_fetch_add(NC + q, 1u, __ATOMIC_RELAXED, __HIP_MEMORY_SCOPE_WORKGROUP);
                        if (pos < 64u) CAND[q * 64 + pos] = ((unsigned long long)f2ord(v) << 32) | (kinv0 - (unsigned)(128 * (4 * c + j) + r)); } }
        }
    }
    __syncthreads();
#pragma unroll 1
    for (int k = 0; k < 2; ++k) {
        const int qq = 2 * wave + k;
        const int fq = __builtin_amdgcn_readlane((int)fine, qq), need = __builtin_amdgcn_readlane((int)(256u - chi), qq);
        if (fq) {
            const unsigned n = NC[qq]; const unsigned long long comp = (unsigned)lane < n ? CAND[qq * 64 + lane] : 0ull;
            const unsigned c_lo = (unsigned)comp, c_hi = (unsigned)(comp >> 32);
            int rank = 0;
#pragma unroll
            for (int jj = 0; jj < 64; ++jj) { const unsigned long long c2 = ((unsigned long long)(unsigned)__builtin_amdgcn_readlane((int)c_hi, jj) << 32) | (unsigned)__builtin_amdgcn_readlane((int)c_lo, jj); rank += (c2 > comp) ? 1 : 0; }
            if (rank == need - 1) THR[qq] = comp;
        }
    }
    __syncthreads();
    if (fine) { const unsigned long long t64 = THR[q]; thr = ord2f((unsigned)(t64 >> 32)); thk = (unsigned)t64; }
    LAS unsigned* mkw = MK + q * 128 + (wave >> 1); const int mksh = 16 * (wave & 1) + 4 * g4;
#pragma unroll
    for (int c = 0; c < 8; ++c) if (c < nc4) {
#pragma unroll
        for (int j = 0; j < 4; ++j) { const int i = 4 * c + j;
            unsigned nib = 0;
#pragma unroll
            for (int r = 0; r < 4; ++r) { const float v = sc[i][r]; nib |= (v > thr || (fine && v == thr && kinv0 - (unsigned)(128 * i + r) >= thk)) ? (1u << r) : 0u; }
            if (nib) __hip_atomic_fetch_or(mkw + 4 * i, nib << mksh, __ATOMIC_RELAXED, __HIP_MEMORY_SCOPE_WORKGROUP); }
    }
    __syncthreads();
    LAS unsigned short* LST = (LAS unsigned short*)(lds + IX_LIST);
#pragma unroll 1
    for (int k = 0; k < 2; ++k) {
        const int qq = 2 * wave + k;
        unsigned long long wd = *(const LAS unsigned long long*)(lds + IX_MASK + (qq * 64 + lane) * 8);
        const int c = __popcll(wd); int incl = c;
#pragma unroll
        for (int d = 1; d < 64; d <<= 1) { const int n = __builtin_amdgcn_ds_bpermute((lane - d) << 2, incl); if (lane >= d) incl += n; }
        int pos = incl - c; const int total = __builtin_amdgcn_readlane(incl, 63);
        while (wd) { const int bbit = __builtin_ctzll(wd); if (pos < 256) LST[qq * 256 + pos] = (unsigned short)(64 * lane + bbit); ++pos; wd &= wd - 1; }
        for (int p = total + lane; p < 256; p += 64) LST[qq * 256 + p] = (unsigned short)0xffffu;
    }
    __syncthreads();
    { const v4u v = *(const LAS v4u*)(lds + IX_LIST + tid * 16);
      *(GAS v4u*)((unsigned char*)(SEL + (size_t)(b * SEQ + t0) * 256) + tid * 16) = v; }
}

struct FSel {
    unsigned long long selmask; int t, cur, hi; const LAS float* BT;
    __device__ __forceinline__ void pre(int) {}
    __device__ __forceinline__ bool skip(int kt) const { return !__any((int)((selmask >> kt) & 1ull)); }
    __device__ __forceinline__ void apply(f32x16 (&s)[2], int kt) {
        const bool on = (selmask >> kt) & 1ull;
        if (kt + 3 <= cur) {
            if (!__all((int)on)) {
#pragma unroll
                for (int st = 0; st < 2; ++st)
#pragma unroll
                    for (int r = 0; r < 16; ++r) s[st][r] = on ? s[st][r] : NEGBIG; }
        } else {
#pragma unroll
            for (int st = 0; st < 2; ++st)
#pragma unroll
                for (int r = 0; r < 16; ++r) { const int dist = t - (64 * kt + 32 * st + crow(r, hi)); const unsigned di = (unsigned)dist < 128u ? (unsigned)dist : 128u;
                    s[st][r] = (on && dist >= 0) ? s[st][r] + BT[di] : NEGBIG; }
        }
    }
};
struct FWin {
    int t, cur, hi; const LAS float* BT;
    __device__ __forceinline__ void pre(int) {}
    __device__ __forceinline__ bool skip(int) const { return false; }
    __device__ __forceinline__ void apply(f32x16 (&s)[2], int kt) {
        const int dk = cur - kt;
        if (!(dk >= 3 && dk <= 7)) {
#pragma unroll
            for (int st = 0; st < 2; ++st)
#pragma unroll
                for (int r = 0; r < 16; ++r) { const int dist = t - (64 * kt + 32 * st + crow(r, hi)); const unsigned di = (unsigned)dist < 128u ? (unsigned)dist : 128u;
                    s[st][r] = (dist >= 0 && dist < 512) ? s[st][r] + BT[di] : NEGBIG; }
        }
    }
};
__device__ __forceinline__ float sigmoidf_(float x) { return __builtin_amdgcn_rcpf(1.0f + __builtin_amdgcn_exp2f(-x * LOG2E)); }

__device__ __forceinline__ void nsa_unit(LAS unsigned char* lds, const bf16* P0, const bf16* KCMP, const bf16* VCMP, bf16* OC, int b, int g, int qt, int tid_in, int lane_in, int wave) {
    int lane = lane_in; asm volatile("" : "+v"(lane)); const int tid = wave * 64 + lane; (void)tid_in;
    const int r32 = lane & 31, hi = lane >> 5, qi = r32 >> 2, hh = r32 & 3, head = g * 4 + hh;
    const int t0 = qt * 64, t = t0 + wave * 8 + qi, cur = qt;
    const bf16* prow = P0 + (size_t)(b * SEQ + t) * EV_INP;
    bf16x8 qf[4]; load_q_scaled<64>(prow + C_QA + head * 64, qf, 0.125f * LOG2E, lane);
    const LAS float* BT = (const LAS float*)(lds + AT_BT) + head * BT_STRIDE;
    const float g0 = sigmoidf_(bf2f(prow[C_GA + g * 12 + hh * 3 + 0])), g1 = sigmoidf_(bf2f(prow[C_GA + g * 12 + hh * 3 + 1])), g2 = sigmoidf_(bf2f(prow[C_GA + g * 12 + hh * 3 + 2]));
    LAS float* impL = (LAS float*)(lds + AT_WS + wave * AT_WS_PER_WAVE);
    LAS unsigned long long* selL = (LAS unsigned long long*)(lds + AT_WS + wave * AT_WS_PER_WAVE + 2048);
    f32x16 oacc[2];
    {
        f32x16 o[2] = {}; float m = NEGBIG, l = 0.f, carry = 0.f;
        float imp[32];
#pragma unroll
        for (int i = 0; i < 32; ++i) imp[i] = 0.f;
        const int ncv = (t0 + 63 >= 31) ? ((t0 + 63 - 31) >> 4) + 1 : 0;
        const int nkt = ncv >= 256 ? 4 : (ncv + 63) >> 6;
        KVSrc kv{KCMP + (size_t)((b * 2 + g) * 256) * 64, 64, nullptr, 0, VCMP + (size_t)((b * 2 + g) * 256) * 64, 64};
        Stage<64, 64, 64> sg;
        __syncthreads();
        if (nkt > 0) { sg.load(kv, 0, tid); sg.store(lds, 0, tid); }
        __syncthreads();
#pragma unroll
        for (int kt = 0; kt < 4; ++kt) {
            if (kt < nkt) {
                const int buf = kt & 1;
                if (kt + 1 < nkt) sg.load(kv, kt + 1, tid);
                f32x16 s[2];
                qk_tile<64, 2>(lds + AT_KBUF + buf * KBUF_BYTES, qf, s, lane);
#pragma unroll
                for (int st = 0; st < 2; ++st)
#pragma unroll
                    for (int r = 0; r < 16; ++r) { const int dist = t - (16 * (64 * kt + 32 * st + crow(r, hi)) + 31); const unsigned di = (unsigned)dist < 128u ? (unsigned)dist : 128u;
                        s[st][r] = dist >= 0 ? s[st][r] + BT[di] : NEGBIG; }
                const float alpha = softmax_tile(s, m, l);
                o[0] = o[0] * alpha; o[1] = o[1] * alpha; carry *= alpha;
#pragma unroll
                for (int i = 0; i < kt * 8; ++i) imp[i] *= alpha;
                pv_tile<64>(lds + AT_VBUF + buf * VBUF_BYTES, s, o, lane);
                float G[2][4], ol[2][4];
#pragma unroll
                for (int st = 0; st < 2; ++st)
#pragma unroll
                    for (int q4 = 0; q4 < 4; ++q4) { G[st][q4] = (s[st][4 * q4] + s[st][4 * q4 + 1]) + (s[st][4 * q4 + 2] + s[st][4 * q4 + 3]); ol[st][q4] = swapget(s[st][4 * q4 + 3]); }
#pragma unroll
                for (int st = 0; st < 2; ++st)
#pragma unroll
                    for (int q4 = 0; q4 < 4; ++q4) { const float prev = q4 > 0 ? ol[st][q4 - 1] : (st == 1 ? ol[0][3] : carry);
                        imp[kt * 8 + st * 4 + q4] = G[st][q4] + (hi ? ol[st][q4] : prev); }
                carry = ol[1][3];
                if (kt + 1 < nkt) sg.store(lds, buf ^ 1, tid);
                __syncthreads();
            }
        }
        const float lt = swapsum(l), inv = lt > 0.f ? 1.f / lt : 0.f;
        oacc[0] = o[0] * (inv * g0); oacc[1] = o[1] * (inv * g0);
#pragma unroll
        for (int i = 0; i < 32; ++i) { float v = imp[i] * inv; v += lx_f<1>(v); v += lx_f<2>(v);
            if (hh == 0) impL[qi * 64 + 16 * (i >> 3) + 8 * ((i >> 2) & 1) + 2 * (i & 3) + hi] = v; }
    }
    LDS_WAIT(); asm volatile("" ::: "memory");
#pragma unroll 1
    for (int q2 = 0; q2 < 8; ++q2) {
        const int j = lane; const bool valid = j <= cur, forced = (j == 0) || (j == cur) || (j == cur - 1);
        const float val = impL[q2 * 64 + j] + (forced ? 1000.f : 0.f);
        const unsigned long long comp = ((unsigned long long)(valid ? __float_as_uint(val) + 1u : 0u) << 6) | (unsigned long long)(63 - j);
        const unsigned clo = (unsigned)comp, chi = (unsigned)(comp >> 32);
        int rank = 0;
#pragma unroll
        for (int jj = 0; jj < 64; ++jj) { const unsigned long long c2 = ((unsigned long long)(unsigned)__builtin_amdgcn_readlane((int)chi, jj) << 32) | (unsigned)__builtin_amdgcn_readlane((int)clo, jj); rank += (c2 > comp) ? 1 : 0; }
        const unsigned long long mk = __ballot(valid && rank < 16);
        if (lane == 0) selL[q2] = mk;
    }
    LDS_WAIT(); asm volatile("" ::: "memory");
    const unsigned long long selmask = selL[qi];
    {
        f32x16 o[2] = {}; SmState S{0.f, 0.f, false};
        KVSrc kv{P0 + (size_t)(b * SEQ) * EV_INP + C_KVA + 2 * 128 + g * 64, EV_INP, nullptr, 0, P0 + (size_t)(b * SEQ) * EV_INP + C_KVA + 3 * 128 + g * 64, EV_INP};
        FSel f{selmask, t, cur, hi, BT};
        int tid2 = tid; asm volatile("" : "+v"(tid2));
        attn_loop<64, 64, 64, FSel, false>(lds, kv, 0, cur + 1, qf, f, o, S, tid2, lane);
        const float lt = swapsum(S.l), inv = lt > 0.f ? 1.f / lt : 0.f;
        oacc[0] = oacc[0] + o[0] * (inv * g1); oacc[1] = oacc[1] + o[1] * (inv * g1);
    }
    {
        f32x16 o[2] = {}; SmState S{0.f, 0.f, false};
        KVSrc kv{P0 + (size_t)(b * SEQ) * EV_INP + C_KVA + 4 * 128 + g * 64, EV_INP, nullptr, 0, P0 + (size_t)(b * SEQ) * EV_INP + C_KVA + 5 * 128 + g * 64, EV_INP};
        FWin f{t, cur, hi, BT};
        int tid3 = tid; asm volatile("" : "+v"(tid3));
        attn_loop<64, 64, 64, FWin, false>(lds, kv, cur >= 8 ? cur - 8 : 0, cur + 1, qf, f, o, S, tid3, lane);
        const float lt = swapsum(S.l), inv = lt > 0.f ? 1.f / lt : 0.f;
        oacc[0] = oacc[0] + o[0] * (inv * g2); oacc[1] = oacc[1] + o[1] * (inv * g2);
    }
    store_ot<64>(OC + (size_t)(b * SEQ + t) * DM + head * 64, oacc, 1.f, lane);
}
constexpr int DG_VP = 192, DG_VT = 64 * DG_VP;
constexpr int DG_HI = AT_WS + 8 * AT_WS_PER_WAVE;
static_assert(6 * DG_VT <= AT_BT && DG_HI + 2 * DG_VT <= LDSCTL_OFF, "DSA gather LDS map");
__device__ __forceinline__ void dsa_unit(LAS unsigned char* lds, const bf16* P0, const unsigned short* SEL, bf16* OC, int b, int qt, int tid_in, int lane_in, int wave) {
    int lane = lane_in; asm volatile("" : "+v"(lane)); (void)tid_in;
    const int r32 = lane & 31, hi = lane >> 5, hh = r32 & 7;
    const LAS float* BT = (const LAS float*)(lds + AT_BT) + (8 + hh) * BT_STRIDE;
    LAS unsigned char* vt = lds + (wave < 6 ? wave * DG_VT : DG_HI + (wave - 6) * DG_VT);
    LAS unsigned short* lq = (LAS unsigned short*)(lds + AT_WS + wave * AT_WS_PER_WAVE);
    const bf16* kb = P0 + (size_t)(b * SEQ) * EV_INP + C_KB + 8 * hi;
    const bf16* vb = P0 + (size_t)(b * SEQ) * EV_INP + C_VB + 8 * (lane & 7);
#define DG_LOADK(LQ, J) do { _Pragma("unroll") for (int st = 0; st < 2; ++st) { unsigned ik = (LQ)[64 * (J) + 32 * st + r32]; ik = ik > 4095u ? 0u : ik; \
        _Pragma("unroll") for (int d0 = 0; d0 < 4; ++d0) kf[st][d0] = *(const GAS bf16x8*)(kb + (size_t)ik * EV_INP + 16 * d0); } } while (0)
#define DG_LOADV(LQ, J) do { _Pragma("unroll") for (int i = 0; i < 8; ++i) { unsigned iv = (LQ)[64 * (J) + 8 * i + (lane >> 3)]; iv = iv > 4095u ? 0u : iv; vr[i] = *(const GAS v4u*)(vb + (size_t)iv * EV_INP); } } while (0)
    bf16x8 kf[2][4]; v4u vr[8];
    { const int t = qt * 32 + wave * 4; *(LAS v2u*)(lq + 4 * lane) = *(const GAS v2u*)(SEL + (size_t)(b * SEQ + t) * 256 + 4 * lane); }
    DG_LOADK(lq, 0); DG_LOADV(lq, 0);
#pragma unroll 1
    for (int qi = 0; qi < 4; ++qi) {
        const int t = qt * 32 + wave * 4 + qi;
        LAS unsigned short* lqc = lq + 256 * (qi & 1); LAS unsigned short* lqn = lq + 256 * ((qi + 1) & 1);
        if (qi + 1 < 4) *(LAS v2u*)(lqn + 4 * lane) = *(const GAS v2u*)(SEL + (size_t)(b * SEQ + t + 1) * 256 + 4 * lane);
        bf16x8 qf[4]; load_q_scaled<64>(P0 + (size_t)(b * SEQ + t) * EV_INP + C_QB + hh * 64, qf, 0.125f * LOG2E, lane);
        f32x16 o[2] = {}; SmState S{0.f, 0.f, false};
#pragma unroll
        for (int j = 0; j < 4; ++j) {
#pragma unroll
            for (int i = 0; i < 8; ++i) { LAS unsigned char* d = vt + (8 * i + (lane >> 3)) * DG_VP + (lane & 7) * 16; *(LAS v2u*)d = (v2u){vr[i].x, vr[i].y}; *(LAS v2u*)(d + 8) = (v2u){vr[i].z, vr[i].w}; }
            if (j < 3) DG_LOADV(lqc, j + 1); else if (qi + 1 < 4) DG_LOADV(lqn, 0);
            f32x16 s[2];
#pragma unroll
            for (int r = 0; r < 16; ++r) { s[0][r] = -S.mhat; s[1][r] = -S.mhat; }
#pragma unroll
            for (int d0 = 0; d0 < 4; ++d0)
#pragma unroll
                for (int st = 0; st < 2; ++st) s[st] = __builtin_amdgcn_mfma_f32_32x32x16_bf16(kf[st][d0], qf[d0], s[st], 0, 0, 0);
            if (j < 3) DG_LOADK(lqc, j + 1); else if (qi + 1 < 4) DG_LOADK(lqn, 0);
            const int lastix = lqc[64 * j + 63];
            if ((j >= 2 || t < 255) && !(lastix != 0xffff && t - lastix >= 113)) {
#pragma unroll
                for (int st = 0; st < 2; ++st)
#pragma unroll
                    for (int r = 0; r < 16; ++r) { const int ix = lqc[64 * j + 32 * st + crow(r, hi)]; const int dist = t - ix; const unsigned di = (unsigned)dist < 128u ? (unsigned)dist : 128u;
                        s[st][r] = dist >= 0 ? s[st][r] + BT[di] : NEGBIG; }
            }
            float mx = NEGBIG;
#pragma unroll
            for (int r = 0; r < 16; ++r) mx = fmx3(mx, s[0][r], s[1][r]);
            mx = swapmax(mx);
            const bool need = S.started ? (mx > DEFER_THR) : (mx > -1e29f);
            if (__any(need)) {
                const float delta = need ? mx : 0.f, fac = (need && S.started) ? __builtin_amdgcn_exp2f(-delta) : 1.f;
                S.mhat += delta; S.l *= fac; S.started = S.started || need;
#pragma unroll
                for (int st = 0; st < 2; ++st)
#pragma unroll
                    for (int r = 0; r < 16; ++r) s[st][r] -= delta;
                o[0] = o[0] * fac; o[1] = o[1] * fac;
            }
#pragma unroll
            for (int st = 0; st < 2; ++st)
#pragma unroll
                for (int r = 0; r < 16; ++r) s[st][r] = __builtin_amdgcn_exp2f(s[st][r]);
            S.l += vsum32(s);
            bf16x8 pf[4]; p_pack(s, pf);
            VFrag vfr; pv_load<DG_VP>(vt, 0, vfr, lane);
            pv_mma(vfr, pf, o[0], o[1]);
        }
        const float lt = swapsum(S.l);
        if (r32 < 8) store_ot<64>(OC + (size_t)(b * SEQ + t) * DM + 512 + hh * 64, o, lt > 0.f ? 1.f / lt : 0.f, lane);
    }
#undef DG_LOADK
#undef DG_LOADV
}


constexpr int D_CQ = 0, D_CKV = 256, D_KR = 384, D_QD = 416, D_KD = 928, D_VD = 1440;
constexpr size_t WS_ROPE = 91 * MiB + 640 * 1024;
constexpr size_t WS_P1 = WS_OV, WS_CQN = WS_OV + 256 * MiB, WS_CKVN = WS_OV + 288 * MiB, WS_KR = WS_OV + 320 * MiB;
constexpr size_t WS_QMLA = WS_Y, WS_KVMLA = WS_Y + 96 * MiB;
static_assert(WS_KR + 4 * MiB <= WS_END && WS_KVMLA + 128 * MiB <= WS_OV, "odd overlay");
constexpr float LAM_INIT = 0.35550906759097f;

__device__ __forceinline__ void rope_table_phase(float* ROPE, int gt, int NGT) {
    for (int idx = gt; idx < SEQ * 16; idx += NGT) { const int t = idx >> 4, i = idx & 15;
        const float inv = exp2f(-(float)i * (13.287712379549449f / 16.0f));
        const double rev = (double)((float)t * inv) * 0.15915494309189535;
        const float fr = (float)(rev - __builtin_floor(rev));
        ROPE[2 * idx] = __builtin_amdgcn_cosf(fr); ROPE[2 * idx + 1] = __builtin_amdgcn_sinf(fr); }
}
__device__ __forceinline__ void odd_prep_rows(const bf16* P1, const float* qn, const float* kvn, const float* ROPE, bf16* CQN, bf16* CKVN, bf16* KR, int gw, int NGW, int lane) {
    float gq[4], gk[2];
#pragma unroll
    for (int j = 0; j < 4; ++j) gq[j] = qn[4 * lane + j];
    gk[0] = kvn[2 * lane]; gk[1] = kvn[2 * lane + 1];
    for (int m = gw; m < MTOK; m += NGW) {
        const bf16* row = P1 + (size_t)m * OD_INP;
        const v2u cq = *(const GAS v2u*)(row + D_CQ + 4 * lane); const unsigned ck = *(const GAS unsigned*)(row + D_CKV + 2 * lane);
        float x[4] = {bf2f((unsigned short)(cq.x & 0xffff)), bf2f((unsigned short)(cq.x >> 16)), bf2f((unsigned short)(cq.y & 0xffff)), bf2f((unsigned short)(cq.y >> 16))};
        float y[2] = {bf2f((unsigned short)(ck & 0xffff)), bf2f((unsigned short)(ck >> 16))};
        const float r1 = __builtin_amdgcn_rsqf(wave_sum((x[0] * x[0] + x[1] * x[1]) + (x[2] * x[2] + x[3] * x[3])) * (1.f / 256.f) + RMS_EPS);
        const float r2 = __builtin_amdgcn_rsqf(wave_sum(y[0] * y[0] + y[1] * y[1]) * (1.f / 128.f) + RMS_EPS);
        v2u o; o.x = pk2(x[0] * r1 * gq[0], x[1] * r1 * gq[1]); o.y = pk2(x[2] * r1 * gq[2], x[3] * r1 * gq[3]);
        *(GAS v2u*)(CQN + (size_t)m * 256 + 4 * lane) = o;
        *(GAS unsigned*)(CKVN + (size_t)m * 256 + 2 * lane) = pk2(y[0] * r2 * gk[0], y[1] * r2 * gk[1]);
        *(GAS unsigned*)(CKVN + (size_t)m * 256 + 128 + 2 * lane) = 0u;
        if (lane < 16) { const int t = m & (SEQ - 1); const float c = ROPE[(t * 16 + lane) * 2], s = ROPE[(t * 16 + lane) * 2 + 1];
            const float x1 = bf2f(row[D_KR + lane]), x2 = bf2f(row[D_KR + 16 + lane]);
            KR[(size_t)m * 32 + lane] = (bf16)f2bf(x1 * c - x2 * s); KR[(size_t)m * 32 + 16 + lane] = (bf16)f2bf(x1 * s + x2 * c); }
    }
}
template <bool BIAS> struct FCausal {
    int t, tmin, tmax, hi; const LAS float* BT;
    __device__ __forceinline__ void pre(int) {}
    __device__ __forceinline__ bool skip(int kt) const { return 64 * kt > tmax; }
    __device__ __forceinline__ void apply(f32x16 (&s)[2], int kt) {
        if (!(64 * kt + 63 <= tmin && (!BIAS || tmin - (64 * kt + 63) >= 113))) {
#pragma unroll
            for (int st = 0; st < 2; ++st)
#pragma unroll
                for (int r = 0; r < 16; ++r) { const int dist = t - (64 * kt + 32 * st + crow(r, hi)); const unsigned di = (unsigned)dist < 128u ? (unsigned)dist : 128u;
                    s[st][r] = dist >= 0 ? s[st][r] + (BIAS ? BT[di] : 0.f) : NEGBIG; }
        }
    }
};
__device__ __forceinline__ void mla_unit(LAS unsigned char* lds, const bf16* QM, const bf16* KVM_, const bf16* KR, const float* ROPE, bf16* OC, int b, int h, int qt, int tid_in, int lane_in, int wave) {
    int lane = lane_in; asm volatile("" : "+v"(lane)); const int tid = wave * 64 + lane; (void)tid_in;
    const int r32 = lane & 31, hi = lane >> 5, t = qt * 256 + wave * 32 + r32;
    bf16x8 qf[6]; load_q<96>(QM + (size_t)(b * SEQ + t) * 768 + h * 96, qf, lane);
    {
        const float* rp = ROPE + (size_t)(t * 16 + 8 * hi) * 2;
        bf16x8 a = qf[4], c = qf[5];
#pragma unroll
        for (int j = 0; j < 8; ++j) { const float cs = rp[2 * j], sn = rp[2 * j + 1], x1 = bf2f((unsigned short)a[j]), x2 = bf2f((unsigned short)c[j]);
            a[j] = (short)f2bf(x1 * cs - x2 * sn); c[j] = (short)f2bf(x1 * sn + x2 * cs); }
        qf[4] = a; qf[5] = c;
    }
#pragma unroll
    for (int d0 = 0; d0 < 6; ++d0) qf[d0] = scale_frag(qf[d0], 0.10206207261596577f * LOG2E);
    KVSrc kv{KVM_ + (size_t)(b * SEQ) * 1024 + h * 128, 1024, KR + (size_t)(b * SEQ) * 32, 32, KVM_ + (size_t)(b * SEQ) * 1024 + h * 128 + 64, 1024};
    f32x16 o[2] = {}; SmState S{0.f, 0.f, false};
    FCausal<false> f{t, qt * 256 + wave * 32, qt * 256 + wave * 32 + 31, hi, nullptr};
    attn_loop<96, 64, 64, FCausal<false>, false, true>(lds, kv, 0, 4 * qt + 4, qf, f, o, S, tid, lane);
    const float lt = swapsum(S.l);
    store_ot<64>(OC + (size_t)(b * SEQ + t) * DM + h * 64, o, lt > 0.f ? 1.f / lt : 0.f, lane);
}
__device__ __forceinline__ void diff_unit(LAS unsigned char* lds, const bf16* P1, const float* lam, const float* subln, bf16* OC, int b, int h, int qt, int tid_in, int lane_in, int wave) {
    int lane = lane_in; asm volatile("" : "+v"(lane)); const int tid = wave * 64 + lane; (void)tid_in;
    const int r32 = lane & 31, hi = lane >> 5, t = qt * 256 + wave * 32 + r32;
    const LAS float* BT = (const LAS float*)(lds + AT_BT) + (16 + h) * BT_STRIDE;
    float d01 = 0.f, d23 = 0.f;
    { d01 = lam[lane] * lam[64 + lane]; d23 = lam[128 + lane] * lam[192 + lane]; d01 = wave_sum(d01); d23 = wave_sum(d23); }
    const float lam_full = __expf(d01) - __expf(d23) + LAM_INIT;
    unsigned o0p[32];
    f32x16 o[4];
#pragma unroll 1
    for (int e = 0; e < 2; ++e) {
        bf16x8 qf[4]; load_q_scaled<64>(P1 + (size_t)(b * SEQ + t) * OD_INP + D_QD + (h * 2 + e) * 64, qf, 0.125f * LOG2E, lane);
        KVSrc kv{P1 + (size_t)(b * SEQ) * OD_INP + D_KD + (h * 2 + e) * 64, OD_INP, nullptr, 0, P1 + (size_t)(b * SEQ) * OD_INP + D_VD + h * 128, OD_INP};
#pragma unroll
        for (int dt = 0; dt < 4; ++dt) o[dt] = (f32x16){};
        SmState S{0.f, 0.f, false};
        FCausal<true> f{t, qt * 256 + wave * 32, qt * 256 + wave * 32 + 31, hi, BT};
        attn_loop<64, 64, 128, FCausal<true>>(lds, kv, 0, 4 * qt + 4, qf, f, o, S, tid, lane);
        const float lt = swapsum(S.l), inv = lt > 0.f ? 1.f / lt : 0.f;
        if (e == 0) {
#pragma unroll
            for (int dt = 0; dt < 4; ++dt)
#pragma unroll
                for (int k = 0; k < 8; ++k) o0p[dt * 8 + k] = cvtpk(o[dt][2 * k] * inv, o[dt][2 * k + 1] * inv);
        } else {
            float ss = 0.f;
#pragma unroll
            for (int dt = 0; dt < 4; ++dt)
#pragma unroll
                for (int k = 0; k < 8; ++k) { const unsigned w = o0p[dt * 8 + k];
                    const float a0 = __uint_as_float(w << 16) - lam_full * (o[dt][2 * k] * inv), a1 = __uint_as_float(w & 0xffff0000u) - lam_full * (o[dt][2 * k + 1] * inv);
                    o[dt][2 * k] = a0; o[dt][2 * k + 1] = a1; ss += a0 * a0 + a1 * a1; }
            ss = swapsum(ss);
            const float rn = __builtin_amdgcn_rsqf(ss * (1.f / 128.f) + RMS_EPS) * (1.0f - LAM_INIT);
            bf16* orow = OC + (size_t)(b * SEQ + t) * DM + 512 + h * 128;
#pragma unroll
            for (int dt = 0; dt < 4; ++dt)
#pragma unroll
                for (int r4 = 0; r4 < 4; r4 += 2) { const int d = 32 * dt + 8 * r4 + 4 * hi; const f32x4 gn = *(const GAS f32x4*)(subln + d), gm = *(const GAS f32x4*)(subln + d + 8);
                    v2u wa, wb; wa.x = cvtpk(o[dt][4 * r4 + 0] * rn * gn.x, o[dt][4 * r4 + 1] * rn * gn.y); wa.y = cvtpk(o[dt][4 * r4 + 2] * rn * gn.z, o[dt][4 * r4 + 3] * rn * gn.w);
                    wb.x = cvtpk(o[dt][4 * r4 + 4] * rn * gm.x, o[dt][4 * r4 + 5] * rn * gm.y); wb.y = cvtpk(o[dt][4 * r4 + 6] * rn * gm.z, o[dt][4 * r4 + 7] * rn * gm.w);
                    swap_pair(wa, wb);
                    *(GAS v4u*)(orow + 32 * dt + 8 * r4 + 8 * hi) = (v4u){wa.x, wa.y, wb.x, wb.y}; }
        }
    }
}


__device__ __forceinline__ void tr_item(const float* W, int N, bf16* WT, int ldk, int drow0, LAS float* scr, int k0, int n0, int lane, const float* grow = nullptr) {
#pragma unroll 8
    for (int i = 0; i < 32; ++i) { const int kk = 2 * i + (lane >> 5); float wv = W[(size_t)(k0 + kk) * N + n0 + (lane & 31)]; if (grow) wv *= grow[k0 + kk]; scr[kk * 33 + (lane & 31)] = wv; }
    LDS_WAIT(); asm volatile("" ::: "memory");
    const int c = lane & 7;
#pragma unroll
    for (int j = 0; j < 4; ++j) { const int n = (lane >> 3) + 8 * j; const LAS float* s = scr + (8 * c) * 33 + n;
        v4u o; o.x = pk2(s[0 * 33], s[1 * 33]); o.y = pk2(s[2 * 33], s[3 * 33]); o.z = pk2(s[4 * 33], s[5 * 33]); o.w = pk2(s[6 * 33], s[7 * 33]);
        *(GAS v4u*)(WT + (size_t)(drow0 + n) * ldk + k0 + 8 * c) = o; }
    LDS_WAIT(); asm volatile("" ::: "memory");
}
__device__ __forceinline__ void tr_item8(const float* W, int N, unsigned char* WT, int ldk, int drow0, LAS float* scr, int k0, int n0, int lane) {
#pragma unroll 8
    for (int i = 0; i < 32; ++i) { const int kk = 2 * i + (lane >> 5); scr[kk * 33 + (lane & 31)] = W[(size_t)(k0 + kk) * N + n0 + (lane & 31)]; }
    LDS_WAIT(); asm volatile("" ::: "memory");
    const int c = lane & 7;
#pragma unroll
    for (int j = 0; j < 4; ++j) { const int n = (lane >> 3) + 8 * j; const LAS float* s = scr + (8 * c) * 33 + n;
        v2u o; o.x = pg8::pk4_fp8(s[0 * 33], s[1 * 33], s[2 * 33], s[3 * 33], pg8::F8S_W); o.y = pg8::pk4_fp8(s[4 * 33], s[5 * 33], s[6 * 33], s[7 * 33], pg8::F8S_W);
        *(GAS v2u*)(WT + (size_t)(drow0 + n) * ldk + k0 + 8 * c) = o; }
    LDS_WAIT(); asm volatile("" ::: "memory");
}
constexpr size_t WS_XB = WS_OV + 370 * MiB;
constexpr size_t WS_RS = 1 * MiB;
constexpr int F8_FROM = 1;
__device__ __forceinline__ void rows_norm_phase(const float* xsrc, float* xdst, const bf16* Y, float w, const float* gpost, const float* gpre, bf16* H, int nrows, int gw, int NGW, int lane, bool f8 = false, float ysc = 1.f, const bf16* xsb = nullptr, bf16* xdb = nullptr, float* Rout = nullptr) {
    f32x4 gp[4], gq[4];
#pragma unroll
    for (int j = 0; j < 4; ++j) {
        gp[j] = Y ? ((const GAS f32x4*)gpost)[lane + 64 * j] * w : (f32x4){0.f, 0.f, 0.f, 0.f};
        gq[j] = gpre ? ((const GAS f32x4*)gpre)[lane + 64 * j] : (f32x4){0.f, 0.f, 0.f, 0.f};
    }
    for (int m = gw; m < nrows; m += NGW) {
        f32x4 x[4];
        if (xsb) {
            const GAS v2u* xr = (const GAS v2u*)(xsb + (size_t)m * DM) + lane;
#pragma unroll
            for (int j = 0; j < 4; ++j) { const v2u xv = xr[64 * j]; x[j] = (f32x4){__uint_as_float(xv.x << 16), __uint_as_float(xv.x & 0xffff0000u), __uint_as_float(xv.y << 16), __uint_as_float(xv.y & 0xffff0000u)}; }
        } else {
            const GAS f32x4* xr = (const GAS f32x4*)(xsrc + (size_t)m * DM) + lane;
#pragma unroll
            for (int j = 0; j < 4; ++j) x[j] = xr[64 * j];
        }
        if (Y) {
            const GAS v2u* yr = (const GAS v2u*)(Y + (size_t)m * DM) + lane;
            f32x4 y[4]; float s = 0.f;
#pragma unroll
            for (int j = 0; j < 4; ++j) { const v2u yv = yr[64 * j]; y[j] = (f32x4){__uint_as_float(yv.x << 16), __uint_as_float(yv.x & 0xffff0000u), __uint_as_float(yv.y << 16), __uint_as_float(yv.y & 0xffff0000u)} * ysc;
                s += (y[j].x * y[j].x + y[j].y * y[j].y) + (y[j].z * y[j].z + y[j].w * y[j].w); }
            const float rstd = __builtin_amdgcn_rsqf(wave_sum(s) * (1.f / DM) + RMS_EPS);
#pragma unroll
            for (int j = 0; j < 4; ++j) x[j] = x[j] + y[j] * rstd * gp[j];
        }
        if (xdst) {
            GAS f32x4* xo = (GAS f32x4*)(xdst + (size_t)m * DM) + lane;
#pragma unroll
            for (int j = 0; j < 4; ++j) xo[64 * j] = x[j];
        }
        if (xdb) {
            GAS v2u* xo = (GAS v2u*)(xdb + (size_t)m * DM) + lane;
#pragma unroll
            for (int j = 0; j < 4; ++j) { v2u o; o.x = pk2(x[j].x, x[j].y); o.y = pk2(x[j].z, x[j].w); xo[64 * j] = o; }
        }
        if (gpre || Rout) {
            float s2 = 0.f;
#pragma unroll
            for (int j = 0; j < 4; ++j) s2 += (x[j].x * x[j].x + x[j].y * x[j].y) + (x[j].z * x[j].z + x[j].w * x[j].w);
            const float r2 = __builtin_amdgcn_rsqf(wave_sum(s2) * (1.f / DM) + RMS_EPS);
            if (Rout && lane == 0) Rout[m] = r2;
            if (gpre) {
            if (f8) {
                GAS unsigned* ho = (GAS unsigned*)((unsigned char*)H + (size_t)m * DM) + lane;
#pragma unroll
                for (int j = 0; j < 4; ++j) { const f32x4 h = x[j] * r2 * gq[j]; ho[64 * j] = pg8::pk4_fp8(h.x, h.y, h.z, h.w, pg8::F8S_H); }
            } else {
            GAS v2u* ho = (GAS v2u*)(H + (size_t)m * DM) + lane;
#pragma unroll
            for (int j = 0; j < 4; ++j) { const f32x4 h = x[j] * r2 * gq[j]; v2u o; o.x = pk2(h.x, h.y); o.y = pk2(h.z, h.w); ho[64 * j] = o; }
            }
            }
        }
    }
}
__device__ __forceinline__ void transpose_cols_phase(const bf16* src, int ld, int col0, int ncols, int nb, int S, bf16* dst, LAS unsigned short* scr, int gw, int NGW, int lane, int gsz = 1 << 30, int gstride = 0) {
    const int nct = ncols / 64, nst = S / 64, nitems = nb * nct * nst;
    for (int it = gw; it < nitems; it += NGW) {
        const int st = it % nst, ct = (it / nst) % nct, b = it / (nst * nct);
        const bf16* sp = src + (size_t)(b * S + st * 64) * ld + col0 + ((ct * 64) / gsz) * gstride + (ct * 64) % gsz;
#pragma unroll
        for (int i = 0; i < 8; ++i) { const int r = i * 8 + (lane >> 3), c8 = (lane & 7) * 8;
            const v4u v = *(const GAS v4u*)(sp + (size_t)r * ld + c8);
            LAS unsigned* d = (LAS unsigned*)(scr + r * 66 + c8); d[0] = v.x; d[1] = v.y; d[2] = v.z; d[3] = v.w; }
        LDS_WAIT(); asm volatile("" ::: "memory");
        bf16* dp = dst + ((size_t)(b * ncols + ct * 64)) * S + st * 64;
#pragma unroll
        for (int i = 0; i < 8; ++i) { const int c = i * 8 + (lane >> 3), r8 = (lane & 7) * 8;
            unsigned short e[8];
#pragma unroll
            for (int k = 0; k < 8; ++k) e[k] = scr[(r8 + k) * 66 + c];
            v4u o; o.x = e[0] | ((unsigned)e[1] << 16); o.y = e[2] | ((unsigned)e[3] << 16); o.z = e[4] | ((unsigned)e[5] << 16); o.w = e[6] | ((unsigned)e[7] << 16);
            *(GAS v4u*)(dp + (size_t)c * S + r8) = o; }
        LDS_WAIT(); asm volatile("" ::: "memory");
    }
}

struct Args { const float* in[24]; float* out; unsigned char* ws; int ph_lo, ph_hi, stop, li; };
constexpr int PH_PRO = 0, PH_MEMKV = 1, PH_MEMVT = 2, PH_L0 = 3, PPL = 17, NPHASE = PH_L0 + 2 * PPL;

#define PHASE_IDS unsigned char* ws = args.ws; asm volatile("" : "+s"(ws)); int bx = bx0, vcu = vcu0; asm volatile("" : "+s"(bx), "+s"(vcu)); const int gw = vcu * NWAVES + wave, NGW = G * NWAVES; (void)gw; (void)NGW; (void)bx; int lane_l; asm volatile("v_mbcnt_lo_u32_b32 %0, -1, 0\n\tv_mbcnt_hi_u32_b32 %0, -1, %0" : "=v"(lane_l)); const int lane = lane_l, tid = wave * 64 + lane; bf16* const H = (bf16*)(ws + WS_H); bf16* const Y = (bf16*)(ws + WS_Y); bf16* const XB = (bf16*)(ws + WS_XB); float* const RS = (float*)(ws + WS_RS); (void)H; (void)Y; (void)XB; (void)RS; (void)tid;
#define IN(k) (lo <= (k) && (k) < hi && (k) < stop)
#define SEAM(k) do { if ((k) + 1 < hi && (k) + 1 < stop) { XcdBarrier b2 = bar; asm volatile("" : "+s"(b2.bar), "+s"(b2.x)); xcd_barrier(b2); } } while (0)
template <int L> __device__ __forceinline__ void layer_phases(const Args& args, LAS unsigned char* lds, const XcdBarrier& bar, int wave, int G, int bx0, int vcu0, int lo, int hi, int stop) {
    const float* x_in = args.in[0]; const float* norm_pre = args.in[3]; const float* norm_post = args.in[4]; float* xout = args.out;

        const int base = PH_L0 + L * PPL;
        const float* gpre = norm_pre + (size_t)L * 4 * DM; const float* gpost = norm_post + (size_t)L * 4 * DM;
        if (IN(base + 0)) {
            PHASE_IDS
            pg8::StaticOrder S; S.init(MTOK, 5632, G, bx);
            if constexpr (L * 2 + 0 >= F8_FROM) {
                pg8::Gemm g{H, (const bf16*)(ws + WS_WGU) + (size_t)(L * 2 + 0) * 5632 * DM, MTOK, 5632, DM};
                pg8::EpiSwiGLU8 E{ws + WS_HID, DFF};
                pg8::gemm_phase<pg8::EpiSwiGLU8, pg8::StaticOrder, true, true, true>(lds, g, S, E, tid);
            } else {
                pg8::Gemm g{XB, (const bf16*)(ws + WS_WGU) + (size_t)(L * 2 + 0) * 5632 * DM, MTOK, 5632, DM};
                pg8::EpiSwiGLUR E{(bf16*)(ws + WS_HID), DFF, RS};
                pg8::gemm_phase<pg8::EpiSwiGLUR, pg8::StaticOrder, true, true>(lds, g, S, E, tid);
            }
            SEAM(base + 0);
        }
        if (IN(base + 1)) {
            PHASE_IDS
            pg8::StaticOrder S; S.init(MTOK, DM, G, bx);
            pg8::EpiBf16P E{Y, DM};
            if constexpr (L * 2 + 0 >= F8_FROM) {
                pg8::Gemm g{(const bf16*)(ws + WS_HID), (const bf16*)(ws + WS_WD) + (size_t)(L * 2 + 0) * DM * DFF, MTOK, DM, DFF};
                pg8::gemm_phase<pg8::EpiBf16P, pg8::StaticOrder, true, true, true>(lds, g, S, E, tid);
            } else {
                pg8::Gemm g{(const bf16*)(ws + WS_HID), (const bf16*)(ws + WS_WD) + (size_t)(L * 2 + 0) * DM * DFF, MTOK, DM, DFF};
                pg8::gemm_phase<pg8::EpiBf16P, pg8::StaticOrder, true, true>(lds, g, S, E, tid);
            }
            SEAM(base + 1);
        }
        if (IN(base + 2)) {
            PHASE_IDS
            rows_norm_phase(nullptr, nullptr, Y, 0.5f, gpost, L == 0 ? nullptr : gpre + DM, H, MTOK, gw, NGW, lane, L == 1, L * 2 + 0 >= F8_FROM ? 1.f / (pg8::F8S_W * pg8::F8S_HID) : 1.f, XB, XB, L == 0 ? RS : nullptr);
            SEAM(base + 2);
        }
        if (L == 0 && IN(base + 3)) {
            PHASE_IDS
            pg8::Gemm g{XB, (const bf16*)(ws + WS_EVIN), MTOK, EV_INP, DM};
            pg8::StaticOrder S; S.init(MTOK, EV_INP, G, bx);
            pg8::EpiBf16PR E{(bf16*)(ws + WS_P0), EV_INP, RS};
            pg8::gemm_phase<pg8::EpiBf16PR, pg8::StaticOrder, true, true>(lds, g, S, E, tid);
            SEAM(base + 3);
        }
        if (L == 0 && IN(base + 4)) {
            PHASE_IDS
            if (args.li == 0) { PHASE_IDS
            const bf16* P0 = (const bf16*)(ws + WS_P0);
            for (int it0 = vcu * 2; it0 < 512; it0 += G * 2) nsa_compress_pair(lds, P0, (const bf16*)(ws + WS_CWT), (const float*)(ws + WS_CBIAS), (bf16*)(ws + WS_KCMP), (bf16*)(ws + WS_VCMP), it0, wave, lane);
            }
            __syncthreads();
            { PHASE_IDS
            const bf16* P0 = (const bf16*)(ws + WS_P0);
            for (int u = vcu, i = 0; u < NB * 256; u += G, ++i) {
                int b, qt;
                if (G == 256) { b = vcu >> 4; const int sub = vcu & 15; qt = (i & 1) ? 16 * i + 15 - sub : 16 * i + sub; } else { b = u & 15; qt = u >> 4; }
                dsa_index_unit(lds, P0, (unsigned short*)(ws + WS_SEL), b, qt, tid, lane, wave);
            } }
            SEAM(base + 4);
        }
        if (L == 0 && IN(base + 5)) {
            PHASE_IDS
            build_bias_tables(lds, args.in[2], tid);
            __syncthreads();
            { PHASE_IDS
            const bf16* P0 = (const bf16*)(ws + WS_P0);
            for (int u = vcu, i = 0; u < NB * 2 * 64; u += G, ++i) {
                int bg, qt;
                if (G == 256) { bg = vcu >> 3; const int sub = vcu & 7; qt = (i & 1) ? 8 * i + 7 - sub : 8 * i + sub; } else { bg = u & 31; qt = u >> 5; }
                nsa_unit(lds, P0, (const bf16*)(ws + WS_KCMP), (const bf16*)(ws + WS_VCMP), H, bg >> 1, bg & 1, qt, tid, lane, wave);
            } }
            { PHASE_IDS
            const bf16* P0 = (const bf16*)(ws + WS_P0);
            for (int u = vcu, i = 0; u < NB * 128; u += G, ++i) {
                int b, qt;
                if (G == 256) { b = vcu >> 4; const int sub = vcu & 15; qt = (i & 1) ? 16 * i + 15 - sub : 16 * i + sub; } else { b = u & 15; qt = u >> 4; }
                dsa_unit(lds, P0, (const unsigned short*)(ws + WS_SEL), H, b, qt, tid, lane, wave);
            } }
            SEAM(base + 5);
        }
        if (L == 1 && IN(base + 3)) {
            PHASE_IDS
            pg8::Gemm g{H, (const bf16*)(ws + WS_ODIN), MTOK, OD_INP, DM};
            pg8::StaticOrder S; S.init(MTOK, OD_INP, G, bx);
            pg8::EpiBf16PS E{(bf16*)(ws + WS_P1), OD_INP, 1.f / (pg8::F8S_W * pg8::F8S_H)};
            pg8::gemm_phase<pg8::EpiBf16PS, pg8::StaticOrder, true, true, true>(lds, g, S, E, tid);
            SEAM(base + 3);
        }
        if (L == 1 && IN(base + 4)) {
            PHASE_IDS
            const bf16* P1 = (const bf16*)(ws + WS_P1);
            odd_prep_rows(P1, args.in[14], args.in[15], (const float*)(ws + WS_ROPE), (bf16*)(ws + WS_CQN), (bf16*)(ws + WS_CKVN), (bf16*)(ws + WS_KR), gw, NGW, lane);
            SEAM(base + 4);
        }
        if (L == 1 && IN(base + 5)) {
            PHASE_IDS
            { pg8::Gemm g{(const bf16*)(ws + WS_CQN), (const bf16*)(ws + WS_WUQ), MTOK, 768, 256};
              pg8::StaticOrder S; S.init(MTOK, 768, G, bx);
              pg8::EpiBf16P E{(bf16*)(ws + WS_QMLA), 768};
              pg8::gemm_phase<pg8::EpiBf16P, pg8::StaticOrder, true, true>(lds, g, S, E, tid); }
            __syncthreads();
            { pg8::Gemm g{(const bf16*)(ws + WS_CKVN), (const bf16*)(ws + WS_WUKV), MTOK, 1024, 256};
              pg8::StaticOrder S; S.init(MTOK, 1024, G, bx);
              pg8::EpiBf16P E{(bf16*)(ws + WS_KVMLA), 1024};
              pg8::gemm_phase<pg8::EpiBf16P, pg8::StaticOrder, true, true>(lds, g, S, E, tid); }
            SEAM(base + 5);
        }
        if (L == 1 && IN(base + 7)) {
            { PHASE_IDS
            build_bias_tables(lds, args.in[2], tid);
            __syncthreads();
            for (int u = vcu, i = 0; u < NB * 8 * 16; u += G, ++i) {
                int bh, qt;
                if (G == 256) { bh = vcu >> 1; const int sub = vcu & 1; qt = (i & 1) ? 2 * i + 1 - sub : 2 * i + sub; } else { bh = u & 127; qt = u >> 7; }
                mla_unit(lds, (const bf16*)(ws + WS_QMLA), (const bf16*)(ws + WS_KVMLA), (const bf16*)(ws + WS_KR), (const float*)(ws + WS_ROPE), H, bh >> 3, bh & 7, qt, tid, lane, wave);
            } }
            { PHASE_IDS
            for (int u = vcu, i = 0; u < NB * 4 * 16; u += G, ++i) {
                int bh, qt;
                if (G == 256) { bh = vcu >> 2; const int sub = vcu & 3; qt = (i & 1) ? 4 * i + 3 - sub : 4 * i + sub; } else { bh = u & 63; qt = u >> 6; }
                diff_unit(lds, (const bf16*)(ws + WS_P1), args.in[18], args.in[19], H, bh >> 2, bh & 3, qt, tid, lane, wave);
            } }
            SEAM(base + 7);
        }
        if (IN(base + 8)) {
            PHASE_IDS
            pg8::Gemm g{H, (const bf16*)(ws + (L == 0 ? WS_EVOUT : WS_ODOUT)), MTOK, DM, DM};
            pg8::StaticOrder S; S.init(MTOK, DM, G, bx);
            pg8::EpiBf16P E{Y, DM};
            pg8::gemm_phase<pg8::EpiBf16P, pg8::StaticOrder, true, true>(lds, g, S, E, tid);
            SEAM(base + 8);
        }
        if (IN(base + 9)) {
            PHASE_IDS
            rows_norm_phase(nullptr, nullptr, Y, 1.0f, gpost + DM, nullptr, H, MTOK, gw, NGW, lane, false, 1.f, XB, XB, RS);
            SEAM(base + 9);
        }
        if (IN(base + 10)) {
            PHASE_IDS
            pg8::Gemm g{XB, (const bf16*)(ws + WS_XWQ) + (size_t)L * 512 * DM, MTOK, 512, DM};
            pg8::StaticOrder S; S.init(MTOK, 512, G, bx);
            pg8::EpiBf16PR E{(bf16*)(ws + WS_XQ), 512, RS};
            pg8::gemm_phase<pg8::EpiBf16PR, pg8::StaticOrder, true, true>(lds, g, S, E, tid);
            SEAM(base + 10);
        }
        if (IN(base + 11)) {
            PHASE_IDS
            for (int u = vcu; u < NB * 4 * 16; u += G) {
                const int qt = u & 15, h = (u >> 4) & 3, b = u >> 6;
                xattn_unit(lds, (const bf16*)(ws + WS_XQ), (const bf16*)(ws + WS_KVM) + (size_t)L * MROWS * DM, H, b, h, qt, tid, lane, wave);
            }
            SEAM(base + 11);
        }
        if (IN(base + 12)) {
            PHASE_IDS
            pg8::Gemm g{H, (const bf16*)(ws + WS_XWO) + (size_t)L * DM * 512, MTOK, DM, 512};
            pg8::StaticOrder S; S.init(MTOK, DM, G, bx);
            pg8::EpiBf16P E{Y, DM};
            pg8::gemm_phase<pg8::EpiBf16P, pg8::StaticOrder, true, true>(lds, g, S, E, tid);
            SEAM(base + 12);
        }
        if (IN(base + 13)) {
            PHASE_IDS
            rows_norm_phase(nullptr, nullptr, Y, 1.0f, gpost + 2 * DM, gpre + 3 * DM, H, MTOK, gw, NGW, lane, L * 2 + 1 >= F8_FROM, 1.f, XB, XB);
            SEAM(base + 13);
        }
        if (IN(base + 14)) {
            PHASE_IDS
            pg8::StaticOrder S; S.init(MTOK, 5632, G, bx);
            if constexpr (L * 2 + 1 >= F8_FROM) {
                pg8::Gemm g{H, (const bf16*)(ws + WS_WGU) + (size_t)(L * 2 + 1) * 5632 * DM, MTOK, 5632, DM};
                pg8::EpiSwiGLU8 E{ws + WS_HID, DFF};
                pg8::gemm_phase<pg8::EpiSwiGLU8, pg8::StaticOrder, true, true, true>(lds, g, S, E, tid);
            } else {
                pg8::Gemm g{H, (const bf16*)(ws + WS_WGU) + (size_t)(L * 2 + 1) * 5632 * DM, MTOK, 5632, DM};
                pg8::EpiSwiGLU E{(bf16*)(ws + WS_HID), DFF};
                pg8::gemm_phase<pg8::EpiSwiGLU, pg8::StaticOrder, true, true>(lds, g, S, E, tid);
            }
            SEAM(base + 14);
        }
        if (IN(base + 15)) {
            PHASE_IDS
            pg8::StaticOrder S; S.init(MTOK, DM, G, bx);
            pg8::EpiBf16P E{Y, DM};
            if constexpr (L * 2 + 1 >= F8_FROM) {
                pg8::Gemm g{(const bf16*)(ws + WS_HID), (const bf16*)(ws + WS_WD) + (size_t)(L * 2 + 1) * DM * DFF, MTOK, DM, DFF};
                pg8::gemm_phase<pg8::EpiBf16P, pg8::StaticOrder, true, true, true>(lds, g, S, E, tid);
            } else {
                pg8::Gemm g{(const bf16*)(ws + WS_HID), (const bf16*)(ws + WS_WD) + (size_t)(L * 2 + 1) * DM * DFF, MTOK, DM, DFF};
                pg8::gemm_phase<pg8::EpiBf16P, pg8::StaticOrder, true, true>(lds, g, S, E, tid);
            }
            SEAM(base + 15);
        }
        if (IN(base + 16)) {
            PHASE_IDS
            rows_norm_phase(nullptr, L == 0 ? nullptr : xout, Y, 0.5f, gpost + 3 * DM, L == 0 ? norm_pre + 4 * DM : nullptr, H, MTOK, gw, NGW, lane, L * 2 + 2 >= F8_FROM, L * 2 + 1 >= F8_FROM ? 1.f / (pg8::F8S_W * pg8::F8S_HID) : 1.f, XB, L == 0 ? XB : nullptr);
            SEAM(base + 16);
        }
}


__global__ void __launch_bounds__(NWAVES * 64, 2) fwd_kernel(Args args) {
    extern __shared__ __attribute__((aligned(16))) unsigned char lds_raw[];
    LAS unsigned char* lds = (LAS unsigned char*)lds_raw;
    volatile LAS unsigned* MISC = (volatile LAS unsigned*)(lds + MISC_OFF);
    const int tid0 = threadIdx.x, wave = __builtin_amdgcn_readfirstlane(tid0 >> 6);
    const int G = gridDim.x, bx0 = blockIdx.x;
    const int vcu0 = (G % 8 == 0) ? (bx0 % 8) * (G / 8) + bx0 / 8 : bx0;
    unsigned* ctl = (unsigned*)(args.ws + WS_CTL);
    for (int u = tid0; u < (LDS_BYTES - LDSCTL_OFF) / 4; u += NWAVES * 64) ((LAS unsigned*)(lds + LDSCTL_OFF))[u] = 0u;
    __syncthreads();
    XcdBarrier bar = xcd_barrier_post(ctl + CW_BAR + args.li * XCD_BAR_WORDS, MISC + 8);
    const int lo = args.ph_lo, hi = args.ph_hi, stop = args.stop;

    const float* x_in = args.in[0]; const float* mem = args.in[1];
    const float* norm_pre = args.in[3]; const float* norm_post = args.in[4]; const float* mem_norm = args.in[5];
    float* xout = args.out;

    if (IN(PH_PRO)) {
            PHASE_IDS
        LAS float* scr = (LAS float*)(lds + wave * 16384);
        constexpr int I_GU = (DM / 64) * (DFF / 32), I_D = (DFF / 64) * (DM / 32);
        constexpr int I_EVIN = (DM / 64) * (EV_IN / 32), I_SQ = (DM / 64) * (DM / 32), I_ODIN = (DM / 64) * (OD_IN / 32);
        constexpr int I_UQ = (256 / 64) * (768 / 32), I_UKV = (128 / 64) * (1024 / 32), I_XQ = (DM / 64) * (512 / 32), I_XO = (512 / 64) * (DM / 32);
        constexpr int I_CW = (2048 / 64) * (64 / 32);
        constexpr int NITEMS = 8 * I_GU + 4 * I_D + I_EVIN + I_SQ + I_ODIN + I_SQ + I_UQ + I_UKV + 2 * I_XQ + 2 * I_SQ + 2 * I_XO + 2 * I_CW;
        for (int it = gw; it < NITEMS; it += NGW) {
            int r = it;
            if (r < 8 * I_GU) { const int mat = r / I_GU, rr = r % I_GU, which = mat & 1, ij = mat >> 1, nblk = DFF / 32, k0 = (rr / nblk) * 64, n0 = (rr % nblk) * 32;
                if (ij >= F8_FROM) tr_item8((which ? args.in[7] : args.in[6]) + (size_t)ij * DM * DFF, DFF, ws + WS_WGU + (size_t)ij * 5632 * DM * 2, DM, (n0 / 128) * 256 + which * 128 + (n0 % 128), scr, k0, n0, lane);
                else tr_item((which ? args.in[7] : args.in[6]) + (size_t)ij * DM * DFF, DFF, (bf16*)(ws + WS_WGU) + (size_t)ij * 5632 * DM, DM, (n0 / 128) * 256 + which * 128 + (n0 % 128), scr, k0, n0, lane, norm_pre);
                continue; } r -= 8 * I_GU;
            if (r < 4 * I_D) { const int mat = r / I_D, rr = r % I_D, nblk = DM / 32, k0 = (rr / nblk) * 64, n0 = (rr % nblk) * 32;
                if (mat >= F8_FROM) tr_item8(args.in[8] + (size_t)mat * DFF * DM, DM, ws + WS_WD + (size_t)mat * DM * DFF * 2, DFF, n0, scr, k0, n0, lane);
                else tr_item(args.in[8] + (size_t)mat * DFF * DM, DM, (bf16*)(ws + WS_WD) + (size_t)mat * DM * DFF, DFF, n0, scr, k0, n0, lane);
                continue; } r -= 4 * I_D;
            if (r < I_EVIN) { const int nblk = EV_IN / 32, k0 = (r / nblk) * 64, n0 = (r % nblk) * 32; tr_item(args.in[9], EV_IN, (bf16*)(ws + WS_EVIN), DM, n0, scr, k0, n0, lane, norm_pre + DM); continue; } r -= I_EVIN;
            if (r < I_SQ) { const int nblk = DM / 32, k0 = (r / nblk) * 64, n0 = (r % nblk) * 32; tr_item(args.in[12], DM, (bf16*)(ws + WS_EVOUT), DM, n0, scr, k0, n0, lane); continue; } r -= I_SQ;
            if (r < I_ODIN) { const int nblk = OD_IN / 32, k0 = (r / nblk) * 64, n0 = (r % nblk) * 32; tr_item8(args.in[13], OD_IN, ws + WS_ODIN, DM, n0, scr, k0, n0, lane); continue; } r -= I_ODIN;
            if (r < I_SQ) { const int nblk = DM / 32, k0 = (r / nblk) * 64, n0 = (r % nblk) * 32; tr_item(args.in[20], DM, (bf16*)(ws + WS_ODOUT), DM, n0, scr, k0, n0, lane); continue; } r -= I_SQ;
            if (r < I_UQ) { const int nblk = 768 / 32, k0 = (r / nblk) * 64, n0 = (r % nblk) * 32; tr_item(args.in[16], 768, (bf16*)(ws + WS_WUQ), 256, n0, scr, k0, n0, lane); continue; } r -= I_UQ;
            if (r < I_UKV) { const int nblk = 1024 / 32, k0 = (r / nblk) * 64, n0 = (r % nblk) * 32; tr_item(args.in[17], 1024, (bf16*)(ws + WS_WUKV), 256, n0, scr, k0, n0, lane); continue; } r -= I_UKV;
            if (r < 2 * I_XQ) { const int mat = r / I_XQ, rr = r % I_XQ, nblk = 512 / 32, k0 = (rr / nblk) * 64, n0 = (rr % nblk) * 32;
                tr_item(args.in[21] + (size_t)mat * DM * 512, 512, (bf16*)(ws + WS_XWQ) + (size_t)mat * 512 * DM, DM, n0, scr, k0, n0, lane, norm_pre + (size_t)(mat * 4 + 2) * DM); continue; } r -= 2 * I_XQ;
            if (r < 2 * I_SQ) { const int mat = r / I_SQ, rr = r % I_SQ, nblk = DM / 32, k0 = (rr / nblk) * 64, n0 = (rr % nblk) * 32;
                tr_item(args.in[22] + (size_t)mat * DM * DM, DM, (bf16*)(ws + WS_XWKV) + (size_t)mat * DM * DM, DM, n0, scr, k0, n0, lane); continue; } r -= 2 * I_SQ;
            if (r < 2 * I_XO) { const int mat = r / I_XO, rr = r % I_XO, nblk = DM / 32, k0 = (rr / nblk) * 64, n0 = (rr % nblk) * 32;
                tr_item(args.in[23] + (size_t)mat * 512 * DM, DM, (bf16*)(ws + WS_XWO) + (size_t)mat * DM * 512, 512, n0, scr, k0, n0, lane); continue; } r -= 2 * I_XO;
            { const int mat = r / I_CW, rr = r % I_CW, nblk = 64 / 32, k0 = (rr / nblk) * 64, n0 = (rr % nblk) * 32;
                tr_item(args.in[11] + (size_t)mat * 2048 * 64, 64, (bf16*)(ws + WS_CWT) + (size_t)mat * 64 * 2048, 2048, n0, scr, k0, n0, lane); }
        }
        { const int gt = vcu * (NWAVES * 64) + tid, NGT = G * NWAVES * 64; const v4u z = (v4u){0u, 0u, 0u, 0u};
          for (int i = gt; i < (EV_INP - EV_IN) * DM / 8; i += NGT) ((GAS v4u*)((bf16*)(ws + WS_EVIN) + (size_t)EV_IN * DM))[i] = z;
          for (int i = gt; i < (OD_INP - OD_IN) * DM / 16; i += NGT) ((GAS v4u*)(ws + WS_ODIN + (size_t)OD_IN * DM))[i] = z;
          for (int i = gt; i < 1024 * 16; i += NGT) ((GAS v4u*)((bf16*)(ws + WS_WUKV) + (size_t)(i >> 4) * 256 + 128))[i & 15] = z; }
        if (gw < 128) { const int c = gw >> 6, e = gw & 63; const float* pe = args.in[10] + (size_t)c * 2048; const float* cw = args.in[11] + (size_t)c * 2048 * 64 + e; float a = 0.f;
            for (int k = lane; k < 2048; k += 64) a += pe[k] * cw[(size_t)k * 64];
            a = wave_sum(a); if (lane == 0) ((float*)(ws + WS_CBIAS))[gw] = a; }
        rope_table_phase((float*)(ws + WS_ROPE), vcu * (NWAVES * 64) + tid, G * NWAVES * 64);
        rows_norm_phase(x_in, nullptr, nullptr, 0.f, nullptr, nullptr, H, MTOK, gw, NGW, lane, false, 1.f, nullptr, XB, RS);
        rows_norm_phase(mem, nullptr, nullptr, 0.f, nullptr, mem_norm, (bf16*)(ws + WS_MN), MROWS, gw, NGW, lane);
        rows_norm_phase(mem, nullptr, nullptr, 0.f, nullptr, mem_norm + DM, (bf16*)(ws + WS_MN) + (size_t)MROWS * DM, MROWS, gw, NGW, lane);
        SEAM(PH_PRO);
    }
    if (IN(PH_MEMKV)) {
            PHASE_IDS
#pragma unroll 1
        for (int i = 0; i < 2; ++i) {
            pg8::Gemm g{(const bf16*)(ws + WS_MN) + (size_t)i * MROWS * DM, (const bf16*)(ws + WS_XWKV) + (size_t)i * DM * DM, MROWS, DM, DM};
            pg8::StaticOrder S; S.init(MROWS, DM, G, (bx + 128 * i) % G);
            pg8::EpiBf16P E{(bf16*)(ws + WS_KVM) + (size_t)i * MROWS * DM, DM};
            pg8::gemm_phase<pg8::EpiBf16P, pg8::StaticOrder, true, true>(lds, g, S, E, tid);
            __syncthreads();
        }
        SEAM(PH_MEMKV);
    }
    layer_phases<0>(args, lds, bar, wave, G, bx0, vcu0, lo, hi, stop);
    layer_phases<1>(args, lds, bar, wave, G, bx0, vcu0, lo, hi, stop);
#undef IN
#undef SEAM
}

#ifndef MK_MODE
#define MK_MODE 1
#endif
#ifndef MK_STOP
#define MK_STOP NPHASE
#endif
extern "C" void kernel_launch(void* const* d_in, const int* in_sizes, int n_in, void* d_out, int out_size, void* d_ws, size_t ws_size, hipStream_t stream) {
    static int grid = 0;
    if (grid == 0) {
        if (n_in != 24 || out_size != MTOK * DM || ws_size < WS_END) { fprintf(stderr, "kernel_launch: unexpected shapes: n_in %d out %d ws %zu\n", n_in, out_size, ws_size); grid = -1; return; }
        int dev = 0, cus = 0, per_cu = 0;
        if (hipGetDevice(&dev) != hipSuccess || hipDeviceGetAttribute(&cus, hipDeviceAttributeMultiprocessorCount, dev) != hipSuccess) { grid = -1; return; }
        if (hipFuncSetAttribute((const void*)fwd_kernel, hipFuncAttributeMaxDynamicSharedMemorySize, LDS_BYTES) != hipSuccess) { fprintf(stderr, "kernel_launch: hipFuncSetAttribute failed\n"); grid = -1; return; }
        if (hipOccupancyMaxActiveBlocksPerMultiprocessor(&per_cu, (const void*)fwd_kernel, NWAVES * 64, LDS_BYTES) != hipSuccess || per_cu < 1)
            fprintf(stderr, "kernel_launch: occupancy query reports %d workgroups per CU\n", per_cu);
        (void)hipGetLastError();
        grid = cus;
    }
    if (grid < 0) return;
    if (hipMemsetAsync((char*)d_ws + WS_CTL, 0, CTL_ZERO_BYTES, stream) != hipSuccess) return;
    Args a{};
    for (int i = 0; i < 24; ++i) a.in[i] = (const float*)d_in[i];
    a.out = (float*)d_out; a.ws = (unsigned char*)d_ws; a.stop = MK_STOP;
#if MK_MODE == 1
    a.ph_lo = 0; a.ph_hi = NPHASE; a.li = 0;
    hipLaunchKernelGGL(fwd_kernel, dim3(grid), dim3(NWAVES * 64), LDS_BYTES, stream, a);
#else
    for (int p = 0; p < NPHASE && p < MK_STOP; ++p) {
        a.ph_lo = p; a.ph_hi = p + 1; a.li = 0;
        hipLaunchKernelGGL(fwd_kernel, dim3(grid), dim3(NWAVES * 64), LDS_BYTES, stream, a);
#ifdef MK_REP
        { const int k = p < PH_L0 ? -1 : (p - PH_L0) % PPL, L = p < PH_L0 ? -1 : (p - PH_L0) / PPL; (void)k; (void)L;
          if (MK_REP) { a.li = 1; hipLaunchKernelGGL(fwd_kernel, dim3(grid), dim3(NWAVES * 64), LDS_BYTES, stream, a); a.li = 0; } }
#endif
    }
#endif
}
```
